# Optimizing an MI355X kernel written in HIP

```python
import jax, jax.numpy as jnp
from jax import lax
import numpy as np

D_MODEL = 1024
BATCH = 4
SEQ = 4096
DEPTH = 2
DEC_BATCH = 128
DEC_SEQ = 8
PAST_LEN = 16384
PAGE_SIZE = 128

N_MIXERS = 2
N_ATTN_LAYERS = (DEPTH + 1) // 2
N_RET_LAYERS = DEPTH // 2
PLE_DIM = 256
ROPE_THETA = 10000.0
NORM_EPS = 1e-6
NEG_INF = -1e30
WINDOW = 128
ATTN_HEADS = 16
ATTN_KV_HEADS = 4
ATTN_HEAD_DIM = 64
ATTN_GROUP = ATTN_HEADS // ATTN_KV_HEADS
ATTN_Q_DIM = ATTN_HEADS * ATTN_HEAD_DIM
ATTN_KV_DIM = ATTN_KV_HEADS * ATTN_HEAD_DIM
ATTN_IN_DIM = 2 * ATTN_Q_DIM + 2 * ATTN_KV_DIM
RET_HEADS = 4
RET_QK_DIM = D_MODEL // RET_HEADS
RET_V_DIM = 2 * RET_QK_DIM
RET_VW = RET_HEADS * RET_V_DIM
RET_IN_DIM = 2 * D_MODEL + 2 * RET_VW
RET_CHUNK = 128

kernel_name = 'hybrid_swa_sink_retention_step'


def rms_norm(x, g):
    xf = x.astype(jnp.float32)
    y = xf * lax.rsqrt(jnp.mean(xf * xf, axis=-1, keepdims=True) + NORM_EPS)
    return (y * g.astype(jnp.float32)).astype(x.dtype)


def rope(x, pos):
    half = x.shape[-1] // 2
    inv = ROPE_THETA ** (-jnp.arange(half, dtype=jnp.float32) / half)
    ang = pos.astype(jnp.float32)[:, None] * inv[None, :]
    cos = jnp.cos(ang)[None, :, None, :]
    sin = jnp.sin(ang)[None, :, None, :]
    xf = x.astype(jnp.float32)
    x1, x2 = xf[..., :half], xf[..., half:]
    return jnp.concatenate([x1 * cos - x2 * sin, x2 * cos + x1 * sin], axis=-1).astype(x.dtype)


def sink_softmax(s, sink, mask):
    s = jnp.where(mask, s, NEG_INF)
    m = jnp.maximum(jnp.max(s, axis=-1, keepdims=True), sink)
    p = jnp.exp(s - m)
    return p / (jnp.sum(p, axis=-1, keepdims=True) + jnp.exp(sink - m))


def swa_project(h, w_in, pos):
    B, T, _ = h.shape
    z = h @ w_in
    q, k, v, g = jnp.split(z, [ATTN_Q_DIM, ATTN_Q_DIM + ATTN_KV_DIM, ATTN_Q_DIM + 2 * ATTN_KV_DIM], axis=-1)
    q = rope(q.reshape(B, T, ATTN_HEADS, ATTN_HEAD_DIM), pos)
    k = rope(k.reshape(B, T, ATTN_KV_HEADS, ATTN_HEAD_DIM), pos)
    v = v.reshape(B, T, ATTN_KV_HEADS, ATTN_HEAD_DIM)
    return q, k, v, g


def swa_prompt(h, w_in, sinks, w_out):
    B, T, _ = h.shape
    nb = T // WINDOW
    q, k, v, g = swa_project(h, w_in, jnp.arange(T))
    qb = q.reshape(B, nb, WINDOW, ATTN_KV_HEADS, ATTN_GROUP, ATTN_HEAD_DIM)
    kb = k.reshape(B, nb, WINDOW, ATTN_KV_HEADS, ATTN_HEAD_DIM)
    vb = v.reshape(B, nb, WINDOW, ATTN_KV_HEADS, ATTN_HEAD_DIM)
    kp = jnp.concatenate([jnp.zeros_like(kb[:, :1]), kb], axis=1)
    vp = jnp.concatenate([jnp.zeros_like(vb[:, :1]), vb], axis=1)
    k_band = jnp.concatenate([kp[:, :-1], kp[:, 1:]], axis=2)
    v_band = jnp.concatenate([vp[:, :-1], vp[:, 1:]], axis=2)
    s = jnp.einsum('bnqkgd,bnskd->bnkgqs', qb, k_band, preferred_element_type=jnp.float32) * (ATTN_HEAD_DIM ** -0.5)
    qi = jnp.arange(WINDOW)[:, None] + WINDOW
    kj = jnp.arange(2 * WINDOW)[None, :]
    diff = qi - kj
    band = (diff >= 0) & (diff < WINDOW)
    not_before_start = (jnp.arange(nb)[:, None, None] > 0) | (kj[None] >= WINDOW)
    mask = (band[None] & not_before_start)[None, :, None, None]
    sink = sinks.astype(jnp.float32).reshape(ATTN_KV_HEADS, ATTN_GROUP, 1, 1)
    p = sink_softmax(s, sink, mask).astype(v.dtype)
    o = jnp.einsum('bnkgqs,bnskd->bnqkgd', p, v_band).reshape(B, T, ATTN_Q_DIM)
    y = (o * jax.nn.silu(g)) @ w_out
    return y, k[:, T - WINDOW:], v[:, T - WINDOW:]


def swa_sample(h, k_buf, v_buf, w_in, sinks, w_out):
    B, L, _ = h.shape
    pos = PAST_LEN + jnp.arange(L)
    q, k, v, g = swa_project(h, w_in, pos)
    kc = jnp.concatenate([k_buf, k], axis=1)
    vc = jnp.concatenate([v_buf, v], axis=1)
    kpos = jnp.concatenate([PAST_LEN - WINDOW + jnp.arange(WINDOW), pos])
    diff = pos[:, None] - kpos[None, :]
    mask = ((diff >= 0) & (diff < WINDOW))[None, None, None]
    qg = q.reshape(B, L, ATTN_KV_HEADS, ATTN_GROUP, ATTN_HEAD_DIM)
    s = jnp.einsum('bqkgd,bskd->bkgqs', qg, kc, preferred_element_type=jnp.float32) * (ATTN_HEAD_DIM ** -0.5)
    sink = sinks.astype(jnp.float32).reshape(ATTN_KV_HEADS, ATTN_GROUP, 1, 1)
    p = sink_softmax(s, sink, mask).astype(vc.dtype)
    o = jnp.einsum('bkgqs,bskd->bqkgd', p, vc).reshape(B, L, ATTN_Q_DIM)
    y = (o * jax.nn.silu(g)) @ w_out
    return y, kc[:, -WINDOW:], vc[:, -WINDOW:]


def ret_log_gamma():
    return jnp.log1p(-(2.0 ** (-5.0 - jnp.arange(RET_HEADS, dtype=jnp.float32))))


def ret_project(h, w_in, pos):
    B, T, _ = h.shape
    z = h @ w_in
    q, k, v, g = jnp.split(z, [D_MODEL, 2 * D_MODEL, 2 * D_MODEL + RET_VW], axis=-1)
    q = rope(q.reshape(B, T, RET_HEADS, RET_QK_DIM), pos)
    k = rope(k.reshape(B, T, RET_HEADS, RET_QK_DIM), pos) * (RET_QK_DIM ** -0.5)
    v = v.reshape(B, T, RET_HEADS, RET_V_DIM)
    return q, k, v, g


def retention_chunk(state, q, k, v, lg):
    L = q.shape[1]
    q = q.astype(jnp.float32)
    k = k.astype(jnp.float32)
    v = v.astype(jnp.float32)
    idx = jnp.arange(L, dtype=jnp.float32)
    diff = idx[:, None] - idx[None, :]
    dmask = jnp.where(diff[None] >= 0, jnp.exp(jnp.maximum(diff, 0.0)[None] * lg[:, None, None]), 0.0)
    a = jnp.einsum('bqhd,bshd->bhqs', q, k) * dmask[None]
    inner = jnp.einsum('bhqs,bshe->bqhe', a, v)
    cross = jnp.einsum('bqhd,bhde->bqhe', q, state) * jnp.exp((idx + 1.0)[:, None] * lg[None])[None, :, :, None]
    k_dec = k * jnp.exp((L - 1.0 - idx)[:, None] * lg[None])[None, :, :, None]
    new_state = jnp.exp(L * lg)[None, :, None, None] * state + jnp.einsum('bshd,bshe->bhde', k_dec, v)
    return new_state, inner + cross


def ret_output(o, g, w_out, dtype):
    B, T = o.shape[0], o.shape[1]
    mu = jnp.mean(o, axis=-1, keepdims=True)
    var = jnp.mean(jnp.square(o - mu), axis=-1, keepdims=True)
    on = ((o - mu) * lax.rsqrt(var + NORM_EPS)).reshape(B, T, RET_VW).astype(dtype)
    return (on * jax.nn.silu(g)) @ w_out


def ret_prompt(h, w_in, w_out):
    B, T, _ = h.shape
    nc = T // RET_CHUNK
    q, k, v, g = ret_project(h, w_in, jnp.arange(T))
    lg = ret_log_gamma()
    to_chunks = lambda a: jnp.moveaxis(a.reshape(B, nc, RET_CHUNK, a.shape[2], a.shape[3]), 1, 0)

    def step(state, qkv):
        qc, kc, vc = qkv
        return retention_chunk(state, qc, kc, vc, lg)

    state0 = jnp.zeros((B, RET_HEADS, RET_QK_DIM, RET_V_DIM), jnp.float32)
    state, o = lax.scan(step, state0, (to_chunks(q), to_chunks(k), to_chunks(v)))
    o = jnp.moveaxis(o, 0, 1).reshape(B, T, RET_HEADS, RET_V_DIM)
    return ret_output(o, g, w_out, h.dtype), state


def ret_sample(h, state, w_in, w_out):
    L = h.shape[1]
    q, k, v, g = ret_project(h, w_in, PAST_LEN + jnp.arange(L))
    new_state, o = retention_chunk(state.astype(jnp.float32), q, k, v, ret_log_gamma())
    return ret_output(o, g, w_out, h.dtype), new_state.astype(state.dtype)


def residual_update(x, y, p, g_post, w_ple, w_gate):
    x = x + rms_norm(y, g_post)
    return x + jax.nn.sigmoid(x @ w_gate) * (p @ w_ple)


def setup_inputs(seed: int = 0) -> dict:
    key = jax.random.key(seed)
    ks = jax.random.split(key, 18)
    f32 = jnp.float32
    nrm = lambda k, shape, scale: jax.random.normal(k, shape, f32) * scale
    return {
        'x_prompt': nrm(ks[0], (BATCH, SEQ, D_MODEL), 1.0),
        'x_sample': nrm(ks[1], (DEC_BATCH, DEC_SEQ, D_MODEL), 1.0),
        'cache_k_win': nrm(ks[2], (N_ATTN_LAYERS, DEC_BATCH, WINDOW, ATTN_KV_HEADS, ATTN_HEAD_DIM), 1.0),
        'cache_v_win': nrm(ks[3], (N_ATTN_LAYERS, DEC_BATCH, WINDOW, ATTN_KV_HEADS, ATTN_HEAD_DIM), 1.0),
        'state_ret': nrm(ks[4], (N_RET_LAYERS, DEC_BATCH, RET_HEADS, RET_QK_DIM, RET_V_DIM), 0.1),
        'p_prompt': nrm(ks[5], (DEPTH, BATCH, SEQ, PLE_DIM), 1.0),
        'p_sample': nrm(ks[6], (DEPTH, DEC_BATCH, DEC_SEQ, PLE_DIM), 1.0),
        'pre_norm': 1.0 + nrm(ks[7], (DEPTH, D_MODEL), 0.1),
        'post_norm': 1.0 + nrm(ks[8], (DEPTH, D_MODEL), 0.1),
        'w_in_attn': nrm(ks[9], (N_ATTN_LAYERS, D_MODEL, ATTN_IN_DIM), D_MODEL ** -0.5),
        'attn_sinks': nrm(ks[10], (N_ATTN_LAYERS, ATTN_HEADS), 0.5),
        'w_out_attn': nrm(ks[11], (N_ATTN_LAYERS, ATTN_Q_DIM, D_MODEL), ATTN_Q_DIM ** -0.5),
        'w_in_ret': nrm(ks[12], (N_RET_LAYERS, D_MODEL, RET_IN_DIM), D_MODEL ** -0.5),
        'w_out_ret': nrm(ks[13], (N_RET_LAYERS, RET_VW, D_MODEL), RET_VW ** -0.5),
        'w_ple': nrm(ks[14], (DEPTH, PLE_DIM, D_MODEL), PLE_DIM ** -0.5),
        'w_ple_gate': nrm(ks[15], (DEPTH, D_MODEL, D_MODEL), D_MODEL ** -0.5),
    }


def reference(x_prompt, x_sample, cache_k_win, cache_v_win, state_ret, p_prompt, p_sample,
              pre_norm, post_norm, w_in_attn, attn_sinks, w_out_attn, w_in_ret, w_out_ret,
              w_ple, w_ple_gate):
    xp, xs = x_prompt, x_sample
    kwp, vwp, kws, vws, srp, srs = [], [], [], [], [], []
    for i in range(DEPTH):
        j = i // N_MIXERS
        hp = rms_norm(xp, pre_norm[i])
        hs = rms_norm(xs, pre_norm[i])
        if i % N_MIXERS == 0:
            yp, kp, vp = swa_prompt(hp, w_in_attn[j], attn_sinks[j], w_out_attn[j])
            ys, kn, vn = swa_sample(hs, cache_k_win[j], cache_v_win[j], w_in_attn[j], attn_sinks[j], w_out_attn[j])
            kwp.append(kp); vwp.append(vp); kws.append(kn); vws.append(vn)
        else:
            yp, sp = ret_prompt(hp, w_in_ret[j], w_out_ret[j])
            ys, sn = ret_sample(hs, state_ret[j], w_in_ret[j], w_out_ret[j])
            srp.append(sp.astype(state_ret.dtype)); srs.append(sn)
        xp = residual_update(xp, yp, p_prompt[i], post_norm[i], w_ple[i], w_ple_gate[i])
        xs = residual_update(xs, ys, p_sample[i], post_norm[i], w_ple[i], w_ple_gate[i])
    k_win_prompt = jnp.stack(kwp)
    v_win_prompt = jnp.stack(vwp)
    k_win_sample = jnp.stack(kws)
    v_win_sample = jnp.stack(vws)
    ret_state_prompt = jnp.stack(srp)
    ret_state_sample = jnp.stack(srs)
    return (xp, xs, k_win_prompt, v_win_prompt, k_win_sample, v_win_sample, ret_state_prompt, ret_state_sample)
```

```cpp
#include <hip/hip_runtime.h>
#include <hip/hip_cooperative_groups.h>
#include <cstdio>
#include <cstdint>
namespace cg = cooperative_groups;

#define LAS __attribute__((address_space(3)))
typedef unsigned short bf16_t;
typedef short bf16x8 __attribute__((ext_vector_type(8)));
typedef float f32x4 __attribute__((ext_vector_type(4)));
typedef float f32x2 __attribute__((ext_vector_type(2)));
typedef unsigned u32x2 __attribute__((ext_vector_type(2)));
typedef unsigned u32x4 __attribute__((ext_vector_type(4)));

constexpr int MP = 16384, MS = 1024, MT = MP + MS;
constexpr int NT = 512;
constexpr int LDS_BYTES = 140 * 1024;
constexpr float EPS = 1e-6f;

constexpr size_t OFF_YP = 0, OFF_YS = 16777216, OFF_KWP = 17825792, OFF_VWP = 17956864, OFF_KWS = 18087936, OFF_VWS = 22282240, OFF_RSP = 26476544, OFF_RSS = 28573696;

constexpr size_t al256(size_t x) { return (x + 255) & ~(size_t)255; }
constexpr size_t WS_WT_IN_ATTN = 0;
constexpr size_t WS_WT_OUT_ATTN = WS_WT_IN_ATTN + (size_t)2560 * 1024 * 2;
constexpr size_t WS_WT_IN_RET = WS_WT_OUT_ATTN + (size_t)1024 * 1024 * 2;
constexpr size_t WS_WT_OUT_RET = WS_WT_IN_RET + (size_t)6144 * 1024 * 2;
constexpr size_t WS_WT_GATE = WS_WT_OUT_RET + (size_t)1024 * 2048 * 2;
constexpr size_t WS_WT_PLE = WS_WT_GATE + (size_t)2 * 1024 * 1024 * 2;
constexpr size_t WS_TABA = WS_WT_PLE + (size_t)2 * 1024 * 256 * 2;
constexpr size_t WS_TABR = WS_TABA + (size_t)4104 * 32 * 8;
constexpr size_t WS_H = al256(WS_TABR + (size_t)4104 * 128 * 8);
constexpr size_t WS_PB = WS_H + (size_t)MT * 1024 * 2;
constexpr size_t WS_PLE = WS_PB + (size_t)2 * MT * 256 * 2;
constexpr size_t WS_Y = WS_PLE + (size_t)MT * 1024 * 4;
constexpr size_t WS_X1 = WS_Y + (size_t)MT * 1024 * 4;
constexpr size_t WS_X2 = WS_X1 + (size_t)MT * 1024 * 4;
constexpr size_t WS_OG = WS_X2 + (size_t)MT * 1024 * 4;
constexpr size_t WS_ZQ = WS_OG + (size_t)MT * 2048 * 2;
constexpr size_t WS_ZK = WS_ZQ + (size_t)MT * 1024 * 2;
constexpr size_t WS_ZG = WS_ZK + (size_t)MT * 1024 * 2;
constexpr size_t WS_VTP = WS_ZG + (size_t)MT * 2048 * 2;
constexpr size_t WS_VTS = WS_VTP + (size_t)16 * 512 * 4096 * 2;
constexpr size_t WS_ABUF = WS_VTS + (size_t)128 * 4 * 512 * 8 * 2;
constexpr size_t WS_KDT = WS_ABUF + (size_t)512 * 128 * 128 * 2;
constexpr size_t WS_ORET = WS_KDT + (size_t)512 * 256 * 128 * 2;
constexpr size_t WS_END = WS_ORET + (size_t)MT * 2048 * 4;

struct Params {
    const float *x_prompt, *x_sample, *cache_k, *cache_v, *state_ret, *p_prompt, *p_sample, *pre_norm, *post_norm, *w_in_attn, *sinks, *w_out_attn, *w_in_ret, *w_out_ret, *w_ple, *w_gate;
    float* out; unsigned char* ws;
};

__device__ __forceinline__ unsigned cvt_pk_bf16(float lo, float hi) { unsigned r; asm volatile("v_cvt_pk_bf16_f32 %0, %1, %2" : "=v"(r) : "v"(lo), "v"(hi)); return r; }
__device__ __forceinline__ u32x2 pk4(f32x4 v) { u32x2 w; w.x = cvt_pk_bf16(v[0], v[1]); w.y = cvt_pk_bf16(v[2], v[3]); return w; }
__device__ __forceinline__ float bf2f(bf16_t b) { return __uint_as_float(((unsigned)b) << 16); }
__device__ __forceinline__ float bflo(unsigned w) { return __uint_as_float(w << 16); }
__device__ __forceinline__ float bfhi(unsigned w) { return __uint_as_float(w & 0xffff0000u); }
__device__ __forceinline__ float silu_f(float x) { return x / (1.f + __expf(-x)); }
__device__ __forceinline__ float sigmoid_f(float x) { return 1.f / (1.f + __expf(-x)); }
__device__ __forceinline__ float wave_sum(float v) {
#pragma unroll
    for (int o = 32; o >= 1; o >>= 1) v += __shfl_xor(v, o, 64);
    return v;
}
__device__ __forceinline__ float ret_lg(int h) { return log1pf(-exp2f(-5.f - (float)h)); }

namespace pg8 {
constexpr int BM = 256, BK = 64, HALF = 128, HTB = HALF * BK * 2, STAGE_BYTES = 8 * HTB, NXCD = 8, WGM = 8;
__host__ __device__ __forceinline__ int lds_byte(int r, int c) { const int st = (r >> 4) * 2 + (c >> 5), rr = r & 15, cc = c & 31, ob = rr * 64 + cc * 2; return st * 1024 + (ob ^ (((ob >> 9) & 1) << 5)); }
__host__ __device__ __forceinline__ void stage_rc(int b, int& R, int& C) { const int st = b / 1024, sb = b % 1024, swz = sb ^ (((sb >> 9) & 1) << 5); R = (st >> 1) * 16 + swz / 64; C = (st & 1) * 32 + (swz % 64) / 2; }
struct Unit { int pm, pn; };
struct Gemm { const bf16_t* A; const bf16_t* Bt; int M, N, K; };
struct StaticOrder {
    int nM, nN, nwg, G, c;
    __host__ __device__ void init(int M, int N, int G_, int c_) { nM = M / BM; nN = N / BM; nwg = nM * nN; G = G_; c = c_; }
    __host__ __device__ bool next(int i, Unit& u) const {
        const long L = (long)i * G + c; if (L >= nwg) return false;
        int wgid = (int)L; { const int q = nwg / NXCD, r = nwg % NXCD, xcd = wgid % NXCD, off = wgid / NXCD; wgid = (xcd < r ? xcd * (q + 1) : r * (q + 1) + (xcd - r) * q) + off; }
        const int nig = WGM * nN, gid = wgid / nig, fm = gid * WGM, gsz = (nM - fm) < WGM ? (nM - fm) : WGM;
        u.pm = fm + ((wgid % nig) % gsz); u.pn = (wgid % nig) / gsz; return true;
    }
};

template <class Epi>
__device__ __forceinline__ void gemm_phase(LAS unsigned char* lds, const Gemm g, const StaticOrder& S, const Epi& E) {
    int tid_ = threadIdx.x; asm volatile("" : "+v"(tid_));
    const int tid = tid_, wid = __builtin_amdgcn_readfirstlane(tid >> 6), lane = tid & 63, wr = wid >> 2, wc = wid & 3, fr = lane & 15, fq = lane >> 4;
    const int K = g.K, nt = K / BK;
    unsigned voffA[2], voffB[2];
#pragma unroll
    for (int i = 0; i < 2; ++i) { int R, C; stage_rc(tid * 16 + i * 8192, R, C); voffA[i] = (unsigned)(R * K + C) * 2u; voffB[i] = voffA[i]; }
    const size_t kstep = (size_t)(BK * 2);
    const size_t hstep = (size_t)HALF * K * 2;
    const size_t tstep = 2 * hstep;
    const unsigned ldsw = (unsigned)wid * 1024u;
    const int aoff = lds_byte(wr * 64 + fr, fq * 8), boff = lds_byte(wc * 32 + fr, fq * 8);
#define PG8_SA(b, h) (((b) * 2 + (h)) * HTB)
#define PG8_SB(b, h) ((4 + (b) * 2 + (h)) * HTB)
#define PG8_STAGE(bufoff, gbase, voff) do { _Pragma("unroll") for (int _i = 0; _i < 2; ++_i) \
        __builtin_amdgcn_global_load_lds((const unsigned*)((const char*)(gbase) + (voff)[_i]), (LAS unsigned*)(lds + (bufoff) + ldsw + _i * 8192), 16, 0, 0); } while (0)
#define PG8_LDA(dst, b, h) do { _Pragma("unroll") for (int m = 0; m < 4; ++m) _Pragma("unroll") for (int k = 0; k < 2; ++k) dst[m][k] = *(const LAS bf16x8*)(lds + PG8_SA(b, h) + aoff + m * 2048 + k * 1024); } while (0)
#define PG8_LDB(dst, b, h) do { _Pragma("unroll") for (int n = 0; n < 2; ++n) _Pragma("unroll") for (int k = 0; k < 2; ++k) dst[n][k] = *(const LAS bf16x8*)(lds + PG8_SB(b, h) + boff + n * 2048 + k * 1024); } while (0)
#define PG8_MMA(ai, bj, At, Bt) do { __builtin_amdgcn_s_setprio(1); _Pragma("unroll") for (int m = 0; m < 4; ++m) _Pragma("unroll") for (int n = 0; n < 2; ++n) _Pragma("unroll") for (int k = 0; k < 2; ++k) \
        acc[ai][bj][m][n] = __builtin_amdgcn_mfma_f32_16x16x32_bf16(Bt[n][k], At[m][k], acc[ai][bj][m][n], 0, 0, 0); __builtin_amdgcn_s_setprio(0); } while (0)
#define PG8_WAIT_V(n) asm volatile("s_waitcnt vmcnt(" #n ")" ::: "memory")
#define PG8_WAIT_L(n) asm volatile("s_waitcnt lgkmcnt(" #n ")" ::: "memory")
#define PG8_BAR __builtin_amdgcn_s_barrier()
#define PG8_SCHED __builtin_amdgcn_sched_barrier(0)
#define PG8_PTRS(u, pa, pb) do { const char* _a = (const char*)g.A + (size_t)(u).pm * tstep; const char* _b = (const char*)g.Bt + (size_t)(u).pn * tstep; if (Epi::swap(u)) { pa = _b; pb = _a; } else { pa = _a; pb = _b; } } while (0)
    Unit cur, nxt; int ui = 0;
    if (!S.next(0, cur)) return;
    f32x4 acc[2][2][4][2];
#pragma unroll
    for (int a = 0; a < 2; ++a)
#pragma unroll
        for (int b = 0; b < 2; ++b)
#pragma unroll
            for (int m = 0; m < 4; ++m)
#pragma unroll
                for (int n = 0; n < 2; ++n) acc[a][b][m][n] = (f32x4){0.f, 0.f, 0.f, 0.f};
    bf16x8 At[4][2], B0[2][2], B1[2][2];
    const char* cA; const char* cB;
    PG8_PTRS(cur, cA, cB);
    PG8_STAGE(PG8_SB(0, 0), cB, voffB); PG8_STAGE(PG8_SA(0, 0), cA, voffA); PG8_STAGE(PG8_SB(0, 1), cB + hstep, voffB); PG8_STAGE(PG8_SA(0, 1), cA + hstep, voffA);
    if (wr == 1) PG8_BAR;
    PG8_WAIT_V(4); PG8_BAR;
    PG8_STAGE(PG8_SB(1, 0), cB + kstep, voffB); PG8_STAGE(PG8_SA(1, 0), cA + kstep, voffA); PG8_STAGE(PG8_SB(1, 1), cB + hstep + kstep, voffB);
    PG8_WAIT_V(6); PG8_BAR;
    for (;;) {
        const bool has_next = S.next(ui + 1, nxt);
        const char* nA = cA; const char* nB = cB;
        if (has_next) PG8_PTRS(nxt, nA, nB);
        for (int t = 0; t < nt; t += 2) {
            const bool last = (t == nt - 2);
            const char* a1 = cA + (size_t)(t + 1) * kstep;
            const char* a2 = last ? nA : cA + (size_t)(t + 2) * kstep; const char* b2 = last ? nB : cB + (size_t)(t + 2) * kstep;
            const char* a3 = a2 + kstep; const char* b3 = b2 + kstep;
            PG8_LDB(B0, 0, 0); PG8_SCHED; PG8_LDA(At, 0, 0); PG8_STAGE(PG8_SA(1, 1), a1 + hstep, voffA);
            PG8_WAIT_L(8); PG8_BAR; PG8_WAIT_L(0); PG8_MMA(0, 0, At, B0); PG8_BAR; PG8_SCHED;
            PG8_LDB(B1, 0, 1); PG8_STAGE(PG8_SB(0, 0), b2, voffB);
            PG8_BAR; PG8_WAIT_L(0); PG8_MMA(0, 1, At, B1); PG8_BAR;
            PG8_LDA(At, 0, 1); PG8_STAGE(PG8_SA(0, 0), a2, voffA);
            PG8_BAR; PG8_WAIT_L(0); PG8_MMA(1, 0, At, B0); PG8_BAR; PG8_SCHED;
            PG8_STAGE(PG8_SB(0, 1), b2 + hstep, voffB);
            PG8_WAIT_V(6); PG8_BAR; PG8_MMA(1, 1, At, B1); PG8_BAR;
            PG8_LDB(B0, 1, 0); PG8_SCHED; PG8_LDA(At, 1, 0); PG8_STAGE(PG8_SA(0, 1), a2 + hstep, voffA);
            PG8_WAIT_L(8); PG8_BAR; PG8_WAIT_L(0); PG8_MMA(0, 0, At, B0); PG8_BAR; PG8_SCHED;
            PG8_LDB(B1, 1, 1); PG8_STAGE(PG8_SB(1, 0), b3, voffB);
            PG8_BAR; PG8_WAIT_L(0); PG8_MMA(0, 1, At, B1); PG8_BAR;
            PG8_LDA(At, 1, 1); PG8_STAGE(PG8_SA(1, 0), a3, voffA);
            PG8_BAR; PG8_WAIT_L(0); PG8_MMA(1, 0, At, B0); PG8_BAR; PG8_SCHED;
            PG8_STAGE(PG8_SB(1, 1), b3 + hstep, voffB);
            PG8_WAIT_V(6); PG8_BAR; PG8_MMA(1, 1, At, B1); PG8_BAR;
        }
        E(acc, cur, wr, wc, fr, fq);
        if (!has_next) break;
#pragma unroll
        for (int a = 0; a < 2; ++a)
#pragma unroll
            for (int b = 0; b < 2; ++b)
#pragma unroll
                for (int m = 0; m < 4; ++m)
#pragma unroll
                    for (int n = 0; n < 2; ++n) acc[a][b][m][n] = (f32x4){0.f, 0.f, 0.f, 0.f};
        cur = nxt; cA = nA; cB = nB; ++ui;
    }
    PG8_WAIT_V(0);
    if (wr == 0) PG8_BAR;
    PG8_BAR;
#undef PG8_SA
#undef PG8_SB
#undef PG8_STAGE
#undef PG8_LDA
#undef PG8_LDB
#undef PG8_MMA
#undef PG8_WAIT_V
#undef PG8_WAIT_L
#undef PG8_BAR
#undef PG8_SCHED
#undef PG8_PTRS
}
}
using pg8::Unit;

struct EpiF32 {
    float* C; int ldc;
    __device__ __forceinline__ static bool swap(const Unit&) { return false; }
    __device__ __forceinline__ void operator()(const f32x4 (&acc)[2][2][4][2], const Unit& u, int wr, int wc, int fr, int fq) const {
        const int row0 = u.pm * 256 + wr * 64 + fr, col0 = u.pn * 256 + wc * 32 + 4 * fq;
#pragma unroll
        for (int ai = 0; ai < 2; ++ai)
#pragma unroll
            for (int m = 0; m < 4; ++m) { float* rowp = C + (size_t)(row0 + ai * 128 + m * 16) * ldc + col0;
#pragma unroll
                for (int bj = 0; bj < 2; ++bj)
#pragma unroll
                    for (int n = 0; n < 2; ++n) *(f32x4*)(rowp + bj * 128 + n * 16) = acc[ai][bj][m][n]; }
    }
};
struct EpiGate {
    const float* X1; const float* PLE; float* O;
    __device__ __forceinline__ static bool swap(const Unit&) { return false; }
    __device__ __forceinline__ void operator()(const f32x4 (&acc)[2][2][4][2], const Unit& u, int wr, int wc, int fr, int fq) const {
        const int row0 = u.pm * 256 + wr * 64 + fr, col0 = u.pn * 256 + wc * 32 + 4 * fq;
#pragma unroll
        for (int ai = 0; ai < 2; ++ai)
#pragma unroll
            for (int m = 0; m < 4; ++m) { const size_t ro = (size_t)(row0 + ai * 128 + m * 16) * 1024 + col0;
#pragma unroll
                for (int bj = 0; bj < 2; ++bj)
#pragma unroll
                    for (int n = 0; n < 2; ++n) { const size_t o = ro + bj * 128 + n * 16; const f32x4 x1 = *(const f32x4*)(X1 + o), pl = *(const f32x4*)(PLE + o), a = acc[ai][bj][m][n]; f32x4 r;
#pragma unroll
                        for (int j = 0; j < 4; ++j) r[j] = x1[j] + sigmoid_f(a[j]) * pl[j];
                        *(f32x4*)(O + o) = r; } }
    }
};
struct EpiInAttn {
    bf16_t *Zq, *Zk, *Zg, *vTp, *vTs; const float* tab; float* out;
    __device__ __forceinline__ static bool swap(const Unit& u) { return u.pn == 5; }
    __device__ __forceinline__ void operator()(const f32x4 (&acc)[2][2][4][2], const Unit& u, int wr, int wc, int fr, int fq) const {
        const int pn = u.pn;
        if (pn < 5) {
            const bool isq = pn < 4;
            const int fi = 16 * (wc & 1) + 4 * fq;
#pragma unroll
            for (int ai = 0; ai < 2; ++ai)
#pragma unroll
                for (int m = 0; m < 4; ++m) {
                    const int r = u.pm * 256 + ai * 128 + wr * 64 + m * 16 + fr;
                    const int pi = r < MP ? (r & 4095) : 4096 + ((r - MP) & 7);
                    const f32x4 t0 = *(const f32x4*)(tab + ((size_t)pi * 32 + fi) * 2), t1 = *(const f32x4*)(tab + ((size_t)pi * 32 + fi) * 2 + 4);
                    const float cs[4] = {t0[0], t0[2], t1[0], t1[2]}, sn[4] = {t0[1], t0[3], t1[1], t1[3]};
#pragma unroll
                    for (int bj = 0; bj < 2; ++bj) {
                        const f32x4 x1 = acc[ai][bj][m][0], x2 = acc[ai][bj][m][1]; f32x4 o1, o2;
#pragma unroll
                        for (int j = 0; j < 4; ++j) { o1[j] = x1[j] * cs[j] - x2[j] * sn[j]; o2[j] = x2[j] * cs[j] + x1[j] * sn[j]; }
                        const int hh = 2 * bj + (wc >> 1), d1 = 16 * (wc & 1) + 4 * fq;
                        if (isq) {
                            bf16_t* p = Zq + (size_t)r * 1024 + pn * 256 + hh * 64 + d1;
                            *(u32x2*)p = pk4(o1 * 0.125f); *(u32x2*)(p + 32) = pk4(o2 * 0.125f);
                        } else {
                            bf16_t* p = Zk + (size_t)r * 256 + hh * 64 + d1;
                            *(u32x2*)p = pk4(o1); *(u32x2*)(p + 32) = pk4(o2);
                            if (r < MP) { const int t = r & 4095; if (t >= 3968) { float* dst = out + OFF_KWP + ((size_t)((r >> 12) * 128 + t - 3968) * 4 + hh) * 64 + d1; *(f32x4*)dst = o1; *(f32x4*)(dst + 32) = o2; } }
                            else { const int rs = r - MP; float* dst = out + OFF_KWS + ((size_t)((rs >> 3) * 128 + 120 + (rs & 7)) * 4 + hh) * 64 + d1; *(f32x4*)dst = o1; *(f32x4*)(dst + 32) = o2; }
                        }
                    }
                    asm volatile("" ::: "memory");
                }
        } else if (pn == 5) {
#pragma unroll
            for (int ai = 0; ai < 2; ++ai)
#pragma unroll
                for (int m = 0; m < 4; ++m) {
                    const int e = ai * 128 + wr * 64 + m * 16 + fr, kvh = e >> 6, d = e & 63;
#pragma unroll
                    for (int bj = 0; bj < 2; ++bj)
#pragma unroll
                        for (int n = 0; n < 2; ++n) {
                            const int tok = u.pm * 256 + bj * 128 + wc * 32 + n * 16 + 4 * fq; const f32x4 v = acc[ai][bj][m][n];
                            if (tok < MP) { const int b = tok >> 12, t = tok & 4095;
                                *(u32x2*)(vTp + ((size_t)((b * 4 + kvh) * 64 + d)) * 4096 + t) = pk4(v);
                                if (t >= 3968) {
#pragma unroll
                                    for (int jj = 0; jj < 4; ++jj) out[OFF_VWP + ((size_t)(b * 128 + t - 3968 + jj) * 4 + kvh) * 64 + d] = v[jj]; }
                            } else { const int ts = tok - MP, bs = ts >> 3, l0 = ts & 7;
                                *(u32x2*)(vTs + ((size_t)((bs * 4 + kvh) * 64 + d)) * 8 + l0) = pk4(v);
#pragma unroll
                                for (int jj = 0; jj < 4; ++jj) out[OFF_VWS + ((size_t)(bs * 128 + 120 + l0 + jj) * 4 + kvh) * 64 + d] = v[jj]; }
                        }
                }
        } else {
#pragma unroll
            for (int ai = 0; ai < 2; ++ai)
#pragma unroll
                for (int m = 0; m < 4; ++m) { const int r = u.pm * 256 + ai * 128 + wr * 64 + m * 16 + fr;
#pragma unroll
                    for (int bj = 0; bj < 2; ++bj)
#pragma unroll
                        for (int n = 0; n < 2; ++n) { const f32x4 a = acc[ai][bj][m][n]; f32x4 s;
#pragma unroll
                            for (int j = 0; j < 4; ++j) s[j] = silu_f(a[j]);
                            *(u32x2*)(Zg + (size_t)r * 1024 + (pn - 6) * 256 + bj * 128 + wc * 32 + n * 16 + 4 * fq) = pk4(s); } }
        }
    }
};
struct EpiInRet {
    bf16_t *Zq, *Zk, *Zg, *vTp, *vTs; const float* tab;
    __device__ __forceinline__ static bool swap(const Unit& u) { return u.pn >= 8 && u.pn < 16; }
    __device__ __forceinline__ void operator()(const f32x4 (&acc)[2][2][4][2], const Unit& u, int wr, int wc, int fr, int fq) const {
        const int pn = u.pn;
        if (pn < 8) {
            const bool isq = pn < 4; const float sc = isq ? 1.f : 0.0625f;
            bf16_t* Z = isq ? Zq : Zk; const int hc = (pn & 3) * 256;
#pragma unroll
            for (int ai = 0; ai < 2; ++ai)
#pragma unroll
                for (int m = 0; m < 4; ++m) {
                    const int r = u.pm * 256 + ai * 128 + wr * 64 + m * 16 + fr;
                    const int pi = r < MP ? (r & 4095) : 4096 + ((r - MP) & 7);
#pragma unroll
                    for (int n = 0; n < 2; ++n) {
                        const int d = wc * 32 + n * 16 + 4 * fq;
                        const f32x4 t0 = *(const f32x4*)(tab + ((size_t)pi * 128 + d) * 2), t1 = *(const f32x4*)(tab + ((size_t)pi * 128 + d) * 2 + 4);
                        const float cs[4] = {t0[0], t0[2], t1[0], t1[2]}, sn[4] = {t0[1], t0[3], t1[1], t1[3]};
                        const f32x4 x1 = acc[ai][0][m][n], x2 = acc[ai][1][m][n]; f32x4 o1, o2;
#pragma unroll
                        for (int j = 0; j < 4; ++j) { o1[j] = (x1[j] * cs[j] - x2[j] * sn[j]) * sc; o2[j] = (x2[j] * cs[j] + x1[j] * sn[j]) * sc; }
                        bf16_t* p = Z + (size_t)r * 1024 + hc + d;
                        *(u32x2*)p = pk4(o1); *(u32x2*)(p + 128) = pk4(o2);
                    }
                }
        } else if (pn < 16) {
#pragma unroll
            for (int ai = 0; ai < 2; ++ai)
#pragma unroll
                for (int m = 0; m < 4; ++m) {
                    const int eg = (pn - 8) * 256 + ai * 128 + wr * 64 + m * 16 + fr, h = eg >> 9, e = eg & 511;
#pragma unroll
                    for (int bj = 0; bj < 2; ++bj)
#pragma unroll
                        for (int n = 0; n < 2; ++n) {
                            const int tok = u.pm * 256 + bj * 128 + wc * 32 + n * 16 + 4 * fq; const u32x2 w = pk4(acc[ai][bj][m][n]);
                            if (tok < MP) { const int b = tok >> 12, t = tok & 4095; *(u32x2*)(vTp + ((size_t)((b * 4 + h) * 512 + e)) * 4096 + t) = w; }
                            else { const int ts = tok - MP, bs = ts >> 3, l0 = ts & 7; *(u32x2*)(vTs + ((size_t)((bs * 4 + h) * 512 + e)) * 8 + l0) = w; }
                        }
                }
        } else {
#pragma unroll
            for (int ai = 0; ai < 2; ++ai)
#pragma unroll
                for (int m = 0; m < 4; ++m) { const int r = u.pm * 256 + ai * 128 + wr * 64 + m * 16 + fr;
#pragma unroll
                    for (int bj = 0; bj < 2; ++bj)
#pragma unroll
                        for (int n = 0; n < 2; ++n) { const f32x4 a = acc[ai][bj][m][n]; f32x4 s;
#pragma unroll
                            for (int j = 0; j < 4; ++j) s[j] = silu_f(a[j]);
                            *(u32x2*)(Zg + (size_t)r * 2048 + (pn - 16) * 256 + bj * 128 + wc * 32 + n * 16 + 4 * fq) = pk4(s); } }
        }
    }
};

__device__ __forceinline__ void transpose_tile(const float* __restrict__ W, bf16_t* __restrict__ Wt, int K, int N, bool perm, int tile, LAS float* T) {
    const int tid = threadIdx.x, ntn = N >> 6;
    const int n0 = (tile % ntn) * 64, k0 = (tile / ntn) * 64, nn = tid & 63;
    const int nd = n0 + nn; int ns = nd;
    if (perm && nd < 1280) { const int p = nd & 63; ns = (nd - p) + (p >> 5) * 16 + (p & 15) + ((p >> 4) & 1) * 32; }
#pragma unroll
    for (int i = 0; i < 8; ++i) { const int kk = (tid >> 6) + 8 * i; T[kk * 65 + nn] = W[(size_t)(k0 + kk) * N + ns]; }
    __syncthreads();
    const int kk2 = (tid & 31) * 2;
#pragma unroll
    for (int i = 0; i < 4; ++i) { const int n2 = (tid >> 5) + 16 * i; *(unsigned*)(Wt + (size_t)(n0 + n2) * K + k0 + kk2) = cvt_pk_bf16(T[kk2 * 65 + n2], T[(kk2 + 1) * 65 + n2]); }
    __syncthreads();
}

__device__ __forceinline__ void rms_rows(const float* __restrict__ Xa, const float* __restrict__ Xb, const float* __restrict__ g, bf16_t* __restrict__ H, int G) {
    const int wave = threadIdx.x >> 6, lane = threadIdx.x & 63;
    for (int row = blockIdx.x * 8 + wave; row < MT; row += G * 8) {
        const float* x = row < MP ? Xa + (size_t)row * 1024 : Xb + (size_t)(row - MP) * 1024;
        f32x4 v[4]; float ss = 0.f;
#pragma unroll
        for (int i = 0; i < 4; ++i) { v[i] = *(const f32x4*)(x + lane * 4 + 256 * i); ss += v[i][0] * v[i][0] + v[i][1] * v[i][1] + v[i][2] * v[i][2] + v[i][3] * v[i][3]; }
        ss = wave_sum(ss);
        const float rr = rsqrtf(ss * (1.f / 1024.f) + EPS);
#pragma unroll
        for (int i = 0; i < 4; ++i) { const f32x4 gg = *(const f32x4*)(g + lane * 4 + 256 * i); *(u32x2*)(H + (size_t)row * 1024 + lane * 4 + 256 * i) = pk4(v[i] * rr * gg); }
    }
}
__device__ __forceinline__ void resid_rows(const float* __restrict__ Xa, const float* __restrict__ Xb, const float* __restrict__ Y, const float* __restrict__ g, float* __restrict__ X1, bf16_t* __restrict__ H, int G) {
    const int wave = threadIdx.x >> 6, lane = threadIdx.x & 63;
    for (int row = blockIdx.x * 8 + wave; row < MT; row += G * 8) {
        const float* x = row < MP ? Xa + (size_t)row * 1024 : Xb + (size_t)(row - MP) * 1024;
        const float* y = Y + (size_t)row * 1024;
        f32x4 v[4]; float ss = 0.f;
#pragma unroll
        for (int i = 0; i < 4; ++i) { v[i] = *(const f32x4*)(y + lane * 4 + 256 * i); ss += v[i][0] * v[i][0] + v[i][1] * v[i][1] + v[i][2] * v[i][2] + v[i][3] * v[i][3]; }
        ss = wave_sum(ss);
        const float rr = rsqrtf(ss * (1.f / 1024.f) + EPS);
#pragma unroll
        for (int i = 0; i < 4; ++i) { const int c = lane * 4 + 256 * i; const f32x4 gg = *(const f32x4*)(g + c), xx = *(const f32x4*)(x + c); const f32x4 o = xx + v[i] * rr * gg;
            *(f32x4*)(X1 + (size_t)row * 1024 + c) = o; *(u32x2*)(H + (size_t)row * 1024 + c) = pk4(o); }
    }
}

__device__ __forceinline__ void attn_prompt(LAS unsigned char* lds, const bf16_t* __restrict__ Zq, const bf16_t* __restrict__ Zk, const bf16_t* __restrict__ Zg, const bf16_t* __restrict__ vTp,
                                            const float* __restrict__ sinks, bf16_t* __restrict__ OG, int G) {
    LAS bf16_t* Ks = (LAS bf16_t*)lds;
    LAS bf16_t* Vt = (LAS bf16_t*)(lds + 256 * 72 * 2);
    const int tid = threadIdx.x, w = tid >> 6, lane = tid & 63, l16 = lane & 15, g = lane >> 4;
    for (int it = blockIdx.x; it < 512; it += G) {
        const int kvh = it & 3, nb = (it >> 2) & 31, b = it >> 7;
        __syncthreads();
#pragma unroll
        for (int i = 0; i < 4; ++i) { const int ch = tid + 512 * i, s = ch >> 3, c8 = ch & 7, t = (nb - 1) * 128 + s;
            u32x4 val = {0u, 0u, 0u, 0u}; if (t >= 0) val = *(const u32x4*)(Zk + (size_t)(b * 4096 + t) * 256 + kvh * 64 + c8 * 8);
            *(LAS u32x4*)(Ks + s * 72 + c8 * 8) = val; }
#pragma unroll
        for (int i = 0; i < 4; ++i) { const int ch = tid + 512 * i, d = ch >> 5, s0 = (ch & 31) * 8, t0 = (nb - 1) * 128 + s0;
            u32x4 val = {0u, 0u, 0u, 0u}; if (t0 >= 0) val = *(const u32x4*)(vTp + ((size_t)((b * 4 + kvh) * 64 + d)) * 4096 + t0);
            *(LAS u32x4*)(Vt + d * 264 + s0) = val; }
        __syncthreads();
        const int head = kvh * 4 + (w >> 1);
        const float sk = sinks[head];
        for (int qi = 0; qi < 4; ++qi) {
            const int qt = (w & 1) * 4 + qi;
            const size_t tq = (size_t)b * 4096 + nb * 128 + qt * 16 + l16;
            bf16x8 qf[2];
#pragma unroll
            for (int ks = 0; ks < 2; ++ks) qf[ks] = *(const bf16x8*)(Zq + tq * 1024 + head * 64 + ks * 32 + g * 8);
            f32x4 sa[9];
#pragma unroll
            for (int j = 0; j < 9; ++j) { sa[j] = (f32x4){0.f, 0.f, 0.f, 0.f};
#pragma unroll
                for (int ks = 0; ks < 2; ++ks) { const bf16x8 kf = *(const LAS bf16x8*)(Ks + (16 * (qt + j) + l16) * 72 + ks * 32 + g * 8);
                    sa[j] = __builtin_amdgcn_mfma_f32_16x16x32_bf16(kf, qf[ks], sa[j], 0, 0, 0); } }
            float mx = sk;
#pragma unroll
            for (int j = 0; j < 9; ++j)
#pragma unroll
                for (int r = 0; r < 4; ++r) {
                    bool vis = true;
                    if (j == 0) vis = (4 * g + r) > l16;
                    if (j == 8) vis = (4 * g + r) <= l16;
                    if (nb == 0 && (qt + j) < 8) vis = false;
                    sa[j][r] = vis ? sa[j][r] : -1e30f;
                    mx = fmaxf(mx, sa[j][r]);
                }
            mx = fmaxf(mx, __shfl_xor(mx, 16, 64)); mx = fmaxf(mx, __shfl_xor(mx, 32, 64));
            float sum = 0.f;
#pragma unroll
            for (int j = 0; j < 9; ++j)
#pragma unroll
                for (int r = 0; r < 4; ++r) { const float p = __expf(sa[j][r] - mx); sa[j][r] = p; sum += p; }
            sum += __shfl_xor(sum, 16, 64); sum += __shfl_xor(sum, 32, 64);
            const float inv = 1.f / (sum + __expf(sk - mx));
            f32x4 oa[4];
#pragma unroll
            for (int dt = 0; dt < 4; ++dt) oa[dt] = (f32x4){0.f, 0.f, 0.f, 0.f};
#pragma unroll
            for (int u = 0; u < 5; ++u) {
                u32x4 pw; pw.x = cvt_pk_bf16(sa[2 * u][0], sa[2 * u][1]); pw.y = cvt_pk_bf16(sa[2 * u][2], sa[2 * u][3]);
                if (u < 4) { pw.z = cvt_pk_bf16(sa[2 * u + 1][0], sa[2 * u + 1][1]); pw.w = cvt_pk_bf16(sa[2 * u + 1][2], sa[2 * u + 1][3]); } else { pw.z = 0u; pw.w = 0u; }
                const bf16x8 pf = __builtin_bit_cast(bf16x8, pw);
                const int k0 = 16 * (qt + 2 * u) + 4 * g, k1 = (u < 4) ? k0 + 16 : k0;
#pragma unroll
                for (int dt = 0; dt < 4; ++dt) {
                    const u32x2 v0 = *(const LAS u32x2*)(Vt + (16 * dt + l16) * 264 + k0), v1 = *(const LAS u32x2*)(Vt + (16 * dt + l16) * 264 + k1);
                    u32x4 vw; vw.x = v0.x; vw.y = v0.y; vw.z = v1.x; vw.w = v1.y;
                    oa[dt] = __builtin_amdgcn_mfma_f32_16x16x32_bf16(__builtin_bit_cast(bf16x8, vw), pf, oa[dt], 0, 0, 0);
                }
            }
#pragma unroll
            for (int dt = 0; dt < 4; ++dt) {
                const size_t o = tq * 1024 + head * 64 + 16 * dt + 4 * g;
                const u32x2 gw = *(const u32x2*)(Zg + o);
                f32x4 r; r[0] = oa[dt][0] * inv * bflo(gw.x); r[1] = oa[dt][1] * inv * bfhi(gw.x); r[2] = oa[dt][2] * inv * bflo(gw.y); r[3] = oa[dt][3] * inv * bfhi(gw.y);
                *(u32x2*)(OG + o) = pk4(r);
            }
        }
    }
}

__device__ __forceinline__ void attn_sample(LAS unsigned char* lds, const Params& P, const bf16_t* __restrict__ Zq, const bf16_t* __restrict__ Zk, const bf16_t* __restrict__ Zg, const bf16_t* __restrict__ vTs,
                                            bf16_t* __restrict__ OG, int G) {
    LAS float* Kc = (LAS float*)lds;
    LAS float* Vc = Kc + 136 * 68;
    LAS float* Qs = Vc + 136 * 68;
    LAS float* Sc = Qs + 32 * 68;
    const int tid = threadIdx.x;
    for (int it = blockIdx.x; it < 512; it += G) {
        const int bs = it >> 2, kvh = it & 3;
        __syncthreads();
#pragma unroll
        for (int i = 0; i < 4; ++i) { const int ch = tid + 512 * i, j = ch >> 4, d4 = (ch & 15) * 4;
            const size_t src = ((size_t)(bs * 128 + j) * 4 + kvh) * 64 + d4;
            const f32x4 kv = *(const f32x4*)(P.cache_k + src), vv = *(const f32x4*)(P.cache_v + src);
            *(LAS f32x4*)(Kc + j * 68 + d4) = kv; *(LAS f32x4*)(Vc + j * 68 + d4) = vv;
            if (j >= 8) { const size_t dst = ((size_t)(bs * 128 + j - 8) * 4 + kvh) * 64 + d4; *(f32x4*)(P.out + OFF_KWS + dst) = kv; *(f32x4*)(P.out + OFF_VWS + dst) = vv; } }
        { const int l = tid >> 6, d = tid & 63;
          Kc[(128 + l) * 68 + d] = bf2f(Zk[(size_t)(MP + bs * 8 + l) * 256 + kvh * 64 + d]);
          Vc[(128 + l) * 68 + d] = bf2f(vTs[((size_t)((bs * 4 + kvh) * 64 + d)) * 8 + l]); }
#pragma unroll
        for (int i = 0; i < 4; ++i) { const int e = tid + 512 * i, rr = e >> 6, d = e & 63, hq = rr >> 3, l = rr & 7;
            Qs[rr * 68 + d] = bf2f(Zq[(size_t)(MP + bs * 8 + l) * 1024 + (kvh * 4 + hq) * 64 + d]); }
        __syncthreads();
        const int rr = tid >> 4, kl = tid & 15, l = rr & 7, hq = rr >> 3, head = kvh * 4 + hq;
        const float sk = P.sinks[head];
        float mx = sk;
#pragma unroll 1
        for (int m = 0; m < 9; ++m) {
            const int key = kl + 16 * m;
            if (key < 136) {
                float dot = -1e30f;
                const bool vis = key < 128 ? (key > l) : ((key - 128) <= l);
                if (vis) { float a = 0.f;
#pragma unroll
                    for (int d4 = 0; d4 < 16; ++d4) { const f32x4 q = *(const LAS f32x4*)(Qs + rr * 68 + d4 * 4), k = *(const LAS f32x4*)(Kc + key * 68 + d4 * 4); a += q[0] * k[0] + q[1] * k[1] + q[2] * k[2] + q[3] * k[3]; }
                    dot = a; }
                Sc[rr * 140 + key] = dot; mx = fmaxf(mx, dot);
            }
        }
#pragma unroll
        for (int o = 1; o < 16; o <<= 1) mx = fmaxf(mx, __shfl_xor(mx, o, 64));
        float sum = 0.f;
#pragma unroll 1
        for (int m = 0; m < 9; ++m) { const int key = kl + 16 * m;
            if (key < 136) { const float sv = Sc[rr * 140 + key]; const float p = sv > -1e29f ? __expf(sv - mx) : 0.f; sum += p; Sc[rr * 140 + key] = p; } }
#pragma unroll
        for (int o = 1; o < 16; o <<= 1) sum += __shfl_xor(sum, o, 64);
        const float inv = 1.f / (sum + __expf(sk - mx));
        __syncthreads();
        f32x4 o = {0.f, 0.f, 0.f, 0.f};
        for (int key = 0; key < 136; ++key) { const float p = Sc[rr * 140 + key]; const f32x4 v = *(const LAS f32x4*)(Vc + key * 68 + kl * 4); o += v * p; }
        const size_t oo = (size_t)(MP + bs * 8 + l) * 1024 + head * 64 + kl * 4;
        const u32x2 gw = *(const u32x2*)(Zg + oo);
        f32x4 r; r[0] = o[0] * inv * bflo(gw.x); r[1] = o[1] * inv * bfhi(gw.x); r[2] = o[2] * inv * bflo(gw.y); r[3] = o[3] * inv * bfhi(gw.y);
        *(u32x2*)(OG + oo) = pk4(r);
    }
}

__device__ __forceinline__ void ret_A(LAS unsigned char* lds, const bf16_t* __restrict__ Zq, const bf16_t* __restrict__ Zk, bf16_t* __restrict__ ABUF, bf16_t* __restrict__ KDT, int G) {
    LAS bf16_t* Qs = (LAS bf16_t*)lds;
    LAS bf16_t* Ks = (LAS bf16_t*)(lds + 128 * 264 * 2);
    const int tid = threadIdx.x, w = tid >> 6, lane = tid & 63, l16 = lane & 15, g = lane >> 4;
    for (int it = blockIdx.x; it < 512; it += G) {
        const int c = it & 31, h = (it >> 5) & 3, b = it >> 7;
        const float lg = ret_lg(h);
        const size_t tok0 = (size_t)b * 4096 + c * 128;
        __syncthreads();
#pragma unroll
        for (int i = 0; i < 8; ++i) { const int ch = tid + 512 * i, s = ch >> 5, c8 = (ch & 31) * 8; const size_t src = (tok0 + s) * 1024 + h * 256 + c8;
            *(LAS u32x4*)(Qs + s * 264 + c8) = *(const u32x4*)(Zq + src); *(LAS u32x4*)(Ks + s * 264 + c8) = *(const u32x4*)(Zk + src); }
        __syncthreads();
        const int i_row = 16 * w + l16;
#pragma unroll
        for (int nt = 0; nt < 8; ++nt) {
            f32x4 a = {0.f, 0.f, 0.f, 0.f};
            if (nt <= w) {
#pragma unroll
                for (int ks = 0; ks < 8; ++ks) { const bf16x8 kf = *(const LAS bf16x8*)(Ks + (16 * nt + l16) * 264 + ks * 32 + g * 8), qf = *(const LAS bf16x8*)(Qs + i_row * 264 + ks * 32 + g * 8);
                    a = __builtin_amdgcn_mfma_f32_16x16x32_bf16(kf, qf, a, 0, 0, 0); }
#pragma unroll
                for (int r = 0; r < 4; ++r) { const int s = 16 * nt + 4 * g + r; a[r] = (s <= i_row) ? a[r] * __expf((float)(i_row - s) * lg) : 0.f; }
            }
            *(u32x2*)(ABUF + ((size_t)it * 128 + i_row) * 128 + 16 * nt + 4 * g) = pk4(a);
        }
        { const int d = tid & 255, sg0 = tid >> 8;
#pragma unroll
          for (int k = 0; k < 8; ++k) { const int s0 = 8 * (sg0 + 2 * k); float v[8];
#pragma unroll
              for (int jj = 0; jj < 8; ++jj) v[jj] = bf2f(Ks[(s0 + jj) * 264 + d]) * __expf((float)(127 - s0 - jj) * lg);
              u32x4 wv; wv.x = cvt_pk_bf16(v[0], v[1]); wv.y = cvt_pk_bf16(v[2], v[3]); wv.z = cvt_pk_bf16(v[4], v[5]); wv.w = cvt_pk_bf16(v[6], v[7]);
              *(u32x4*)(KDT + ((size_t)it * 256 + d) * 128 + s0) = wv; } }
    }
}

__device__ __forceinline__ void ret_seq(LAS unsigned char* lds, const bf16_t* __restrict__ Zq, const bf16_t* __restrict__ vTp, const bf16_t* __restrict__ ABUF, const bf16_t* __restrict__ KDT,
                                        float* __restrict__ ORET, float* __restrict__ out, int G) {
    LAS bf16_t* ST = (LAS bf16_t*)lds;
    const int tid = threadIdx.x, w = tid >> 6, lane = tid & 63, l16 = lane & 15, g = lane >> 4;
    for (int u = blockIdx.x; u < 256; u += G) {
        const int xcd = u & 7, slot = u >> 3, bh = xcd * 2 + (slot >> 4), es = slot & 15, b = bh >> 2, h = bh & 3;
        const float lg = ret_lg(h), g128 = __expf(128.f * lg), gi = __expf((float)(16 * w + l16 + 1) * lg);
        __syncthreads();
        for (int e = tid; e < 2 * 32 * 264 / 2; e += NT) ((LAS unsigned*)ST)[e] = 0u;
        f32x4 sacc[2][2];
#pragma unroll
        for (int dt = 0; dt < 2; ++dt)
#pragma unroll
            for (int et = 0; et < 2; ++et) sacc[dt][et] = (f32x4){0.f, 0.f, 0.f, 0.f};
        __syncthreads();
        for (int c = 0; c < 32; ++c) {
            const int buf = c & 1; const size_t item = (size_t)bh * 32 + c; const size_t tok0 = (size_t)b * 4096 + c * 128;
            bf16x8 vf[2][4], af[4], qf[8], kf[2][4];
#pragma unroll
            for (int et = 0; et < 2; ++et)
#pragma unroll
                for (int ks = 0; ks < 4; ++ks) vf[et][ks] = *(const bf16x8*)(vTp + ((size_t)bh * 512 + es * 32 + 16 * et + l16) * 4096 + c * 128 + 32 * ks + 8 * g);
#pragma unroll
            for (int ks = 0; ks < 4; ++ks) af[ks] = *(const bf16x8*)(ABUF + (item * 128 + 16 * w + l16) * 128 + 32 * ks + 8 * g);
#pragma unroll
            for (int kd = 0; kd < 8; ++kd) qf[kd] = *(const bf16x8*)(Zq + (tok0 + 16 * w + l16) * 1024 + h * 256 + 32 * kd + 8 * g);
#pragma unroll
            for (int dt = 0; dt < 2; ++dt)
#pragma unroll
                for (int ks = 0; ks < 4; ++ks) kf[dt][ks] = *(const bf16x8*)(KDT + (item * 256 + 32 * w + 16 * dt + l16) * 128 + 32 * ks + 8 * g);
#pragma unroll
            for (int et = 0; et < 2; ++et) {
                f32x4 oin = {0.f, 0.f, 0.f, 0.f}, ocr = {0.f, 0.f, 0.f, 0.f};
#pragma unroll
                for (int ks = 0; ks < 4; ++ks) oin = __builtin_amdgcn_mfma_f32_16x16x32_bf16(vf[et][ks], af[ks], oin, 0, 0, 0);
#pragma unroll
                for (int kd = 0; kd < 8; ++kd) { const bf16x8 sf = *(const LAS bf16x8*)(ST + (buf * 32 + 16 * et + l16) * 264 + 32 * kd + 8 * g);
                    ocr = __builtin_amdgcn_mfma_f32_16x16x32_bf16(sf, qf[kd], ocr, 0, 0, 0); }
                *(f32x4*)(ORET + (tok0 + 16 * w + l16) * 2048 + h * 512 + es * 32 + 16 * et + 4 * g) = oin + ocr * gi;
            }
#pragma unroll
            for (int dt = 0; dt < 2; ++dt)
#pragma unroll
                for (int et = 0; et < 2; ++et) {
                    f32x4 s = sacc[dt][et] * g128;
#pragma unroll
                    for (int ks = 0; ks < 4; ++ks) s = __builtin_amdgcn_mfma_f32_16x16x32_bf16(kf[dt][ks], vf[et][ks], s, 0, 0, 0);
                    sacc[dt][et] = s;
                    *(LAS u32x2*)(ST + ((buf ^ 1) * 32 + 16 * et + l16) * 264 + 32 * w + 16 * dt + 4 * g) = pk4(s);
                }
            __syncthreads();
        }
#pragma unroll
        for (int dt = 0; dt < 2; ++dt)
#pragma unroll
            for (int et = 0; et < 2; ++et)
#pragma unroll
                for (int r = 0; r < 4; ++r) out[OFF_RSP + ((size_t)bh * 256 + 32 * w + 16 * dt + 4 * g + r) * 512 + es * 32 + 16 * et + l16] = sacc[dt][et][r];
    }
}

__device__ __forceinline__ void ret_sample(LAS unsigned char* lds, const Params& P, const bf16_t* __restrict__ Zq, const bf16_t* __restrict__ Zk, const bf16_t* __restrict__ vTs, float* __restrict__ ORET, int G) {
    LAS float* qs = (LAS float*)lds;
    LAS float* kds = qs + 2048;
    LAS float* A8 = kds + 2048;
    LAS float* red = A8 + 64;
    const int tid = threadIdx.x;
    for (int it = blockIdx.x; it < 512; it += G) {
        const int bs = it >> 2, h = it & 3;
        const float lg = ret_lg(h), g8 = __expf(8.f * lg), ig8 = __expf(-8.f * lg);
        __syncthreads();
#pragma unroll
        for (int k = 0; k < 4; ++k) { const int e = tid + 512 * k, i = e >> 8, d = e & 255; const size_t src = (size_t)(MP + bs * 8 + i) * 1024 + h * 256 + d;
            qs[d * 8 + i] = bf2f(Zq[src]) * __expf((float)(i + 1) * lg); kds[d * 8 + i] = bf2f(Zk[src]) * __expf((float)(7 - i) * lg); }
        __syncthreads();
        if (tid < 64) { const int i = tid >> 3, s = tid & 7; float a = 0.f;
            if (s <= i) { for (int d = 0; d < 256; ++d) a += qs[d * 8 + i] * kds[d * 8 + s]; a *= ig8; }
            A8[tid] = a; }
        const int eg = tid & 127, dp = tid >> 7, e0 = 4 * eg;
        float vv[8][4];
#pragma unroll
        for (int jj = 0; jj < 4; ++jj) { const u32x4 wv = *(const u32x4*)(vTs + ((size_t)((bs * 4 + h) * 512 + e0 + jj)) * 8);
            vv[0][jj] = bflo(wv.x); vv[1][jj] = bfhi(wv.x); vv[2][jj] = bflo(wv.y); vv[3][jj] = bfhi(wv.y); vv[4][jj] = bflo(wv.z); vv[5][jj] = bfhi(wv.z); vv[6][jj] = bflo(wv.w); vv[7][jj] = bfhi(wv.w); }
        f32x4 cr[8];
#pragma unroll
        for (int i = 0; i < 8; ++i) cr[i] = (f32x4){0.f, 0.f, 0.f, 0.f};
        const size_t sbase = ((size_t)(bs * 4 + h) * 256) * 512 + e0;
#pragma unroll 4
        for (int dd = 0; dd < 64; ++dd) {
            const int d = dp * 64 + dd;
            const f32x4 st = *(const f32x4*)(P.state_ret + sbase + (size_t)d * 512);
            const f32x4 qa = *(const LAS f32x4*)(qs + d * 8), qb = *(const LAS f32x4*)(qs + d * 8 + 4), ka = *(const LAS f32x4*)(kds + d * 8), kb = *(const LAS f32x4*)(kds + d * 8 + 4);
            const float q8[8] = {qa[0], qa[1], qa[2], qa[3], qb[0], qb[1], qb[2], qb[3]}, k8[8] = {ka[0], ka[1], ka[2], ka[3], kb[0], kb[1], kb[2], kb[3]};
            f32x4 ns = st * g8;
#pragma unroll
            for (int s = 0; s < 8; ++s)
#pragma unroll
                for (int jj = 0; jj < 4; ++jj) ns[jj] += k8[s] * vv[s][jj];
            *(f32x4*)(P.out + OFF_RSS + sbase + (size_t)d * 512) = ns;
#pragma unroll
            for (int i = 0; i < 8; ++i) cr[i] += st * q8[i];
        }
#pragma unroll
        for (int i = 0; i < 8; ++i) *(LAS f32x4*)(red + (dp * 8 + i) * 512 + e0) = cr[i];
        __syncthreads();
        { const int i = tid >> 6, e8 = (tid & 63) * 8;
          float o[8];
#pragma unroll
          for (int jj = 0; jj < 8; ++jj) o[jj] = red[(0 * 8 + i) * 512 + e8 + jj] + red[(1 * 8 + i) * 512 + e8 + jj] + red[(2 * 8 + i) * 512 + e8 + jj] + red[(3 * 8 + i) * 512 + e8 + jj];
#pragma unroll
          for (int jj = 0; jj < 8; ++jj) { const u32x4 wv = *(const u32x4*)(vTs + ((size_t)((bs * 4 + h) * 512 + e8 + jj)) * 8);
              const float v8[8] = {bflo(wv.x), bfhi(wv.x), bflo(wv.y), bfhi(wv.y), bflo(wv.z), bfhi(wv.z), bflo(wv.w), bfhi(wv.w)};
#pragma unroll
              for (int s = 0; s < 8; ++s) o[jj] += A8[i * 8 + s] * v8[s]; }
          float* dst = ORET + (size_t)(MP + bs * 8 + i) * 2048 + h * 512 + e8;
          *(f32x4*)dst = (f32x4){o[0], o[1], o[2], o[3]}; *(f32x4*)(dst + 4) = (f32x4){o[4], o[5], o[6], o[7]}; }
    }
}

__device__ __forceinline__ void ret_gnorm(const float* __restrict__ ORET, const bf16_t* __restrict__ Zg, bf16_t* __restrict__ OG, int G) {
    const int wave = threadIdx.x >> 6, lane = threadIdx.x & 63;
    for (int task = blockIdx.x * 8 + wave; task < MT * 4; task += G * 8) {
        const size_t o = (size_t)(task >> 2) * 2048 + (task & 3) * 512 + lane * 8;
        const f32x4 a = *(const f32x4*)(ORET + o), b = *(const f32x4*)(ORET + o + 4);
        const float mu = wave_sum(a[0] + a[1] + a[2] + a[3] + b[0] + b[1] + b[2] + b[3]) * (1.f / 512.f);
        const f32x4 da = a - mu, db = b - mu;
        const float var = wave_sum(da[0] * da[0] + da[1] * da[1] + da[2] * da[2] + da[3] * da[3] + db[0] * db[0] + db[1] * db[1] + db[2] * db[2] + db[3] * db[3]) * (1.f / 512.f);
        const float rs = rsqrtf(var + EPS);
        const u32x4 gw = *(const u32x4*)(Zg + o);
        u32x4 r;
        r.x = cvt_pk_bf16(da[0] * rs * bflo(gw.x), da[1] * rs * bfhi(gw.x)); r.y = cvt_pk_bf16(da[2] * rs * bflo(gw.y), da[3] * rs * bfhi(gw.y));
        r.z = cvt_pk_bf16(db[0] * rs * bflo(gw.z), db[1] * rs * bfhi(gw.z)); r.w = cvt_pk_bf16(db[2] * rs * bflo(gw.w), db[3] * rs * bfhi(gw.w));
        *(u32x4*)(OG + o) = r;
    }
}

__global__ void __launch_bounds__(NT) hybrid_fwd(Params P) {
    extern __shared__ __attribute__((aligned(16))) unsigned char lds_raw[];
    LAS unsigned char* lds = (LAS unsigned char*)lds_raw;
    cg::grid_group grid = cg::this_grid();
    const int G = gridDim.x, tid = threadIdx.x;
    unsigned char* ws = P.ws;
    bf16_t* WT_IN_ATTN = (bf16_t*)(ws + WS_WT_IN_ATTN); bf16_t* WT_OUT_ATTN = (bf16_t*)(ws + WS_WT_OUT_ATTN); bf16_t* WT_IN_RET = (bf16_t*)(ws + WS_WT_IN_RET); bf16_t* WT_OUT_RET = (bf16_t*)(ws + WS_WT_OUT_RET);
    bf16_t* WT_GATE = (bf16_t*)(ws + WS_WT_GATE); bf16_t* WT_PLE = (bf16_t*)(ws + WS_WT_PLE);
    float* TABA = (float*)(ws + WS_TABA); float* TABR = (float*)(ws + WS_TABR);
    bf16_t* H = (bf16_t*)(ws + WS_H); bf16_t* PB = (bf16_t*)(ws + WS_PB);
    float* PLE = (float*)(ws + WS_PLE); float* Y = (float*)(ws + WS_Y); float* X1 = (float*)(ws + WS_X1); float* X2 = (float*)(ws + WS_X2);
    bf16_t* OG = (bf16_t*)(ws + WS_OG); bf16_t* ZQ = (bf16_t*)(ws + WS_ZQ); bf16_t* ZK = (bf16_t*)(ws + WS_ZK); bf16_t* ZG = (bf16_t*)(ws + WS_ZG);
    bf16_t* VTP = (bf16_t*)(ws + WS_VTP); bf16_t* VTS = (bf16_t*)(ws + WS_VTS); bf16_t* ABUF = (bf16_t*)(ws + WS_ABUF); bf16_t* KDT = (bf16_t*)(ws + WS_KDT); float* ORET = (float*)(ws + WS_ORET);
    pg8::StaticOrder SO;

    for (int t = blockIdx.x; t < 3584; t += G) {
        LAS float* T = (LAS float*)lds;
        if (t < 640) transpose_tile(P.w_in_attn, WT_IN_ATTN, 1024, 2560, true, t, T);
        else if (t < 896) transpose_tile(P.w_out_attn, WT_OUT_ATTN, 1024, 1024, false, t - 640, T);
        else if (t < 2432) transpose_tile(P.w_in_ret, WT_IN_RET, 1024, 6144, false, t - 896, T);
        else if (t < 2944) transpose_tile(P.w_out_ret, WT_OUT_RET, 2048, 1024, false, t - 2432, T);
        else if (t < 3200) transpose_tile(P.w_gate, WT_GATE, 1024, 1024, false, t - 2944, T);
        else if (t < 3456) transpose_tile(P.w_gate + 1024 * 1024, WT_GATE + 1024 * 1024, 1024, 1024, false, t - 3200, T);
        else if (t < 3520) transpose_tile(P.w_ple, WT_PLE, 256, 1024, false, t - 3456, T);
        else transpose_tile(P.w_ple + 256 * 1024, WT_PLE + 1024 * 256, 256, 1024, false, t - 3520, T);
    }
    for (int e = blockIdx.x * NT + tid; e < 4104 * 160; e += G * NT) {
        const int pi = e / 160, f = e % 160; const int pos = pi < 4096 ? pi : 16384 + (pi - 4096);
        if (f < 32) { const float inv = powf(10000.f, -(float)f / 32.f), ang = (float)pos * inv; TABA[((size_t)pi * 32 + f) * 2] = cosf(ang); TABA[((size_t)pi * 32 + f) * 2 + 1] = sinf(ang); }
        else { const int f2 = f - 32; const float inv = powf(10000.f, -(float)f2 / 128.f), ang = (float)pos * inv; TABR[((size_t)pi * 128 + f2) * 2] = cosf(ang); TABR[((size_t)pi * 128 + f2) * 2 + 1] = sinf(ang); }
    }
    for (int e = blockIdx.x * NT + tid; e < 2 * MT * 64; e += G * NT) {
        const int i = e / (MT * 64), rem = e % (MT * 64), row = rem >> 6, c4 = (rem & 63) * 4;
        const float* src = row < MP ? P.p_prompt + ((size_t)i * MP + row) * 256 + c4 : P.p_sample + ((size_t)i * MS + row - MP) * 256 + c4;
        *(u32x2*)(PB + ((size_t)i * MT + row) * 256 + c4) = pk4(*(const f32x4*)src);
    }
    rms_rows(P.x_prompt, P.x_sample, P.pre_norm, H, G);
    grid.sync();

    { pg8::Gemm g{H, WT_IN_ATTN, MT, 2560, 1024}; SO.init(MT, 2560, G, blockIdx.x);
      EpiInAttn E{ZQ, ZK, ZG, VTP, VTS, TABA, P.out}; pg8::gemm_phase(lds, g, SO, E); }
    { pg8::Gemm g{PB, WT_PLE, MT, 1024, 256}; SO.init(MT, 1024, G, blockIdx.x);
      EpiF32 E{PLE, 1024}; pg8::gemm_phase(lds, g, SO, E); }
    grid.sync();

    attn_prompt(lds, ZQ, ZK, ZG, VTP, P.sinks, OG, G);
    attn_sample(lds, P, ZQ, ZK, ZG, VTS, OG, G);
    grid.sync();

    { pg8::Gemm g{OG, WT_OUT_ATTN, MT, 1024, 1024}; SO.init(MT, 1024, G, blockIdx.x); EpiF32 E{Y, 1024}; pg8::gemm_phase(lds, g, SO, E); }
    grid.sync();
    resid_rows(P.x_prompt, P.x_sample, Y, P.post_norm, X1, H, G);
    grid.sync();
    { pg8::Gemm g{H, WT_GATE, MT, 1024, 1024}; SO.init(MT, 1024, G, blockIdx.x); EpiGate E{X1, PLE, X2}; pg8::gemm_phase(lds, g, SO, E); }
    grid.sync();
    rms_rows(X2, X2 + (size_t)MP * 1024, P.pre_norm + 1024, H, G);
    grid.sync();
    { pg8::Gemm g{H, WT_IN_RET, MT, 6144, 1024}; SO.init(MT, 6144, G, blockIdx.x);
      EpiInRet E{ZQ, ZK, ZG, VTP, VTS, TABR}; pg8::gemm_phase(lds, g, SO, E); }
    { pg8::Gemm g{PB + (size_t)MT * 256, WT_PLE + 1024 * 256, MT, 1024, 256}; SO.init(MT, 1024, G, blockIdx.x);
      EpiF32 E{PLE, 1024}; pg8::gemm_phase(lds, g, SO, E); }
    grid.sync();
    ret_A(lds, ZQ, ZK, ABUF, KDT, G);
    grid.sync();
    ret_seq(lds, ZQ, VTP, ABUF, KDT, ORET, P.out, G);
    ret_sample(lds, P, ZQ, ZK, VTS, ORET, G);
    grid.sync();
    ret_gnorm(ORET, ZG, OG, G);
    grid.sync();
    { pg8::Gemm g{OG, WT_OUT_RET, MT, 1024, 2048}; SO.init(MT, 1024, G, blockIdx.x); EpiF32 E{Y, 1024}; pg8::gemm_phase(lds, g, SO, E); }
    grid.sync();
    resid_rows(X2, X2 + (size_t)MP * 1024, Y, P.post_norm + 1024, X1, H, G);
    grid.sync();
    { pg8::Gemm g{H, WT_GATE + 1024 * 1024, MT, 1024, 1024}; SO.init(MT, 1024, G, blockIdx.x); EpiGate E{X1, PLE, P.out}; pg8::gemm_phase(lds, g, SO, E); }
}

extern "C" void kernel_launch(void* const* d_in, const int* in_sizes, int n_in, void* d_out, int out_size, void* d_ws, size_t ws_size, hipStream_t stream) {
    static int grid_blocks = 0;
    if (!grid_blocks) {
        int dev = 0, cus = 0, per_cu = 0;
        hipGetDevice(&dev);
        hipDeviceGetAttribute(&cus, hipDeviceAttributeMultiprocessorCount, dev);
        hipFuncSetAttribute((const void*)hybrid_fwd, hipFuncAttributeMaxDynamicSharedMemorySize, LDS_BYTES);
        hipOccupancyMaxActiveBlocksPerMultiprocessor(&per_cu, (const void*)hybrid_fwd, NT, LDS_BYTES);
        if (per_cu < 1) per_cu = 1;
        if (per_cu > 1) per_cu = 1;
        grid_blocks = cus * per_cu;
        if (ws_size < WS_END) fprintf(stderr, "kernel_launch: workspace too small: %zu < %zu\n", ws_size, (size_t)WS_END);
    }
    Params p{};
    p.x_prompt = (const float*)d_in[0]; p.x_sample = (const float*)d_in[1]; p.cache_k = (const float*)d_in[2]; p.cache_v = (const float*)d_in[3]; p.state_ret = (const float*)d_in[4];
    p.p_prompt = (const float*)d_in[5]; p.p_sample = (const float*)d_in[6]; p.pre_norm = (const float*)d_in[7]; p.post_norm = (const float*)d_in[8]; p.w_in_attn = (const float*)d_in[9];
    p.sinks = (const float*)d_in[10]; p.w_out_attn = (const float*)d_in[11]; p.w_in_ret = (const float*)d_in[12]; p.w_out_ret = (const float*)d_in[13]; p.w_ple = (const float*)d_in[14]; p.w_gate = (const float*)d_in[15];
    p.out = (float*)d_out; p.ws = (unsigned char*)d_ws;
    void* args[] = {&p};
    hipError_t e = hipLaunchCooperativeKernel((const void*)hybrid_fwd, dim3(grid_blocks), dim3(NT), args, LDS_BYTES, stream);
    if (e != hipSuccess) fprintf(stderr, "cooperative launch failed: %s (grid %d)\n", hipGetErrorString(e), grid_blocks);
}
```

```cpp
#include <hip/hip_runtime.h>
#include <hip/hip_cooperative_groups.h>
#include <cstdio>
#include <cstdint>
namespace cg = cooperative_groups;

#define LAS __attribute__((address_space(3)))
typedef unsigned short bf16_t;
typedef short bf16x8 __attribute__((ext_vector_type(8)));
typedef float f32x4 __attribute__((ext_vector_type(4)));
typedef float f32x2 __attribute__((ext_vector_type(2)));
typedef unsigned u32x2 __attribute__((ext_vector_type(2)));
typedef unsigned u32x4 __attribute__((ext_vector_type(4)));

constexpr int MP = 16384, MS = 1024, MT = MP + MS;
constexpr int NT = 512;
#define REP_P0 1
#define REP_GIN 1
#define REP_ATT 1
#define REP_RA 1
#define REP_RS 1
#define REP_RSMP 1
#define REP_SYNC 0
#define REP_ROW 1
#define REP_GN1 1
constexpr int LDS_BYTES = 140 * 1024;
constexpr float EPS = 1e-6f;

constexpr size_t OFF_YP = 0, OFF_YS = 16777216, OFF_KWP = 17825792, OFF_VWP = 17956864, OFF_KWS = 18087936, OFF_VWS = 22282240, OFF_RSP = 26476544, OFF_RSS = 28573696;

constexpr size_t al256(size_t x) { return (x + 255) & ~(size_t)255; }
constexpr size_t WS_WT_IN_ATTN = 0;
constexpr size_t WS_WT_OUT_ATTN = WS_WT_IN_ATTN + (size_t)2560 * 1024 * 2;
constexpr size_t WS_WT_IN_RET = WS_WT_OUT_ATTN + (size_t)1024 * 1024 * 2;
constexpr size_t WS_WT_OUT_RET = WS_WT_IN_RET + (size_t)6144 * 1024 * 2;
constexpr size_t WS_WT_GATE = WS_WT_OUT_RET + (size_t)1024 * 2048 * 2;
constexpr size_t WS_WT_PLE = WS_WT_GATE + (size_t)2 * 1024 * 1024 * 2;
constexpr size_t WS_TABA = WS_WT_PLE + (size_t)2 * 1024 * 256 * 2;
constexpr size_t WS_TABR = WS_TABA + (size_t)4104 * 32 * 8;
constexpr size_t WS_H = al256(WS_TABR + (size_t)4104 * 128 * 8);
constexpr size_t WS_PB = WS_H + (size_t)MT * 1024 * 2;
constexpr size_t WS_PLE = WS_PB + (size_t)2 * MT * 256 * 2;
constexpr size_t WS_Y = WS_PLE + (size_t)MT * 1024 * 4;
constexpr size_t WS_X1 = WS_Y + (size_t)MT * 1024 * 4;
constexpr size_t WS_X2 = WS_X1 + (size_t)MT * 1024 * 4;
constexpr size_t WS_OG = WS_X2 + (size_t)MT * 1024 * 4;
constexpr size_t WS_ZQ = WS_OG + (size_t)MT * 2048 * 2;
constexpr size_t WS_ZK = WS_ZQ + (size_t)MT * 1024 * 2;
constexpr size_t WS_ZG = WS_ZK + (size_t)MT * 1024 * 2;
constexpr size_t WS_VTP = WS_ZG + (size_t)MT * 2048 * 2;
constexpr size_t WS_VTS = WS_VTP + (size_t)16 * 512 * 4096 * 2;
constexpr size_t WS_ABUF = WS_VTS + (size_t)128 * 4 * 512 * 8 * 2;
constexpr size_t WS_KDT = WS_ABUF + (size_t)512 * 128 * 128 * 2;
constexpr size_t WS_ORET = WS_KDT + (size_t)512 * 256 * 128 * 2;
constexpr size_t WS_BAR = WS_ORET + (size_t)MT * 2048 * 4;
constexpr size_t WS_END = WS_BAR + 16384;

struct Params {
    const float *x_prompt, *x_sample, *cache_k, *cache_v, *state_ret, *p_prompt, *p_sample, *pre_norm, *post_norm, *w_in_attn, *sinks, *w_out_attn, *w_in_ret, *w_out_ret, *w_ple, *w_gate;
    float* out; unsigned char* ws;
};

__device__ __forceinline__ unsigned cvt_pk_bf16(float lo, float hi) { unsigned r; asm volatile("v_cvt_pk_bf16_f32 %0, %1, %2" : "=v"(r) : "v"(lo), "v"(hi)); return r; }
__device__ __forceinline__ u32x2 pk4(f32x4 v) { u32x2 w; w.x = cvt_pk_bf16(v[0], v[1]); w.y = cvt_pk_bf16(v[2], v[3]); return w; }
__device__ __forceinline__ float bf2f(bf16_t b) { return __uint_as_float(((unsigned)b) << 16); }
__device__ __forceinline__ float bflo(unsigned w) { return __uint_as_float(w << 16); }
__device__ __forceinline__ float bfhi(unsigned w) { return __uint_as_float(w & 0xffff0000u); }
__device__ __forceinline__ float silu_f(float x) { return x / (1.f + __expf(-x)); }
__device__ __forceinline__ float sigmoid_f(float x) { return 1.f / (1.f + __expf(-x)); }
__device__ __forceinline__ float wave_sum(float v) {
#pragma unroll
    for (int o = 32; o >= 1; o >>= 1) v += __shfl_xor(v, o, 64);
    return v;
}
__device__ __forceinline__ int otid() { int t = threadIdx.x; asm volatile("" : "+v"(t)); return t; }
__device__ __forceinline__ float ret_lg(int h) { return log1pf(-exp2f(-5.f - (float)h)); }

#define XB_TMO      128
#define XB_XCNT(j)  (256  + 64 * (j))
#define XB_XSUB(j)  (1280 + 64 * (j))
#define XB_XGEN(j)  (2304 + 64 * (j))
#define XB_TOP      3328
#define XB_TOPGEN   3392
#define XCD_BAR_WORDS 3456
#define XB_SPIN_CAP (1u << 18)

__device__ __forceinline__ unsigned xb_ld(unsigned* p)              { return __hip_atomic_load(p, __ATOMIC_RELAXED, __HIP_MEMORY_SCOPE_AGENT); }
__device__ __forceinline__ unsigned xb_add(unsigned* p, unsigned v) { return __hip_atomic_fetch_add(p, v, __ATOMIC_RELAXED, __HIP_MEMORY_SCOPE_AGENT); }
__device__ __forceinline__ unsigned xb_xcc_id() { return (unsigned)__builtin_amdgcn_s_getreg((3 << 11) | 20) & 0xFu; }
#define XB_SPIN(cond, bar) do { unsigned _sp = 0; while (cond) { __builtin_amdgcn_s_sleep(1); \
    if ((++_sp & 255u) == 0u) { if (xb_ld(&(bar)[XB_TMO])) break; if (_sp > XB_SPIN_CAP) { atomicAdd(&(bar)[XB_TMO], 1u); break; } } } } while (0)

struct XcdBarrier {
    unsigned* bar; unsigned x;
    volatile LAS unsigned* st;
};

__device__ __forceinline__ XcdBarrier xcd_barrier_post(unsigned* bar, volatile LAS unsigned* st) {
    XcdBarrier b; b.bar = bar; b.x = xb_xcc_id(); b.st = st;
    if (threadIdx.x == 0) (void)xb_add(&bar[XB_XCNT(b.x)], 1u);
    return b;
}
__device__ __forceinline__ void xcd_barrier_complete(unsigned* bar, unsigned x, unsigned& nloc, unsigned& nx) {
    const unsigned G = gridDim.x * gridDim.y * gridDim.z;
    unsigned sum, cnt, mine, sp = 0u;
    for (;;) {
        sum = 0u; cnt = 0u; mine = 0u;
#pragma unroll
        for (unsigned j = 0; j < 16; ++j) { const unsigned c = xb_ld(&bar[XB_XCNT(j)]); sum += c; cnt += (c > 0u) ? 1u : 0u; mine = (j == x) ? c : mine; }
        if (sum == G) break;
        __builtin_amdgcn_s_sleep(1);
        if ((++sp & 255u) == 0u) { if (xb_ld(&bar[XB_TMO])) break; if (sp > XB_SPIN_CAP) { atomicAdd(&bar[XB_TMO], 1u); break; } }
    }
    nloc = mine > 0u ? mine : 1u; nx = cnt > 0u ? cnt : 1u;
}

__device__ __forceinline__ void xcd_barrier(const XcdBarrier& b) {
    asm volatile("s_waitcnt vmcnt(0)" ::: "memory");
    __syncthreads();
    if (threadIdx.x == 0) {
        unsigned* bar = b.bar;
        __builtin_amdgcn_s_waitcnt(0);
        unsigned nloc = b.st[0], nx = b.st[1];
        if (nloc == 0u) { xcd_barrier_complete(bar, b.x, nloc, nx); b.st[0] = nloc; b.st[1] = nx; }
        const unsigned old = xb_add(&bar[XB_XSUB(b.x)], 1u);
        const unsigned gen = old / nloc;
        if (old + 1u == (gen + 1u) * nloc) {
            __builtin_amdgcn_fence(__ATOMIC_RELEASE, "agent");
            asm volatile("s_waitcnt vmcnt(0)" ::: "memory");
            const unsigned og = xb_add(&bar[XB_TOP], 1u);
            const unsigned tg = og / nx;
            if (og + 1u == (tg + 1u) * nx) xb_add(&bar[XB_TOPGEN], 1u);
            else XB_SPIN(xb_ld(&bar[XB_TOPGEN]) == tg, bar);
            __builtin_amdgcn_fence(__ATOMIC_ACQUIRE, "agent");
            xb_add(&bar[XB_XGEN(b.x)], 1u);
            asm volatile("s_waitcnt vmcnt(0)" ::: "memory");
        } else {
            XB_SPIN(xb_ld(&bar[XB_XGEN(b.x)]) == gen, bar);
            __builtin_amdgcn_fence(__ATOMIC_ACQUIRE, "agent");
            asm volatile("s_waitcnt vmcnt(0)" ::: "memory");
        }
    }
    __syncthreads();
}

namespace pg8 {
constexpr int BM = 256, BK = 64, HALF = 128, HTB = HALF * BK * 2, STAGE_BYTES = 8 * HTB, NXCD = 8, WGM = 8;
__host__ __device__ __forceinline__ int lds_byte(int r, int c) { const int st = (r >> 4) * 2 + (c >> 5), rr = r & 15, cc = c & 31, ob = rr * 64 + cc * 2; return st * 1024 + (ob ^ (((ob >> 9) & 1) << 5)); }
__host__ __device__ __forceinline__ void stage_rc(int b, int& R, int& C) { const int st = b / 1024, sb = b % 1024, swz = sb ^ (((sb >> 9) & 1) << 5); R = (st >> 1) * 16 + swz / 64; C = (st & 1) * 32 + (swz % 64) / 2; }
struct Unit { int pm, pn; };
struct Gemm { const bf16_t* A; const bf16_t* Bt; int M, N, K; };
struct StaticOrder {
    int nM, nN, nwg, G, c;
    __host__ __device__ void init(int M, int N, int G_, int c_) { nM = M / BM; nN = N / BM; nwg = nM * nN; G = G_; c = c_; }
    __host__ __device__ bool next(int i, Unit& u) const {
        const long L = (long)i * G + c; if (L >= nwg) return false;
        int wgid = (int)L; { const int q = nwg / NXCD, r = nwg % NXCD, xcd = wgid % NXCD, off = wgid / NXCD; wgid = (xcd < r ? xcd * (q + 1) : r * (q + 1) + (xcd - r) * q) + off; }
        const int nig = WGM * nN, gid = wgid / nig, fm = gid * WGM, gsz = (nM - fm) < WGM ? (nM - fm) : WGM;
        u.pm = fm + ((wgid % nig) % gsz); u.pn = (wgid % nig) / gsz; return true;
    }
};

template <class Epi>
__device__ __forceinline__ void gemm_phase(LAS unsigned char* lds, const Gemm g, const StaticOrder& S, const Epi& E) {
    const int tid = otid(), wid = __builtin_amdgcn_readfirstlane(tid >> 6), lane = tid & 63, wr = wid >> 2, wc = wid & 3, fr = lane & 15, fq = lane >> 4;
    const int K = g.K, nt = K / BK;
    unsigned voffA[2], voffB[2];
#pragma unroll
    for (int i = 0; i < 2; ++i) { int R, C; stage_rc(tid * 16 + i * 8192, R, C); voffA[i] = (unsigned)(R * K + C) * 2u; voffB[i] = voffA[i]; }
    const size_t kstep = (size_t)(BK * 2);
    const size_t hstep = (size_t)HALF * K * 2;
    const size_t tstep = 2 * hstep;
    const unsigned ldsw = (unsigned)wid * 1024u;
    const int aoff = lds_byte(wr * 64 + fr, fq * 8), boff = lds_byte(wc * 32 + fr, fq * 8);
#define PG8_SA(b, h) (((b) * 2 + (h)) * HTB)
#define PG8_SB(b, h) ((4 + (b) * 2 + (h)) * HTB)
#define PG8_STAGE(bufoff, gbase, voff) do { _Pragma("unroll") for (int _i = 0; _i < 2; ++_i) \
        __builtin_amdgcn_global_load_lds((const unsigned*)((const char*)(gbase) + (voff)[_i]), (LAS unsigned*)(lds + (bufoff) + ldsw + _i * 8192), 16, 0, 0); } while (0)
#define PG8_LDA(dst, b, h) do { _Pragma("unroll") for (int m = 0; m < 4; ++m) _Pragma("unroll") for (int k = 0; k < 2; ++k) dst[m][k] = *(const LAS bf16x8*)(lds + PG8_SA(b, h) + aoff + m * 2048 + k * 1024); } while (0)
#define PG8_LDB(dst, b, h) do { _Pragma("unroll") for (int n = 0; n < 2; ++n) _Pragma("unroll") for (int k = 0; k < 2; ++k) dst[n][k] = *(const LAS bf16x8*)(lds + PG8_SB(b, h) + boff + n * 2048 + k * 1024); } while (0)
#define PG8_MMA(ai, bj, At, Bt) do { __builtin_amdgcn_s_setprio(1); _Pragma("unroll") for (int m = 0; m < 4; ++m) _Pragma("unroll") for (int n = 0; n < 2; ++n) _Pragma("unroll") for (int k = 0; k < 2; ++k) \
        acc[ai][bj][m][n] = __builtin_amdgcn_mfma_f32_16x16x32_bf16(Bt[n][k], At[m][k], acc[ai][bj][m][n], 0, 0, 0); __builtin_amdgcn_s_setprio(0); } while (0)
#define PG8_WAIT_V(n) asm volatile("s_waitcnt vmcnt(" #n ")" ::: "memory")
#define PG8_WAIT_L(n) asm volatile("s_waitcnt lgkmcnt(" #n ")" ::: "memory")
#define PG8_BAR __builtin_amdgcn_s_barrier()
#define PG8_SCHED __builtin_amdgcn_sched_barrier(0)
#define PG8_PTRS(u, pa, pb) do { const char* _a = (const char*)g.A + (size_t)(u).pm * tstep; const char* _b = (const char*)g.Bt + (size_t)(u).pn * tstep; if (Epi::swap(u)) { pa = _b; pb = _a; } else { pa = _a; pb = _b; } } while (0)
    Unit cur, nxt; int ui = 0;
    if (!S.next(0, cur)) return;
    f32x4 acc[2][2][4][2];
#pragma unroll
    for (int a = 0; a < 2; ++a)
#pragma unroll
        for (int b = 0; b < 2; ++b)
#pragma unroll
            for (int m = 0; m < 4; ++m)
#pragma unroll
                for (int n = 0; n < 2; ++n) acc[a][b][m][n] = (f32x4){0.f, 0.f, 0.f, 0.f};
    bf16x8 At[4][2], B0[2][2], B1[2][2];
    const char* cA; const char* cB;
    PG8_PTRS(cur, cA, cB);
    PG8_STAGE(PG8_SB(0, 0), cB, voffB); PG8_STAGE(PG8_SA(0, 0), cA, voffA); PG8_STAGE(PG8_SB(0, 1), cB + hstep, voffB); PG8_STAGE(PG8_SA(0, 1), cA + hstep, voffA);
    if (wr == 1) PG8_BAR;
    PG8_WAIT_V(4); PG8_BAR;
    PG8_STAGE(PG8_SB(1, 0), cB + kstep, voffB); PG8_STAGE(PG8_SA(1, 0), cA + kstep, voffA); PG8_STAGE(PG8_SB(1, 1), cB + hstep + kstep, voffB);
    PG8_WAIT_V(6); PG8_BAR;
    for (;;) {
        const bool has_next = S.next(ui + 1, nxt);
        const char* nA = cA; const char* nB = cB;
        if (has_next) PG8_PTRS(nxt, nA, nB);
        for (int t = 0; t < nt; t += 2) {
            const bool last = (t == nt - 2);
            const char* a1 = cA + (size_t)(t + 1) * kstep;
            const char* a2 = last ? nA : cA + (size_t)(t + 2) * kstep; const char* b2 = last ? nB : cB + (size_t)(t + 2) * kstep;
            const char* a3 = a2 + kstep; const char* b3 = b2 + kstep;
            PG8_LDB(B0, 0, 0); PG8_SCHED; PG8_LDA(At, 0, 0); PG8_STAGE(PG8_SA(1, 1), a1 + hstep, voffA);
            PG8_WAIT_L(8); PG8_BAR; PG8_WAIT_L(0); PG8_MMA(0, 0, At, B0); PG8_BAR; PG8_SCHED;
            PG8_LDB(B1, 0, 1); PG8_STAGE(PG8_SB(0, 0), b2, voffB);
            PG8_BAR; PG8_WAIT_L(0); PG8_MMA(0, 1, At, B1); PG8_BAR;
            PG8_LDA(At, 0, 1); PG8_STAGE(PG8_SA(0, 0), a2, voffA);
            PG8_BAR; PG8_WAIT_L(0); PG8_MMA(1, 0, At, B0); PG8_BAR; PG8_SCHED;
            PG8_STAGE(PG8_SB(0, 1), b2 + hstep, voffB);
            PG8_WAIT_V(6); PG8_BAR; PG8_MMA(1, 1, At, B1); PG8_BAR;
            PG8_LDB(B0, 1, 0); PG8_SCHED; PG8_LDA(At, 1, 0); PG8_STAGE(PG8_SA(0, 1), a2 + hstep, voffA);
            PG8_WAIT_L(8); PG8_BAR; PG8_WAIT_L(0); PG8_MMA(0, 0, At, B0); PG8_BAR; PG8_SCHED;
            PG8_LDB(B1, 1, 1); PG8_STAGE(PG8_SB(1, 0), b3, voffB);
            PG8_BAR; PG8_WAIT_L(0); PG8_MMA(0, 1, At, B1); PG8_BAR;
            PG8_LDA(At, 1, 1); PG8_STAGE(PG8_SA(1, 0), a3, voffA);
            PG8_BAR; PG8_WAIT_L(0); PG8_MMA(1, 0, At, B0); PG8_BAR; PG8_SCHED;
            PG8_STAGE(PG8_SB(1, 1), b3 + hstep, voffB);
            PG8_WAIT_V(6); PG8_BAR; PG8_MMA(1, 1, At, B1); PG8_BAR;
        }
        E(acc, cur, wr, wc, fr, fq);
        if (!has_next) break;
#pragma unroll
        for (int a = 0; a < 2; ++a)
#pragma unroll
            for (int b = 0; b < 2; ++b)
#pragma unroll
                for (int m = 0; m < 4; ++m)
#pragma unroll
                    for (int n = 0; n < 2; ++n) acc[a][b][m][n] = (f32x4){0.f, 0.f, 0.f, 0.f};
        cur = nxt; cA = nA; cB = nB; ++ui;
    }
    PG8_WAIT_V(0);
    if (wr == 0) PG8_BAR;
    PG8_BAR;
#undef PG8_SA
#undef PG8_SB
#undef PG8_STAGE
#undef PG8_LDA
#undef PG8_LDB
#undef PG8_MMA
#undef PG8_WAIT_V
#undef PG8_WAIT_L
#undef PG8_BAR
#undef PG8_SCHED
#undef PG8_PTRS
}
}
using pg8::Unit;

struct EpiF32 {
    float* C; int ldc;
    __device__ __forceinline__ static bool swap(const Unit&) { return false; }
    __device__ __forceinline__ void operator()(const f32x4 (&acc)[2][2][4][2], const Unit& u, int wr, int wc, int fr, int fq) const {
        const int row0 = u.pm * 256 + wr * 64 + fr, col0 = u.pn * 256 + wc * 32 + 4 * fq;
#pragma unroll
        for (int ai = 0; ai < 2; ++ai)
#pragma unroll
            for (int m = 0; m < 4; ++m) { float* rowp = C + (size_t)(row0 + ai * 128 + m * 16) * ldc + col0;
#pragma unroll
                for (int bj = 0; bj < 2; ++bj)
#pragma unroll
                    for (int n = 0; n < 2; ++n) *(f32x4*)(rowp + bj * 128 + n * 16) = acc[ai][bj][m][n]; }
    }
};
struct EpiGate {
    const float* X1; const float* PLE; float* O;
    __device__ __forceinline__ static bool swap(const Unit&) { return false; }
    __device__ __forceinline__ void operator()(const f32x4 (&acc)[2][2][4][2], const Unit& u, int wr, int wc, int fr, int fq) const {
        const int row0 = u.pm * 256 + wr * 64 + fr, col0 = u.pn * 256 + wc * 32 + 4 * fq;
#pragma unroll
        for (int ai = 0; ai < 2; ++ai)
#pragma unroll
            for (int m = 0; m < 4; ++m) { const size_t ro = (size_t)(row0 + ai * 128 + m * 16) * 1024 + col0;
#pragma unroll
                for (int bj = 0; bj < 2; ++bj)
#pragma unroll
                    for (int n = 0; n < 2; ++n) { const size_t o = ro + bj * 128 + n * 16; const f32x4 x1 = *(const f32x4*)(X1 + o), pl = *(const f32x4*)(PLE + o), a = acc[ai][bj][m][n]; f32x4 r;
#pragma unroll
                        for (int j = 0; j < 4; ++j) r[j] = x1[j] + sigmoid_f(a[j]) * pl[j];
                        *(f32x4*)(O + o) = r; } }
    }
};
struct EpiInAttn {
    bf16_t *Zq, *Zk, *Zg, *vTp, *vTs; const float* tab; float* out;
    __device__ __forceinline__ static bool swap(const Unit& u) { return u.pn == 5; }
    __device__ __forceinline__ void operator()(const f32x4 (&acc)[2][2][4][2], const Unit& u, int wr, int wc, int fr, int fq) const {
        const int pn = u.pn;
        if (pn < 5) {
            const bool isq = pn < 4;
            const int fi = 16 * (wc & 1) + 4 * fq;
#pragma unroll
            for (int ai = 0; ai < 2; ++ai)
#pragma unroll
                for (int m = 0; m < 4; ++m) {
                    const int r = u.pm * 256 + ai * 128 + wr * 64 + m * 16 + fr;
                    const int pi = r < MP ? (r & 4095) : 4096 + ((r - MP) & 7);
                    const f32x4 t0 = *(const f32x4*)(tab + ((size_t)pi * 32 + fi) * 2), t1 = *(const f32x4*)(tab + ((size_t)pi * 32 + fi) * 2 + 4);
                    const float cs[4] = {t0[0], t0[2], t1[0], t1[2]}, sn[4] = {t0[1], t0[3], t1[1], t1[3]};
#pragma unroll
                    for (int bj = 0; bj < 2; ++bj) {
                        const f32x4 x1 = acc[ai][bj][m][0], x2 = acc[ai][bj][m][1]; f32x4 o1, o2;
#pragma unroll
                        for (int j = 0; j < 4; ++j) { o1[j] = x1[j] * cs[j] - x2[j] * sn[j]; o2[j] = x2[j] * cs[j] + x1[j] * sn[j]; }
                        const int hh = 2 * bj + (wc >> 1), d1 = 16 * (wc & 1) + 4 * fq;
                        if (isq) {
                            bf16_t* p = Zq + (size_t)r * 1024 + pn * 256 + hh * 64 + d1;
                            *(u32x2*)p = pk4(o1 * 0.125f); *(u32x2*)(p + 32) = pk4(o2 * 0.125f);
                        } else {
                            bf16_t* p = Zk + (size_t)r * 256 + hh * 64 + d1;
                            *(u32x2*)p = pk4(o1); *(u32x2*)(p + 32) = pk4(o2);
                            if (r < MP) { const int t = r & 4095; if (t >= 3968) { float* dst = out + OFF_KWP + ((size_t)((r >> 12) * 128 + t - 3968) * 4 + hh) * 64 + d1; *(f32x4*)dst = o1; *(f32x4*)(dst + 32) = o2; } }
                            else { const int rs = r - MP; float* dst = out + OFF_KWS + ((size_t)((rs >> 3) * 128 + 120 + (rs & 7)) * 4 + hh) * 64 + d1; *(f32x4*)dst = o1; *(f32x4*)(dst + 32) = o2; }
                        }
                    }
                    asm volatile("" ::: "memory");
                }
        } else if (pn == 5) {
#pragma unroll
            for (int ai = 0; ai < 2; ++ai)
#pragma unroll
                for (int m = 0; m < 4; ++m) {
                    const int e = ai * 128 + wr * 64 + m * 16 + fr, kvh = e >> 6, d = e & 63;
#pragma unroll
                    for (int bj = 0; bj < 2; ++bj)
#pragma unroll
                        for (int n = 0; n < 2; ++n) {
                            const int tok = u.pm * 256 + bj * 128 + wc * 32 + n * 16 + 4 * fq; const f32x4 v = acc[ai][bj][m][n];
                            if (tok < MP) { const int b = tok >> 12, t = tok & 4095;
                                *(u32x2*)(vTp + ((size_t)((b * 4 + kvh) * 64 + d)) * 4096 + t) = pk4(v);
                                if (t >= 3968) {
#pragma unroll
                                    for (int jj = 0; jj < 4; ++jj) out[OFF_VWP + ((size_t)(b * 128 + t - 3968 + jj) * 4 + kvh) * 64 + d] = v[jj]; }
                            } else { const int ts = tok - MP, bs = ts >> 3, l0 = ts & 7;
                                *(u32x2*)(vTs + ((size_t)((bs * 4 + kvh) * 64 + d)) * 8 + l0) = pk4(v);
#pragma unroll
                                for (int jj = 0; jj < 4; ++jj) out[OFF_VWS + ((size_t)(bs * 128 + 120 + l0 + jj) * 4 + kvh) * 64 + d] = v[jj]; }
                        }
                }
        } else {
#pragma unroll
            for (int ai = 0; ai < 2; ++ai)
#pragma unroll
                for (int m = 0; m < 4; ++m) { const int r = u.pm * 256 + ai * 128 + wr * 64 + m * 16 + fr;
#pragma unroll
                    for (int bj = 0; bj < 2; ++bj)
#pragma unroll
                        for (int n = 0; n < 2; ++n) { const f32x4 a = acc[ai][bj][m][n]; f32x4 s;
#pragma unroll
                            for (int j = 0; j < 4; ++j) s[j] = silu_f(a[j]);
                            *(u32x2*)(Zg + (size_t)r * 1024 + (pn - 6) * 256 + bj * 128 + wc * 32 + n * 16 + 4 * fq) = pk4(s); } }
        }
    }
};
struct EpiInRet {
    bf16_t *Zq, *Zk, *Zg, *vTp, *vTs; const float* tab;
    __device__ __forceinline__ static bool swap(const Unit& u) { return u.pn >= 8 && u.pn < 16; }
    __device__ __forceinline__ void operator()(const f32x4 (&acc)[2][2][4][2], const Unit& u, int wr, int wc, int fr, int fq) const {
        const int pn = u.pn;
        if (pn < 8) {
            const bool isq = pn < 4; const float sc = isq ? 1.f : 0.0625f;
            bf16_t* Z = isq ? Zq : Zk; const int hc = (pn & 3) * 256;
#pragma unroll
            for (int ai = 0; ai < 2; ++ai)
#pragma unroll
                for (int m = 0; m < 4; ++m) {
                    const int r = u.pm * 256 + ai * 128 + wr * 64 + m * 16 + fr;
                    const int pi = r < MP ? (r & 4095) : 4096 + ((r - MP) & 7);
#pragma unroll
                    for (int n = 0; n < 2; ++n) {
                        const int d = wc * 32 + n * 16 + 4 * fq;
                        const f32x4 t0 = *(const f32x4*)(tab + ((size_t)pi * 128 + d) * 2), t1 = *(const f32x4*)(tab + ((size_t)pi * 128 + d) * 2 + 4);
                        const float cs[4] = {t0[0], t0[2], t1[0], t1[2]}, sn[4] = {t0[1], t0[3], t1[1], t1[3]};
                        const f32x4 x1 = acc[ai][0][m][n], x2 = acc[ai][1][m][n]; f32x4 o1, o2;
#pragma unroll
                        for (int j = 0; j < 4; ++j) { o1[j] = (x1[j] * cs[j] - x2[j] * sn[j]) * sc; o2[j] = (x2[j] * cs[j] + x1[j] * sn[j]) * sc; }
                        bf16_t* p = Z + (size_t)r * 1024 + hc + d;
                        *(u32x2*)p = pk4(o1); *(u32x2*)(p + 128) = pk4(o2);
                    }
                }
        } else if (pn < 16) {
#pragma unroll
            for (int ai = 0; ai < 2; ++ai)
#pragma unroll
                for (int m = 0; m < 4; ++m) {
                    const int eg = (pn - 8) * 256 + ai * 128 + wr * 64 + m * 16 + fr, h = eg >> 9, e = eg & 511;
#pragma unroll
                    for (int bj = 0; bj < 2; ++bj)
#pragma unroll
                        for (int n = 0; n < 2; ++n) {
                            const int tok = u.pm * 256 + bj * 128 + wc * 32 + n * 16 + 4 * fq; const u32x2 w = pk4(acc[ai][bj][m][n]);
                            if (tok < MP) { const int b = tok >> 12, t = tok & 4095; *(u32x2*)(vTp + ((size_t)((b * 4 + h) * 512 + e)) * 4096 + t) = w; }
                            else { const int ts = tok - MP, bs = ts >> 3, l0 = ts & 7; *(u32x2*)(vTs + ((size_t)((bs * 4 + h) * 512 + e)) * 8 + l0) = w; }
                        }
                }
        } else {
#pragma unroll
            for (int ai = 0; ai < 2; ++ai)
#pragma unroll
                for (int m = 0; m < 4; ++m) { const int r = u.pm * 256 + ai * 128 + wr * 64 + m * 16 + fr;
#pragma unroll
                    for (int bj = 0; bj < 2; ++bj)
#pragma unroll
                        for (int n = 0; n < 2; ++n) { const f32x4 a = acc[ai][bj][m][n]; f32x4 s;
#pragma unroll
                            for (int j = 0; j < 4; ++j) s[j] = silu_f(a[j]);
                            *(u32x2*)(Zg + (size_t)r * 2048 + (pn - 16) * 256 + bj * 128 + wc * 32 + n * 16 + 4 * fq) = pk4(s); } }
        }
    }
};

__device__ __forceinline__ void transpose_tile(const float* __restrict__ W, bf16_t* __restrict__ Wt, int K, int N, bool perm, int tile, LAS float* T) {
    const int tid = otid(), ntn = N >> 6;
    const int n0 = (tile % ntn) * 64, k0 = (tile / ntn) * 64, nn = tid & 63;
    const int nd = n0 + nn; int ns = nd;
    if (perm && nd < 1280) { const int p = nd & 63; ns = (nd - p) + (p >> 5) * 16 + (p & 15) + ((p >> 4) & 1) * 32; }
#pragma unroll
    for (int i = 0; i < 8; ++i) { const int kk = (tid >> 6) + 8 * i; T[kk * 65 + nn] = W[(size_t)(k0 + kk) * N + ns]; }
    __syncthreads();
    const int kk2 = (tid & 31) * 2;
#pragma unroll
    for (int i = 0; i < 4; ++i) { const int n2 = (tid >> 5) + 16 * i; *(unsigned*)(Wt + (size_t)(n0 + n2) * K + k0 + kk2) = cvt_pk_bf16(T[kk2 * 65 + n2], T[(kk2 + 1) * 65 + n2]); }
    __syncthreads();
}

__device__ __forceinline__ void rms_rows(const float* __restrict__ Xa, const float* __restrict__ Xb, const float* __restrict__ g, bf16_t* __restrict__ H, int G) {
    const int tid_o = otid(), wave = tid_o >> 6, lane = tid_o & 63;
    for (int row = blockIdx.x * 8 + wave; row < MT; row += G * 8) {
        const float* x = row < MP ? Xa + (size_t)row * 1024 : Xb + (size_t)(row - MP) * 1024;
        f32x4 v[4]; float ss = 0.f;
#pragma unroll
        for (int i = 0; i < 4; ++i) { v[i] = *(const f32x4*)(x + lane * 4 + 256 * i); ss += v[i][0] * v[i][0] + v[i][1] * v[i][1] + v[i][2] * v[i][2] + v[i][3] * v[i][3]; }
        ss = wave_sum(ss);
        const float rr = rsqrtf(ss * (1.f / 1024.f) + EPS);
#pragma unroll
        for (int i = 0; i < 4; ++i) { const f32x4 gg = *(const f32x4*)(g + lane * 4 + 256 * i); *(u32x2*)(H + (size_t)row * 1024 + lane * 4 + 256 * i) = pk4(v[i] * rr * gg); }
    }
}
__device__ __forceinline__ void resid_rows(const float* __restrict__ Xa, const float* __restrict__ Xb, const float* __restrict__ Y, const float* __restrict__ g, float* __restrict__ X1, bf16_t* __restrict__ H, int G) {
    const int tid_o = otid(), wave = tid_o >> 6, lane = tid_o & 63;
    for (int row = blockIdx.x * 8 + wave; row < MT; row += G * 8) {
        const float* x = row < MP ? Xa + (size_t)row * 1024 : Xb + (size_t)(row - MP) * 1024;
        const float* y = Y + (size_t)row * 1024;
        f32x4 v[4]; float ss = 0.f;
#pragma unroll
        for (int i = 0; i < 4; ++i) { v[i] = *(const f32x4*)(y + lane * 4 + 256 * i); ss += v[i][0] * v[i][0] + v[i][1] * v[i][1] + v[i][2] * v[i][2] + v[i][3] * v[i][3]; }
        ss = wave_sum(ss);
        const float rr = rsqrtf(ss * (1.f / 1024.f) + EPS);
#pragma unroll
        for (int i = 0; i < 4; ++i) { const int c = lane * 4 + 256 * i; const f32x4 gg = *(const f32x4*)(g + c), xx = *(const f32x4*)(x + c); const f32x4 o = xx + v[i] * rr * gg;
            *(f32x4*)(X1 + (size_t)row * 1024 + c) = o; *(u32x2*)(H + (size_t)row * 1024 + c) = pk4(o); }
    }
}

__device__ __forceinline__ void attn_prompt(LAS unsigned char* lds, const bf16_t* __restrict__ Zq, const bf16_t* __restrict__ Zk, const bf16_t* __restrict__ Zg, const bf16_t* __restrict__ vTp,
                                            const float* __restrict__ sinks, bf16_t* __restrict__ OG, int G) {
    LAS bf16_t* Ks = (LAS bf16_t*)lds;
    LAS bf16_t* Vt = (LAS bf16_t*)(lds + 256 * 72 * 2);
    const int tid = otid(), w = tid >> 6, lane = tid & 63, l16 = lane & 15, g = lane >> 4;
    for (int it = blockIdx.x; it < 512; it += G) {
        const int kvh = it & 3, nb = (it >> 2) & 31, b = it >> 7;
        __syncthreads();
#pragma unroll
        for (int i = 0; i < 4; ++i) { const int ch = tid + 512 * i, s = ch >> 3, c8 = ch & 7, t = (nb - 1) * 128 + s;
            u32x4 val = {0u, 0u, 0u, 0u}; if (t >= 0) val = *(const u32x4*)(Zk + (size_t)(b * 4096 + t) * 256 + kvh * 64 + c8 * 8);
            *(LAS u32x4*)(Ks + s * 72 + c8 * 8) = val; }
#pragma unroll
        for (int i = 0; i < 4; ++i) { const int ch = tid + 512 * i, d = ch >> 5, s0 = (ch & 31) * 8, t0 = (nb - 1) * 128 + s0;
            u32x4 val = {0u, 0u, 0u, 0u}; if (t0 >= 0) val = *(const u32x4*)(vTp + ((size_t)((b * 4 + kvh) * 64 + d)) * 4096 + t0);
            *(LAS u32x4*)(Vt + d * 264 + s0) = val; }
        __syncthreads();
        const int head = kvh * 4 + (w >> 1);
        const float sk = sinks[head];
        for (int qi = 0; qi < 4; ++qi) {
            const int qt = (w & 1) * 4 + qi;
            const size_t tq = (size_t)b * 4096 + nb * 128 + qt * 16 + l16;
            bf16x8 qf[2];
#pragma unroll
            for (int ks = 0; ks < 2; ++ks) qf[ks] = *(const bf16x8*)(Zq + tq * 1024 + head * 64 + ks * 32 + g * 8);
            f32x4 sa[9];
#pragma unroll
            for (int j = 0; j < 9; ++j) { sa[j] = (f32x4){0.f, 0.f, 0.f, 0.f};
#pragma unroll
                for (int ks = 0; ks < 2; ++ks) { const bf16x8 kf = *(const LAS bf16x8*)(Ks + (16 * (qt + j) + l16) * 72 + ks * 32 + g * 8);
                    sa[j] = __builtin_amdgcn_mfma_f32_16x16x32_bf16(kf, qf[ks], sa[j], 0, 0, 0); } }
            float mx = sk;
#pragma unroll
            for (int j = 0; j < 9; ++j)
#pragma unroll
                for (int r = 0; r < 4; ++r) {
                    bool vis = true;
                    if (j == 0) vis = (4 * g + r) > l16;
                    if (j == 8) vis = (4 * g + r) <= l16;
                    if (nb == 0 && (qt + j) < 8) vis = false;
                    sa[j][r] = vis ? sa[j][r] : -1e30f;
                    mx = fmaxf(mx, sa[j][r]);
                }
            mx = fmaxf(mx, __shfl_xor(mx, 16, 64)); mx = fmaxf(mx, __shfl_xor(mx, 32, 64));
            float sum = 0.f;
#pragma unroll
            for (int j = 0; j < 9; ++j)
#pragma unroll
                for (int r = 0; r < 4; ++r) { const float p = __expf(sa[j][r] - mx); sa[j][r] = p; sum += p; }
            sum += __shfl_xor(sum, 16, 64); sum += __shfl_xor(sum, 32, 64);
            const float inv = 1.f / (sum + __expf(sk - mx));
            f32x4 oa[4];
#pragma unroll
            for (int dt = 0; dt < 4; ++dt) oa[dt] = (f32x4){0.f, 0.f, 0.f, 0.f};
#pragma unroll
            for (int u = 0; u < 5; ++u) {
                u32x4 pw; pw.x = cvt_pk_bf16(sa[2 * u][0], sa[2 * u][1]); pw.y = cvt_pk_bf16(sa[2 * u][2], sa[2 * u][3]);
                if (u < 4) { pw.z = cvt_pk_bf16(sa[2 * u + 1][0], sa[2 * u + 1][1]); pw.w = cvt_pk_bf16(sa[2 * u + 1][2], sa[2 * u + 1][3]); } else { pw.z = 0u; pw.w = 0u; }
                const bf16x8 pf = __builtin_bit_cast(bf16x8, pw);
                const int k0 = 16 * (qt + 2 * u) + 4 * g, k1 = (u < 4) ? k0 + 16 : k0;
#pragma unroll
                for (int dt = 0; dt < 4; ++dt) {
                    const u32x2 v0 = *(const LAS u32x2*)(Vt + (16 * dt + l16) * 264 + k0), v1 = *(const LAS u32x2*)(Vt + (16 * dt + l16) * 264 + k1);
                    u32x4 vw; vw.x = v0.x; vw.y = v0.y; vw.z = v1.x; vw.w = v1.y;
                    oa[dt] = __builtin_amdgcn_mfma_f32_16x16x32_bf16(__builtin_bit_cast(bf16x8, vw), pf, oa[dt], 0, 0, 0);
                }
            }
#pragma unroll
            for (int dt = 0; dt < 4; ++dt) {
                const size_t o = tq * 1024 + head * 64 + 16 * dt + 4 * g;
                const u32x2 gw = *(const u32x2*)(Zg + o);
                f32x4 r; r[0] = oa[dt][0] * inv * bflo(gw.x); r[1] = oa[dt][1] * inv * bfhi(gw.x); r[2] = oa[dt][2] * inv * bflo(gw.y); r[3] = oa[dt][3] * inv * bfhi(gw.y);
                *(u32x2*)(OG + o) = pk4(r);
            }
        }
    }
}

__device__ __forceinline__ void attn_sample(LAS unsigned char* lds, const Params& P, const bf16_t* __restrict__ Zq, const bf16_t* __restrict__ Zk, const bf16_t* __restrict__ Zg, const bf16_t* __restrict__ vTs,
                                            bf16_t* __restrict__ OG, int G) {
    LAS float* Kc = (LAS float*)lds;
    LAS float* Vc = Kc + 136 * 68;
    LAS float* Qs = Vc + 136 * 68;
    LAS float* Sc = Qs + 32 * 68;
    const int tid = otid();
    for (int it = blockIdx.x; it < 512; it += G) {
        const int bs = it >> 2, kvh = it & 3;
        __syncthreads();
#pragma unroll
        for (int i = 0; i < 4; ++i) { const int ch = tid + 512 * i, j = ch >> 4, d4 = (ch & 15) * 4;
            const size_t src = ((size_t)(bs * 128 + j) * 4 + kvh) * 64 + d4;
            const f32x4 kv = *(const f32x4*)(P.cache_k + src), vv = *(const f32x4*)(P.cache_v + src);
            *(LAS f32x4*)(Kc + j * 68 + d4) = kv; *(LAS f32x4*)(Vc + j * 68 + d4) = vv;
            if (j >= 8) { const size_t dst = ((size_t)(bs * 128 + j - 8) * 4 + kvh) * 64 + d4; *(f32x4*)(P.out + OFF_KWS + dst) = kv; *(f32x4*)(P.out + OFF_VWS + dst) = vv; } }
        { const int l = tid >> 6, d = tid & 63;
          Kc[(128 + l) * 68 + d] = bf2f(Zk[(size_t)(MP + bs * 8 + l) * 256 + kvh * 64 + d]);
          Vc[(128 + l) * 68 + d] = bf2f(vTs[((size_t)((bs * 4 + kvh) * 64 + d)) * 8 + l]); }
#pragma unroll
        for (int i = 0; i < 4; ++i) { const int e = tid + 512 * i, rr = e >> 6, d = e & 63, hq = rr >> 3, l = rr & 7;
            Qs[rr * 68 + d] = bf2f(Zq[(size_t)(MP + bs * 8 + l) * 1024 + (kvh * 4 + hq) * 64 + d]); }
        __syncthreads();
        const int rr = tid >> 4, kl = tid & 15, l = rr & 7, hq = rr >> 3, head = kvh * 4 + hq;
        const float sk = P.sinks[head];
        float mx = sk;
#pragma unroll 1
        for (int m = 0; m < 9; ++m) {
            const int key = kl + 16 * m;
            if (key < 136) {
                float dot = -1e30f;
                const bool vis = key < 128 ? (key > l) : ((key - 128) <= l);
                if (vis) { float a = 0.f;
#pragma unroll
                    for (int d4 = 0; d4 < 16; ++d4) { const f32x4 q = *(const LAS f32x4*)(Qs + rr * 68 + d4 * 4), k = *(const LAS f32x4*)(Kc + key * 68 + d4 * 4); a += q[0] * k[0] + q[1] * k[1] + q[2] * k[2] + q[3] * k[3]; }
                    dot = a; }
                Sc[rr * 140 + key] = dot; mx = fmaxf(mx, dot);
            }
        }
#pragma unroll
        for (int o = 1; o < 16; o <<= 1) mx = fmaxf(mx, __shfl_xor(mx, o, 64));
        float sum = 0.f;
#pragma unroll 1
        for (int m = 0; m < 9; ++m) { const int key = kl + 16 * m;
            if (key < 136) { const float sv = Sc[rr * 140 + key]; const float p = sv > -1e29f ? __expf(sv - mx) : 0.f; sum += p; Sc[rr * 140 + key] = p; } }
#pragma unroll
        for (int o = 1; o < 16; o <<= 1) sum += __shfl_xor(sum, o, 64);
        const float inv = 1.f / (sum + __expf(sk - mx));
        __syncthreads();
        f32x4 o = {0.f, 0.f, 0.f, 0.f};
        for (int key = 0; key < 136; ++key) { const float p = Sc[rr * 140 + key]; const f32x4 v = *(const LAS f32x4*)(Vc + key * 68 + kl * 4); o += v * p; }
        const size_t oo = (size_t)(MP + bs * 8 + l) * 1024 + head * 64 + kl * 4;
        const u32x2 gw = *(const u32x2*)(Zg + oo);
        f32x4 r; r[0] = o[0] * inv * bflo(gw.x); r[1] = o[1] * inv * bfhi(gw.x); r[2] = o[2] * inv * bflo(gw.y); r[3] = o[3] * inv * bfhi(gw.y);
        *(u32x2*)(OG + oo) = pk4(r);
    }
}

__device__ __forceinline__ void ret_A(LAS unsigned char* lds, const bf16_t* __restrict__ Zq, const bf16_t* __restrict__ Zk, bf16_t* __restrict__ ABUF, bf16_t* __restrict__ KDT, int G) {
    LAS bf16_t* Qs = (LAS bf16_t*)lds;
    LAS bf16_t* Ks = (LAS bf16_t*)(lds + 128 * 264 * 2);
    const int tid = otid(), w = tid >> 6, lane = tid & 63, l16 = lane & 15, g = lane >> 4;
    for (int it = blockIdx.x; it < 512; it += G) {
        const int c = it & 31, h = (it >> 5) & 3, b = it >> 7;
        const float lg = ret_lg(h);
        const size_t tok0 = (size_t)b * 4096 + c * 128;
        __syncthreads();
#pragma unroll
        for (int i = 0; i < 8; ++i) { const int ch = tid + 512 * i, s = ch >> 5, c8 = (ch & 31) * 8; const size_t src = (tok0 + s) * 1024 + h * 256 + c8;
            *(LAS u32x4*)(Qs + s * 264 + c8) = *(const u32x4*)(Zq + src); *(LAS u32x4*)(Ks + s * 264 + c8) = *(const u32x4*)(Zk + src); }
        __syncthreads();
        const int i_row = 16 * w + l16;
#pragma unroll
        for (int nt = 0; nt < 8; ++nt) {
            f32x4 a = {0.f, 0.f, 0.f, 0.f};
            if (nt <= w) {
#pragma unroll
                for (int ks = 0; ks < 8; ++ks) { const bf16x8 kf = *(const LAS bf16x8*)(Ks + (16 * nt + l16) * 264 + ks * 32 + g * 8), qf = *(const LAS bf16x8*)(Qs + i_row * 264 + ks * 32 + g * 8);
                    a = __builtin_amdgcn_mfma_f32_16x16x32_bf16(kf, qf, a, 0, 0, 0); }
#pragma unroll
                for (int r = 0; r < 4; ++r) { const int s = 16 * nt + 4 * g + r; a[r] = (s <= i_row) ? a[r] * __expf((float)(i_row - s) * lg) : 0.f; }
            }
            *(u32x2*)(ABUF + ((size_t)it * 128 + i_row) * 128 + 16 * nt + 4 * g) = pk4(a);
        }
        { const int d = tid & 255, sg0 = tid >> 8;
#pragma unroll
          for (int k = 0; k < 8; ++k) { const int s0 = 8 * (sg0 + 2 * k); float v[8];
#pragma unroll
              for (int jj = 0; jj < 8; ++jj) v[jj] = bf2f(Ks[(s0 + jj) * 264 + d]) * __expf((float)(127 - s0 - jj) * lg);
              u32x4 wv; wv.x = cvt_pk_bf16(v[0], v[1]); wv.y = cvt_pk_bf16(v[2], v[3]); wv.z = cvt_pk_bf16(v[4], v[5]); wv.w = cvt_pk_bf16(v[6], v[7]);
              *(u32x4*)(KDT + ((size_t)it * 256 + d) * 128 + s0) = wv; } }
    }
}

__device__ __forceinline__ void ret_seq(LAS unsigned char* lds, const bf16_t* __restrict__ Zq, const bf16_t* __restrict__ vTp, const bf16_t* __restrict__ ABUF, const bf16_t* __restrict__ KDT,
                                        float* __restrict__ ORET, float* __restrict__ out, int G) {
    LAS bf16_t* ST = (LAS bf16_t*)lds;
    const int tid = otid(), w = tid >> 6, lane = tid & 63, l16 = lane & 15, g = lane >> 4;
    for (int u = blockIdx.x; u < 256; u += G) {
        const int xcd = u & 7, slot = u >> 3, bh = xcd * 2 + (slot >> 4), es = slot & 15, b = bh >> 2, h = bh & 3;
        const float lg = ret_lg(h), g128 = __expf(128.f * lg), gi = __expf((float)(16 * w + l16 + 1) * lg);
        __syncthreads();
        for (int e = tid; e < 2 * 32 * 264 / 2; e += NT) ((LAS unsigned*)ST)[e] = 0u;
        f32x4 sacc[2][2];
#pragma unroll
        for (int dt = 0; dt < 2; ++dt)
#pragma unroll
            for (int et = 0; et < 2; ++et) sacc[dt][et] = (f32x4){0.f, 0.f, 0.f, 0.f};
        __syncthreads();
        for (int c = 0; c < 32; ++c) {
            const int buf = c & 1; const size_t item = (size_t)bh * 32 + c; const size_t tok0 = (size_t)b * 4096 + c * 128;
            bf16x8 vf[2][4], af[4], qf[8], kf[2][4];
#pragma unroll
            for (int et = 0; et < 2; ++et)
#pragma unroll
                for (int ks = 0; ks < 4; ++ks) vf[et][ks] = *(const bf16x8*)(vTp + ((size_t)bh * 512 + es * 32 + 16 * et + l16) * 4096 + c * 128 + 32 * ks + 8 * g);
#pragma unroll
            for (int ks = 0; ks < 4; ++ks) af[ks] = *(const bf16x8*)(ABUF + (item * 128 + 16 * w + l16) * 128 + 32 * ks + 8 * g);
#pragma unroll
            for (int kd = 0; kd < 8; ++kd) qf[kd] = *(const bf16x8*)(Zq + (tok0 + 16 * w + l16) * 1024 + h * 256 + 32 * kd + 8 * g);
#pragma unroll
            for (int dt = 0; dt < 2; ++dt)
#pragma unroll
                for (int ks = 0; ks < 4; ++ks) kf[dt][ks] = *(const bf16x8*)(KDT + (item * 256 + 32 * w + 16 * dt + l16) * 128 + 32 * ks + 8 * g);
#pragma unroll
            for (int et = 0; et < 2; ++et) {
                f32x4 oin = {0.f, 0.f, 0.f, 0.f}, ocr = {0.f, 0.f, 0.f, 0.f};
#pragma unroll
                for (int ks = 0; ks < 4; ++ks) oin = __builtin_amdgcn_mfma_f32_16x16x32_bf16(vf[et][ks], af[ks], oin, 0, 0, 0);
#pragma unroll
                for (int kd = 0; kd < 8; ++kd) { const bf16x8 sf = *(const LAS bf16x8*)(ST + (buf * 32 + 16 * et + l16) * 264 + 32 * kd + 8 * g);
                    ocr = __builtin_amdgcn_mfma_f32_16x16x32_bf16(sf, qf[kd], ocr, 0, 0, 0); }
                *(f32x4*)(ORET + (tok0 + 16 * w + l16) * 2048 + h * 512 + es * 32 + 16 * et + 4 * g) = oin + ocr * gi;
            }
#pragma unroll
            for (int dt = 0; dt < 2; ++dt)
#pragma unroll
                for (int et = 0; et < 2; ++et) {
                    f32x4 s = sacc[dt][et] * g128;
#pragma unroll
                    for (int ks = 0; ks < 4; ++ks) s = __builtin_amdgcn_mfma_f32_16x16x32_bf16(kf[dt][ks], vf[et][ks], s, 0, 0, 0);
                    sacc[dt][et] = s;
                    *(LAS u32x2*)(ST + ((buf ^ 1) * 32 + 16 * et + l16) * 264 + 32 * w + 16 * dt + 4 * g) = pk4(s);
                }
            __syncthreads();
        }
#pragma unroll
        for (int dt = 0; dt < 2; ++dt)
#pragma unroll
            for (int et = 0; et < 2; ++et)
#pragma unroll
                for (int r = 0; r < 4; ++r) out[OFF_RSP + ((size_t)bh * 256 + 32 * w + 16 * dt + 4 * g + r) * 512 + es * 32 + 16 * et + l16] = sacc[dt][et][r];
    }
}

__device__ __forceinline__ void ret_sample(LAS unsigned char* lds, const Params& P, const bf16_t* __restrict__ Zq, const bf16_t* __restrict__ Zk, const bf16_t* __restrict__ vTs, float* __restrict__ ORET, int G) {
    LAS float* qs = (LAS float*)lds;
    LAS float* kds = qs + 2048;
    LAS float* A8 = kds + 2048;
    LAS float* red = A8 + 64;
    const int tid = otid();
    for (int it = blockIdx.x; it < 512; it += G) {
        const int bs = it >> 2, h = it & 3;
        const float lg = ret_lg(h), g8 = __expf(8.f * lg), ig8 = __expf(-8.f * lg);
        __syncthreads();
#pragma unroll
        for (int k = 0; k < 4; ++k) { const int e = tid + 512 * k, i = e >> 8, d = e & 255; const size_t src = (size_t)(MP + bs * 8 + i) * 1024 + h * 256 + d;
            qs[d * 8 + i] = bf2f(Zq[src]) * __expf((float)(i + 1) * lg); kds[d * 8 + i] = bf2f(Zk[src]) * __expf((float)(7 - i) * lg); }
        __syncthreads();
        if (tid < 64) { const int i = tid >> 3, s = tid & 7; float a = 0.f;
            if (s <= i) { for (int d = 0; d < 256; ++d) a += qs[d * 8 + i] * kds[d * 8 + s]; a *= ig8; }
            A8[tid] = a; }
        const int eg = tid & 127, dp = tid >> 7, e0 = 4 * eg;
        float vv[8][4];
#pragma unroll
        for (int jj = 0; jj < 4; ++jj) { const u32x4 wv = *(const u32x4*)(vTs + ((size_t)((bs * 4 + h) * 512 + e0 + jj)) * 8);
            vv[0][jj] = bflo(wv.x); vv[1][jj] = bfhi(wv.x); vv[2][jj] = bflo(wv.y); vv[3][jj] = bfhi(wv.y); vv[4][jj] = bflo(wv.z); vv[5][jj] = bfhi(wv.z); vv[6][jj] = bflo(wv.w); vv[7][jj] = bfhi(wv.w); }
        f32x4 cr[8];
#pragma unroll
        for (int i = 0; i < 8; ++i) cr[i] = (f32x4){0.f, 0.f, 0.f, 0.f};
        const size_t sbase = ((size_t)(bs * 4 + h) * 256) * 512 + e0;
#pragma unroll 4
        for (int dd = 0; dd < 64; ++dd) {
            const int d = dp * 64 + dd;
            const f32x4 st = *(const f32x4*)(P.state_ret + sbase + (size_t)d * 512);
            const f32x4 qa = *(const LAS f32x4*)(qs + d * 8), qb = *(const LAS f32x4*)(qs + d * 8 + 4), ka = *(const LAS f32x4*)(kds + d * 8), kb = *(const LAS f32x4*)(kds + d * 8 + 4);
            const float q8[8] = {qa[0], qa[1], qa[2], qa[3], qb[0], qb[1], qb[2], qb[3]}, k8[8] = {ka[0], ka[1], ka[2], ka[3], kb[0], kb[1], kb[2], kb[3]};
            f32x4 ns = st * g8;
#pragma unroll
            for (int s = 0; s < 8; ++s)
#pragma unroll
                for (int jj = 0; jj < 4; ++jj) ns[jj] += k8[s] * vv[s][jj];
            *(f32x4*)(P.out + OFF_RSS + sbase + (size_t)d * 512) = ns;
#pragma unroll
            for (int i = 0; i < 8; ++i) cr[i] += st * q8[i];
        }
#pragma unroll
        for (int i = 0; i < 8; ++i) *(LAS f32x4*)(red + (dp * 8 + i) * 512 + e0) = cr[i];
        __syncthreads();
        { const int i = tid >> 6, e8 = (tid & 63) * 8;
          float o[8];
#pragma unroll
          for (int jj = 0; jj < 8; ++jj) o[jj] = red[(0 * 8 + i) * 512 + e8 + jj] + red[(1 * 8 + i) * 512 + e8 + jj] + red[(2 * 8 + i) * 512 + e8 + jj] + red[(3 * 8 + i) * 512 + e8 + jj];
#pragma unroll
          for (int jj = 0; jj < 8; ++jj) { const u32x4 wv = *(const u32x4*)(vTs + ((size_t)((bs * 4 + h) * 512 + e8 + jj)) * 8);
              const float v8[8] = {bflo(wv.x), bfhi(wv.x), bflo(wv.y), bfhi(wv.y), bflo(wv.z), bfhi(wv.z), bflo(wv.w), bfhi(wv.w)};
#pragma unroll
              for (int s = 0; s < 8; ++s) o[jj] += A8[i * 8 + s] * v8[s]; }
          float* dst = ORET + (size_t)(MP + bs * 8 + i) * 2048 + h * 512 + e8;
          *(f32x4*)dst = (f32x4){o[0], o[1], o[2], o[3]}; *(f32x4*)(dst + 4) = (f32x4){o[4], o[5], o[6], o[7]}; }
    }
}

__device__ __forceinline__ void ret_gnorm(const float* __restrict__ ORET, const bf16_t* __restrict__ Zg, bf16_t* __restrict__ OG, int G) {
    const int tid_o = otid(), wave = tid_o >> 6, lane = tid_o & 63;
    for (int task = blockIdx.x * 8 + wave; task < MT * 4; task += G * 8) {
        const size_t o = (size_t)(task >> 2) * 2048 + (task & 3) * 512 + lane * 8;
        const f32x4 a = *(const f32x4*)(ORET + o), b = *(const f32x4*)(ORET + o + 4);
        const float mu = wave_sum(a[0] + a[1] + a[2] + a[3] + b[0] + b[1] + b[2] + b[3]) * (1.f / 512.f);
        const f32x4 da = a - mu, db = b - mu;
        const float var = wave_sum(da[0] * da[0] + da[1] * da[1] + da[2] * da[2] + da[3] * da[3] + db[0] * db[0] + db[1] * db[1] + db[2] * db[2] + db[3] * db[3]) * (1.f / 512.f);
        const float rs = rsqrtf(var + EPS);
        const u32x4 gw = *(const u32x4*)(Zg + o);
        u32x4 r;
        r.x = cvt_pk_bf16(da[0] * rs * bflo(gw.x), da[1] * rs * bfhi(gw.x)); r.y = cvt_pk_bf16(da[2] * rs * bflo(gw.y), da[3] * rs * bfhi(gw.y));
        r.z = cvt_pk_bf16(db[0] * rs * bflo(gw.z), db[1] * rs * bfhi(gw.z)); r.w = cvt_pk_bf16(db[2] * rs * bflo(gw.w), db[3] * rs * bfhi(gw.w));
        *(u32x4*)(OG + o) = r;
    }
}

__global__ void __launch_bounds__(NT) hybrid_fwd(Params P) {
    extern __shared__ __attribute__((aligned(16))) unsigned char lds_raw[];
    LAS unsigned char* lds = (LAS unsigned char*)lds_raw;
    cg::grid_group grid = cg::this_grid();
    const int G = gridDim.x, tid = threadIdx.x;
    unsigned char* ws = P.ws;
    bf16_t* WT_IN_ATTN = (bf16_t*)(ws + WS_WT_IN_ATTN); bf16_t* WT_OUT_ATTN = (bf16_t*)(ws + WS_WT_OUT_ATTN); bf16_t* WT_IN_RET = (bf16_t*)(ws + WS_WT_IN_RET); bf16_t* WT_OUT_RET = (bf16_t*)(ws + WS_WT_OUT_RET);
    bf16_t* WT_GATE = (bf16_t*)(ws + WS_WT_GATE); bf16_t* WT_PLE = (bf16_t*)(ws + WS_WT_PLE);
    float* TABA = (float*)(ws + WS_TABA); float* TABR = (float*)(ws + WS_TABR);
    bf16_t* H = (bf16_t*)(ws + WS_H); bf16_t* PB = (bf16_t*)(ws + WS_PB);
    float* PLE = (float*)(ws + WS_PLE); float* Y = (float*)(ws + WS_Y); float* X1 = (float*)(ws + WS_X1); float* X2 = (float*)(ws + WS_X2);
    bf16_t* OG = (bf16_t*)(ws + WS_OG); bf16_t* ZQ = (bf16_t*)(ws + WS_ZQ); bf16_t* ZK = (bf16_t*)(ws + WS_ZK); bf16_t* ZG = (bf16_t*)(ws + WS_ZG);
    bf16_t* VTP = (bf16_t*)(ws + WS_VTP); bf16_t* VTS = (bf16_t*)(ws + WS_VTS); bf16_t* ABUF = (bf16_t*)(ws + WS_ABUF); bf16_t* KDT = (bf16_t*)(ws + WS_KDT); float* ORET = (float*)(ws + WS_ORET);
    pg8::StaticOrder SO;
    volatile LAS unsigned* bst = (volatile LAS unsigned*)(lds + LDS_BYTES - 16);
    if (tid < 4) bst[tid] = 0u;
    __syncthreads();
    const XcdBarrier xbar = xcd_barrier_post((unsigned*)(ws + WS_BAR), bst);
#define GSYNC() xcd_barrier(xbar)

for (int rep_ = 0; rep_ < REP_P0; ++rep_) {
    for (int t = blockIdx.x; t < 3584; t += G) {
        LAS float* T = (LAS float*)lds;
        if (t < 640) transpose_tile(P.w_in_attn, WT_IN_ATTN, 1024, 2560, true, t, T);
        else if (t < 896) transpose_tile(P.w_out_attn, WT_OUT_ATTN, 1024, 1024, false, t - 640, T);
        else if (t < 2432) transpose_tile(P.w_in_ret, WT_IN_RET, 1024, 6144, false, t - 896, T);
        else if (t < 2944) transpose_tile(P.w_out_ret, WT_OUT_RET, 2048, 1024, false, t - 2432, T);
        else if (t < 3200) transpose_tile(P.w_gate, WT_GATE, 1024, 1024, false, t - 2944, T);
        else if (t < 3456) transpose_tile(P.w_gate + 1024 * 1024, WT_GATE + 1024 * 1024, 1024, 1024, false, t - 3200, T);
        else if (t < 3520) transpose_tile(P.w_ple, WT_PLE, 256, 1024, false, t - 3456, T);
        else transpose_tile(P.w_ple + 256 * 1024, WT_PLE + 1024 * 256, 256, 1024, false, t - 3520, T);
    }
    for (int e = blockIdx.x * NT + tid; e < 4104 * 160; e += G * NT) {
        const int pi = e / 160, f = e % 160; const int pos = pi < 4096 ? pi : 16384 + (pi - 4096);
        if (f < 32) { const float inv = powf(10000.f, -(float)f / 32.f), ang = (float)pos * inv; TABA[((size_t)pi * 32 + f) * 2] = cosf(ang); TABA[((size_t)pi * 32 + f) * 2 + 1] = sinf(ang); }
        else { const int f2 = f - 32; const float inv = powf(10000.f, -(float)f2 / 128.f), ang = (float)pos * inv; TABR[((size_t)pi * 128 + f2) * 2] = cosf(ang); TABR[((size_t)pi * 128 + f2) * 2 + 1] = sinf(ang); }
    }
    for (int e = blockIdx.x * NT + tid; e < 2 * MT * 64; e += G * NT) {
        const int i = e / (MT * 64), rem = e % (MT * 64), row = rem >> 6, c4 = (rem & 63) * 4;
        const float* src = row < MP ? P.p_prompt + ((size_t)i * MP + row) * 256 + c4 : P.p_sample + ((size_t)i * MS + row - MP) * 256 + c4;
        *(u32x2*)(PB + ((size_t)i * MT + row) * 256 + c4) = pk4(*(const f32x4*)src);
    }
    rms_rows(P.x_prompt, P.x_sample, P.pre_norm, H, G);
}
    grid.sync();

for (int rep_ = 0; rep_ < REP_GIN; ++rep_) {
    { pg8::Gemm g{H, WT_IN_ATTN, MT, 2560, 1024}; SO.init(MT, 2560, G, blockIdx.x);
      EpiInAttn E{ZQ, ZK, ZG, VTP, VTS, TABA, P.out}; pg8::gemm_phase(lds, g, SO, E); }
    { pg8::Gemm g{PB, WT_PLE, MT, 1024, 256}; SO.init(MT, 1024, G, blockIdx.x);
      EpiF32 E{PLE, 1024}; pg8::gemm_phase(lds, g, SO, E); }
}
    GSYNC();

for (int rep_ = 0; rep_ < REP_ATT; ++rep_) {
    attn_prompt(lds, ZQ, ZK, ZG, VTP, P.sinks, OG, G);
    attn_sample(lds, P, ZQ, ZK, ZG, VTS, OG, G);
}
    GSYNC();

for (int rep_ = 0; rep_ < REP_GN1; ++rep_) {
    { pg8::Gemm g{OG, WT_OUT_ATTN, MT, 1024, 1024}; SO.init(MT, 1024, G, blockIdx.x); EpiF32 E{Y, 1024}; pg8::gemm_phase(lds, g, SO, E); }
}
    GSYNC();
for (int rep_ = 0; rep_ < REP_ROW; ++rep_) {
    resid_rows(P.x_prompt, P.x_sample, Y, P.post_norm, X1, H, G);
}
    GSYNC();
for (int rep_ = 0; rep_ < REP_GN1; ++rep_) {
    { pg8::Gemm g{H, WT_GATE, MT, 1024, 1024}; SO.init(MT, 1024, G, blockIdx.x); EpiGate E{X1, PLE, X2}; pg8::gemm_phase(lds, g, SO, E); }
}
    GSYNC();
for (int rep_ = 0; rep_ < REP_ROW; ++rep_) {
    rms_rows(X2, X2 + (size_t)MP * 1024, P.pre_norm + 1024, H, G);
}
    GSYNC();
for (int rep_ = 0; rep_ < REP_GIN; ++rep_) {
    { pg8::Gemm g{H, WT_IN_RET, MT, 6144, 1024}; SO.init(MT, 6144, G, blockIdx.x);
      EpiInRet E{ZQ, ZK, ZG, VTP, VTS, TABR}; pg8::gemm_phase(lds, g, SO, E); }
    { pg8::Gemm g{PB + (size_t)MT * 256, WT_PLE + 1024 * 256, MT, 1024, 256}; SO.init(MT, 1024, G, blockIdx.x);
      EpiF32 E{PLE, 1024}; pg8::gemm_phase(lds, g, SO, E); }
}
    GSYNC();
for (int rep_ = 0; rep_ < REP_RA; ++rep_) {
    ret_A(lds, ZQ, ZK, ABUF, KDT, G);
}
    GSYNC();
for (int rep_ = 0; rep_ < REP_RS; ++rep_) {
    ret_seq(lds, ZQ, VTP, ABUF, KDT, ORET, P.out, G);
}
for (int rep_ = 0; rep_ < REP_RSMP; ++rep_) {
    ret_sample(lds, P, ZQ, ZK, VTS, ORET, G);
}
for (int rep_ = 0; rep_ < REP_SYNC; ++rep_) GSYNC();
    GSYNC();
for (int rep_ = 0; rep_ < REP_ROW; ++rep_) {
    ret_gnorm(ORET, ZG, OG, G);
}
    GSYNC();
for (int rep_ = 0; rep_ < REP_GN1; ++rep_) {
    { pg8::Gemm g{OG, WT_OUT_RET, MT, 1024, 2048}; SO.init(MT, 1024, G, blockIdx.x); EpiF32 E{Y, 1024}; pg8::gemm_phase(lds, g, SO, E); }
}
    GSYNC();
for (int rep_ = 0; rep_ < REP_ROW; ++rep_) {
    resid_rows(X2, X2 + (size_t)MP * 1024, Y, P.post_norm + 1024, X1, H, G);
}
    GSYNC();
for (int rep_ = 0; rep_ < REP_GN1; ++rep_) {
    { pg8::Gemm g{H, WT_GATE + 1024 * 1024, MT, 1024, 1024}; SO.init(MT, 1024, G, blockIdx.x); EpiGate E{X1, PLE, P.out}; pg8::gemm_phase(lds, g, SO, E); }
}
}

extern "C" void kernel_launch(void* const* d_in, const int* in_sizes, int n_in, void* d_out, int out_size, void* d_ws, size_t ws_size, hipStream_t stream) {
    static int grid_blocks = 0;
    if (!grid_blocks) {
        int dev = 0, cus = 0, per_cu = 0;
        hipGetDevice(&dev);
        hipDeviceGetAttribute(&cus, hipDeviceAttributeMultiprocessorCount, dev);
        hipFuncSetAttribute((const void*)hybrid_fwd, hipFuncAttributeMaxDynamicSharedMemorySize, LDS_BYTES);
        hipOccupancyMaxActiveBlocksPerMultiprocessor(&per_cu, (const void*)hybrid_fwd, NT, LDS_BYTES);
        if (per_cu < 1) per_cu = 1;
        if (per_cu > 1) per_cu = 1;
        grid_blocks = cus * per_cu;
        if (ws_size < WS_END) fprintf(stderr, "kernel_launch: workspace too small: %zu < %zu\n", ws_size, (size_t)WS_END);
    }
    Params p{};
    p.x_prompt = (const float*)d_in[0]; p.x_sample = (const float*)d_in[1]; p.cache_k = (const float*)d_in[2]; p.cache_v = (const float*)d_in[3]; p.state_ret = (const float*)d_in[4];
    p.p_prompt = (const float*)d_in[5]; p.p_sample = (const float*)d_in[6]; p.pre_norm = (const float*)d_in[7]; p.post_norm = (const float*)d_in[8]; p.w_in_attn = (const float*)d_in[9];
    p.sinks = (const float*)d_in[10]; p.w_out_attn = (const float*)d_in[11]; p.w_in_ret = (const float*)d_in[12]; p.w_out_ret = (const float*)d_in[13]; p.w_ple = (const float*)d_in[14]; p.w_gate = (const float*)d_in[15];
    p.out = (float*)d_out; p.ws = (unsigned char*)d_ws;
    (void)hipMemsetAsync((unsigned char*)d_ws + WS_BAR, 0, 16384, stream);
    void* args[] = {&p};
    hipError_t e = hipLaunchCooperativeKernel((const void*)hybrid_fwd, dim3(grid_blocks), dim3(NT), args, LDS_BYTES, stream);
    if (e != hipSuccess) fprintf(stderr, "cooperative launch failed: %s (grid %d)\n", hipGetErrorString(e), grid_blocks);
}
```

```cpp
#include <hip/hip_runtime.h>
#include <hip/hip_cooperative_groups.h>
#include <cstdio>
#include <cstdint>
namespace cg = cooperative_groups;

#define LAS __attribute__((address_space(3)))
typedef unsigned short bf16_t;
typedef short bf16x8 __attribute__((ext_vector_type(8)));
typedef float f32x4 __attribute__((ext_vector_type(4)));
typedef float f32x2 __attribute__((ext_vector_type(2)));
typedef unsigned u32x2 __attribute__((ext_vector_type(2)));
typedef unsigned u32x4 __attribute__((ext_vector_type(4)));

constexpr int MP = 16384, MS = 1024, MT = MP + MS;
constexpr int NT = 512;
#define REP_P0 1
#define REP_GIN 1
#define REP_ATT 1
#define REP_RA 1
#define REP_RS 1
#define REP_RSMP 1
#define REP_SYNC 0
#define REP_ROW 1
#define REP_GN1 1
constexpr int LDS_BYTES = 140 * 1024;
constexpr float EPS = 1e-6f;

constexpr size_t OFF_YP = 0, OFF_YS = 16777216, OFF_KWP = 17825792, OFF_VWP = 17956864, OFF_KWS = 18087936, OFF_VWS = 22282240, OFF_RSP = 26476544, OFF_RSS = 28573696;

constexpr size_t al256(size_t x) { return (x + 255) & ~(size_t)255; }
constexpr size_t WS_WT_IN_ATTN = 0;
constexpr size_t WS_WT_OUT_ATTN = WS_WT_IN_ATTN + (size_t)2560 * 1024 * 2;
constexpr size_t WS_WT_IN_RET = WS_WT_OUT_ATTN + (size_t)1024 * 1024 * 2;
constexpr size_t WS_WT_OUT_RET = WS_WT_IN_RET + (size_t)6144 * 1024 * 2;
constexpr size_t WS_WT_GATE = WS_WT_OUT_RET + (size_t)1024 * 2048 * 2;
constexpr size_t WS_WT_PLE = WS_WT_GATE + (size_t)2 * 1024 * 1024 * 2;
constexpr size_t WS_TABA = WS_WT_PLE + (size_t)2 * 1024 * 256 * 2;
constexpr size_t WS_TABR = WS_TABA + (size_t)4104 * 32 * 8;
constexpr size_t WS_H = al256(WS_TABR + (size_t)4104 * 128 * 8);
constexpr size_t WS_PB = WS_H + (size_t)MT * 1024 * 2;
constexpr size_t WS_PLE = WS_PB + (size_t)2 * MT * 256 * 2;
constexpr size_t WS_Y = WS_PLE + (size_t)MT * 1024 * 4;
constexpr size_t WS_X1 = WS_Y + (size_t)MT * 1024 * 4;
constexpr size_t WS_X2 = WS_X1 + (size_t)MT * 1024 * 4;
constexpr size_t WS_OG = WS_X2 + (size_t)MT * 1024 * 4;
constexpr size_t WS_ZQ = WS_OG + (size_t)MT * 2048 * 2;
constexpr size_t WS_ZK = WS_ZQ + (size_t)MT * 1024 * 2;
constexpr size_t WS_ZG = WS_ZK + (size_t)MT * 1024 * 2;
constexpr size_t WS_VTP = WS_ZG + (size_t)MT * 2048 * 2;
constexpr size_t WS_VTS = WS_VTP + (size_t)16 * 512 * 4096 * 2;
constexpr size_t WS_ABUF = WS_VTS + (size_t)128 * 4 * 512 * 8 * 2;
constexpr size_t WS_KDT = WS_ABUF + (size_t)512 * 128 * 128 * 2;
constexpr size_t WS_ORET = WS_KDT + (size_t)512 * 256 * 128 * 2;
constexpr size_t WS_BAR = WS_ORET + (size_t)MT * 2048 * 4;
constexpr size_t WS_END = WS_BAR + 16384;

struct Params {
    const float *x_prompt, *x_sample, *cache_k, *cache_v, *state_ret, *p_prompt, *p_sample, *pre_norm, *post_norm, *w_in_attn, *sinks, *w_out_attn, *w_in_ret, *w_out_ret, *w_ple, *w_gate;
    float* out; unsigned char* ws;
};

__device__ __forceinline__ unsigned cvt_pk_bf16(float lo, float hi) { unsigned r; asm volatile("v_cvt_pk_bf16_f32 %0, %1, %2" : "=v"(r) : "v"(lo), "v"(hi)); return r; }
__device__ __forceinline__ u32x2 pk4(f32x4 v) { u32x2 w; w.x = cvt_pk_bf16(v[0], v[1]); w.y = cvt_pk_bf16(v[2], v[3]); return w; }
__device__ __forceinline__ float bf2f(bf16_t b) { return __uint_as_float(((unsigned)b) << 16); }
__device__ __forceinline__ float bflo(unsigned w) { return __uint_as_float(w << 16); }
__device__ __forceinline__ float bfhi(unsigned w) { return __uint_as_float(w & 0xffff0000u); }
__device__ __forceinline__ float silu_f(float x) { return x / (1.f + __expf(-x)); }
__device__ __forceinline__ float sigmoid_f(float x) { return 1.f / (1.f + __expf(-x)); }
__device__ __forceinline__ float wave_sum(float v) {
#pragma unroll
    for (int o = 32; o >= 1; o >>= 1) v += __shfl_xor(v, o, 64);
    return v;
}
__device__ __forceinline__ int otid() { int t = threadIdx.x; asm volatile("" : "+v"(t)); return t; }
__device__ __forceinline__ float ret_lg(int h) { return log1pf(-exp2f(-5.f - (float)h)); }

#define XB_TMO      128
#define XB_XCNT(j)  (256  + 64 * (j))
#define XB_XSUB(j)  (1280 + 64 * (j))
#define XB_XGEN(j)  (2304 + 64 * (j))
#define XB_TOP      3328
#define XB_TOPGEN   3392
#define XCD_BAR_WORDS 3456
#define XB_SPIN_CAP (1u << 18)

__device__ __forceinline__ unsigned xb_ld(unsigned* p)              { return __hip_atomic_load(p, __ATOMIC_RELAXED, __HIP_MEMORY_SCOPE_AGENT); }
__device__ __forceinline__ unsigned xb_add(unsigned* p, unsigned v) { return __hip_atomic_fetch_add(p, v, __ATOMIC_RELAXED, __HIP_MEMORY_SCOPE_AGENT); }
__device__ __forceinline__ unsigned xb_xcc_id() { return (unsigned)__builtin_amdgcn_s_getreg((3 << 11) | 20) & 0xFu; }
#define XB_SPIN(cond, bar) do { unsigned _sp = 0; while (cond) { __builtin_amdgcn_s_sleep(1); \
    if ((++_sp & 255u) == 0u) { if (xb_ld(&(bar)[XB_TMO])) break; if (_sp > XB_SPIN_CAP) { atomicAdd(&(bar)[XB_TMO], 1u); break; } } } } while (0)

struct XcdBarrier {
    unsigned* bar; unsigned x;
    volatile LAS unsigned* st;
};

__device__ __forceinline__ XcdBarrier xcd_barrier_post(unsigned* bar, volatile LAS unsigned* st) {
    XcdBarrier b; b.bar = bar; b.x = xb_xcc_id(); b.st = st;
    if (threadIdx.x == 0) (void)xb_add(&bar[XB_XCNT(b.x)], 1u);
    return b;
}
__device__ __forceinline__ void xcd_barrier_complete(unsigned* bar, unsigned x, unsigned& nloc, unsigned& nx) {
    const unsigned G = gridDim.x * gridDim.y * gridDim.z;
    unsigned sum, cnt, mine, sp = 0u;
    for (;;) {
        sum = 0u; cnt = 0u; mine = 0u;
#pragma unroll
        for (unsigned j = 0; j < 16; ++j) { const unsigned c = xb_ld(&bar[XB_XCNT(j)]); sum += c; cnt += (c > 0u) ? 1u : 0u; mine = (j == x) ? c : mine; }
        if (sum == G) break;
        __builtin_amdgcn_s_sleep(1);
        if ((++sp & 255u) == 0u) { if (xb_ld(&bar[XB_TMO])) break; if (sp > XB_SPIN_CAP) { atomicAdd(&bar[XB_TMO], 1u); break; } }
    }
    nloc = mine > 0u ? mine : 1u; nx = cnt > 0u ? cnt : 1u;
}

__device__ __forceinline__ void xcd_barrier(const XcdBarrier& b) {
    asm volatile("s_waitcnt vmcnt(0)" ::: "memory");
    __syncthreads();
    if (threadIdx.x == 0) {
        unsigned* bar = b.bar;
        __builtin_amdgcn_s_waitcnt(0);
        unsigned nloc = b.st[0], nx = b.st[1];
        if (nloc == 0u) { xcd_barrier_complete(bar, b.x, nloc, nx); b.st[0] = nloc; b.st[1] = nx; }
        const unsigned old = xb_add(&bar[XB_XSUB(b.x)], 1u);
        const unsigned gen = old / nloc;
        if (old + 1u == (gen + 1u) * nloc) {
            __builtin_amdgcn_fence(__ATOMIC_RELEASE, "agent");
            asm volatile("s_waitcnt vmcnt(0)" ::: "memory");
            const unsigned og = xb_add(&bar[XB_TOP], 1u);
            const unsigned tg = og / nx;
            if (og + 1u == (tg + 1u) * nx) xb_add(&bar[XB_TOPGEN], 1u);
            else XB_SPIN(xb_ld(&bar[XB_TOPGEN]) == tg, bar);
            __builtin_amdgcn_fence(__ATOMIC_ACQUIRE, "agent");
            xb_add(&bar[XB_XGEN(b.x)], 1u);
            asm volatile("s_waitcnt vmcnt(0)" ::: "memory");
        } else {
            XB_SPIN(xb_ld(&bar[XB_XGEN(b.x)]) == gen, bar);
            __builtin_amdgcn_fence(__ATOMIC_ACQUIRE, "agent");
            asm volatile("s_waitcnt vmcnt(0)" ::: "memory");
        }
    }
    __syncthreads();
}

namespace pg8 {
constexpr int BM = 256, BK = 64, HALF = 128, HTB = HALF * BK * 2, STAGE_BYTES = 8 * HTB, NXCD = 8, WGM = 8;
__host__ __device__ __forceinline__ int lds_byte(int r, int c) { const int st = (r >> 4) * 2 + (c >> 5), rr = r & 15, cc = c & 31, ob = rr * 64 + cc * 2; return st * 1024 + (ob ^ (((ob >> 9) & 1) << 5)); }
__host__ __device__ __forceinline__ void stage_rc(int b, int& R, int& C) { const int st = b / 1024, sb = b % 1024, swz = sb ^ (((sb >> 9) & 1) << 5); R = (st >> 1) * 16 + swz / 64; C = (st & 1) * 32 + (swz % 64) / 2; }
struct Unit { int pm, pn; };
struct Gemm { const bf16_t* A; const bf16_t* Bt; int M, N, K; };
struct StaticOrder {
    int nM, nN, nwg, G, c;
    __host__ __device__ void init(int M, int N, int G_, int c_) { nM = M / BM; nN = N / BM; nwg = nM * nN; G = G_; c = c_; }
    __host__ __device__ bool next(int i, Unit& u) const {
        const long L = (long)i * G + c; if (L >= nwg) return false;
        int wgid = (int)L; { const int q = nwg / NXCD, r = nwg % NXCD, xcd = wgid % NXCD, off = wgid / NXCD; wgid = (xcd < r ? xcd * (q + 1) : r * (q + 1) + (xcd - r) * q) + off; }
        const int nig = WGM * nN, gid = wgid / nig, fm = gid * WGM, gsz = (nM - fm) < WGM ? (nM - fm) : WGM;
        u.pm = fm + ((wgid % nig) % gsz); u.pn = (wgid % nig) / gsz; return true;
    }
};

template <class Epi>
__device__ __forceinline__ void gemm_phase(LAS unsigned char* lds, const Gemm g, const StaticOrder& S, const Epi& E) {
    const int tid = otid(), wid = __builtin_amdgcn_readfirstlane(tid >> 6), lane = tid & 63, wr = wid >> 2, wc = wid & 3, fr = lane & 15, fq = lane >> 4;
    const int K = g.K, nt = K / BK;
    unsigned voffA[2], voffB[2];
#pragma unroll
    for (int i = 0; i < 2; ++i) { int R, C; stage_rc(tid * 16 + i * 8192, R, C); voffA[i] = (unsigned)(R * K + C) * 2u; voffB[i] = voffA[i]; }
    const size_t kstep = (size_t)(BK * 2);
    const size_t hstep = (size_t)HALF * K * 2;
    const size_t tstep = 2 * hstep;
    const unsigned ldsw = (unsigned)wid * 1024u;
    const int aoff = lds_byte(wr * 64 + fr, fq * 8), boff = lds_byte(wc * 32 + fr, fq * 8);
#define PG8_SA(b, h) (((b) * 2 + (h)) * HTB)
#define PG8_SB(b, h) ((4 + (b) * 2 + (h)) * HTB)
#define PG8_STAGE(bufoff, gbase, voff) do { _Pragma("unroll") for (int _i = 0; _i < 2; ++_i) \
        __builtin_amdgcn_global_load_lds((const unsigned*)((const char*)(gbase) + (voff)[_i]), (LAS unsigned*)(lds + (bufoff) + ldsw + _i * 8192), 16, 0, 0); } while (0)
#define PG8_LDA(dst, b, h) do { _Pragma("unroll") for (int m = 0; m < 4; ++m) _Pragma("unroll") for (int k = 0; k < 2; ++k) dst[m][k] = *(const LAS bf16x8*)(lds + PG8_SA(b, h) + aoff + m * 2048 + k * 1024); } while (0)
#define PG8_LDB(dst, b, h) do { _Pragma("unroll") for (int n = 0; n < 2; ++n) _Pragma("unroll") for (int k = 0; k < 2; ++k) dst[n][k] = *(const LAS bf16x8*)(lds + PG8_SB(b, h) + boff + n * 2048 + k * 1024); } while (0)
#define PG8_MMA(ai, bj, At, Bt) do { __builtin_amdgcn_s_setprio(1); _Pragma("unroll") for (int m = 0; m < 4; ++m) _Pragma("unroll") for (int n = 0; n < 2; ++n) _Pragma("unroll") for (int k = 0; k < 2; ++k) \
        acc[ai][bj][m][n] = __builtin_amdgcn_mfma_f32_16x16x32_bf16(Bt[n][k], At[m][k], acc[ai][bj][m][n], 0, 0, 0); __builtin_amdgcn_s_setprio(0); } while (0)
#define PG8_WAIT_V(n) asm volatile("s_waitcnt vmcnt(" #n ")" ::: "memory")
#define PG8_WAIT_L(n) asm volatile("s_waitcnt lgkmcnt(" #n ")" ::: "memory")
#define PG8_BAR __builtin_amdgcn_s_barrier()
#define PG8_SCHED __builtin_amdgcn_sched_barrier(0)
#define PG8_PTRS(u, pa, pb) do { const char* _a = (const char*)g.A + (size_t)(u).pm * tstep; const char* _b = (const char*)g.Bt + (size_t)(u).pn * tstep; if (Epi::swap(u)) { pa = _b; pb = _a; } else { pa = _a; pb = _b; } } while (0)
    Unit cur, nxt; int ui = 0;
    if (!S.next(0, cur)) return;
    f32x4 acc[2][2][4][2];
#pragma unroll
    for (int a = 0; a < 2; ++a)
#pragma unroll
        for (int b = 0; b < 2; ++b)
#pragma unroll
            for (int m = 0; m < 4; ++m)
#pragma unroll
                for (int n = 0; n < 2; ++n) acc[a][b][m][n] = (f32x4){0.f, 0.f, 0.f, 0.f};
    bf16x8 At[4][2], B0[2][2], B1[2][2];
    const char* cA; const char* cB;
    PG8_PTRS(cur, cA, cB);
    PG8_STAGE(PG8_SB(0, 0), cB, voffB); PG8_STAGE(PG8_SA(0, 0), cA, voffA); PG8_STAGE(PG8_SB(0, 1), cB + hstep, voffB); PG8_STAGE(PG8_SA(0, 1), cA + hstep, voffA);
    if (wr == 1) PG8_BAR;
    PG8_WAIT_V(4); PG8_BAR;
    PG8_STAGE(PG8_SB(1, 0), cB + kstep, voffB); PG8_STAGE(PG8_SA(1, 0), cA + kstep, voffA); PG8_STAGE(PG8_SB(1, 1), cB + hstep + kstep, voffB);
    PG8_WAIT_V(6); PG8_BAR;
    for (;;) {
        const bool has_next = S.next(ui + 1, nxt);
        const char* nA = cA; const char* nB = cB;
        if (has_next) PG8_PTRS(nxt, nA, nB);
        for (int t = 0; t < nt; t += 2) {
            const bool last = (t == nt - 2);
            const char* a1 = cA + (size_t)(t + 1) * kstep;
            const char* a2 = last ? nA : cA + (size_t)(t + 2) * kstep; const char* b2 = last ? nB : cB + (size_t)(t + 2) * kstep;
            const char* a3 = a2 + kstep; const char* b3 = b2 + kstep;
            PG8_LDB(B0, 0, 0); PG8_SCHED; PG8_LDA(At, 0, 0); PG8_STAGE(PG8_SA(1, 1), a1 + hstep, voffA);
            PG8_WAIT_L(8); PG8_BAR; PG8_WAIT_L(0); PG8_MMA(0, 0, At, B0); PG8_BAR; PG8_SCHED;
            PG8_LDB(B1, 0, 1); PG8_STAGE(PG8_SB(0, 0), b2, voffB);
            PG8_BAR; PG8_WAIT_L(0); PG8_MMA(0, 1, At, B1); PG8_BAR;
            PG8_LDA(At, 0, 1); PG8_STAGE(PG8_SA(0, 0), a2, voffA);
            PG8_BAR; PG8_WAIT_L(0); PG8_MMA(1, 0, At, B0); PG8_BAR; PG8_SCHED;
            PG8_STAGE(PG8_SB(0, 1), b2 + hstep, voffB);
            PG8_WAIT_V(6); PG8_BAR; PG8_MMA(1, 1, At, B1); PG8_BAR;
            PG8_LDB(B0, 1, 0); PG8_SCHED; PG8_LDA(At, 1, 0); PG8_STAGE(PG8_SA(0, 1), a2 + hstep, voffA);
            PG8_WAIT_L(8); PG8_BAR; PG8_WAIT_L(0); PG8_MMA(0, 0, At, B0); PG8_BAR; PG8_SCHED;
            PG8_LDB(B1, 1, 1); PG8_STAGE(PG8_SB(1, 0), b3, voffB);
            PG8_BAR; PG8_WAIT_L(0); PG8_MMA(0, 1, At, B1); PG8_BAR;
            PG8_LDA(At, 1, 1); PG8_STAGE(PG8_SA(1, 0), a3, voffA);
            PG8_BAR; PG8_WAIT_L(0); PG8_MMA(1, 0, At, B0); PG8_BAR; PG8_SCHED;
            PG8_STAGE(PG8_SB(1, 1), b3 + hstep, voffB);
            PG8_WAIT_V(6); PG8_BAR; PG8_MMA(1, 1, At, B1); PG8_BAR;
        }
        E(acc, cur, wr, wc, fr, fq);
        if (!has_next) break;
#pragma unroll
        for (int a = 0; a < 2; ++a)
#pragma unroll
            for (int b = 0; b < 2; ++b)
#pragma unroll
                for (int m = 0; m < 4; ++m)
#pragma unroll
                    for (int n = 0; n < 2; ++n) acc[a][b][m][n] = (f32x4){0.f, 0.f, 0.f, 0.f};
        cur = nxt; cA = nA; cB = nB; ++ui;
    }
    PG8_WAIT_V(0);
    if (wr == 0) PG8_BAR;
    PG8_BAR;
#undef PG8_SA
#undef PG8_SB
#undef PG8_STAGE
#undef PG8_LDA
#undef PG8_LDB
#undef PG8_MMA
#undef PG8_WAIT_V
#undef PG8_WAIT_L
#undef PG8_BAR
#undef PG8_SCHED
#undef PG8_PTRS
}
}
using pg8::Unit;

struct EpiF32 {
    float* C; int ldc;
    __device__ __forceinline__ static bool swap(const Unit&) { return false; }
    __device__ __forceinline__ void operator()(const f32x4 (&acc)[2][2][4][2], const Unit& u, int wr, int wc, int fr, int fq) const {
        const int row0 = u.pm * 256 + wr * 64 + fr, col0 = u.pn * 256 + wc * 32 + 4 * fq;
#pragma unroll
        for (int ai = 0; ai < 2; ++ai)
#pragma unroll
            for (int m = 0; m < 4; ++m) { float* rowp = C + (size_t)(row0 + ai * 128 + m * 16) * ldc + col0;
#pragma unroll
                for (int bj = 0; bj < 2; ++bj)
#pragma unroll
                    for (int n = 0; n < 2; ++n) *(f32x4*)(rowp + bj * 128 + n * 16) = acc[ai][bj][m][n]; }
    }
};
struct EpiGate {
    const float* X1; const float* PLE; float* O;
    __device__ __forceinline__ static bool swap(const Unit&) { return false; }
    __device__ __forceinline__ void operator()(const f32x4 (&acc)[2][2][4][2], const Unit& u, int wr, int wc, int fr, int fq) const {
        const int row0 = u.pm * 256 + wr * 64 + fr, col0 = u.pn * 256 + wc * 32 + 4 * fq;
#pragma unroll
        for (int ai = 0; ai < 2; ++ai)
#pragma unroll
            for (int m = 0; m < 4; ++m) { const size_t ro = (size_t)(row0 + ai * 128 + m * 16) * 1024 + col0;
#pragma unroll
                for (int bj = 0; bj < 2; ++bj)
#pragma unroll
                    for (int n = 0; n < 2; ++n) { const size_t o = ro + bj * 128 + n * 16; const f32x4 x1 = *(const f32x4*)(X1 + o), pl = *(const f32x4*)(PLE + o), a = acc[ai][bj][m][n]; f32x4 r;
#pragma unroll
                        for (int j = 0; j < 4; ++j) r[j] = x1[j] + sigmoid_f(a[j]) * pl[j];
                        *(f32x4*)(O + o) = r; } }
    }
};
struct EpiInAttn {
    bf16_t *Zq, *Zk, *Zg, *vTp, *vTs; const float* tab; float* out;
    __device__ __forceinline__ static bool swap(const Unit& u) { return u.pn == 5; }
    __device__ __forceinline__ void operator()(const f32x4 (&acc)[2][2][4][2], const Unit& u, int wr, int wc, int fr, int fq) const {
        const int pn = u.pn;
        if (pn < 5) {
            const bool isq = pn < 4;
            const int fi = 16 * (wc & 1) + 4 * fq;
#pragma unroll
            for (int ai = 0; ai < 2; ++ai)
#pragma unroll
                for (int m = 0; m < 4; ++m) {
                    const int r = u.pm * 256 + ai * 128 + wr * 64 + m * 16 + fr;
                    const int pi = r < MP ? (r & 4095) : 4096 + ((r - MP) & 7);
                    const f32x4 t0 = *(const f32x4*)(tab + ((size_t)pi * 32 + fi) * 2), t1 = *(const f32x4*)(tab + ((size_t)pi * 32 + fi) * 2 + 4);
                    const float cs[4] = {t0[0], t0[2], t1[0], t1[2]}, sn[4] = {t0[1], t0[3], t1[1], t1[3]};
#pragma unroll
                    for (int bj = 0; bj < 2; ++bj) {
                        const f32x4 x1 = acc[ai][bj][m][0], x2 = acc[ai][bj][m][1]; f32x4 o1, o2;
#pragma unroll
                        for (int j = 0; j < 4; ++j) { o1[j] = x1[j] * cs[j] - x2[j] * sn[j]; o2[j] = x2[j] * cs[j] + x1[j] * sn[j]; }
                        const int hh = 2 * bj + (wc >> 1), d1 = 16 * (wc & 1) + 4 * fq;
                        if (isq) {
                            bf16_t* p = Zq + (size_t)r * 1024 + pn * 256 + hh * 64 + d1;
                            *(u32x2*)p = pk4(o1 * 0.125f); *(u32x2*)(p + 32) = pk4(o2 * 0.125f);
                        } else {
                            bf16_t* p = Zk + (size_t)r * 256 + hh * 64 + d1;
                            *(u32x2*)p = pk4(o1); *(u32x2*)(p + 32) = pk4(o2);
                            if (r < MP) { const int t = r & 4095; if (t >= 3968) { float* dst = out + OFF_KWP + ((size_t)((r >> 12) * 128 + t - 3968) * 4 + hh) * 64 + d1; *(f32x4*)dst = o1; *(f32x4*)(dst + 32) = o2; } }
                            else { const int rs = r - MP; float* dst = out + OFF_KWS + ((size_t)((rs >> 3) * 128 + 120 + (rs & 7)) * 4 + hh) * 64 + d1; *(f32x4*)dst = o1; *(f32x4*)(dst + 32) = o2; }
                        }
                    }
                    asm volatile("" ::: "memory");
                }
        } else if (pn == 5) {
#pragma unroll
            for (int ai = 0; ai < 2; ++ai)
#pragma unroll
                for (int m = 0; m < 4; ++m) {
                    const int e = ai * 128 + wr * 64 + m * 16 + fr, kvh = e >> 6, d = e & 63;
#pragma unroll
                    for (int bj = 0; bj < 2; ++bj)
#pragma unroll
                        for (int n = 0; n < 2; ++n) {
                            const int tok = u.pm * 256 + bj * 128 + wc * 32 + n * 16 + 4 * fq; const f32x4 v = acc[ai][bj][m][n];
                            if (tok < MP) { const int b = tok >> 12, t = tok & 4095;
                                *(u32x2*)(vTp + ((size_t)((b * 4 + kvh) * 64 + d)) * 4096 + t) = pk4(v);
                                if (t >= 3968) {
#pragma unroll
                                    for (int jj = 0; jj < 4; ++jj) out[OFF_VWP + ((size_t)(b * 128 + t - 3968 + jj) * 4 + kvh) * 64 + d] = v[jj]; }
                            } else { const int ts = tok - MP, bs = ts >> 3, l0 = ts & 7;
                                *(u32x2*)(vTs + ((size_t)((bs * 4 + kvh) * 64 + d)) * 8 + l0) = pk4(v);
#pragma unroll
                                for (int jj = 0; jj < 4; ++jj) out[OFF_VWS + ((size_t)(bs * 128 + 120 + l0 + jj) * 4 + kvh) * 64 + d] = v[jj]; }
                        }
                }
        } else {
#pragma unroll
            for (int ai = 0; ai < 2; ++ai)
#pragma unroll
                for (int m = 0; m < 4; ++m) { const int r = u.pm * 256 + ai * 128 + wr * 64 + m * 16 + fr;
#pragma unroll
                    for (int bj = 0; bj < 2; ++bj)
#pragma unroll
                        for (int n = 0; n < 2; ++n) { const f32x4 a = acc[ai][bj][m][n]; f32x4 s;
#pragma unroll
                            for (int j = 0; j < 4; ++j) s[j] = silu_f(a[j]);
                            *(u32x2*)(Zg + (size_t)r * 1024 + (pn - 6) * 256 + bj * 128 + wc * 32 + n * 16 + 4 * fq) = pk4(s); } }
        }
    }
};
struct EpiInRet {
    bf16_t *Zq, *Zk, *Zg, *vTp, *vTs; const float* tab;
    __device__ __forceinline__ static bool swap(const Unit& u) { return u.pn >= 8 && u.pn < 16; }
    __device__ __forceinline__ void operator()(const f32x4 (&acc)[2][2][4][2], const Unit& u, int wr, int wc, int fr, int fq) const {
        const int pn = u.pn;
        if (pn < 8) {
            const bool isq = pn < 4; const float sc = isq ? 1.f : 0.0625f;
            bf16_t* Z = isq ? Zq : Zk; const int hc = (pn & 3) * 256;
#pragma unroll
            for (int ai = 0; ai < 2; ++ai)
#pragma unroll
                for (int m = 0; m < 4; ++m) {
                    const int r = u.pm * 256 + ai * 128 + wr * 64 + m * 16 + fr;
                    const int pi = r < MP ? (r & 4095) : 4096 + ((r - MP) & 7);
#pragma unroll
                    for (int n = 0; n < 2; ++n) {
                        const int d = wc * 32 + n * 16 + 4 * fq;
                        const f32x4 t0 = *(const f32x4*)(tab + ((size_t)pi * 128 + d) * 2), t1 = *(const f32x4*)(tab + ((size_t)pi * 128 + d) * 2 + 4);
                        const float cs[4] = {t0[0], t0[2], t1[0], t1[2]}, sn[4] = {t0[1], t0[3], t1[1], t1[3]};
                        const f32x4 x1 = acc[ai][0][m][n], x2 = acc[ai][1][m][n]; f32x4 o1, o2;
#pragma unroll
                        for (int j = 0; j < 4; ++j) { o1[j] = (x1[j] * cs[j] - x2[j] * sn[j]) * sc; o2[j] = (x2[j] * cs[j] + x1[j] * sn[j]) * sc; }
                        bf16_t* p = Z + (size_t)r * 1024 + hc + d;
                        *(u32x2*)p = pk4(o1); *(u32x2*)(p + 128) = pk4(o2);
                    }
                }
        } else if (pn < 16) {
#pragma unroll
            for (int ai = 0; ai < 2; ++ai)
#pragma unroll
                for (int m = 0; m < 4; ++m) {
                    const int eg = (pn - 8) * 256 + ai * 128 + wr * 64 + m * 16 + fr, h = eg >> 9, e = eg & 511;
#pragma unroll
                    for (int bj = 0; bj < 2; ++bj)
#pragma unroll
                        for (int n = 0; n < 2; ++n) {
                            const int tok = u.pm * 256 + bj * 128 + wc * 32 + n * 16 + 4 * fq; const u32x2 w = pk4(acc[ai][bj][m][n]);
                            if (tok < MP) { const int b = tok >> 12, t = tok & 4095; *(u32x2*)(vTp + ((size_t)((b * 4 + h) * 512 + e)) * 4096 + t) = w; }
                            else { const int ts = tok - MP, bs = ts >> 3, l0 = ts & 7; *(u32x2*)(vTs + ((size_t)((bs * 4 + h) * 512 + e)) * 8 + l0) = w; }
                        }
                }
        } else {
#pragma unroll
            for (int ai = 0; ai < 2; ++ai)
#pragma unroll
                for (int m = 0; m < 4; ++m) { const int r = u.pm * 256 + ai * 128 + wr * 64 + m * 16 + fr;
#pragma unroll
                    for (int bj = 0; bj < 2; ++bj)
#pragma unroll
                        for (int n = 0; n < 2; ++n) { const f32x4 a = acc[ai][bj][m][n]; f32x4 s;
#pragma unroll
                            for (int j = 0; j < 4; ++j) s[j] = silu_f(a[j]);
                            *(u32x2*)(Zg + (size_t)r * 2048 + (pn - 16) * 256 + bj * 128 + wc * 32 + n * 16 + 4 * fq) = pk4(s); } }
        }
    }
};

__device__ __forceinline__ void transpose_tile(const float* __restrict__ W, bf16_t* __restrict__ Wt, int K, int N, bool perm, int tile, LAS float* T) {
    const int tid = otid(), ntn = N >> 6;
    const int n0 = (tile % ntn) * 64, k0 = (tile / ntn) * 64, nn = tid & 63;
    const int nd = n0 + nn; int ns = nd;
    if (perm && nd < 1280) { const int p = nd & 63; ns = (nd - p) + (p >> 5) * 16 + (p & 15) + ((p >> 4) & 1) * 32; }
#pragma unroll
    for (int i = 0; i < 8; ++i) { const int kk = (tid >> 6) + 8 * i; T[kk * 65 + nn] = W[(size_t)(k0 + kk) * N + ns]; }
    __syncthreads();
    const int kk2 = (tid & 31) * 2;
#pragma unroll
    for (int i = 0; i < 4; ++i) { const int n2 = (tid >> 5) + 16 * i; *(unsigned*)(Wt + (size_t)(n0 + n2) * K + k0 + kk2) = cvt_pk_bf16(T[kk2 * 65 + n2], T[(kk2 + 1) * 65 + n2]); }
    __syncthreads();
}

__device__ __forceinline__ void rms_rows(const float* __restrict__ Xa, const float* __restrict__ Xb, const float* __restrict__ g, bf16_t* __restrict__ H, int G) {
    const int tid_o = otid(), wave = tid_o >> 6, lane = tid_o & 63;
    for (int row = blockIdx.x * 8 + wave; row < MT; row += G * 8) {
        const float* x = row < MP ? Xa + (size_t)row * 1024 : Xb + (size_t)(row - MP) * 1024;
        f32x4 v[4]; float ss = 0.f;
#pragma unroll
        for (int i = 0; i < 4; ++i) { v[i] = *(const f32x4*)(x + lane * 4 + 256 * i); ss += v[i][0] * v[i][0] + v[i][1] * v[i][1] + v[i][2] * v[i][2] + v[i][3] * v[i][3]; }
        ss = wave_sum(ss);
        const float rr = rsqrtf(ss * (1.f / 1024.f) + EPS);
#pragma unroll
        for (int i = 0; i < 4; ++i) { const f32x4 gg = *(const f32x4*)(g + lane * 4 + 256 * i); *(u32x2*)(H + (size_t)row * 1024 + lane * 4 + 256 * i) = pk4(v[i] * rr * gg); }
    }
}
__device__ __forceinline__ void resid_rows(const float* __restrict__ Xa, const float* __restrict__ Xb, const float* __restrict__ Y, const float* __restrict__ g, float* __restrict__ X1, bf16_t* __restrict__ H, int G) {
    const int tid_o = otid(), wave = tid_o >> 6, lane = tid_o & 63;
    for (int row = blockIdx.x * 8 + wave; row < MT; row += G * 8) {
        const float* x = row < MP ? Xa + (size_t)row * 1024 : Xb + (size_t)(row - MP) * 1024;
        const float* y = Y + (size_t)row * 1024;
        f32x4 v[4]; float ss = 0.f;
#pragma unroll
        for (int i = 0; i < 4; ++i) { v[i] = *(const f32x4*)(y + lane * 4 + 256 * i); ss += v[i][0] * v[i][0] + v[i][1] * v[i][1] + v[i][2] * v[i][2] + v[i][3] * v[i][3]; }
        ss = wave_sum(ss);
        const float rr = rsqrtf(ss * (1.f / 1024.f) + EPS);
#pragma unroll
        for (int i = 0; i < 4; ++i) { const int c = lane * 4 + 256 * i; const f32x4 gg = *(const f32x4*)(g + c), xx = *(const f32x4*)(x + c); const f32x4 o = xx + v[i] * rr * gg;
            *(f32x4*)(X1 + (size_t)row * 1024 + c) = o; *(u32x2*)(H + (size_t)row * 1024 + c) = pk4(o); }
    }
}


struct SkF32 { float* C; __device__ __forceinline__ void operator()(int row, int col, f32x4 v) const { *(f32x4*)(C + (size_t)row * 1024 + col) = v; } };
struct SkGate { const float* X1; const float* PLE; float* O;
    __device__ __forceinline__ void operator()(int row, int col, f32x4 a) const { const size_t o = (size_t)row * 1024 + col; const f32x4 x1 = *(const f32x4*)(X1 + o), pl = *(const f32x4*)(PLE + o); f32x4 r;
#pragma unroll
        for (int j = 0; j < 4; ++j) r[j] = x1[j] + sigmoid_f(a[j]) * pl[j];
        *(f32x4*)(O + o) = r; } };
template <class Epi>
__device__ __forceinline__ void skinny_gemm(LAS unsigned char* lds, const bf16_t* __restrict__ A, const bf16_t* __restrict__ Bt, int K, const Epi& E, int G) {
    LAS float* red = (LAS float*)lds;
    const int tid = otid(), w = tid >> 6, lane = tid & 63, l16 = lane & 15, g = lane >> 4;
    const int KS = K >> 3, nks = KS >> 5;
    for (int u = blockIdx.x; u < 256; u += G) {
        const int row0 = (u >> 4) * 64, col0 = (u & 15) * 64;
        const bf16_t* ap = A + (size_t)(row0 + l16) * K + w * KS + 8 * g;
        const bf16_t* bp = Bt + (size_t)(col0 + l16) * K + w * KS + 8 * g;
        f32x4 acc[4][4];
#pragma unroll
        for (int mt = 0; mt < 4; ++mt)
#pragma unroll
            for (int nt = 0; nt < 4; ++nt) acc[mt][nt] = (f32x4){0.f, 0.f, 0.f, 0.f};
#pragma unroll 4
        for (int ks = 0; ks < nks; ++ks) {
            bf16x8 af[4], bf[4];
#pragma unroll
            for (int t = 0; t < 4; ++t) { af[t] = *(const bf16x8*)(ap + (size_t)(16 * t) * K + 32 * ks); bf[t] = *(const bf16x8*)(bp + (size_t)(16 * t) * K + 32 * ks); }
#pragma unroll
            for (int mt = 0; mt < 4; ++mt)
#pragma unroll
                for (int nt = 0; nt < 4; ++nt) acc[mt][nt] = __builtin_amdgcn_mfma_f32_16x16x32_bf16(bf[nt], af[mt], acc[mt][nt], 0, 0, 0);
        }
        __syncthreads();
#pragma unroll
        for (int mt = 0; mt < 4; ++mt)
#pragma unroll
            for (int nt = 0; nt < 4; ++nt) *(LAS f32x4*)(red + (w * 64 + 16 * mt + l16) * 68 + 16 * nt + 4 * g) = acc[mt][nt];
        __syncthreads();
#pragma unroll
        for (int j = 0; j < 2; ++j) { const int q = tid + 512 * j, row = q >> 4, c4 = (q & 15) * 4; f32x4 sum = *(const LAS f32x4*)(red + row * 68 + c4);
#pragma unroll
            for (int ww = 1; ww < 8; ++ww) sum += *(const LAS f32x4*)(red + (ww * 64 + row) * 68 + c4);
            E(row0 + row, col0 + c4, sum); }
    }
}

__device__ __forceinline__ void attn_prompt(LAS unsigned char* lds, const bf16_t* __restrict__ Zq, const bf16_t* __restrict__ Zk, const bf16_t* __restrict__ Zg, const bf16_t* __restrict__ vTp,
                                            const float* __restrict__ sinks, bf16_t* __restrict__ OG, int G) {
    LAS bf16_t* Ks = (LAS bf16_t*)lds;
    LAS bf16_t* Vt = (LAS bf16_t*)(lds + 256 * 72 * 2);
    const int tid = otid(), w = tid >> 6, lane = tid & 63, l16 = lane & 15, g = lane >> 4;
    for (int it = blockIdx.x; it < 512; it += G) {
        const int kvh = it & 3, nb = (it >> 2) & 31, b = it >> 7;
        __syncthreads();
#pragma unroll
        for (int i = 0; i < 4; ++i) { const int ch = tid + 512 * i, s = ch >> 3, c8 = ch & 7, t = (nb - 1) * 128 + s;
            u32x4 val = {0u, 0u, 0u, 0u}; if (t >= 0) val = *(const u32x4*)(Zk + (size_t)(b * 4096 + t) * 256 + kvh * 64 + c8 * 8);
            *(LAS u32x4*)(Ks + s * 72 + c8 * 8) = val; }
#pragma unroll
        for (int i = 0; i < 4; ++i) { const int ch = tid + 512 * i, d = ch >> 5, s0 = (ch & 31) * 8, t0 = (nb - 1) * 128 + s0;
            u32x4 val = {0u, 0u, 0u, 0u}; if (t0 >= 0) val = *(const u32x4*)(vTp + ((size_t)((b * 4 + kvh) * 64 + d)) * 4096 + t0);
            *(LAS u32x4*)(Vt + d * 264 + s0) = val; }
        __syncthreads();
        const int head = kvh * 4 + (w >> 1);
        const float sk = sinks[head];
        for (int qi = 0; qi < 4; ++qi) {
            const int qt = (w & 1) * 4 + qi;
            const size_t tq = (size_t)b * 4096 + nb * 128 + qt * 16 + l16;
            bf16x8 qf[2];
#pragma unroll
            for (int ks = 0; ks < 2; ++ks) qf[ks] = *(const bf16x8*)(Zq + tq * 1024 + head * 64 + ks * 32 + g * 8);
            f32x4 sa[9];
#pragma unroll
            for (int j = 0; j < 9; ++j) { sa[j] = (f32x4){0.f, 0.f, 0.f, 0.f};
#pragma unroll
                for (int ks = 0; ks < 2; ++ks) { const bf16x8 kf = *(const LAS bf16x8*)(Ks + (16 * (qt + j) + l16) * 72 + ks * 32 + g * 8);
                    sa[j] = __builtin_amdgcn_mfma_f32_16x16x32_bf16(kf, qf[ks], sa[j], 0, 0, 0); } }
            float mx = sk;
#pragma unroll
            for (int j = 0; j < 9; ++j)
#pragma unroll
                for (int r = 0; r < 4; ++r) {
                    bool vis = true;
                    if (j == 0) vis = (4 * g + r) > l16;
                    if (j == 8) vis = (4 * g + r) <= l16;
                    if (nb == 0 && (qt + j) < 8) vis = false;
                    sa[j][r] = vis ? sa[j][r] : -1e30f;
                    mx = fmaxf(mx, sa[j][r]);
                }
            mx = fmaxf(mx, __shfl_xor(mx, 16, 64)); mx = fmaxf(mx, __shfl_xor(mx, 32, 64));
            float sum = 0.f;
#pragma unroll
            for (int j = 0; j < 9; ++j)
#pragma unroll
                for (int r = 0; r < 4; ++r) { const float p = __expf(sa[j][r] - mx); sa[j][r] = p; sum += p; }
            sum += __shfl_xor(sum, 16, 64); sum += __shfl_xor(sum, 32, 64);
            const float inv = 1.f / (sum + __expf(sk - mx));
            f32x4 oa[4];
#pragma unroll
            for (int dt = 0; dt < 4; ++dt) oa[dt] = (f32x4){0.f, 0.f, 0.f, 0.f};
#pragma unroll
            for (int u = 0; u < 5; ++u) {
                u32x4 pw; pw.x = cvt_pk_bf16(sa[2 * u][0], sa[2 * u][1]); pw.y = cvt_pk_bf16(sa[2 * u][2], sa[2 * u][3]);
                if (u < 4) { pw.z = cvt_pk_bf16(sa[2 * u + 1][0], sa[2 * u + 1][1]); pw.w = cvt_pk_bf16(sa[2 * u + 1][2], sa[2 * u + 1][3]); } else { pw.z = 0u; pw.w = 0u; }
                const bf16x8 pf = __builtin_bit_cast(bf16x8, pw);
                const int k0 = 16 * (qt + 2 * u) + 4 * g, k1 = (u < 4) ? k0 + 16 : k0;
#pragma unroll
                for (int dt = 0; dt < 4; ++dt) {
                    const u32x2 v0 = *(const LAS u32x2*)(Vt + (16 * dt + l16) * 264 + k0), v1 = *(const LAS u32x2*)(Vt + (16 * dt + l16) * 264 + k1);
                    u32x4 vw; vw.x = v0.x; vw.y = v0.y; vw.z = v1.x; vw.w = v1.y;
                    oa[dt] = __builtin_amdgcn_mfma_f32_16x16x32_bf16(__builtin_bit_cast(bf16x8, vw), pf, oa[dt], 0, 0, 0);
                }
            }
#pragma unroll
            for (int dt = 0; dt < 4; ++dt) {
                const size_t o = tq * 1024 + head * 64 + 16 * dt + 4 * g;
                const u32x2 gw = *(const u32x2*)(Zg + o);
                f32x4 r; r[0] = oa[dt][0] * inv * bflo(gw.x); r[1] = oa[dt][1] * inv * bfhi(gw.x); r[2] = oa[dt][2] * inv * bflo(gw.y); r[3] = oa[dt][3] * inv * bfhi(gw.y);
                *(u32x2*)(OG + o) = pk4(r);
            }
        }
    }
}

__device__ __forceinline__ void attn_sample(LAS unsigned char* lds, const Params& P, const bf16_t* __restrict__ Zq, const bf16_t* __restrict__ Zk, const bf16_t* __restrict__ Zg, const bf16_t* __restrict__ vTs,
                                            bf16_t* __restrict__ OG, int G) {
    LAS float* Kc = (LAS float*)lds;
    LAS float* Vc = Kc + 136 * 68;
    LAS float* Qs = Vc + 136 * 68;
    LAS float* Sc = Qs + 32 * 68;
    const int tid = otid();
    for (int it = blockIdx.x; it < 512; it += G) {
        const int bs = it >> 2, kvh = it & 3;
        __syncthreads();
#pragma unroll
        for (int i = 0; i < 4; ++i) { const int ch = tid + 512 * i, j = ch >> 4, d4 = (ch & 15) * 4;
            const size_t src = ((size_t)(bs * 128 + j) * 4 + kvh) * 64 + d4;
            const f32x4 kv = *(const f32x4*)(P.cache_k + src), vv = *(const f32x4*)(P.cache_v + src);
            *(LAS f32x4*)(Kc + j * 68 + d4) = kv; *(LAS f32x4*)(Vc + j * 68 + d4) = vv;
            if (j >= 8) { const size_t dst = ((size_t)(bs * 128 + j - 8) * 4 + kvh) * 64 + d4; *(f32x4*)(P.out + OFF_KWS + dst) = kv; *(f32x4*)(P.out + OFF_VWS + dst) = vv; } }
        { const int l = tid >> 6, d = tid & 63;
          Kc[(128 + l) * 68 + d] = bf2f(Zk[(size_t)(MP + bs * 8 + l) * 256 + kvh * 64 + d]);
          Vc[(128 + l) * 68 + d] = bf2f(vTs[((size_t)((bs * 4 + kvh) * 64 + d)) * 8 + l]); }
#pragma unroll
        for (int i = 0; i < 4; ++i) { const int e = tid + 512 * i, rr = e >> 6, d = e & 63, hq = rr >> 3, l = rr & 7;
            Qs[rr * 68 + d] = bf2f(Zq[(size_t)(MP + bs * 8 + l) * 1024 + (kvh * 4 + hq) * 64 + d]); }
        __syncthreads();
        const int rr = tid >> 4, kl = tid & 15, l = rr & 7, hq = rr >> 3, head = kvh * 4 + hq;
        const float sk = P.sinks[head];
        float mx = sk;
#pragma unroll 1
        for (int m = 0; m < 9; ++m) {
            const int key = kl + 16 * m;
            if (key < 136) {
                float dot = -1e30f;
                const bool vis = key < 128 ? (key > l) : ((key - 128) <= l);
                if (vis) { float a = 0.f;
#pragma unroll
                    for (int d4 = 0; d4 < 16; ++d4) { const f32x4 q = *(const LAS f32x4*)(Qs + rr * 68 + d4 * 4), k = *(const LAS f32x4*)(Kc + key * 68 + d4 * 4); a += q[0] * k[0] + q[1] * k[1] + q[2] * k[2] + q[3] * k[3]; }
                    dot = a; }
                Sc[rr * 140 + key] = dot; mx = fmaxf(mx, dot);
            }
        }
#pragma unroll
        for (int o = 1; o < 16; o <<= 1) mx = fmaxf(mx, __shfl_xor(mx, o, 64));
        float sum = 0.f;
#pragma unroll 1
        for (int m = 0; m < 9; ++m) { const int key = kl + 16 * m;
            if (key < 136) { const float sv = Sc[rr * 140 + key]; const float p = sv > -1e29f ? __expf(sv - mx) : 0.f; sum += p; Sc[rr * 140 + key] = p; } }
#pragma unroll
        for (int o = 1; o < 16; o <<= 1) sum += __shfl_xor(sum, o, 64);
        const float inv = 1.f / (sum + __expf(sk - mx));
        __syncthreads();
        f32x4 o = {0.f, 0.f, 0.f, 0.f};
        for (int key = 0; key < 136; ++key) { const float p = Sc[rr * 140 + key]; const f32x4 v = *(const LAS f32x4*)(Vc + key * 68 + kl * 4); o += v * p; }
        const size_t oo = (size_t)(MP + bs * 8 + l) * 1024 + head * 64 + kl * 4;
        const u32x2 gw = *(const u32x2*)(Zg + oo);
        f32x4 r; r[0] = o[0] * inv * bflo(gw.x); r[1] = o[1] * inv * bfhi(gw.x); r[2] = o[2] * inv * bflo(gw.y); r[3] = o[3] * inv * bfhi(gw.y);
        *(u32x2*)(OG + oo) = pk4(r);
    }
}

__device__ __forceinline__ void ret_A(LAS unsigned char* lds, const bf16_t* __restrict__ Zq, const bf16_t* __restrict__ Zk, bf16_t* __restrict__ ABUF, bf16_t* __restrict__ KDT, int G) {
    LAS bf16_t* Qs = (LAS bf16_t*)lds;
    LAS bf16_t* Ks = (LAS bf16_t*)(lds + 128 * 264 * 2);
    const int tid = otid(), w = tid >> 6, lane = tid & 63, l16 = lane & 15, g = lane >> 4;
    for (int it = blockIdx.x; it < 512; it += G) {
        const int c = it & 31, h = (it >> 5) & 3, b = it >> 7;
        const float lg = ret_lg(h);
        const size_t tok0 = (size_t)b * 4096 + c * 128;
        __syncthreads();
#pragma unroll
        for (int i = 0; i < 8; ++i) { const int ch = tid + 512 * i, s = ch >> 5, c8 = (ch & 31) * 8; const size_t src = (tok0 + s) * 1024 + h * 256 + c8;
            *(LAS u32x4*)(Qs + s * 264 + c8) = *(const u32x4*)(Zq + src); *(LAS u32x4*)(Ks + s * 264 + c8) = *(const u32x4*)(Zk + src); }
        __syncthreads();
        const int i_row = 16 * w + l16;
#pragma unroll
        for (int nt = 0; nt < 8; ++nt) {
            f32x4 a = {0.f, 0.f, 0.f, 0.f};
            if (nt <= w) {
#pragma unroll
                for (int ks = 0; ks < 8; ++ks) { const bf16x8 kf = *(const LAS bf16x8*)(Ks + (16 * nt + l16) * 264 + ks * 32 + g * 8), qf = *(const LAS bf16x8*)(Qs + i_row * 264 + ks * 32 + g * 8);
                    a = __builtin_amdgcn_mfma_f32_16x16x32_bf16(kf, qf, a, 0, 0, 0); }
#pragma unroll
                for (int r = 0; r < 4; ++r) { const int s = 16 * nt + 4 * g + r; a[r] = (s <= i_row) ? a[r] * __expf((float)(i_row - s) * lg) : 0.f; }
            }
            *(u32x2*)(ABUF + ((size_t)it * 128 + i_row) * 128 + 16 * nt + 4 * g) = pk4(a);
        }
        { const int d = tid & 255, sg0 = tid >> 8;
#pragma unroll
          for (int k = 0; k < 8; ++k) { const int s0 = 8 * (sg0 + 2 * k); float v[8];
#pragma unroll
              for (int jj = 0; jj < 8; ++jj) v[jj] = bf2f(Ks[(s0 + jj) * 264 + d]) * __expf((float)(127 - s0 - jj) * lg);
              u32x4 wv; wv.x = cvt_pk_bf16(v[0], v[1]); wv.y = cvt_pk_bf16(v[2], v[3]); wv.z = cvt_pk_bf16(v[4], v[5]); wv.w = cvt_pk_bf16(v[6], v[7]);
              *(u32x4*)(KDT + ((size_t)it * 256 + d) * 128 + s0) = wv; } }
    }
}

__device__ __forceinline__ void ret_seq_unit(LAS unsigned char* lds, int u, const bf16_t* __restrict__ Zq, const bf16_t* __restrict__ vTp, const bf16_t* __restrict__ ABUF, const bf16_t* __restrict__ KDT,
                                             float* __restrict__ ORET, float* __restrict__ out) {
    LAS bf16_t* ST = (LAS bf16_t*)lds;
    LAS bf16_t* VT = (LAS bf16_t*)(lds + 2 * 64 * 264 * 2);
    const int tid = otid(), w = tid >> 6, lane = tid & 63, l16 = lane & 15, g = lane >> 4;
    const int xcd = u & 7, jj = u >> 3, bh = xcd * 2 + (jj >> 3), es = jj & 7, b = bh >> 2, h = bh & 3;
    const float lg = ret_lg(h), g128 = __expf(128.f * lg), gi = __expf((float)(16 * w + l16 + 1) * lg);
    __syncthreads();
    for (int e = tid; e < 64 * 264 / 2; e += NT) ((LAS unsigned*)ST)[e] = 0u;
    const bf16_t* vrow = vTp + ((size_t)bh * 512 + es * 64 + (tid >> 3)) * 4096 + (tid & 7) * 16;
    LAS bf16_t* vdst = VT + (tid >> 3) * 136 + (tid & 7) * 16;
    { const u32x4 a = *(const u32x4*)vrow, bq = *(const u32x4*)(vrow + 8); *(LAS u32x4*)vdst = a; *(LAS u32x4*)(vdst + 8) = bq; }
    f32x4 sacc[2][4];
#pragma unroll
    for (int dt = 0; dt < 2; ++dt)
#pragma unroll
        for (int et = 0; et < 4; ++et) sacc[dt][et] = (f32x4){0.f, 0.f, 0.f, 0.f};
    const bf16_t* aptr = ABUF + ((size_t)bh * 32 * 128 + 16 * w + l16) * 128 + 8 * g;
    const bf16_t* qptr = Zq + ((size_t)b * 4096 + 16 * w + l16) * 1024 + h * 256 + 8 * g;
    const bf16_t* kptr = KDT + ((size_t)bh * 32 * 256 + 32 * w + l16) * 128 + 8 * g;
    float* optr = ORET + ((size_t)b * 4096 + 16 * w + l16) * 2048 + h * 512 + es * 64 + 4 * g;
    bf16x8 af[4], qf[8], kf[2][4];
#pragma unroll
    for (int ks = 0; ks < 4; ++ks) af[ks] = *(const bf16x8*)(aptr + 32 * ks);
#pragma unroll
    for (int kd = 0; kd < 8; ++kd) qf[kd] = *(const bf16x8*)(qptr + 32 * kd);
    __syncthreads();
    for (int c = 0; c < 32; ++c) {
        const int buf = c & 1;
#pragma unroll
        for (int dt = 0; dt < 2; ++dt)
#pragma unroll
            for (int ks = 0; ks < 4; ++ks) kf[dt][ks] = *(const bf16x8*)(kptr + (size_t)c * 256 * 128 + dt * 2048 + 32 * ks);
        u32x4 nv0 = {0u, 0u, 0u, 0u}, nv1 = {0u, 0u, 0u, 0u};
        if (c < 31) { nv0 = *(const u32x4*)(vrow + (c + 1) * 128); nv1 = *(const u32x4*)(vrow + (c + 1) * 128 + 8); }
        const LAS bf16_t* VTb = VT + buf * 64 * 136; const LAS bf16_t* STb = ST + buf * 64 * 264;
#pragma unroll
        for (int et = 0; et < 4; ++et) {
            f32x4 oin = {0.f, 0.f, 0.f, 0.f}, ocr = {0.f, 0.f, 0.f, 0.f};
#pragma unroll
            for (int ks = 0; ks < 4; ++ks) { const bf16x8 vf = *(const LAS bf16x8*)(VTb + (16 * et + l16) * 136 + 32 * ks + 8 * g); oin = __builtin_amdgcn_mfma_f32_16x16x32_bf16(vf, af[ks], oin, 0, 0, 0); }
#pragma unroll
            for (int kd = 0; kd < 8; ++kd) { const bf16x8 sf = *(const LAS bf16x8*)(STb + (16 * et + l16) * 264 + 32 * kd + 8 * g); ocr = __builtin_amdgcn_mfma_f32_16x16x32_bf16(sf, qf[kd], ocr, 0, 0, 0); }
            *(f32x4*)(optr + (size_t)c * 128 * 2048 + 16 * et) = oin + ocr * gi;
        }
        if (c < 31) {
#pragma unroll
            for (int ks = 0; ks < 4; ++ks) af[ks] = *(const bf16x8*)(aptr + (size_t)(c + 1) * 128 * 128 + 32 * ks);
#pragma unroll
            for (int kd = 0; kd < 8; ++kd) qf[kd] = *(const bf16x8*)(qptr + (size_t)(c + 1) * 128 * 1024 + 32 * kd);
        }
#pragma unroll
        for (int dt = 0; dt < 2; ++dt)
#pragma unroll
            for (int et = 0; et < 4; ++et) sacc[dt][et] *= g128;
#pragma unroll
        for (int et = 0; et < 4; ++et)
#pragma unroll
            for (int ks = 0; ks < 4; ++ks) { const bf16x8 vf = *(const LAS bf16x8*)(VTb + (16 * et + l16) * 136 + 32 * ks + 8 * g);
#pragma unroll
                for (int dt = 0; dt < 2; ++dt) sacc[dt][et] = __builtin_amdgcn_mfma_f32_16x16x32_bf16(kf[dt][ks], vf, sacc[dt][et], 0, 0, 0); }
#pragma unroll
        for (int dt = 0; dt < 2; ++dt)
#pragma unroll
            for (int et = 0; et < 4; ++et) *(LAS u32x2*)(ST + ((buf ^ 1) * 64 + 16 * et + l16) * 264 + 32 * w + 16 * dt + 4 * g) = pk4(sacc[dt][et]);
        if (c < 31) { LAS bf16_t* d2 = vdst + (buf ^ 1) * 64 * 136; *(LAS u32x4*)d2 = nv0; *(LAS u32x4*)(d2 + 8) = nv1; }
        __syncthreads();
    }
#pragma unroll
    for (int dt = 0; dt < 2; ++dt)
#pragma unroll
        for (int et = 0; et < 4; ++et)
#pragma unroll
            for (int r = 0; r < 4; ++r) out[OFF_RSP + ((size_t)bh * 256 + 32 * w + 16 * dt + 4 * g + r) * 512 + es * 64 + 16 * et + l16] = sacc[dt][et][r];
}

__device__ __forceinline__ void ret_sample(LAS unsigned char* lds, const Params& P, const bf16_t* __restrict__ Zq, const bf16_t* __restrict__ Zk, const bf16_t* __restrict__ vTs, float* __restrict__ ORET, unsigned* ctr) {
    LAS float* qs = (LAS float*)lds;
    LAS float* kds = qs + 2048;
    LAS float* A8 = kds + 2048;
    LAS float* red = A8 + 64;
    volatile LAS int* slot = (volatile LAS int*)(lds + LDS_BYTES - 32);
    for (;;) {
        const int tid = otid();
        __syncthreads();
        if (tid == 0) *slot = (int)atomicAdd(ctr, 1u);
        __syncthreads();
        const int it = *slot;
        if (it >= 512) break;
        const int bs = it >> 2, h = it & 3;
        const float lg = ret_lg(h), g8 = __expf(8.f * lg), ig8 = __expf(-8.f * lg);
#pragma unroll
        for (int k = 0; k < 4; ++k) { const int e = tid + 512 * k, i = e >> 8, d = e & 255; const size_t src = (size_t)(MP + bs * 8 + i) * 1024 + h * 256 + d;
            qs[d * 8 + i] = bf2f(Zq[src]) * __expf((float)(i + 1) * lg); kds[d * 8 + i] = bf2f(Zk[src]) * __expf((float)(7 - i) * lg); }
        __syncthreads();
        if (tid < 64) { const int i = tid >> 3, s = tid & 7; float a = 0.f;
            if (s <= i) { for (int d = 0; d < 256; ++d) a += qs[d * 8 + i] * kds[d * 8 + s]; a *= ig8; }
            A8[tid] = a; }
        const int eg = tid & 127, dp = tid >> 7, e0 = 4 * eg;
        float vv[8][4];
#pragma unroll
        for (int jj = 0; jj < 4; ++jj) { const u32x4 wv = *(const u32x4*)(vTs + ((size_t)((bs * 4 + h) * 512 + e0 + jj)) * 8);
            vv[0][jj] = bflo(wv.x); vv[1][jj] = bfhi(wv.x); vv[2][jj] = bflo(wv.y); vv[3][jj] = bfhi(wv.y); vv[4][jj] = bflo(wv.z); vv[5][jj] = bfhi(wv.z); vv[6][jj] = bflo(wv.w); vv[7][jj] = bfhi(wv.w); }
        f32x4 cr[8];
#pragma unroll
        for (int i = 0; i < 8; ++i) cr[i] = (f32x4){0.f, 0.f, 0.f, 0.f};
        const size_t sbase = ((size_t)(bs * 4 + h) * 256) * 512 + e0;
#pragma unroll 8
        for (int dd = 0; dd < 64; ++dd) {
            const int d = dp * 64 + dd;
            const f32x4 st = *(const f32x4*)(P.state_ret + sbase + (size_t)d * 512);
            const f32x4 qa = *(const LAS f32x4*)(qs + d * 8), qb = *(const LAS f32x4*)(qs + d * 8 + 4), ka = *(const LAS f32x4*)(kds + d * 8), kb = *(const LAS f32x4*)(kds + d * 8 + 4);
            const float q8[8] = {qa[0], qa[1], qa[2], qa[3], qb[0], qb[1], qb[2], qb[3]}, k8[8] = {ka[0], ka[1], ka[2], ka[3], kb[0], kb[1], kb[2], kb[3]};
            f32x4 ns = st * g8;
#pragma unroll
            for (int s = 0; s < 8; ++s)
#pragma unroll
                for (int jj = 0; jj < 4; ++jj) ns[jj] += k8[s] * vv[s][jj];
            *(f32x4*)(P.out + OFF_RSS + sbase + (size_t)d * 512) = ns;
#pragma unroll
            for (int i = 0; i < 8; ++i) cr[i] += st * q8[i];
        }
#pragma unroll
        for (int i = 0; i < 8; ++i) *(LAS f32x4*)(red + (dp * 8 + i) * 512 + e0) = cr[i];
        __syncthreads();
        { const int i = tid >> 6, e8 = (tid & 63) * 8;
          float o[8];
#pragma unroll
          for (int jj = 0; jj < 8; ++jj) o[jj] = red[(0 * 8 + i) * 512 + e8 + jj] + red[(1 * 8 + i) * 512 + e8 + jj] + red[(2 * 8 + i) * 512 + e8 + jj] + red[(3 * 8 + i) * 512 + e8 + jj];
#pragma unroll
          for (int jj = 0; jj < 8; ++jj) { const u32x4 wv = *(const u32x4*)(vTs + ((size_t)((bs * 4 + h) * 512 + e8 + jj)) * 8);
              const float v8[8] = {bflo(wv.x), bfhi(wv.x), bflo(wv.y), bfhi(wv.y), bflo(wv.z), bfhi(wv.z), bflo(wv.w), bfhi(wv.w)};
#pragma unroll
              for (int s = 0; s < 8; ++s) o[jj] += A8[i * 8 + s] * v8[s]; }
          float* dst = ORET + (size_t)(MP + bs * 8 + i) * 2048 + h * 512 + e8;
          *(f32x4*)dst = (f32x4){o[0], o[1], o[2], o[3]}; *(f32x4*)(dst + 4) = (f32x4){o[4], o[5], o[6], o[7]}; }
    }
}

__device__ __forceinline__ void ret_gnorm(const float* __restrict__ ORET, const bf16_t* __restrict__ Zg, bf16_t* __restrict__ OG, int G) {
    const int tid_o = otid(), wave = tid_o >> 6, lane = tid_o & 63;
    for (int task = blockIdx.x * 8 + wave; task < MT * 4; task += G * 8) {
        const size_t o = (size_t)(task >> 2) * 2048 + (task & 3) * 512 + lane * 8;
        const f32x4 a = *(const f32x4*)(ORET + o), b = *(const f32x4*)(ORET + o + 4);
        const float mu = wave_sum(a[0] + a[1] + a[2] + a[3] + b[0] + b[1] + b[2] + b[3]) * (1.f / 512.f);
        const f32x4 da = a - mu, db = b - mu;
        const float var = wave_sum(da[0] * da[0] + da[1] * da[1] + da[2] * da[2] + da[3] * da[3] + db[0] * db[0] + db[1] * db[1] + db[2] * db[2] + db[3] * db[3]) * (1.f / 512.f);
        const float rs = rsqrtf(var + EPS);
        const u32x4 gw = *(const u32x4*)(Zg + o);
        u32x4 r;
        r.x = cvt_pk_bf16(da[0] * rs * bflo(gw.x), da[1] * rs * bfhi(gw.x)); r.y = cvt_pk_bf16(da[2] * rs * bflo(gw.y), da[3] * rs * bfhi(gw.y));
        r.z = cvt_pk_bf16(db[0] * rs * bflo(gw.z), db[1] * rs * bfhi(gw.z)); r.w = cvt_pk_bf16(db[2] * rs * bflo(gw.w), db[3] * rs * bfhi(gw.w));
        *(u32x4*)(OG + o) = r;
    }
}

__global__ void __launch_bounds__(NT) hybrid_fwd(Params P) {
    extern __shared__ __attribute__((aligned(16))) unsigned char lds_raw[];
    LAS unsigned char* lds = (LAS unsigned char*)lds_raw;
    cg::grid_group grid = cg::this_grid();
    const int G = gridDim.x, tid = threadIdx.x;
    unsigned char* ws = P.ws;
    bf16_t* WT_IN_ATTN = (bf16_t*)(ws + WS_WT_IN_ATTN); bf16_t* WT_OUT_ATTN = (bf16_t*)(ws + WS_WT_OUT_ATTN); bf16_t* WT_IN_RET = (bf16_t*)(ws + WS_WT_IN_RET); bf16_t* WT_OUT_RET = (bf16_t*)(ws + WS_WT_OUT_RET);
    bf16_t* WT_GATE = (bf16_t*)(ws + WS_WT_GATE); bf16_t* WT_PLE = (bf16_t*)(ws + WS_WT_PLE);
    float* TABA = (float*)(ws + WS_TABA); float* TABR = (float*)(ws + WS_TABR);
    bf16_t* H = (bf16_t*)(ws + WS_H); bf16_t* PB = (bf16_t*)(ws + WS_PB);
    float* PLE = (float*)(ws + WS_PLE); float* Y = (float*)(ws + WS_Y); float* X1 = (float*)(ws + WS_X1); float* X2 = (float*)(ws + WS_X2);
    bf16_t* OG = (bf16_t*)(ws + WS_OG); bf16_t* ZQ = (bf16_t*)(ws + WS_ZQ); bf16_t* ZK = (bf16_t*)(ws + WS_ZK); bf16_t* ZG = (bf16_t*)(ws + WS_ZG);
    bf16_t* VTP = (bf16_t*)(ws + WS_VTP); bf16_t* VTS = (bf16_t*)(ws + WS_VTS); bf16_t* ABUF = (bf16_t*)(ws + WS_ABUF); bf16_t* KDT = (bf16_t*)(ws + WS_KDT); float* ORET = (float*)(ws + WS_ORET);
    pg8::StaticOrder SO;
    volatile LAS unsigned* bst = (volatile LAS unsigned*)(lds + LDS_BYTES - 16);
    if (tid < 4) bst[tid] = 0u;
    __syncthreads();
    const XcdBarrier xbar = xcd_barrier_post((unsigned*)(ws + WS_BAR), bst);
#define GSYNC() xcd_barrier(xbar)

for (int rep_ = 0; rep_ < REP_P0; ++rep_) {
    for (int t = blockIdx.x; t < 3584; t += G) {
        LAS float* T = (LAS float*)lds;
        if (t < 640) transpose_tile(P.w_in_attn, WT_IN_ATTN, 1024, 2560, true, t, T);
        else if (t < 896) transpose_tile(P.w_out_attn, WT_OUT_ATTN, 1024, 1024, false, t - 640, T);
        else if (t < 2432) transpose_tile(P.w_in_ret, WT_IN_RET, 1024, 6144, false, t - 896, T);
        else if (t < 2944) transpose_tile(P.w_out_ret, WT_OUT_RET, 2048, 1024, false, t - 2432, T);
        else if (t < 3200) transpose_tile(P.w_gate, WT_GATE, 1024, 1024, false, t - 2944, T);
        else if (t < 3456) transpose_tile(P.w_gate + 1024 * 1024, WT_GATE + 1024 * 1024, 1024, 1024, false, t - 3200, T);
        else if (t < 3520) transpose_tile(P.w_ple, WT_PLE, 256, 1024, false, t - 3456, T);
        else transpose_tile(P.w_ple + 256 * 1024, WT_PLE + 1024 * 256, 256, 1024, false, t - 3520, T);
    }
    for (int e = blockIdx.x * NT + tid; e < 4104 * 160; e += G * NT) {
        const int pi = e / 160, f = e % 160; const int pos = pi < 4096 ? pi : 16384 + (pi - 4096);
        if (f < 32) { const float inv = powf(10000.f, -(float)f / 32.f), ang = (float)pos * inv; TABA[((size_t)pi * 32 + f) * 2] = cosf(ang); TABA[((size_t)pi * 32 + f) * 2 + 1] = sinf(ang); }
        else { const int f2 = f - 32; const float inv = powf(10000.f, -(float)f2 / 128.f), ang = (float)pos * inv; TABR[((size_t)pi * 128 + f2) * 2] = cosf(ang); TABR[((size_t)pi * 128 + f2) * 2 + 1] = sinf(ang); }
    }
    for (int e = blockIdx.x * NT + tid; e < 2 * MT * 64; e += G * NT) {
        const int i = e / (MT * 64), rem = e % (MT * 64), row = rem >> 6, c4 = (rem & 63) * 4;
        const float* src = row < MP ? P.p_prompt + ((size_t)i * MP + row) * 256 + c4 : P.p_sample + ((size_t)i * MS + row - MP) * 256 + c4;
        *(u32x2*)(PB + ((size_t)i * MT + row) * 256 + c4) = pk4(*(const f32x4*)src);
    }
    rms_rows(P.x_prompt, P.x_sample, P.pre_norm, H, G);
}
    grid.sync();

for (int rep_ = 0; rep_ < REP_GIN; ++rep_) {
    { pg8::Gemm g{H, WT_IN_ATTN, MT, 2560, 1024}; SO.init(MT, 2560, G, blockIdx.x);
      EpiInAttn E{ZQ, ZK, ZG, VTP, VTS, TABA, P.out}; pg8::gemm_phase(lds, g, SO, E); }
    { pg8::Gemm g{PB, WT_PLE, MP, 1024, 256}; SO.init(MP, 1024, G, blockIdx.x);
      EpiF32 E{PLE, 1024}; pg8::gemm_phase(lds, g, SO, E);
      skinny_gemm(lds, PB + (size_t)MP * 256, WT_PLE, 256, SkF32{PLE + (size_t)MP * 1024}, G); }
}
    GSYNC();

for (int rep_ = 0; rep_ < REP_ATT; ++rep_) {
    attn_prompt(lds, ZQ, ZK, ZG, VTP, P.sinks, OG, G);
    attn_sample(lds, P, ZQ, ZK, ZG, VTS, OG, G);
}
    GSYNC();

for (int rep_ = 0; rep_ < REP_GN1; ++rep_) {
    { pg8::Gemm g{OG, WT_OUT_ATTN, MP, 1024, 1024}; SO.init(MP, 1024, G, blockIdx.x); EpiF32 E{Y, 1024}; pg8::gemm_phase(lds, g, SO, E);
      skinny_gemm(lds, OG + (size_t)MP * 1024, WT_OUT_ATTN, 1024, SkF32{Y + (size_t)MP * 1024}, G); }
}
    GSYNC();
for (int rep_ = 0; rep_ < REP_ROW; ++rep_) {
    resid_rows(P.x_prompt, P.x_sample, Y, P.post_norm, X1, H, G);
}
    GSYNC();
for (int rep_ = 0; rep_ < REP_GN1; ++rep_) {
    { pg8::Gemm g{H, WT_GATE, MP, 1024, 1024}; SO.init(MP, 1024, G, blockIdx.x); EpiGate E{X1, PLE, X2}; pg8::gemm_phase(lds, g, SO, E);
      skinny_gemm(lds, H + (size_t)MP * 1024, WT_GATE, 1024, SkGate{X1 + (size_t)MP * 1024, PLE + (size_t)MP * 1024, X2 + (size_t)MP * 1024}, G); }
}
    GSYNC();
for (int rep_ = 0; rep_ < REP_ROW; ++rep_) {
    rms_rows(X2, X2 + (size_t)MP * 1024, P.pre_norm + 1024, H, G);
}
    GSYNC();
for (int rep_ = 0; rep_ < REP_GIN; ++rep_) {
    { pg8::Gemm g{H, WT_IN_RET, MT, 6144, 1024}; SO.init(MT, 6144, G, blockIdx.x);
      EpiInRet E{ZQ, ZK, ZG, VTP, VTS, TABR}; pg8::gemm_phase(lds, g, SO, E); }
    { pg8::Gemm g{PB + (size_t)MT * 256, WT_PLE + 1024 * 256, MP, 1024, 256}; SO.init(MP, 1024, G, blockIdx.x);
      EpiF32 E{PLE, 1024}; pg8::gemm_phase(lds, g, SO, E);
      skinny_gemm(lds, PB + (size_t)MT * 256 + (size_t)MP * 256, WT_PLE + 1024 * 256, 256, SkF32{PLE + (size_t)MP * 1024}, G); }
}
    GSYNC();
for (int rep_ = 0; rep_ < REP_RA; ++rep_) {
    ret_A(lds, ZQ, ZK, ABUF, KDT, G);
}
    GSYNC();
for (int rep_ = 0; rep_ < REP_RS; ++rep_) {
    for (int u = blockIdx.x; u < 128; u += G) ret_seq_unit(lds, u, ZQ, VTP, ABUF, KDT, ORET, P.out);
}
for (int rep_ = 0; rep_ < REP_RSMP; ++rep_) {
    ret_sample(lds, P, ZQ, ZK, VTS, ORET, (unsigned*)(ws + WS_BAR + 14336) + 64 * rep_);
}
for (int rep_ = 0; rep_ < REP_SYNC; ++rep_) GSYNC();
    GSYNC();
for (int rep_ = 0; rep_ < REP_ROW; ++rep_) {
    ret_gnorm(ORET, ZG, OG, G);
}
    GSYNC();
for (int rep_ = 0; rep_ < REP_GN1; ++rep_) {
    { pg8::Gemm g{OG, WT_OUT_RET, MP, 1024, 2048}; SO.init(MP, 1024, G, blockIdx.x); EpiF32 E{Y, 1024}; pg8::gemm_phase(lds, g, SO, E);
      skinny_gemm(lds, OG + (size_t)MP * 2048, WT_OUT_RET, 2048, SkF32{Y + (size_t)MP * 1024}, G); }
}
    GSYNC();
for (int rep_ = 0; rep_ < REP_ROW; ++rep_) {
    resid_rows(X2, X2 + (size_t)MP * 1024, Y, P.post_norm + 1024, X1, H, G);
}
    GSYNC();
for (int rep_ = 0; rep_ < REP_GN1; ++rep_) {
    { pg8::Gemm g{H, WT_GATE + 1024 * 1024, MP, 1024, 1024}; SO.init(MP, 1024, G, blockIdx.x); EpiGate E{X1, PLE, P.out}; pg8::gemm_phase(lds, g, SO, E);
      skinny_gemm(lds, H + (size_t)MP * 1024, WT_GATE + 1024 * 1024, 1024, SkGate{X1 + (size_t)MP * 1024, PLE + (size_t)MP * 1024, P.out + (size_t)MP * 1024}, G); }
}
}

extern "C" void kernel_launch(void* const* d_in, const int* in_sizes, int n_in, void* d_out, int out_size, void* d_ws, size_t ws_size, hipStream_t stream) {
    static int grid_blocks = 0;
    if (!grid_blocks) {
        int dev = 0, cus = 0, per_cu = 0;
        hipGetDevice(&dev);
        hipDeviceGetAttribute(&cus, hipDeviceAttributeMultiprocessorCount, dev);
        hipFuncSetAttribute((const void*)hybrid_fwd, hipFuncAttributeMaxDynamicSharedMemorySize, LDS_BYTES);
        hipOccupancyMaxActiveBlocksPerMultiprocessor(&per_cu, (const void*)hybrid_fwd, NT, LDS_BYTES);
        if (per_cu < 1) per_cu = 1;
        if (per_cu > 1) per_cu = 1;
        grid_blocks = cus * per_cu;
        if (ws_size < WS_END) fprintf(stderr, "kernel_launch: workspace too small: %zu < %zu\n", ws_size, (size_t)WS_END);
    }
    Params p{};
    p.x_prompt = (const float*)d_in[0]; p.x_sample = (const float*)d_in[1]; p.cache_k = (const float*)d_in[2]; p.cache_v = (const float*)d_in[3]; p.state_ret = (const float*)d_in[4];
    p.p_prompt = (const float*)d_in[5]; p.p_sample = (const float*)d_in[6]; p.pre_norm = (const float*)d_in[7]; p.post_norm = (const float*)d_in[8]; p.w_in_attn = (const float*)d_in[9];
    p.sinks = (const float*)d_in[10]; p.w_out_attn = (const float*)d_in[11]; p.w_in_ret = (const float*)d_in[12]; p.w_out_ret = (const float*)d_in[13]; p.w_ple = (const float*)d_in[14]; p.w_gate = (const float*)d_in[15];
    p.out = (float*)d_out; p.ws = (unsigned char*)d_ws;
    (void)hipMemsetAsync((unsigned char*)d_ws + WS_BAR, 0, 16384, stream);
    void* args[] = {&p};
    hipError_t e = hipLaunchCooperativeKernel((const void*)hybrid_fwd, dim3(grid_blocks), dim3(NT), args, LDS_BYTES, stream);
    if (e != hipSuccess) fprintf(stderr, "cooperative launch failed: %s (grid %d)\n", hipGetErrorString(e), grid_blocks);
}
```

```cpp
#include <hip/hip_runtime.h>
#include <hip/hip_cooperative_groups.h>
#include <cstdio>
#include <cstdint>
namespace cg = cooperative_groups;

#define LAS __attribute__((address_space(3)))
typedef unsigned short bf16_t;
typedef short bf16x8 __attribute__((ext_vector_type(8)));
typedef float f32x4 __attribute__((ext_vector_type(4)));
typedef float f32x2 __attribute__((ext_vector_type(2)));
typedef unsigned u32x2 __attribute__((ext_vector_type(2)));
typedef unsigned u32x4 __attribute__((ext_vector_type(4)));

constexpr int MP = 16384, MS = 1024, MT = MP + MS;
constexpr int NT = 512;
#define REP_P0 1
#define REP_GIN 1
#define REP_ATT 1
#define REP_RA 1
#define REP_SYNC 0
#define REP_R3 1
#define REP_SCAN 1
#define REP_ROW 1
#define REP_GN1 1
constexpr int LDS_BYTES = 140 * 1024;
constexpr float EPS = 1e-6f;

constexpr size_t OFF_YP = 0, OFF_YS = 16777216, OFF_KWP = 17825792, OFF_VWP = 17956864, OFF_KWS = 18087936, OFF_VWS = 22282240, OFF_RSP = 26476544, OFF_RSS = 28573696;

constexpr size_t al256(size_t x) { return (x + 255) & ~(size_t)255; }
constexpr size_t WS_WT_IN_ATTN = 0;
constexpr size_t WS_WT_OUT_ATTN = WS_WT_IN_ATTN + (size_t)2560 * 1024 * 2;
constexpr size_t WS_WT_IN_RET = WS_WT_OUT_ATTN + (size_t)1024 * 1024 * 2;
constexpr size_t WS_WT_OUT_RET = WS_WT_IN_RET + (size_t)6144 * 1024 * 2;
constexpr size_t WS_WT_GATE = WS_WT_OUT_RET + (size_t)1024 * 2048 * 2;
constexpr size_t WS_WT_PLE = WS_WT_GATE + (size_t)2 * 1024 * 1024 * 2;
constexpr size_t WS_TABA = WS_WT_PLE + (size_t)2 * 1024 * 256 * 2;
constexpr size_t WS_TABR = WS_TABA + (size_t)4104 * 32 * 8;
constexpr size_t WS_H = al256(WS_TABR + (size_t)4104 * 128 * 8);
constexpr size_t WS_PB = WS_H + (size_t)MT * 1024 * 2;
constexpr size_t WS_PLE = WS_PB + (size_t)2 * MT * 256 * 2;
constexpr size_t WS_Y = WS_PLE + (size_t)MT * 1024 * 4;
constexpr size_t WS_X1 = WS_Y + (size_t)MT * 1024 * 4;
constexpr size_t WS_X2 = WS_X1 + (size_t)MT * 1024 * 4;
constexpr size_t WS_OG = WS_X2 + (size_t)MT * 1024 * 4;
constexpr size_t WS_ZQ = WS_OG + (size_t)MT * 2048 * 2;
constexpr size_t WS_ZK = WS_ZQ + (size_t)MT * 1024 * 2;
constexpr size_t WS_ZG = WS_ZK + (size_t)MT * 1024 * 2;
constexpr size_t WS_VTP = WS_ZG + (size_t)MT * 2048 * 2;
constexpr size_t WS_VTS = WS_VTP + (size_t)16 * 512 * 4096 * 2;
constexpr size_t WS_ABUF = WS_VTS + (size_t)128 * 4 * 512 * 8 * 2;
constexpr size_t WS_KDT = WS_ABUF + (size_t)512 * 128 * 128 * 2;
constexpr size_t WS_ORET = WS_KDT + (size_t)512 * 256 * 128 * 2;
constexpr size_t WS_BAR = WS_ORET + (size_t)MT * 2048 * 4;
constexpr size_t WS_END = WS_BAR + 16384;

struct Params {
    const float *x_prompt, *x_sample, *cache_k, *cache_v, *state_ret, *p_prompt, *p_sample, *pre_norm, *post_norm, *w_in_attn, *sinks, *w_out_attn, *w_in_ret, *w_out_ret, *w_ple, *w_gate;
    float* out; unsigned char* ws;
};

__device__ __forceinline__ unsigned cvt_pk_bf16(float lo, float hi) { unsigned r; asm volatile("v_cvt_pk_bf16_f32 %0, %1, %2" : "=v"(r) : "v"(lo), "v"(hi)); return r; }
__device__ __forceinline__ u32x2 pk4(f32x4 v) { u32x2 w; w.x = cvt_pk_bf16(v[0], v[1]); w.y = cvt_pk_bf16(v[2], v[3]); return w; }
__device__ __forceinline__ float bf2f(bf16_t b) { return __uint_as_float(((unsigned)b) << 16); }
__device__ __forceinline__ float bflo(unsigned w) { return __uint_as_float(w << 16); }
__device__ __forceinline__ float bfhi(unsigned w) { return __uint_as_float(w & 0xffff0000u); }
__device__ __forceinline__ float silu_f(float x) { return x / (1.f + __expf(-x)); }
__device__ __forceinline__ float sigmoid_f(float x) { return 1.f / (1.f + __expf(-x)); }
__device__ __forceinline__ float wave_sum(float v) {
#pragma unroll
    for (int o = 32; o >= 1; o >>= 1) v += __shfl_xor(v, o, 64);
    return v;
}
__device__ __forceinline__ int otid() { int t = threadIdx.x; asm volatile("" : "+v"(t)); return t; }
__device__ __forceinline__ void lds_barrier() { asm volatile("s_waitcnt lgkmcnt(0)" ::: "memory"); __builtin_amdgcn_s_barrier(); asm volatile("" ::: "memory"); }
__device__ __forceinline__ float ret_lg(int h) { return log1pf(-exp2f(-5.f - (float)h)); }

#define XB_TMO      128
#define XB_XCNT(j)  (256  + 64 * (j))
#define XB_XSUB(j)  (1280 + 64 * (j))
#define XB_XGEN(j)  (2304 + 64 * (j))
#define XB_TOP      3328
#define XB_TOPGEN   3392
#define XCD_BAR_WORDS 3456
#define XB_SPIN_CAP (1u << 18)

__device__ __forceinline__ unsigned xb_ld(unsigned* p)              { return __hip_atomic_load(p, __ATOMIC_RELAXED, __HIP_MEMORY_SCOPE_AGENT); }
__device__ __forceinline__ unsigned xb_add(unsigned* p, unsigned v) { return __hip_atomic_fetch_add(p, v, __ATOMIC_RELAXED, __HIP_MEMORY_SCOPE_AGENT); }
__device__ __forceinline__ unsigned xb_xcc_id() { return (unsigned)__builtin_amdgcn_s_getreg((3 << 11) | 20) & 0xFu; }
#define XB_SPIN(cond, bar) do { unsigned _sp = 0; while (cond) { __builtin_amdgcn_s_sleep(1); \
    if ((++_sp & 255u) == 0u) { if (xb_ld(&(bar)[XB_TMO])) break; if (_sp > XB_SPIN_CAP) { atomicAdd(&(bar)[XB_TMO], 1u); break; } } } } while (0)

struct XcdBarrier {
    unsigned* bar; unsigned x;
    volatile LAS unsigned* st;
};

__device__ __forceinline__ XcdBarrier xcd_barrier_post(unsigned* bar, volatile LAS unsigned* st) {
    XcdBarrier b; b.bar = bar; b.x = xb_xcc_id(); b.st = st;
    if (threadIdx.x == 0) (void)xb_add(&bar[XB_XCNT(b.x)], 1u);
    return b;
}
__device__ __forceinline__ void xcd_barrier_complete(unsigned* bar, unsigned x, unsigned& nloc, unsigned& nx) {
    const unsigned G = gridDim.x * gridDim.y * gridDim.z;
    unsigned sum, cnt, mine, sp = 0u;
    for (;;) {
        sum = 0u; cnt = 0u; mine = 0u;
#pragma unroll
        for (unsigned j = 0; j < 16; ++j) { const unsigned c = xb_ld(&bar[XB_XCNT(j)]); sum += c; cnt += (c > 0u) ? 1u : 0u; mine = (j == x) ? c : mine; }
        if (sum == G) break;
        __builtin_amdgcn_s_sleep(1);
        if ((++sp & 255u) == 0u) { if (xb_ld(&bar[XB_TMO])) break; if (sp > XB_SPIN_CAP) { atomicAdd(&bar[XB_TMO], 1u); break; } }
    }
    nloc = mine > 0u ? mine : 1u; nx = cnt > 0u ? cnt : 1u;
}

__device__ __forceinline__ void xcd_barrier(const XcdBarrier& b) {
    asm volatile("s_waitcnt vmcnt(0)" ::: "memory");
    __syncthreads();
    if (threadIdx.x == 0) {
        unsigned* bar = b.bar;
        __builtin_amdgcn_s_waitcnt(0);
        unsigned nloc = b.st[0], nx = b.st[1];
        if (nloc == 0u) { xcd_barrier_complete(bar, b.x, nloc, nx); b.st[0] = nloc; b.st[1] = nx; }
        const unsigned old = xb_add(&bar[XB_XSUB(b.x)], 1u);
        const unsigned gen = old / nloc;
        if (old + 1u == (gen + 1u) * nloc) {
            __builtin_amdgcn_fence(__ATOMIC_RELEASE, "agent");
            asm volatile("s_waitcnt vmcnt(0)" ::: "memory");
            const unsigned og = xb_add(&bar[XB_TOP], 1u);
            const unsigned tg = og / nx;
            if (og + 1u == (tg + 1u) * nx) xb_add(&bar[XB_TOPGEN], 1u);
            else XB_SPIN(xb_ld(&bar[XB_TOPGEN]) == tg, bar);
            __builtin_amdgcn_fence(__ATOMIC_ACQUIRE, "agent");
            xb_add(&bar[XB_XGEN(b.x)], 1u);
            asm volatile("s_waitcnt vmcnt(0)" ::: "memory");
        } else {
            XB_SPIN(xb_ld(&bar[XB_XGEN(b.x)]) == gen, bar);
            __builtin_amdgcn_fence(__ATOMIC_ACQUIRE, "agent");
            asm volatile("s_waitcnt vmcnt(0)" ::: "memory");
        }
    }
    __syncthreads();
}

namespace pg8 {
constexpr int BM = 256, BK = 64, HALF = 128, HTB = HALF * BK * 2, STAGE_BYTES = 8 * HTB, NXCD = 8, WGM = 8;
__host__ __device__ __forceinline__ int lds_byte(int r, int c) { const int st = (r >> 4) * 2 + (c >> 5), rr = r & 15, cc = c & 31, ob = rr * 64 + cc * 2; return st * 1024 + (ob ^ (((ob >> 9) & 1) << 5)); }
__host__ __device__ __forceinline__ void stage_rc(int b, int& R, int& C) { const int st = b / 1024, sb = b % 1024, swz = sb ^ (((sb >> 9) & 1) << 5); R = (st >> 1) * 16 + swz / 64; C = (st & 1) * 32 + (swz % 64) / 2; }
struct Unit { int pm, pn; };
struct Gemm { const bf16_t* A; const bf16_t* Bt; int M, N, K; };
struct StaticOrder {
    int nM, nN, nwg, G, c;
    __host__ __device__ void init(int M, int N, int G_, int c_) { nM = M / BM; nN = N / BM; nwg = nM * nN; G = G_; c = c_; }
    __host__ __device__ bool next(int i, Unit& u) const {
        const long L = (long)i * G + c; if (L >= nwg) return false;
        int wgid = (int)L; { const int q = nwg / NXCD, r = nwg % NXCD, xcd = wgid % NXCD, off = wgid / NXCD; wgid = (xcd < r ? xcd * (q + 1) : r * (q + 1) + (xcd - r) * q) + off; }
        const int nig = WGM * nN, gid = wgid / nig, fm = gid * WGM, gsz = (nM - fm) < WGM ? (nM - fm) : WGM;
        u.pm = fm + ((wgid % nig) % gsz); u.pn = (wgid % nig) / gsz; return true;
    }
};

template <class Epi>
__device__ __forceinline__ void gemm_phase(LAS unsigned char* lds, const Gemm g, const StaticOrder& S, const Epi& E) {
    const int tid = otid(), wid = __builtin_amdgcn_readfirstlane(tid >> 6), lane = tid & 63, wr = wid >> 2, wc = wid & 3, fr = lane & 15, fq = lane >> 4;
    const int K = g.K, nt = K / BK;
    unsigned voffA[2], voffB[2];
#pragma unroll
    for (int i = 0; i < 2; ++i) { int R, C; stage_rc(tid * 16 + i * 8192, R, C); voffA[i] = (unsigned)(R * K + C) * 2u; voffB[i] = voffA[i]; }
    const size_t kstep = (size_t)(BK * 2);
    const size_t hstep = (size_t)HALF * K * 2;
    const size_t tstep = 2 * hstep;
    const unsigned ldsw = (unsigned)wid * 1024u;
    const int aoff = lds_byte(wr * 64 + fr, fq * 8), boff = lds_byte(wc * 32 + fr, fq * 8);
#define PG8_SA(b, h) (((b) * 2 + (h)) * HTB)
#define PG8_SB(b, h) ((4 + (b) * 2 + (h)) * HTB)
#define PG8_STAGE(bufoff, gbase, voff) do { _Pragma("unroll") for (int _i = 0; _i < 2; ++_i) \
        __builtin_amdgcn_global_load_lds((const unsigned*)((const char*)(gbase) + (voff)[_i]), (LAS unsigned*)(lds + (bufoff) + ldsw + _i * 8192), 16, 0, 0); } while (0)
#define PG8_LDA(dst, b, h) do { _Pragma("unroll") for (int m = 0; m < 4; ++m) _Pragma("unroll") for (int k = 0; k < 2; ++k) dst[m][k] = *(const LAS bf16x8*)(lds + PG8_SA(b, h) + aoff + m * 2048 + k * 1024); } while (0)
#define PG8_LDB(dst, b, h) do { _Pragma("unroll") for (int n = 0; n < 2; ++n) _Pragma("unroll") for (int k = 0; k < 2; ++k) dst[n][k] = *(const LAS bf16x8*)(lds + PG8_SB(b, h) + boff + n * 2048 + k * 1024); } while (0)
#define PG8_MMA(ai, bj, At, Bt) do { __builtin_amdgcn_s_setprio(1); _Pragma("unroll") for (int m = 0; m < 4; ++m) _Pragma("unroll") for (int n = 0; n < 2; ++n) _Pragma("unroll") for (int k = 0; k < 2; ++k) \
        acc[ai][bj][m][n] = __builtin_amdgcn_mfma_f32_16x16x32_bf16(Bt[n][k], At[m][k], acc[ai][bj][m][n], 0, 0, 0); __builtin_amdgcn_s_setprio(0); } while (0)
#define PG8_WAIT_V(n) asm volatile("s_waitcnt vmcnt(" #n ")" ::: "memory")
#define PG8_WAIT_L(n) asm volatile("s_waitcnt lgkmcnt(" #n ")" ::: "memory")
#define PG8_BAR __builtin_amdgcn_s_barrier()
#define PG8_SCHED __builtin_amdgcn_sched_barrier(0)
#define PG8_PTRS(u, pa, pb) do { const char* _a = (const char*)g.A + (size_t)(u).pm * tstep; const char* _b = (const char*)g.Bt + (size_t)(u).pn * tstep; if (Epi::swap(u)) { pa = _b; pb = _a; } else { pa = _a; pb = _b; } } while (0)
    Unit cur, nxt; int ui = 0;
    if (!S.next(0, cur)) return;
    f32x4 acc[2][2][4][2];
#pragma unroll
    for (int a = 0; a < 2; ++a)
#pragma unroll
        for (int b = 0; b < 2; ++b)
#pragma unroll
            for (int m = 0; m < 4; ++m)
#pragma unroll
                for (int n = 0; n < 2; ++n) acc[a][b][m][n] = (f32x4){0.f, 0.f, 0.f, 0.f};
    bf16x8 At[4][2], B0[2][2], B1[2][2];
    const char* cA; const char* cB;
    PG8_PTRS(cur, cA, cB);
    PG8_STAGE(PG8_SB(0, 0), cB, voffB); PG8_STAGE(PG8_SA(0, 0), cA, voffA); PG8_STAGE(PG8_SB(0, 1), cB + hstep, voffB); PG8_STAGE(PG8_SA(0, 1), cA + hstep, voffA);
    if (wr == 1) PG8_BAR;
    PG8_WAIT_V(4); PG8_BAR;
    PG8_STAGE(PG8_SB(1, 0), cB + kstep, voffB); PG8_STAGE(PG8_SA(1, 0), cA + kstep, voffA); PG8_STAGE(PG8_SB(1, 1), cB + hstep + kstep, voffB);
    PG8_WAIT_V(6); PG8_BAR;
    for (;;) {
        const bool has_next = S.next(ui + 1, nxt);
        const char* nA = cA; const char* nB = cB;
        if (has_next) PG8_PTRS(nxt, nA, nB);
        for (int t = 0; t < nt; t += 2) {
            const bool last = (t == nt - 2);
            const char* a1 = cA + (size_t)(t + 1) * kstep;
            const char* a2 = last ? nA : cA + (size_t)(t + 2) * kstep; const char* b2 = last ? nB : cB + (size_t)(t + 2) * kstep;
            const char* a3 = a2 + kstep; const char* b3 = b2 + kstep;
            PG8_LDB(B0, 0, 0); PG8_SCHED; PG8_LDA(At, 0, 0); PG8_STAGE(PG8_SA(1, 1), a1 + hstep, voffA);
            PG8_WAIT_L(8); PG8_BAR; PG8_WAIT_L(0); PG8_MMA(0, 0, At, B0); PG8_BAR; PG8_SCHED;
            PG8_LDB(B1, 0, 1); PG8_STAGE(PG8_SB(0, 0), b2, voffB);
            PG8_BAR; PG8_WAIT_L(0); PG8_MMA(0, 1, At, B1); PG8_BAR;
            PG8_LDA(At, 0, 1); PG8_STAGE(PG8_SA(0, 0), a2, voffA);
            PG8_BAR; PG8_WAIT_L(0); PG8_MMA(1, 0, At, B0); PG8_BAR; PG8_SCHED;
            PG8_STAGE(PG8_SB(0, 1), b2 + hstep, voffB);
            PG8_WAIT_V(6); PG8_BAR; PG8_MMA(1, 1, At, B1); PG8_BAR;
            PG8_LDB(B0, 1, 0); PG8_SCHED; PG8_LDA(At, 1, 0); PG8_STAGE(PG8_SA(0, 1), a2 + hstep, voffA);
            PG8_WAIT_L(8); PG8_BAR; PG8_WAIT_L(0); PG8_MMA(0, 0, At, B0); PG8_BAR; PG8_SCHED;
            PG8_LDB(B1, 1, 1); PG8_STAGE(PG8_SB(1, 0), b3, voffB);
            PG8_BAR; PG8_WAIT_L(0); PG8_MMA(0, 1, At, B1); PG8_BAR;
            PG8_LDA(At, 1, 1); PG8_STAGE(PG8_SA(1, 0), a3, voffA);
            PG8_BAR; PG8_WAIT_L(0); PG8_MMA(1, 0, At, B0); PG8_BAR; PG8_SCHED;
            PG8_STAGE(PG8_SB(1, 1), b3 + hstep, voffB);
            PG8_WAIT_V(6); PG8_BAR; PG8_MMA(1, 1, At, B1); PG8_BAR;
        }
        E(acc, cur, wr, wc, fr, fq);
        if (!has_next) break;
#pragma unroll
        for (int a = 0; a < 2; ++a)
#pragma unroll
            for (int b = 0; b < 2; ++b)
#pragma unroll
                for (int m = 0; m < 4; ++m)
#pragma unroll
                    for (int n = 0; n < 2; ++n) acc[a][b][m][n] = (f32x4){0.f, 0.f, 0.f, 0.f};
        cur = nxt; cA = nA; cB = nB; ++ui;
    }
    PG8_WAIT_V(0);
    if (wr == 0) PG8_BAR;
    PG8_BAR;
#undef PG8_SA
#undef PG8_SB
#undef PG8_STAGE
#undef PG8_LDA
#undef PG8_LDB
#undef PG8_MMA
#undef PG8_WAIT_V
#undef PG8_WAIT_L
#undef PG8_BAR
#undef PG8_SCHED
#undef PG8_PTRS
}
}
using pg8::Unit;

struct EpiF32 {
    float* C; int ldc;
    __device__ __forceinline__ static bool swap(const Unit&) { return false; }
    __device__ __forceinline__ void operator()(const f32x4 (&acc)[2][2][4][2], const Unit& u, int wr, int wc, int fr, int fq) const {
        const int row0 = u.pm * 256 + wr * 64 + fr, col0 = u.pn * 256 + wc * 32 + 4 * fq;
#pragma unroll
        for (int ai = 0; ai < 2; ++ai)
#pragma unroll
            for (int m = 0; m < 4; ++m) { float* rowp = C + (size_t)(row0 + ai * 128 + m * 16) * ldc + col0;
#pragma unroll
                for (int bj = 0; bj < 2; ++bj)
#pragma unroll
                    for (int n = 0; n < 2; ++n) *(f32x4*)(rowp + bj * 128 + n * 16) = acc[ai][bj][m][n]; }
    }
};
struct EpiB16 {
    bf16_t* C; int ldc;
    __device__ __forceinline__ static bool swap(const Unit&) { return false; }
    __device__ __forceinline__ void operator()(const f32x4 (&acc)[2][2][4][2], const Unit& u, int wr, int wc, int fr, int fq) const {
        const int row0 = u.pm * 256 + wr * 64 + fr, col0 = u.pn * 256 + wc * 32 + 4 * fq;
#pragma unroll
        for (int ai = 0; ai < 2; ++ai)
#pragma unroll
            for (int m = 0; m < 4; ++m) { bf16_t* rowp = C + (size_t)(row0 + ai * 128 + m * 16) * ldc + col0;
#pragma unroll
                for (int bj = 0; bj < 2; ++bj)
#pragma unroll
                    for (int n = 0; n < 2; ++n) *(u32x2*)(rowp + bj * 128 + n * 16) = pk4(acc[ai][bj][m][n]); }
    }
};
struct EpiGate {
    const float* X1; const bf16_t* PLE; float* O;
    __device__ __forceinline__ static bool swap(const Unit&) { return false; }
    __device__ __forceinline__ void operator()(const f32x4 (&acc)[2][2][4][2], const Unit& u, int wr, int wc, int fr, int fq) const {
        const int row0 = u.pm * 256 + wr * 64 + fr, col0 = u.pn * 256 + wc * 32 + 4 * fq;
#pragma unroll
        for (int ai = 0; ai < 2; ++ai)
#pragma unroll
            for (int m = 0; m < 4; ++m) { const size_t ro = (size_t)(row0 + ai * 128 + m * 16) * 1024 + col0;
#pragma unroll
                for (int bj = 0; bj < 2; ++bj)
#pragma unroll
                    for (int n = 0; n < 2; ++n) { const size_t o = ro + bj * 128 + n * 16; const f32x4 x1 = *(const f32x4*)(X1 + o), a = acc[ai][bj][m][n]; const u32x2 pw = *(const u32x2*)(PLE + o); const f32x4 pl = {bflo(pw.x), bfhi(pw.x), bflo(pw.y), bfhi(pw.y)}; f32x4 r;
#pragma unroll
                        for (int j = 0; j < 4; ++j) r[j] = x1[j] + sigmoid_f(a[j]) * pl[j];
                        *(f32x4*)(O + o) = r; } }
    }
};
struct EpiInAttn {
    bf16_t *Zq, *Zk, *Zg, *vTp, *vTs; const float* tab; float* out;
    __device__ __forceinline__ static bool swap(const Unit& u) { return u.pn == 5; }
    __device__ __forceinline__ void operator()(const f32x4 (&acc)[2][2][4][2], const Unit& u, int wr, int wc, int fr, int fq) const {
        const int pn = u.pn;
        if (pn < 5) {
            const bool isq = pn < 4;
            const int fi = 16 * (wc & 1) + 4 * fq;
#pragma unroll
            for (int ai = 0; ai < 2; ++ai)
#pragma unroll
                for (int m = 0; m < 4; ++m) {
                    const int r = u.pm * 256 + ai * 128 + wr * 64 + m * 16 + fr;
                    const int pi = r < MP ? (r & 4095) : 4096 + ((r - MP) & 7);
                    const f32x4 t0 = *(const f32x4*)(tab + ((size_t)pi * 32 + fi) * 2), t1 = *(const f32x4*)(tab + ((size_t)pi * 32 + fi) * 2 + 4);
                    const float cs[4] = {t0[0], t0[2], t1[0], t1[2]}, sn[4] = {t0[1], t0[3], t1[1], t1[3]};
#pragma unroll
                    for (int bj = 0; bj < 2; ++bj) {
                        const f32x4 x1 = acc[ai][bj][m][0], x2 = acc[ai][bj][m][1]; f32x4 o1, o2;
#pragma unroll
                        for (int j = 0; j < 4; ++j) { o1[j] = x1[j] * cs[j] - x2[j] * sn[j]; o2[j] = x2[j] * cs[j] + x1[j] * sn[j]; }
                        const int hh = 2 * bj + (wc >> 1), d1 = 16 * (wc & 1) + 4 * fq;
                        if (isq) {
                            bf16_t* p = Zq + (size_t)r * 1024 + pn * 256 + hh * 64 + d1;
                            *(u32x2*)p = pk4(o1 * 0.125f); *(u32x2*)(p + 32) = pk4(o2 * 0.125f);
                        } else {
                            bf16_t* p = Zk + (size_t)r * 256 + hh * 64 + d1;
                            *(u32x2*)p = pk4(o1); *(u32x2*)(p + 32) = pk4(o2);
                            if (r < MP) { const int t = r & 4095; if (t >= 3968) { float* dst = out + OFF_KWP + ((size_t)((r >> 12) * 128 + t - 3968) * 4 + hh) * 64 + d1; *(f32x4*)dst = o1; *(f32x4*)(dst + 32) = o2; } }
                            else { const int rs = r - MP; float* dst = out + OFF_KWS + ((size_t)((rs >> 3) * 128 + 120 + (rs & 7)) * 4 + hh) * 64 + d1; *(f32x4*)dst = o1; *(f32x4*)(dst + 32) = o2; }
                        }
                    }
                    asm volatile("" ::: "memory");
                }
        } else if (pn == 5) {
#pragma unroll
            for (int ai = 0; ai < 2; ++ai)
#pragma unroll
                for (int m = 0; m < 4; ++m) {
                    const int e = ai * 128 + wr * 64 + m * 16 + fr, kvh = e >> 6, d = e & 63;
#pragma unroll
                    for (int bj = 0; bj < 2; ++bj)
#pragma unroll
                        for (int n = 0; n < 2; ++n) {
                            const int tok = u.pm * 256 + bj * 128 + wc * 32 + n * 16 + 4 * fq; const f32x4 v = acc[ai][bj][m][n];
                            if (tok < MP) { const int b = tok >> 12, t = tok & 4095;
                                *(u32x2*)(vTp + ((size_t)((b * 4 + kvh) * 64 + d)) * 4096 + t) = pk4(v);
                                if (t >= 3968) {
#pragma unroll
                                    for (int jj = 0; jj < 4; ++jj) out[OFF_VWP + ((size_t)(b * 128 + t - 3968 + jj) * 4 + kvh) * 64 + d] = v[jj]; }
                            } else { const int ts = tok - MP, bs = ts >> 3, l0 = ts & 7;
                                *(u32x2*)(vTs + ((size_t)((bs * 4 + kvh) * 64 + d)) * 8 + l0) = pk4(v);
#pragma unroll
                                for (int jj = 0; jj < 4; ++jj) out[OFF_VWS + ((size_t)(bs * 128 + 120 + l0 + jj) * 4 + kvh) * 64 + d] = v[jj]; }
                        }
                }
        } else {
#pragma unroll
            for (int ai = 0; ai < 2; ++ai)
#pragma unroll
                for (int m = 0; m < 4; ++m) { const int r = u.pm * 256 + ai * 128 + wr * 64 + m * 16 + fr;
#pragma unroll
                    for (int bj = 0; bj < 2; ++bj)
#pragma unroll
                        for (int n = 0; n < 2; ++n) { const f32x4 a = acc[ai][bj][m][n]; f32x4 s;
#pragma unroll
                            for (int j = 0; j < 4; ++j) s[j] = silu_f(a[j]);
                            *(u32x2*)(Zg + (size_t)r * 1024 + (pn - 6) * 256 + bj * 128 + wc * 32 + n * 16 + 4 * fq) = pk4(s); } }
        }
    }
};
struct EpiInRet {
    bf16_t *Zq, *Zk, *Zg, *vTp, *vTs; const float* tab;
    __device__ __forceinline__ static bool swap(const Unit& u) { return u.pn >= 8 && u.pn < 16; }
    __device__ __forceinline__ void operator()(const f32x4 (&acc)[2][2][4][2], const Unit& u, int wr, int wc, int fr, int fq) const {
        const int pn = u.pn;
        if (pn < 8) {
            const bool isq = pn < 4; const float sc = isq ? 1.f : 0.0625f;
            bf16_t* Z = isq ? Zq : Zk; const int hc = (pn & 3) * 256;
#pragma unroll
            for (int ai = 0; ai < 2; ++ai)
#pragma unroll
                for (int m = 0; m < 4; ++m) {
                    const int r = u.pm * 256 + ai * 128 + wr * 64 + m * 16 + fr;
                    const int pi = r < MP ? (r & 4095) : 4096 + ((r - MP) & 7);
#pragma unroll
                    for (int n = 0; n < 2; ++n) {
                        const int d = wc * 32 + n * 16 + 4 * fq;
                        const f32x4 t0 = *(const f32x4*)(tab + ((size_t)pi * 128 + d) * 2), t1 = *(const f32x4*)(tab + ((size_t)pi * 128 + d) * 2 + 4);
                        const float cs[4] = {t0[0], t0[2], t1[0], t1[2]}, sn[4] = {t0[1], t0[3], t1[1], t1[3]};
                        const f32x4 x1 = acc[ai][0][m][n], x2 = acc[ai][1][m][n]; f32x4 o1, o2;
#pragma unroll
                        for (int j = 0; j < 4; ++j) { o1[j] = (x1[j] * cs[j] - x2[j] * sn[j]) * sc; o2[j] = (x2[j] * cs[j] + x1[j] * sn[j]) * sc; }
                        bf16_t* p = Z + (size_t)r * 1024 + hc + d;
                        *(u32x2*)p = pk4(o1); *(u32x2*)(p + 128) = pk4(o2);
                    }
                }
        } else if (pn < 16) {
#pragma unroll
            for (int ai = 0; ai < 2; ++ai)
#pragma unroll
                for (int m = 0; m < 4; ++m) {
                    const int eg = (pn - 8) * 256 + ai * 128 + wr * 64 + m * 16 + fr, h = eg >> 9, e = eg & 511;
#pragma unroll
                    for (int bj = 0; bj < 2; ++bj)
#pragma unroll
                        for (int n = 0; n < 2; ++n) {
                            const int tok = u.pm * 256 + bj * 128 + wc * 32 + n * 16 + 4 * fq; const u32x2 w = pk4(acc[ai][bj][m][n]);
                            if (tok < MP) { const int b = tok >> 12, t = tok & 4095; *(u32x2*)(vTp + ((size_t)((b * 4 + h) * 512 + e)) * 4096 + t) = w; }
                            else { const int ts = tok - MP, bs = ts >> 3, l0 = ts & 7; *(u32x2*)(vTs + ((size_t)((bs * 4 + h) * 512 + e)) * 8 + l0) = w; }
                        }
                }
        } else {
#pragma unroll
            for (int ai = 0; ai < 2; ++ai)
#pragma unroll
                for (int m = 0; m < 4; ++m) { const int r = u.pm * 256 + ai * 128 + wr * 64 + m * 16 + fr;
#pragma unroll
                    for (int bj = 0; bj < 2; ++bj)
#pragma unroll
                        for (int n = 0; n < 2; ++n) { const f32x4 a = acc[ai][bj][m][n]; f32x4 s;
#pragma unroll
                            for (int j = 0; j < 4; ++j) s[j] = silu_f(a[j]);
                            *(u32x2*)(Zg + (size_t)r * 2048 + (pn - 16) * 256 + bj * 128 + wc * 32 + n * 16 + 4 * fq) = pk4(s); } }
        }
    }
};

__device__ __forceinline__ void transpose_tile(const float* __restrict__ W, bf16_t* __restrict__ Wt, int K, int N, bool perm, int tile, LAS float* T) {
    const int tid = otid(), ntn = N >> 6;
    const int n0 = (tile % ntn) * 64, k0 = (tile / ntn) * 64, nn = tid & 63;
    const int nd = n0 + nn; int ns = nd;
    if (perm && nd < 1280) { const int p = nd & 63; ns = (nd - p) + (p >> 5) * 16 + (p & 15) + ((p >> 4) & 1) * 32; }
#pragma unroll
    for (int i = 0; i < 8; ++i) { const int kk = (tid >> 6) + 8 * i; T[kk * 65 + nn] = W[(size_t)(k0 + kk) * N + ns]; }
    __syncthreads();
    const int kk2 = (tid & 31) * 2;
#pragma unroll
    for (int i = 0; i < 4; ++i) { const int n2 = (tid >> 5) + 16 * i; *(unsigned*)(Wt + (size_t)(n0 + n2) * K + k0 + kk2) = cvt_pk_bf16(T[kk2 * 65 + n2], T[(kk2 + 1) * 65 + n2]); }
    __syncthreads();
}

__device__ __forceinline__ void rms_rows(const float* __restrict__ Xa, const float* __restrict__ Xb, const float* __restrict__ g, bf16_t* __restrict__ H, int G) {
    const int tid_o = otid(), wave = tid_o >> 6, lane = tid_o & 63;
    for (int row = blockIdx.x * 8 + wave; row < MT; row += G * 8) {
        const float* x = row < MP ? Xa + (size_t)row * 1024 : Xb + (size_t)(row - MP) * 1024;
        f32x4 v[4]; float ss = 0.f;
#pragma unroll
        for (int i = 0; i < 4; ++i) { v[i] = *(const f32x4*)(x + lane * 4 + 256 * i); ss += v[i][0] * v[i][0] + v[i][1] * v[i][1] + v[i][2] * v[i][2] + v[i][3] * v[i][3]; }
        ss = wave_sum(ss);
        const float rr = rsqrtf(ss * (1.f / 1024.f) + EPS);
#pragma unroll
        for (int i = 0; i < 4; ++i) { const f32x4 gg = *(const f32x4*)(g + lane * 4 + 256 * i); *(u32x2*)(H + (size_t)row * 1024 + lane * 4 + 256 * i) = pk4(v[i] * rr * gg); }
    }
}
__device__ __forceinline__ void resid_rows(const float* __restrict__ Xa, const float* __restrict__ Xb, const bf16_t* __restrict__ Y, const float* __restrict__ g, float* __restrict__ X1, bf16_t* __restrict__ H, int G) {
    const int tid_o = otid(), wave = tid_o >> 6, lane = tid_o & 63;
    for (int row = blockIdx.x * 8 + wave; row < MT; row += G * 8) {
        const float* x = row < MP ? Xa + (size_t)row * 1024 : Xb + (size_t)(row - MP) * 1024;
        const bf16_t* y = Y + (size_t)row * 1024;
        f32x4 v[4]; float ss = 0.f;
#pragma unroll
        for (int i = 0; i < 4; ++i) { const u32x2 yw = *(const u32x2*)(y + lane * 4 + 256 * i); v[i] = (f32x4){bflo(yw.x), bfhi(yw.x), bflo(yw.y), bfhi(yw.y)}; ss += v[i][0] * v[i][0] + v[i][1] * v[i][1] + v[i][2] * v[i][2] + v[i][3] * v[i][3]; }
        ss = wave_sum(ss);
        const float rr = rsqrtf(ss * (1.f / 1024.f) + EPS);
#pragma unroll
        for (int i = 0; i < 4; ++i) { const int c = lane * 4 + 256 * i; const f32x4 gg = *(const f32x4*)(g + c), xx = *(const f32x4*)(x + c); const f32x4 o = xx + v[i] * rr * gg;
            *(f32x4*)(X1 + (size_t)row * 1024 + c) = o; *(u32x2*)(H + (size_t)row * 1024 + c) = pk4(o); }
    }
}


struct SkF32 { float* C; __device__ __forceinline__ void operator()(int row, int col, f32x4 v) const { *(f32x4*)(C + (size_t)row * 1024 + col) = v; } };
struct SkB16 { bf16_t* C; __device__ __forceinline__ void operator()(int row, int col, f32x4 v) const { *(u32x2*)(C + (size_t)row * 1024 + col) = pk4(v); } };
struct SkGate { const float* X1; const bf16_t* PLE; float* O;
    __device__ __forceinline__ void operator()(int row, int col, f32x4 a) const { const size_t o = (size_t)row * 1024 + col; const f32x4 x1 = *(const f32x4*)(X1 + o); const u32x2 pw = *(const u32x2*)(PLE + o); const f32x4 pl = {bflo(pw.x), bfhi(pw.x), bflo(pw.y), bfhi(pw.y)}; f32x4 r;
#pragma unroll
        for (int j = 0; j < 4; ++j) r[j] = x1[j] + sigmoid_f(a[j]) * pl[j];
        *(f32x4*)(O + o) = r; } };
template <class Epi>
__device__ __forceinline__ void skinny_gemm(LAS unsigned char* lds, const bf16_t* __restrict__ A, const bf16_t* __restrict__ Bt, int K, const Epi& E, int G) {
    LAS float* red = (LAS float*)lds;
    const int tid = otid(), w = tid >> 6, lane = tid & 63, l16 = lane & 15, g = lane >> 4;
    const int KS = K >> 3, nks = KS >> 5;
    for (int u = blockIdx.x; u < 256; u += G) {
        const int row0 = (u >> 4) * 64, col0 = (u & 15) * 64;
        const bf16_t* ap = A + (size_t)(row0 + l16) * K + w * KS + 8 * g;
        const bf16_t* bp = Bt + (size_t)(col0 + l16) * K + w * KS + 8 * g;
        f32x4 acc[4][4];
#pragma unroll
        for (int mt = 0; mt < 4; ++mt)
#pragma unroll
            for (int nt = 0; nt < 4; ++nt) acc[mt][nt] = (f32x4){0.f, 0.f, 0.f, 0.f};
#pragma unroll 4
        for (int ks = 0; ks < nks; ++ks) {
            bf16x8 af[4], bf[4];
#pragma unroll
            for (int t = 0; t < 4; ++t) { af[t] = *(const bf16x8*)(ap + (size_t)(16 * t) * K + 32 * ks); bf[t] = *(const bf16x8*)(bp + (size_t)(16 * t) * K + 32 * ks); }
#pragma unroll
            for (int mt = 0; mt < 4; ++mt)
#pragma unroll
                for (int nt = 0; nt < 4; ++nt) acc[mt][nt] = __builtin_amdgcn_mfma_f32_16x16x32_bf16(bf[nt], af[mt], acc[mt][nt], 0, 0, 0);
        }
        __syncthreads();
#pragma unroll
        for (int mt = 0; mt < 4; ++mt)
#pragma unroll
            for (int nt = 0; nt < 4; ++nt) *(LAS f32x4*)(red + (w * 64 + 16 * mt + l16) * 68 + 16 * nt + 4 * g) = acc[mt][nt];
        __syncthreads();
#pragma unroll
        for (int j = 0; j < 2; ++j) { const int q = tid + 512 * j, row = q >> 4, c4 = (q & 15) * 4; f32x4 sum = *(const LAS f32x4*)(red + row * 68 + c4);
#pragma unroll
            for (int ww = 1; ww < 8; ++ww) sum += *(const LAS f32x4*)(red + (ww * 64 + row) * 68 + c4);
            E(row0 + row, col0 + c4, sum); }
    }
}

__device__ __forceinline__ void attn_prompt(LAS unsigned char* lds, const bf16_t* __restrict__ Zq, const bf16_t* __restrict__ Zk, const bf16_t* __restrict__ Zg, const bf16_t* __restrict__ vTp,
                                            const float* __restrict__ sinks, bf16_t* __restrict__ OG, int G) {
    LAS bf16_t* Ks = (LAS bf16_t*)lds;
    LAS bf16_t* Vt = (LAS bf16_t*)(lds + 256 * 72 * 2);
    const int tid = otid(), w = tid >> 6, lane = tid & 63, l16 = lane & 15, g = lane >> 4;
    for (int it = blockIdx.x; it < 512; it += G) {
        const int kvh = it & 3, nb = (it >> 2) & 31, b = it >> 7;
        __syncthreads();
#pragma unroll
        for (int i = 0; i < 4; ++i) { const int ch = tid + 512 * i, s = ch >> 3, c8 = ch & 7, t = (nb - 1) * 128 + s;
            u32x4 val = {0u, 0u, 0u, 0u}; if (t >= 0) val = *(const u32x4*)(Zk + (size_t)(b * 4096 + t) * 256 + kvh * 64 + c8 * 8);
            *(LAS u32x4*)(Ks + s * 72 + c8 * 8) = val; }
#pragma unroll
        for (int i = 0; i < 4; ++i) { const int ch = tid + 512 * i, d = ch >> 5, s0 = (ch & 31) * 8, t0 = (nb - 1) * 128 + s0;
            u32x4 val = {0u, 0u, 0u, 0u}; if (t0 >= 0) val = *(const u32x4*)(vTp + ((size_t)((b * 4 + kvh) * 64 + d)) * 4096 + t0);
            *(LAS u32x4*)(Vt + d * 264 + s0) = val; }
        __syncthreads();
        const int head = kvh * 4 + (w >> 1);
        const float sk = sinks[head];
        for (int qi = 0; qi < 4; ++qi) {
            const int qt = (w & 1) * 4 + qi;
            const size_t tq = (size_t)b * 4096 + nb * 128 + qt * 16 + l16;
            bf16x8 qf[2];
#pragma unroll
            for (int ks = 0; ks < 2; ++ks) qf[ks] = *(const bf16x8*)(Zq + tq * 1024 + head * 64 + ks * 32 + g * 8);
            f32x4 sa[9];
#pragma unroll
            for (int j = 0; j < 9; ++j) { sa[j] = (f32x4){0.f, 0.f, 0.f, 0.f};
#pragma unroll
                for (int ks = 0; ks < 2; ++ks) { const bf16x8 kf = *(const LAS bf16x8*)(Ks + (16 * (qt + j) + l16) * 72 + ks * 32 + g * 8);
                    sa[j] = __builtin_amdgcn_mfma_f32_16x16x32_bf16(kf, qf[ks], sa[j], 0, 0, 0); } }
            float mx = sk;
#pragma unroll
            for (int j = 0; j < 9; ++j)
#pragma unroll
                for (int r = 0; r < 4; ++r) {
                    bool vis = true;
                    if (j == 0) vis = (4 * g + r) > l16;
                    if (j == 8) vis = (4 * g + r) <= l16;
                    if (nb == 0 && (qt + j) < 8) vis = false;
                    sa[j][r] = vis ? sa[j][r] : -1e30f;
                    mx = fmaxf(mx, sa[j][r]);
                }
            mx = fmaxf(mx, __shfl_xor(mx, 16, 64)); mx = fmaxf(mx, __shfl_xor(mx, 32, 64));
            float sum = 0.f;
#pragma unroll
            for (int j = 0; j < 9; ++j)
#pragma unroll
                for (int r = 0; r < 4; ++r) { const float p = __expf(sa[j][r] - mx); sa[j][r] = p; sum += p; }
            sum += __shfl_xor(sum, 16, 64); sum += __shfl_xor(sum, 32, 64);
            const float inv = 1.f / (sum + __expf(sk - mx));
            f32x4 oa[4];
#pragma unroll
            for (int dt = 0; dt < 4; ++dt) oa[dt] = (f32x4){0.f, 0.f, 0.f, 0.f};
#pragma unroll
            for (int u = 0; u < 5; ++u) {
                u32x4 pw; pw.x = cvt_pk_bf16(sa[2 * u][0], sa[2 * u][1]); pw.y = cvt_pk_bf16(sa[2 * u][2], sa[2 * u][3]);
                if (u < 4) { pw.z = cvt_pk_bf16(sa[2 * u + 1][0], sa[2 * u + 1][1]); pw.w = cvt_pk_bf16(sa[2 * u + 1][2], sa[2 * u + 1][3]); } else { pw.z = 0u; pw.w = 0u; }
                const bf16x8 pf = __builtin_bit_cast(bf16x8, pw);
                const int k0 = 16 * (qt + 2 * u) + 4 * g, k1 = (u < 4) ? k0 + 16 : k0;
#pragma unroll
                for (int dt = 0; dt < 4; ++dt) {
                    const u32x2 v0 = *(const LAS u32x2*)(Vt + (16 * dt + l16) * 264 + k0), v1 = *(const LAS u32x2*)(Vt + (16 * dt + l16) * 264 + k1);
                    u32x4 vw; vw.x = v0.x; vw.y = v0.y; vw.z = v1.x; vw.w = v1.y;
                    oa[dt] = __builtin_amdgcn_mfma_f32_16x16x32_bf16(__builtin_bit_cast(bf16x8, vw), pf, oa[dt], 0, 0, 0);
                }
            }
#pragma unroll
            for (int dt = 0; dt < 4; ++dt) {
                const size_t o = tq * 1024 + head * 64 + 16 * dt + 4 * g;
                const u32x2 gw = *(const u32x2*)(Zg + o);
                f32x4 r; r[0] = oa[dt][0] * inv * bflo(gw.x); r[1] = oa[dt][1] * inv * bfhi(gw.x); r[2] = oa[dt][2] * inv * bflo(gw.y); r[3] = oa[dt][3] * inv * bfhi(gw.y);
                *(u32x2*)(OG + o) = pk4(r);
            }
        }
    }
}

__device__ __forceinline__ void attn_sample(LAS unsigned char* lds, const Params& P, const bf16_t* __restrict__ Zq, const bf16_t* __restrict__ Zk, const bf16_t* __restrict__ Zg, const bf16_t* __restrict__ vTs,
                                            bf16_t* __restrict__ OG, int G) {
    LAS float* Kc = (LAS float*)lds;
    LAS float* Vc = Kc + 136 * 68;
    LAS float* Qs = Vc + 136 * 68;
    LAS float* Sc = Qs + 32 * 68;
    const int tid = otid();
    for (int it = blockIdx.x; it < 512; it += G) {
        const int bs = it >> 2, kvh = it & 3;
        __syncthreads();
#pragma unroll
        for (int i = 0; i < 4; ++i) { const int ch = tid + 512 * i, j = ch >> 4, d4 = (ch & 15) * 4;
            const size_t src = ((size_t)(bs * 128 + j) * 4 + kvh) * 64 + d4;
            const f32x4 kv = *(const f32x4*)(P.cache_k + src), vv = *(const f32x4*)(P.cache_v + src);
            *(LAS f32x4*)(Kc + j * 68 + d4) = kv; *(LAS f32x4*)(Vc + j * 68 + d4) = vv;
            if (j >= 8) { const size_t dst = ((size_t)(bs * 128 + j - 8) * 4 + kvh) * 64 + d4; *(f32x4*)(P.out + OFF_KWS + dst) = kv; *(f32x4*)(P.out + OFF_VWS + dst) = vv; } }
        { const int l = tid >> 6, d = tid & 63;
          Kc[(128 + l) * 68 + d] = bf2f(Zk[(size_t)(MP + bs * 8 + l) * 256 + kvh * 64 + d]);
          Vc[(128 + l) * 68 + d] = bf2f(vTs[((size_t)((bs * 4 + kvh) * 64 + d)) * 8 + l]); }
#pragma unroll
        for (int i = 0; i < 4; ++i) { const int e = tid + 512 * i, rr = e >> 6, d = e & 63, hq = rr >> 3, l = rr & 7;
            Qs[rr * 68 + d] = bf2f(Zq[(size_t)(MP + bs * 8 + l) * 1024 + (kvh * 4 + hq) * 64 + d]); }
        __syncthreads();
        const int rr = tid >> 4, kl = tid & 15, l = rr & 7, hq = rr >> 3, head = kvh * 4 + hq;
        const float sk = P.sinks[head];
        float mx = sk;
#pragma unroll 1
        for (int m = 0; m < 9; ++m) {
            const int key = kl + 16 * m;
            if (key < 136) {
                float dot = -1e30f;
                const bool vis = key < 128 ? (key > l) : ((key - 128) <= l);
                if (vis) { float a = 0.f;
#pragma unroll
                    for (int d4 = 0; d4 < 16; ++d4) { const f32x4 q = *(const LAS f32x4*)(Qs + rr * 68 + d4 * 4), k = *(const LAS f32x4*)(Kc + key * 68 + d4 * 4); a += q[0] * k[0] + q[1] * k[1] + q[2] * k[2] + q[3] * k[3]; }
                    dot = a; }
                Sc[rr * 140 + key] = dot; mx = fmaxf(mx, dot);
            }
        }
#pragma unroll
        for (int o = 1; o < 16; o <<= 1) mx = fmaxf(mx, __shfl_xor(mx, o, 64));
        float sum = 0.f;
#pragma unroll 1
        for (int m = 0; m < 9; ++m) { const int key = kl + 16 * m;
            if (key < 136) { const float sv = Sc[rr * 140 + key]; const float p = sv > -1e29f ? __expf(sv - mx) : 0.f; sum += p; Sc[rr * 140 + key] = p; } }
#pragma unroll
        for (int o = 1; o < 16; o <<= 1) sum += __shfl_xor(sum, o, 64);
        const float inv = 1.f / (sum + __expf(sk - mx));
        __syncthreads();
        f32x4 o = {0.f, 0.f, 0.f, 0.f};
        for (int key = 0; key < 136; ++key) { const float p = Sc[rr * 140 + key]; const f32x4 v = *(const LAS f32x4*)(Vc + key * 68 + kl * 4); o += v * p; }
        const size_t oo = (size_t)(MP + bs * 8 + l) * 1024 + head * 64 + kl * 4;
        const u32x2 gw = *(const u32x2*)(Zg + oo);
        f32x4 r; r[0] = o[0] * inv * bflo(gw.x); r[1] = o[1] * inv * bfhi(gw.x); r[2] = o[2] * inv * bflo(gw.y); r[3] = o[3] * inv * bfhi(gw.y);
        *(u32x2*)(OG + oo) = pk4(r);
    }
}

__device__ __forceinline__ void ret_A(LAS unsigned char* lds, const bf16_t* __restrict__ Zq, const bf16_t* __restrict__ Zk, bf16_t* __restrict__ ABUF, bf16_t* __restrict__ KDT, int G) {
    LAS bf16_t* Qs = (LAS bf16_t*)lds;
    LAS bf16_t* Ks = (LAS bf16_t*)(lds + 128 * 264 * 2);
    const int tid = otid(), w = tid >> 6, lane = tid & 63, l16 = lane & 15, g = lane >> 4;
    for (int it = blockIdx.x; it < 512; it += G) {
        const int c = it & 31, h = (it >> 5) & 3, b = it >> 7;
        const float lg = ret_lg(h);
        const size_t tok0 = (size_t)b * 4096 + c * 128;
        __syncthreads();
#pragma unroll
        for (int i = 0; i < 8; ++i) { const int ch = tid + 512 * i, s = ch >> 5, c8 = (ch & 31) * 8; const size_t src = (tok0 + s) * 1024 + h * 256 + c8;
            *(LAS u32x4*)(Qs + s * 264 + c8) = *(const u32x4*)(Zq + src); *(LAS u32x4*)(Ks + s * 264 + c8) = *(const u32x4*)(Zk + src); }
        __syncthreads();
        const int i_row = 16 * w + l16;
#pragma unroll
        for (int nt = 0; nt < 8; ++nt) {
            f32x4 a = {0.f, 0.f, 0.f, 0.f};
            if (nt <= w) {
#pragma unroll
                for (int ks = 0; ks < 8; ++ks) { const bf16x8 kf = *(const LAS bf16x8*)(Ks + (16 * nt + l16) * 264 + ks * 32 + g * 8), qf = *(const LAS bf16x8*)(Qs + i_row * 264 + ks * 32 + g * 8);
                    a = __builtin_amdgcn_mfma_f32_16x16x32_bf16(kf, qf, a, 0, 0, 0); }
#pragma unroll
                for (int r = 0; r < 4; ++r) { const int s = 16 * nt + 4 * g + r; a[r] = (s <= i_row) ? a[r] * __expf((float)(i_row - s) * lg) : 0.f; }
            }
            *(u32x2*)(ABUF + ((size_t)it * 128 + i_row) * 128 + 16 * nt + 4 * g) = pk4(a);
        }
        { const int d = tid & 255, sg0 = tid >> 8;
#pragma unroll
          for (int k = 0; k < 8; ++k) { const int s0 = 8 * (sg0 + 2 * k); float v[8];
#pragma unroll
              for (int jj = 0; jj < 8; ++jj) v[jj] = bf2f(Ks[(s0 + jj) * 264 + d]) * __expf((float)(127 - s0 - jj) * lg);
              u32x4 wv; wv.x = cvt_pk_bf16(v[0], v[1]); wv.y = cvt_pk_bf16(v[2], v[3]); wv.z = cvt_pk_bf16(v[4], v[5]); wv.w = cvt_pk_bf16(v[6], v[7]);
              *(u32x4*)(KDT + ((size_t)it * 256 + d) * 128 + s0) = wv; } }
    }
}

__device__ __forceinline__ void ret_scan_unit(LAS unsigned char* lds, int u, const bf16_t* __restrict__ vTp, const bf16_t* __restrict__ KDT, bf16_t* __restrict__ SC, float* __restrict__ out) {
    LAS bf16_t* VT = (LAS bf16_t*)lds;
    const int tid = otid(), w = tid >> 6, lane = tid & 63, l16 = lane & 15, g = lane >> 4;
    const int xcd = u & 7, jj = u >> 3, bh = xcd * 2 + (jj >> 3), es = jj & 7, h = bh & 3;
    const float lg = ret_lg(h), g128 = __expf(128.f * lg);
    __syncthreads();
    const bf16_t* vrow = vTp + ((size_t)bh * 512 + es * 64 + (tid >> 3)) * 4096 + (tid & 7) * 16;
    LAS bf16_t* vdst = VT + (tid >> 3) * 136 + (tid & 7) * 16;
    { const u32x4 a = *(const u32x4*)vrow, bq = *(const u32x4*)(vrow + 8); *(LAS u32x4*)vdst = a; *(LAS u32x4*)(vdst + 8) = bq; }
    f32x4 sacc[2][4];
#pragma unroll
    for (int dt = 0; dt < 2; ++dt)
#pragma unroll
        for (int et = 0; et < 4; ++et) sacc[dt][et] = (f32x4){0.f, 0.f, 0.f, 0.f};
    const bf16_t* kptr = KDT + ((size_t)bh * 32 * 256 + 32 * w + l16) * 128 + 8 * g;
    bf16_t* scp = SC + (((size_t)bh * 32) * 512 + es * 64 + l16) * 256 + 32 * w + 4 * g;
    bf16x8 kf[2][4], kn[2][4];
#pragma unroll
    for (int dt = 0; dt < 2; ++dt)
#pragma unroll
        for (int ks = 0; ks < 4; ++ks) { kf[dt][ks] = *(const bf16x8*)(kptr + dt * 2048 + 32 * ks); kn[dt][ks] = kf[dt][ks]; }
    __syncthreads();
    for (int c = 0; c < 32; ++c) {
        const int buf = c & 1;
        u32x4 nv0 = {0u, 0u, 0u, 0u}, nv1 = {0u, 0u, 0u, 0u};
        if (c < 31) { nv0 = *(const u32x4*)(vrow + (c + 1) * 128); nv1 = *(const u32x4*)(vrow + (c + 1) * 128 + 8);
#pragma unroll
            for (int dt = 0; dt < 2; ++dt)
#pragma unroll
                for (int ks = 0; ks < 4; ++ks) kn[dt][ks] = *(const bf16x8*)(kptr + (size_t)(c + 1) * 256 * 128 + dt * 2048 + 32 * ks); }
        asm volatile("" ::: "memory");
        const LAS bf16_t* VTb = VT + buf * 64 * 136;
#pragma unroll
        for (int dt = 0; dt < 2; ++dt)
#pragma unroll
            for (int et = 0; et < 4; ++et) sacc[dt][et] *= g128;
#pragma unroll
        for (int et = 0; et < 4; ++et)
#pragma unroll
            for (int ks = 0; ks < 4; ++ks) { const bf16x8 vf = *(const LAS bf16x8*)(VTb + (16 * et + l16) * 136 + 32 * ks + 8 * g);
#pragma unroll
                for (int dt = 0; dt < 2; ++dt) sacc[dt][et] = __builtin_amdgcn_mfma_f32_16x16x32_bf16(kf[dt][ks], vf, sacc[dt][et], 0, 0, 0); }
        if (c < 31) {
#pragma unroll
            for (int dt = 0; dt < 2; ++dt)
#pragma unroll
                for (int et = 0; et < 4; ++et) *(u32x2*)(scp + (size_t)(c + 1) * 512 * 256 + (size_t)(16 * et) * 256 + 16 * dt) = pk4(sacc[dt][et]);
            LAS bf16_t* d2 = vdst + (buf ^ 1) * 64 * 136; *(LAS u32x4*)d2 = nv0; *(LAS u32x4*)(d2 + 8) = nv1;
        }
        lds_barrier();
#pragma unroll
        for (int dt = 0; dt < 2; ++dt)
#pragma unroll
            for (int ks = 0; ks < 4; ++ks) kf[dt][ks] = kn[dt][ks];
    }
#pragma unroll
    for (int dt = 0; dt < 2; ++dt)
#pragma unroll
        for (int et = 0; et < 4; ++et)
#pragma unroll
            for (int r = 0; r < 4; ++r) out[OFF_RSP + ((size_t)bh * 256 + 32 * w + 16 * dt + 4 * g + r) * 512 + es * 64 + 16 * et + l16] = sacc[dt][et][r];
}

__device__ __forceinline__ void ret_out_items(LAS unsigned char* lds, const bf16_t* __restrict__ Zq, const bf16_t* __restrict__ vTp, const bf16_t* __restrict__ ABUF, const bf16_t* __restrict__ SC, bf16_t* __restrict__ ORET, int G) {
    LAS bf16_t* VS = (LAS bf16_t*)lds;
    LAS bf16_t* SS = (LAS bf16_t*)(lds + 2 * 64 * 136 * 2);
    for (int it = blockIdx.x; it < 512; it += G) {
        const int tid = otid(), w = tid >> 6, lane = tid & 63, l16 = lane & 15, g = lane >> 4;
        const int bh = it >> 5, c = it & 31, b = bh >> 2, h = bh & 3;
        const float lg = ret_lg(h), gi = __expf((float)(16 * w + l16 + 1) * lg);
        bf16x8 af[4], qf[8];
        { const bf16_t* aptr = ABUF + (((size_t)bh * 32 + c) * 128 + 16 * w + l16) * 128 + 8 * g;
          const bf16_t* qptr = Zq + ((size_t)b * 4096 + c * 128 + 16 * w + l16) * 1024 + h * 256 + 8 * g;
#pragma unroll
          for (int ks = 0; ks < 4; ++ks) af[ks] = *(const bf16x8*)(aptr + 32 * ks);
#pragma unroll
          for (int kd = 0; kd < 8; ++kd) qf[kd] = *(const bf16x8*)(qptr + 32 * kd); }
        const bf16_t* vsrc = vTp + ((size_t)bh * 512 + (tid >> 4)) * 4096 + c * 128 + (tid & 15) * 8;
        const bf16_t* ssrc = SC + (((size_t)bh * 32 + c) * 512 + (tid >> 5)) * 256 + (tid & 31) * 8;
        LAS bf16_t* vd = VS + (tid >> 4) * 136 + (tid & 15) * 8; LAS bf16_t* sd = SS + (tid >> 5) * 264 + (tid & 31) * 8;
        bf16_t* optr = ORET + ((size_t)b * 4096 + c * 128 + 16 * w + l16) * 2048 + h * 512 + 4 * g;
        u32x4 rv[2], rs[4];
#pragma unroll
        for (int j = 0; j < 2; ++j) rv[j] = *(const u32x4*)(vsrc + (size_t)(32 * j) * 4096);
#pragma unroll
        for (int j = 0; j < 4; ++j) rs[j] = *(const u32x4*)(ssrc + (size_t)(16 * j) * 256);
        __syncthreads();
#pragma unroll
        for (int j = 0; j < 2; ++j) *(LAS u32x4*)(vd + 32 * j * 136) = rv[j];
#pragma unroll
        for (int j = 0; j < 4; ++j) *(LAS u32x4*)(sd + 16 * j * 264) = rs[j];
        __syncthreads();
        for (int es = 0; es < 8; ++es) {
            const int buf = es & 1;
            if (es < 7) {
#pragma unroll
                for (int j = 0; j < 2; ++j) rv[j] = *(const u32x4*)(vsrc + (size_t)((es + 1) * 64 + 32 * j) * 4096);
#pragma unroll
                for (int j = 0; j < 4; ++j) rs[j] = *(const u32x4*)(ssrc + (size_t)((es + 1) * 64 + 16 * j) * 256);
            }
            asm volatile("" ::: "memory");
            const LAS bf16_t* VSb = VS + buf * 64 * 136; const LAS bf16_t* SSb = SS + buf * 64 * 264;
#pragma unroll
            for (int et = 0; et < 4; ++et) {
                f32x4 oin = {0.f, 0.f, 0.f, 0.f}, ocr = {0.f, 0.f, 0.f, 0.f};
#pragma unroll
                for (int ks = 0; ks < 4; ++ks) { const bf16x8 vf = *(const LAS bf16x8*)(VSb + (16 * et + l16) * 136 + 32 * ks + 8 * g); oin = __builtin_amdgcn_mfma_f32_16x16x32_bf16(vf, af[ks], oin, 0, 0, 0); }
                if (c > 0) {
#pragma unroll
                    for (int kd = 0; kd < 8; ++kd) { const bf16x8 sf = *(const LAS bf16x8*)(SSb + (16 * et + l16) * 264 + 32 * kd + 8 * g); ocr = __builtin_amdgcn_mfma_f32_16x16x32_bf16(sf, qf[kd], ocr, 0, 0, 0); }
                }
                *(u32x2*)(optr + es * 64 + 16 * et) = pk4(oin + ocr * gi);
            }
            if (es < 7) {
#pragma unroll
                for (int j = 0; j < 2; ++j) *(LAS u32x4*)(vd + ((buf ^ 1) * 64 + 32 * j) * 136) = rv[j];
#pragma unroll
                for (int j = 0; j < 4; ++j) *(LAS u32x4*)(sd + ((buf ^ 1) * 64 + 16 * j) * 264) = rs[j];
            }
            lds_barrier();
        }
    }
}

__device__ __forceinline__ void ret_sample(LAS unsigned char* lds, const Params& P, const bf16_t* __restrict__ Zq, const bf16_t* __restrict__ Zk, const bf16_t* __restrict__ vTs, bf16_t* __restrict__ ORET, unsigned* ctr, unsigned* done, unsigned target) {
    LAS float* qs = (LAS float*)lds;
    LAS float* kds = qs + 2048;
    LAS float* A8 = kds + 2048;
    LAS float* red = A8 + 64;
    volatile LAS int* slot = (volatile LAS int*)(lds + LDS_BYTES - 32);
    for (;;) {
        const int tid = otid();
        __syncthreads();
        if (tid == 0) *slot = (done && xb_ld(done) >= target) ? 512 : (int)atomicAdd(ctr, 1u);
        __syncthreads();
        const int it = *slot;
        if (it >= 512) break;
        const int bs = it >> 2, h = it & 3;
        const float lg = ret_lg(h), g8 = __expf(8.f * lg), ig8 = __expf(-8.f * lg);
#pragma unroll
        for (int k = 0; k < 4; ++k) { const int e = tid + 512 * k, i = e >> 8, d = e & 255; const size_t src = (size_t)(MP + bs * 8 + i) * 1024 + h * 256 + d;
            qs[d * 8 + i] = bf2f(Zq[src]) * __expf((float)(i + 1) * lg); kds[d * 8 + i] = bf2f(Zk[src]) * __expf((float)(7 - i) * lg); }
        __syncthreads();
        if (tid < 64) { const int i = tid >> 3, s = tid & 7; float a = 0.f;
            if (s <= i) { for (int d = 0; d < 256; ++d) a += qs[d * 8 + i] * kds[d * 8 + s]; a *= ig8; }
            A8[tid] = a; }
        const int eg = tid & 127, dp = tid >> 7, e0 = 4 * eg;
        f32x4 vq[8];
#pragma unroll
        for (int jj = 0; jj < 4; ++jj) { const u32x4 wv = *(const u32x4*)(vTs + ((size_t)((bs * 4 + h) * 512 + e0 + jj)) * 8);
            vq[0][jj] = bflo(wv.x); vq[1][jj] = bfhi(wv.x); vq[2][jj] = bflo(wv.y); vq[3][jj] = bfhi(wv.y); vq[4][jj] = bflo(wv.z); vq[5][jj] = bfhi(wv.z); vq[6][jj] = bflo(wv.w); vq[7][jj] = bfhi(wv.w); }
        f32x4 cr[8];
#pragma unroll
        for (int i = 0; i < 8; ++i) cr[i] = (f32x4){0.f, 0.f, 0.f, 0.f};
        const size_t sbase = ((size_t)(bs * 4 + h) * 256 + dp * 64) * 512 + e0;
        const float* __restrict__ sp = P.state_ret + sbase; float* __restrict__ op = P.out + OFF_RSS + sbase;
        f32x4 sta[8];
#pragma unroll
        for (int j = 0; j < 8; ++j) sta[j] = __builtin_nontemporal_load((const f32x4*)(sp + (size_t)j * 512));
#pragma unroll 1
        for (int d0 = 0; d0 < 64; d0 += 8) {
            const bool more = d0 + 8 < 64;
#pragma unroll
            for (int j = 0; j < 8; ++j) {
                const int d = dp * 64 + d0 + j; const f32x4 st = sta[j];
                if (more) sta[j] = __builtin_nontemporal_load((const f32x4*)(sp + (size_t)(d0 + 8 + j) * 512));
                const f32x4 qa = *(const LAS f32x4*)(qs + d * 8), qb = *(const LAS f32x4*)(qs + d * 8 + 4), ka = *(const LAS f32x4*)(kds + d * 8), kb = *(const LAS f32x4*)(kds + d * 8 + 4);
                const float q8[8] = {qa[0], qa[1], qa[2], qa[3], qb[0], qb[1], qb[2], qb[3]}, k8[8] = {ka[0], ka[1], ka[2], ka[3], kb[0], kb[1], kb[2], kb[3]};
                f32x4 ns = st * g8;
#pragma unroll
                for (int s2 = 0; s2 < 8; ++s2) ns += vq[s2] * k8[s2];
                __builtin_nontemporal_store(ns, (f32x4*)(op + (size_t)(d0 + j) * 512));
#pragma unroll
                for (int i = 0; i < 8; ++i) cr[i] += st * q8[i];
                asm volatile("" ::: "memory");
            }
        }
#pragma unroll
        for (int i = 0; i < 8; ++i) *(LAS f32x4*)(red + (dp * 8 + i) * 512 + e0) = cr[i];
        __syncthreads();
        { const int i = tid >> 6, e8 = (tid & 63) * 8;
          float o[8];
#pragma unroll
          for (int jj = 0; jj < 8; ++jj) o[jj] = red[(0 * 8 + i) * 512 + e8 + jj] + red[(1 * 8 + i) * 512 + e8 + jj] + red[(2 * 8 + i) * 512 + e8 + jj] + red[(3 * 8 + i) * 512 + e8 + jj];
#pragma unroll
          for (int jj = 0; jj < 8; ++jj) { const u32x4 wv = *(const u32x4*)(vTs + ((size_t)((bs * 4 + h) * 512 + e8 + jj)) * 8);
              const float v8[8] = {bflo(wv.x), bfhi(wv.x), bflo(wv.y), bfhi(wv.y), bflo(wv.z), bfhi(wv.z), bflo(wv.w), bfhi(wv.w)};
#pragma unroll
              for (int s = 0; s < 8; ++s) o[jj] += A8[i * 8 + s] * v8[s]; }
          bf16_t* dst = ORET + (size_t)(MP + bs * 8 + i) * 2048 + h * 512 + e8;
          u32x4 ow; ow.x = cvt_pk_bf16(o[0], o[1]); ow.y = cvt_pk_bf16(o[2], o[3]); ow.z = cvt_pk_bf16(o[4], o[5]); ow.w = cvt_pk_bf16(o[6], o[7]); *(u32x4*)dst = ow; }
    }
}

__device__ __forceinline__ void ret_gnorm(const bf16_t* __restrict__ ORET, const bf16_t* __restrict__ Zg, bf16_t* __restrict__ OG, int G) {
    const int tid_o = otid(), wave = tid_o >> 6, lane = tid_o & 63;
    for (int task = blockIdx.x * 8 + wave; task < MT * 4; task += G * 8) {
        const size_t o = (size_t)(task >> 2) * 2048 + (task & 3) * 512 + lane * 8;
        const u32x4 ow = *(const u32x4*)(ORET + o); const f32x4 a = {bflo(ow.x), bfhi(ow.x), bflo(ow.y), bfhi(ow.y)}, b = {bflo(ow.z), bfhi(ow.z), bflo(ow.w), bfhi(ow.w)};
        const float mu = wave_sum(a[0] + a[1] + a[2] + a[3] + b[0] + b[1] + b[2] + b[3]) * (1.f / 512.f);
        const f32x4 da = a - mu, db = b - mu;
        const float var = wave_sum(da[0] * da[0] + da[1] * da[1] + da[2] * da[2] + da[3] * da[3] + db[0] * db[0] + db[1] * db[1] + db[2] * db[2] + db[3] * db[3]) * (1.f / 512.f);
        const float rs = rsqrtf(var + EPS);
        const u32x4 gw = *(const u32x4*)(Zg + o);
        u32x4 r;
        r.x = cvt_pk_bf16(da[0] * rs * bflo(gw.x), da[1] * rs * bfhi(gw.x)); r.y = cvt_pk_bf16(da[2] * rs * bflo(gw.y), da[3] * rs * bfhi(gw.y));
        r.z = cvt_pk_bf16(db[0] * rs * bflo(gw.z), db[1] * rs * bfhi(gw.z)); r.w = cvt_pk_bf16(db[2] * rs * bflo(gw.w), db[3] * rs * bfhi(gw.w));
        *(u32x4*)(OG + o) = r;
    }
}

__global__ void __launch_bounds__(NT) hybrid_fwd(Params P) {
    extern __shared__ __attribute__((aligned(16))) unsigned char lds_raw[];
    LAS unsigned char* lds = (LAS unsigned char*)lds_raw;
    cg::grid_group grid = cg::this_grid();
    const int G = gridDim.x, tid = threadIdx.x;
    unsigned char* ws = P.ws;
    bf16_t* WT_IN_ATTN = (bf16_t*)(ws + WS_WT_IN_ATTN); bf16_t* WT_OUT_ATTN = (bf16_t*)(ws + WS_WT_OUT_ATTN); bf16_t* WT_IN_RET = (bf16_t*)(ws + WS_WT_IN_RET); bf16_t* WT_OUT_RET = (bf16_t*)(ws + WS_WT_OUT_RET);
    bf16_t* WT_GATE = (bf16_t*)(ws + WS_WT_GATE); bf16_t* WT_PLE = (bf16_t*)(ws + WS_WT_PLE);
    float* TABA = (float*)(ws + WS_TABA); float* TABR = (float*)(ws + WS_TABR);
    bf16_t* H = (bf16_t*)(ws + WS_H); bf16_t* PB = (bf16_t*)(ws + WS_PB);
    bf16_t* PLE = (bf16_t*)(ws + WS_PLE); bf16_t* Y = (bf16_t*)(ws + WS_Y); float* X1 = (float*)(ws + WS_X1); float* X2 = (float*)(ws + WS_X2);
    bf16_t* OG = (bf16_t*)(ws + WS_OG); bf16_t* ZQ = (bf16_t*)(ws + WS_ZQ); bf16_t* ZK = (bf16_t*)(ws + WS_ZK); bf16_t* ZG = (bf16_t*)(ws + WS_ZG);
    bf16_t* VTP = (bf16_t*)(ws + WS_VTP); bf16_t* VTS = (bf16_t*)(ws + WS_VTS); bf16_t* ABUF = (bf16_t*)(ws + WS_ABUF); bf16_t* KDT = (bf16_t*)(ws + WS_KDT); bf16_t* ORET = (bf16_t*)(ws + WS_ORET);
    bf16_t* SC = (bf16_t*)(ws + WS_Y);
    pg8::StaticOrder SO;
    volatile LAS unsigned* bst = (volatile LAS unsigned*)(lds + LDS_BYTES - 16);
    if (tid < 4) bst[tid] = 0u;
    __syncthreads();
    const XcdBarrier xbar = xcd_barrier_post((unsigned*)(ws + WS_BAR), bst);
#define GSYNC() xcd_barrier(xbar)

for (int rep_ = 0; rep_ < REP_P0; ++rep_) {
    for (int t = blockIdx.x; t < 3584; t += G) {
        LAS float* T = (LAS float*)lds;
        if (t < 640) transpose_tile(P.w_in_attn, WT_IN_ATTN, 1024, 2560, true, t, T);
        else if (t < 896) transpose_tile(P.w_out_attn, WT_OUT_ATTN, 1024, 1024, false, t - 640, T);
        else if (t < 2432) transpose_tile(P.w_in_ret, WT_IN_RET, 1024, 6144, false, t - 896, T);
        else if (t < 2944) transpose_tile(P.w_out_ret, WT_OUT_RET, 2048, 1024, false, t - 2432, T);
        else if (t < 3200) transpose_tile(P.w_gate, WT_GATE, 1024, 1024, false, t - 2944, T);
        else if (t < 3456) transpose_tile(P.w_gate + 1024 * 1024, WT_GATE + 1024 * 1024, 1024, 1024, false, t - 3200, T);
        else if (t < 3520) transpose_tile(P.w_ple, WT_PLE, 256, 1024, false, t - 3456, T);
        else transpose_tile(P.w_ple + 256 * 1024, WT_PLE + 1024 * 256, 256, 1024, false, t - 3520, T);
    }
    for (int e = blockIdx.x * NT + tid; e < 4104 * 160; e += G * NT) {
        const int pi = e / 160, f = e % 160; const int pos = pi < 4096 ? pi : 16384 + (pi - 4096);
        if (f < 32) { const float inv = powf(10000.f, -(float)f / 32.f), ang = (float)pos * inv; TABA[((size_t)pi * 32 + f) * 2] = cosf(ang); TABA[((size_t)pi * 32 + f) * 2 + 1] = sinf(ang); }
        else { const int f2 = f - 32; const float inv = powf(10000.f, -(float)f2 / 128.f), ang = (float)pos * inv; TABR[((size_t)pi * 128 + f2) * 2] = cosf(ang); TABR[((size_t)pi * 128 + f2) * 2 + 1] = sinf(ang); }
    }
    for (int e = blockIdx.x * NT + tid; e < 2 * MT * 64; e += G * NT) {
        const int i = e / (MT * 64), rem = e % (MT * 64), row = rem >> 6, c4 = (rem & 63) * 4;
        const float* src = row < MP ? P.p_prompt + ((size_t)i * MP + row) * 256 + c4 : P.p_sample + ((size_t)i * MS + row - MP) * 256 + c4;
        *(u32x2*)(PB + ((size_t)i * MT + row) * 256 + c4) = pk4(*(const f32x4*)src);
    }
    rms_rows(P.x_prompt, P.x_sample, P.pre_norm, H, G);
}
    grid.sync();

for (int rep_ = 0; rep_ < REP_GIN; ++rep_) {
    { pg8::Gemm g{H, WT_IN_ATTN, MT, 2560, 1024}; SO.init(MT, 2560, G, blockIdx.x);
      EpiInAttn E{ZQ, ZK, ZG, VTP, VTS, TABA, P.out}; pg8::gemm_phase(lds, g, SO, E); }
    { pg8::Gemm g{PB, WT_PLE, MP, 1024, 256}; SO.init(MP, 1024, G, blockIdx.x);
      EpiB16 E{PLE, 1024}; pg8::gemm_phase(lds, g, SO, E);
      skinny_gemm(lds, PB + (size_t)MP * 256, WT_PLE, 256, SkB16{PLE + (size_t)MP * 1024}, G); }
}
    GSYNC();

for (int rep_ = 0; rep_ < REP_ATT; ++rep_) {
    attn_prompt(lds, ZQ, ZK, ZG, VTP, P.sinks, OG, G);
    attn_sample(lds, P, ZQ, ZK, ZG, VTS, OG, G);
}
    GSYNC();

for (int rep_ = 0; rep_ < REP_GN1; ++rep_) {
    { pg8::Gemm g{OG, WT_OUT_ATTN, MP, 1024, 1024}; SO.init(MP, 1024, G, blockIdx.x); EpiB16 E{Y, 1024}; pg8::gemm_phase(lds, g, SO, E);
      skinny_gemm(lds, OG + (size_t)MP * 1024, WT_OUT_ATTN, 1024, SkB16{Y + (size_t)MP * 1024}, G); }
}
    GSYNC();
for (int rep_ = 0; rep_ < REP_ROW; ++rep_) {
    resid_rows(P.x_prompt, P.x_sample, Y, P.post_norm, X1, H, G);
}
    GSYNC();
for (int rep_ = 0; rep_ < REP_GN1; ++rep_) {
    { pg8::Gemm g{H, WT_GATE, MP, 1024, 1024}; SO.init(MP, 1024, G, blockIdx.x); EpiGate E{X1, PLE, X2}; pg8::gemm_phase(lds, g, SO, E);
      skinny_gemm(lds, H + (size_t)MP * 1024, WT_GATE, 1024, SkGate{X1 + (size_t)MP * 1024, PLE + (size_t)MP * 1024, X2 + (size_t)MP * 1024}, G); }
}
    GSYNC();
for (int rep_ = 0; rep_ < REP_ROW; ++rep_) {
    rms_rows(X2, X2 + (size_t)MP * 1024, P.pre_norm + 1024, H, G);
}
    GSYNC();
for (int rep_ = 0; rep_ < REP_GIN; ++rep_) {
    { pg8::Gemm g{H, WT_IN_RET, MT, 6144, 1024}; SO.init(MT, 6144, G, blockIdx.x);
      EpiInRet E{ZQ, ZK, ZG, VTP, VTS, TABR}; pg8::gemm_phase(lds, g, SO, E); }
    { pg8::Gemm g{PB + (size_t)MT * 256, WT_PLE + 1024 * 256, MP, 1024, 256}; SO.init(MP, 1024, G, blockIdx.x);
      EpiB16 E{PLE, 1024}; pg8::gemm_phase(lds, g, SO, E);
      skinny_gemm(lds, PB + (size_t)MT * 256 + (size_t)MP * 256, WT_PLE + 1024 * 256, 256, SkB16{PLE + (size_t)MP * 1024}, G); }
}
    GSYNC();
for (int rep_ = 0; rep_ < REP_RA; ++rep_) {
    ret_A(lds, ZQ, ZK, ABUF, KDT, G);
}
    GSYNC();
    { unsigned* ctr = (unsigned*)(ws + WS_BAR + 14336); unsigned* done = ctr + 64;
      const unsigned nscan = G < 128 ? (unsigned)G : 128u;
      if (blockIdx.x < 128) { for (int rep_ = 0; rep_ < REP_SCAN; ++rep_) for (int u = blockIdx.x; u < 128; u += G) ret_scan_unit(lds, u, VTP, KDT, SC, P.out); if (tid == 0) xb_add(done, 1u); }
      else ret_sample(lds, P, ZQ, ZK, VTS, ORET, ctr, done, nscan);
      GSYNC();
      for (int rep_ = 0; rep_ < REP_R3; ++rep_) ret_out_items(lds, ZQ, VTP, ABUF, SC, ORET, G);
      ret_sample(lds, P, ZQ, ZK, VTS, ORET, ctr, nullptr, 0u); }
for (int rep_ = 0; rep_ < REP_SYNC; ++rep_) GSYNC();
    GSYNC();
for (int rep_ = 0; rep_ < REP_ROW; ++rep_) {
    ret_gnorm(ORET, ZG, OG, G);
}
    GSYNC();
for (int rep_ = 0; rep_ < REP_GN1; ++rep_) {
    { pg8::Gemm g{OG, WT_OUT_RET, MP, 1024, 2048}; SO.init(MP, 1024, G, blockIdx.x); EpiB16 E{Y, 1024}; pg8::gemm_phase(lds, g, SO, E);
      skinny_gemm(lds, OG + (size_t)MP * 2048, WT_OUT_RET, 2048, SkB16{Y + (size_t)MP * 1024}, G); }
}
    GSYNC();
for (int rep_ = 0; rep_ < REP_ROW; ++rep_) {
    resid_rows(X2, X2 + (size_t)MP * 1024, Y, P.post_norm + 1024, X1, H, G);
}
    GSYNC();
for (int rep_ = 0; rep_ < REP_GN1; ++rep_) {
    { pg8::Gemm g{H, WT_GATE + 1024 * 1024, MP, 1024, 1024}; SO.init(MP, 1024, G, blockIdx.x); EpiGate E{X1, PLE, P.out}; pg8::gemm_phase(lds, g, SO, E);
      skinny_gemm(lds, H + (size_t)MP * 1024, WT_GATE + 1024 * 1024, 1024, SkGate{X1 + (size_t)MP * 1024, PLE + (size_t)MP * 1024, P.out + (size_t)MP * 1024}, G); }
}
}

extern "C" void kernel_launch(void* const* d_in, const int* in_sizes, int n_in, void* d_out, int out_size, void* d_ws, size_t ws_size, hipStream_t stream) {
    static int grid_blocks = 0;
    if (!grid_blocks) {
        int dev = 0, cus = 0, per_cu = 0;
        hipGetDevice(&dev);
        hipDeviceGetAttribute(&cus, hipDeviceAttributeMultiprocessorCount, dev);
        hipFuncSetAttribute((const void*)hybrid_fwd, hipFuncAttributeMaxDynamicSharedMemorySize, LDS_BYTES);
        hipOccupancyMaxActiveBlocksPerMultiprocessor(&per_cu, (const void*)hybrid_fwd, NT, LDS_BYTES);
        if (per_cu < 1) per_cu = 1;
        if (per_cu > 1) per_cu = 1;
        grid_blocks = cus * per_cu;
        if (ws_size < WS_END) fprintf(stderr, "kernel_launch: workspace too small: %zu < %zu\n", ws_size, (size_t)WS_END);
    }
    Params p{};
    p.x_prompt = (const float*)d_in[0]; p.x_sample = (const float*)d_in[1]; p.cache_k = (const float*)d_in[2]; p.cache_v = (const float*)d_in[3]; p.state_ret = (const float*)d_in[4];
    p.p_prompt = (const float*)d_in[5]; p.p_sample = (const float*)d_in[6]; p.pre_norm = (const float*)d_in[7]; p.post_norm = (const float*)d_in[8]; p.w_in_attn = (const float*)d_in[9];
    p.sinks = (const float*)d_in[10]; p.w_out_attn = (const float*)d_in[11]; p.w_in_ret = (const float*)d_in[12]; p.w_out_ret = (const float*)d_in[13]; p.w_ple = (const float*)d_in[14]; p.w_gate = (const float*)d_in[15];
    p.out = (float*)d_out; p.ws = (unsigned char*)d_ws;
    (void)hipMemsetAsync((unsigned char*)d_ws + WS_BAR, 0, 16384, stream);
    void* args[] = {&p};
    hipError_t e = hipLaunchCooperativeKernel((const void*)hybrid_fwd, dim3(grid_blocks), dim3(NT), args, LDS_BYTES, stream);
    if (e != hipSuccess) fprintf(stderr, "cooperative launch failed: %s (grid %d)\n", hipGetErrorString(e), grid_blocks);
}
```

```cpp
#include <hip/hip_runtime.h>
#include <hip/hip_cooperative_groups.h>
#include <cstdio>
#include <cstdint>
namespace cg = cooperative_groups;

#define LAS __attribute__((address_space(3)))
typedef unsigned short bf16_t;
typedef short bf16x8 __attribute__((ext_vector_type(8)));
typedef float f32x4 __attribute__((ext_vector_type(4)));
typedef float f32x2 __attribute__((ext_vector_type(2)));
typedef unsigned u32x2 __attribute__((ext_vector_type(2)));
typedef unsigned u32x4 __attribute__((ext_vector_type(4)));

constexpr int MP = 16384, MS = 1024, MT = MP + MS;
constexpr int NT = 512;
#define REP_P0 1
#define REP_GIN 1
#define REP_ATT 1
#define REP_RA 1
#define REP_SYNC 0
#define REP_R3 1
#define REP_SCAN 1
#define REP_ROW 1
#define REP_GN1 1
constexpr int LDS_BYTES = 140 * 1024;
constexpr float EPS = 1e-6f;

constexpr size_t OFF_YP = 0, OFF_YS = 16777216, OFF_KWP = 17825792, OFF_VWP = 17956864, OFF_KWS = 18087936, OFF_VWS = 22282240, OFF_RSP = 26476544, OFF_RSS = 28573696;

constexpr size_t al256(size_t x) { return (x + 255) & ~(size_t)255; }
constexpr size_t WS_WT_IN_ATTN = 0;
constexpr size_t WS_WT_OUT_ATTN = WS_WT_IN_ATTN + (size_t)2560 * 1024 * 2;
constexpr size_t WS_WT_IN_RET = WS_WT_OUT_ATTN + (size_t)1024 * 1024 * 2;
constexpr size_t WS_WT_OUT_RET = WS_WT_IN_RET + (size_t)6144 * 1024 * 2;
constexpr size_t WS_WT_GATE = WS_WT_OUT_RET + (size_t)1024 * 2048 * 2;
constexpr size_t WS_WT_PLE = WS_WT_GATE + (size_t)2 * 1024 * 1024 * 2;
constexpr size_t WS_TABA = WS_WT_PLE + (size_t)2 * 1024 * 256 * 2;
constexpr size_t WS_TABR = WS_TABA + (size_t)4104 * 32 * 8;
constexpr size_t WS_H = al256(WS_TABR + (size_t)4104 * 128 * 8);
constexpr size_t WS_PB = WS_H + (size_t)MT * 1024 * 2;
constexpr size_t WS_PLE = WS_PB + (size_t)2 * MT * 256 * 2;
constexpr size_t WS_Y = WS_PLE + (size_t)MT * 1024 * 4;
constexpr size_t WS_X1 = WS_Y + (size_t)MT * 1024 * 4;
constexpr size_t WS_X2 = WS_X1 + (size_t)MT * 1024 * 4;
constexpr size_t WS_OG = WS_X2 + (size_t)MT * 1024 * 4;
constexpr size_t WS_ZQ = WS_OG + (size_t)MT * 2048 * 2;
constexpr size_t WS_ZK = WS_ZQ + (size_t)MT * 1024 * 2;
constexpr size_t WS_ZG = WS_ZK + (size_t)MT * 1024 * 2;
constexpr size_t WS_VTP = WS_ZG + (size_t)MT * 2048 * 2;
constexpr size_t WS_VTS = WS_VTP + (size_t)16 * 512 * 4096 * 2;
constexpr size_t WS_ABUF = WS_VTS + (size_t)128 * 4 * 512 * 8 * 2;
constexpr size_t WS_KDT = WS_ABUF + (size_t)512 * 128 * 128 * 2;
constexpr size_t WS_ORET = WS_KDT + (size_t)512 * 256 * 128 * 2;
constexpr size_t WS_BAR = WS_ORET + (size_t)MT * 2048 * 4;
constexpr size_t WS_END = WS_BAR + 16384;

struct Params {
    const float *x_prompt, *x_sample, *cache_k, *cache_v, *state_ret, *p_prompt, *p_sample, *pre_norm, *post_norm, *w_in_attn, *sinks, *w_out_attn, *w_in_ret, *w_out_ret, *w_ple, *w_gate;
    float* out; unsigned char* ws;
};

__device__ __forceinline__ unsigned cvt_pk_bf16(float lo, float hi) { unsigned r; asm volatile("v_cvt_pk_bf16_f32 %0, %1, %2" : "=v"(r) : "v"(lo), "v"(hi)); return r; }
__device__ __forceinline__ u32x2 pk4(f32x4 v) { u32x2 w; w.x = cvt_pk_bf16(v[0], v[1]); w.y = cvt_pk_bf16(v[2], v[3]); return w; }
__device__ __forceinline__ float bf2f(bf16_t b) { return __uint_as_float(((unsigned)b) << 16); }
__device__ __forceinline__ float bflo(unsigned w) { return __uint_as_float(w << 16); }
__device__ __forceinline__ float bfhi(unsigned w) { return __uint_as_float(w & 0xffff0000u); }
__device__ __forceinline__ float silu_f(float x) { return x / (1.f + __expf(-x)); }
__device__ __forceinline__ float sigmoid_f(float x) { return 1.f / (1.f + __expf(-x)); }
__device__ __forceinline__ float wave_sum(float v) {
#pragma unroll
    for (int o = 32; o >= 1; o >>= 1) v += __shfl_xor(v, o, 64);
    return v;
}
__device__ __forceinline__ int otid() { int t = threadIdx.x; asm volatile("" : "+v"(t)); return t; }
__device__ __forceinline__ void lds_barrier() { asm volatile("s_waitcnt lgkmcnt(0)" ::: "memory"); __builtin_amdgcn_s_barrier(); asm volatile("" ::: "memory"); }
__device__ __forceinline__ float ret_lg(int h) { return log1pf(-exp2f(-5.f - (float)h)); }

#define XB_TMO      128
#define XB_XCNT(j)  (256  + 64 * (j))
#define XB_XSUB(j)  (1280 + 64 * (j))
#define XB_XGEN(j)  (2304 + 64 * (j))
#define XB_TOP      3328
#define XB_TOPGEN   3392
#define XCD_BAR_WORDS 3456
#define XB_SPIN_CAP (1u << 18)

__device__ __forceinline__ unsigned xb_ld(unsigned* p)              { return __hip_atomic_load(p, __ATOMIC_RELAXED, __HIP_MEMORY_SCOPE_AGENT); }
__device__ __forceinline__ unsigned xb_add(unsigned* p, unsigned v) { return __hip_atomic_fetch_add(p, v, __ATOMIC_RELAXED, __HIP_MEMORY_SCOPE_AGENT); }
__device__ __forceinline__ unsigned xb_xcc_id() { return (unsigned)__builtin_amdgcn_s_getreg((3 << 11) | 20) & 0xFu; }
#define XB_SPIN(cond, bar) do { unsigned _sp = 0; while (cond) { __builtin_amdgcn_s_sleep(1); \
    if ((++_sp & 255u) == 0u) { if (xb_ld(&(bar)[XB_TMO])) break; if (_sp > XB_SPIN_CAP) { atomicAdd(&(bar)[XB_TMO], 1u); break; } } } } while (0)

struct XcdBarrier {
    unsigned* bar; unsigned x;
    volatile LAS unsigned* st;
};

__device__ __forceinline__ XcdBarrier xcd_barrier_post(unsigned* bar, volatile LAS unsigned* st) {
    XcdBarrier b; b.bar = bar; b.x = xb_xcc_id(); b.st = st;
    if (threadIdx.x == 0) (void)xb_add(&bar[XB_XCNT(b.x)], 1u);
    return b;
}
__device__ __forceinline__ void xcd_barrier_complete(unsigned* bar, unsigned x, unsigned& nloc, unsigned& nx) {
    const unsigned G = gridDim.x * gridDim.y * gridDim.z;
    unsigned sum, cnt, mine, sp = 0u;
    for (;;) {
        sum = 0u; cnt = 0u; mine = 0u;
#pragma unroll
        for (unsigned j = 0; j < 16; ++j) { const unsigned c = xb_ld(&bar[XB_XCNT(j)]); sum += c; cnt += (c > 0u) ? 1u : 0u; mine = (j == x) ? c : mine; }
        if (sum == G) break;
        __builtin_amdgcn_s_sleep(1);
        if ((++sp & 255u) == 0u) { if (xb_ld(&bar[XB_TMO])) break; if (sp > XB_SPIN_CAP) { atomicAdd(&bar[XB_TMO], 1u); break; } }
    }
    nloc = mine > 0u ? mine : 1u; nx = cnt > 0u ? cnt : 1u;
}

__device__ __forceinline__ void xcd_barrier(const XcdBarrier& b) {
    asm volatile("s_waitcnt vmcnt(0)" ::: "memory");
    __syncthreads();
    if (threadIdx.x == 0) {
        unsigned* bar = b.bar;
        __builtin_amdgcn_s_waitcnt(0);
        unsigned nloc = b.st[0], nx = b.st[1];
        if (nloc == 0u) { xcd_barrier_complete(bar, b.x, nloc, nx); b.st[0] = nloc; b.st[1] = nx; }
        const unsigned old = xb_add(&bar[XB_XSUB(b.x)], 1u);
        const unsigned gen = old / nloc;
        if (old + 1u == (gen + 1u) * nloc) {
            __builtin_amdgcn_fence(__ATOMIC_RELEASE, "agent");
            asm volatile("s_waitcnt vmcnt(0)" ::: "memory");
            const unsigned og = xb_add(&bar[XB_TOP], 1u);
            const unsigned tg = og / nx;
            if (og + 1u == (tg + 1u) * nx) xb_add(&bar[XB_TOPGEN], 1u);
            else XB_SPIN(xb_ld(&bar[XB_TOPGEN]) == tg, bar);
            __builtin_amdgcn_fence(__ATOMIC_ACQUIRE, "agent");
            xb_add(&bar[XB_XGEN(b.x)], 1u);
            asm volatile("s_waitcnt vmcnt(0)" ::: "memory");
        } else {
            XB_SPIN(xb_ld(&bar[XB_XGEN(b.x)]) == gen, bar);
            __builtin_amdgcn_fence(__ATOMIC_ACQUIRE, "agent");
            asm volatile("s_waitcnt vmcnt(0)" ::: "memory");
        }
    }
    __syncthreads();
}

namespace pg8 {
constexpr int BM = 256, BK = 64, HALF = 128, HTB = HALF * BK * 2, STAGE_BYTES = 8 * HTB, NXCD = 8, WGM = 8;
__host__ __device__ __forceinline__ int lds_byte(int r, int c) { const int st = (r >> 4) * 2 + (c >> 5), rr = r & 15, cc = c & 31, ob = rr * 64 + cc * 2; return st * 1024 + (ob ^ (((ob >> 9) & 1) << 5)); }
__host__ __device__ __forceinline__ void stage_rc(int b, int& R, int& C) { const int st = b / 1024, sb = b % 1024, swz = sb ^ (((sb >> 9) & 1) << 5); R = (st >> 1) * 16 + swz / 64; C = (st & 1) * 32 + (swz % 64) / 2; }
struct Unit { int pm, pn; };
struct Gemm { const bf16_t* A; const bf16_t* Bt; int M, N, K; };
struct StaticOrder {
    int nM, nN, nwg, G, c;
    __host__ __device__ void init(int M, int N, int G_, int c_) { nM = M / BM; nN = N / BM; nwg = nM * nN; G = G_; c = c_; }
    __host__ __device__ bool next(int i, Unit& u) const {
        const long L = (long)i * G + c; if (L >= nwg) return false;
        int wgid = (int)L; { const int q = nwg / NXCD, r = nwg % NXCD, xcd = wgid % NXCD, off = wgid / NXCD; wgid = (xcd < r ? xcd * (q + 1) : r * (q + 1) + (xcd - r) * q) + off; }
        const int nig = WGM * nN, gid = wgid / nig, fm = gid * WGM, gsz = (nM - fm) < WGM ? (nM - fm) : WGM;
        u.pm = fm + ((wgid % nig) % gsz); u.pn = (wgid % nig) / gsz; return true;
    }
};

template <class Epi>
__device__ __forceinline__ void gemm_phase(LAS unsigned char* lds, const Gemm g, const StaticOrder& S, const Epi& E) {
    const int tid = otid(), wid = __builtin_amdgcn_readfirstlane(tid >> 6), lane = tid & 63, wr = wid >> 2, wc = wid & 3, fr = lane & 15, fq = lane >> 4;
    const int K = g.K, nt = K / BK;
    unsigned voffA[2], voffB[2];
#pragma unroll
    for (int i = 0; i < 2; ++i) { int R, C; stage_rc(tid * 16 + i * 8192, R, C); voffA[i] = (unsigned)(R * K + C) * 2u; voffB[i] = voffA[i]; }
    const size_t kstep = (size_t)(BK * 2);
    const size_t hstep = (size_t)HALF * K * 2;
    const size_t tstep = 2 * hstep;
    const unsigned ldsw = (unsigned)wid * 1024u;
    const int aoff = lds_byte(wr * 64 + fr, fq * 8), boff = lds_byte(wc * 32 + fr, fq * 8);
#define PG8_SA(b, h) (((b) * 2 + (h)) * HTB)
#define PG8_SB(b, h) ((4 + (b) * 2 + (h)) * HTB)
#define PG8_STAGE(bufoff, gbase, voff) do { _Pragma("unroll") for (int _i = 0; _i < 2; ++_i) \
        __builtin_amdgcn_global_load_lds((const unsigned*)((const char*)(gbase) + (voff)[_i]), (LAS unsigned*)(lds + (bufoff) + ldsw + _i * 8192), 16, 0, 0); } while (0)
#define PG8_LDA(dst, b, h) do { _Pragma("unroll") for (int m = 0; m < 4; ++m) _Pragma("unroll") for (int k = 0; k < 2; ++k) dst[m][k] = *(const LAS bf16x8*)(lds + PG8_SA(b, h) + aoff + m * 2048 + k * 1024); } while (0)
#define PG8_LDB(dst, b, h) do { _Pragma("unroll") for (int n = 0; n < 2; ++n) _Pragma("unroll") for (int k = 0; k < 2; ++k) dst[n][k] = *(const LAS bf16x8*)(lds + PG8_SB(b, h) + boff + n * 2048 + k * 1024); } while (0)
#define PG8_MMA(ai, bj, At, Bt) do { __builtin_amdgcn_s_setprio(1); _Pragma("unroll") for (int m = 0; m < 4; ++m) _Pragma("unroll") for (int n = 0; n < 2; ++n) _Pragma("unroll") for (int k = 0; k < 2; ++k) \
        acc[ai][bj][m][n] = __builtin_amdgcn_mfma_f32_16x16x32_bf16(Bt[n][k], At[m][k], acc[ai][bj][m][n], 0, 0, 0); __builtin_amdgcn_s_setprio(0); } while (0)
#define PG8_WAIT_V(n) asm volatile("s_waitcnt vmcnt(" #n ")" ::: "memory")
#define PG8_WAIT_L(n) asm volatile("s_waitcnt lgkmcnt(" #n ")" ::: "memory")
#define PG8_BAR __builtin_amdgcn_s_barrier()
#define PG8_SCHED __builtin_amdgcn_sched_barrier(0)
#define PG8_PTRS(u, pa, pb) do { const char* _a = (const char*)g.A + (size_t)(u).pm * tstep; const char* _b = (const char*)g.Bt + (size_t)(u).pn * tstep; if (Epi::swap(u)) { pa = _b; pb = _a; } else { pa = _a; pb = _b; } } while (0)
    Unit cur, nxt; int ui = 0;
    if (!S.next(0, cur)) return;
    f32x4 acc[2][2][4][2];
#pragma unroll
    for (int a = 0; a < 2; ++a)
#pragma unroll
        for (int b = 0; b < 2; ++b)
#pragma unroll
            for (int m = 0; m < 4; ++m)
#pragma unroll
                for (int n = 0; n < 2; ++n) acc[a][b][m][n] = (f32x4){0.f, 0.f, 0.f, 0.f};
    bf16x8 At[4][2], B0[2][2], B1[2][2];
    const char* cA; const char* cB;
    PG8_PTRS(cur, cA, cB);
    PG8_STAGE(PG8_SB(0, 0), cB, voffB); PG8_STAGE(PG8_SA(0, 0), cA, voffA); PG8_STAGE(PG8_SB(0, 1), cB + hstep, voffB); PG8_STAGE(PG8_SA(0, 1), cA + hstep, voffA);
    if (wr == 1) PG8_BAR;
    PG8_WAIT_V(4); PG8_BAR;
    PG8_STAGE(PG8_SB(1, 0), cB + kstep, voffB); PG8_STAGE(PG8_SA(1, 0), cA + kstep, voffA); PG8_STAGE(PG8_SB(1, 1), cB + hstep + kstep, voffB);
    PG8_WAIT_V(6); PG8_BAR;
    for (;;) {
        const bool has_next = S.next(ui + 1, nxt);
        const char* nA = cA; const char* nB = cB;
        if (has_next) PG8_PTRS(nxt, nA, nB);
        for (int t = 0; t < nt; t += 2) {
            const bool last = (t == nt - 2);
            const char* a1 = cA + (size_t)(t + 1) * kstep;
            const char* a2 = last ? nA : cA + (size_t)(t + 2) * kstep; const char* b2 = last ? nB : cB + (size_t)(t + 2) * kstep;
            const char* a3 = a2 + kstep; const char* b3 = b2 + kstep;
            PG8_LDB(B0, 0, 0); PG8_SCHED; PG8_LDA(At, 0, 0); PG8_STAGE(PG8_SA(1, 1), a1 + hstep, voffA);
            PG8_WAIT_L(8); PG8_BAR; PG8_WAIT_L(0); PG8_MMA(0, 0, At, B0); PG8_BAR; PG8_SCHED;
            PG8_LDB(B1, 0, 1); PG8_STAGE(PG8_SB(0, 0), b2, voffB);
            PG8_BAR; PG8_WAIT_L(0); PG8_MMA(0, 1, At, B1); PG8_BAR;
            PG8_LDA(At, 0, 1); PG8_STAGE(PG8_SA(0, 0), a2, voffA);
            PG8_BAR; PG8_WAIT_L(0); PG8_MMA(1, 0, At, B0); PG8_BAR; PG8_SCHED;
            PG8_STAGE(PG8_SB(0, 1), b2 + hstep, voffB);
            PG8_WAIT_V(6); PG8_BAR; PG8_MMA(1, 1, At, B1); PG8_BAR;
            PG8_LDB(B0, 1, 0); PG8_SCHED; PG8_LDA(At, 1, 0); PG8_STAGE(PG8_SA(0, 1), a2 + hstep, voffA);
            PG8_WAIT_L(8); PG8_BAR; PG8_WAIT_L(0); PG8_MMA(0, 0, At, B0); PG8_BAR; PG8_SCHED;
            PG8_LDB(B1, 1, 1); PG8_STAGE(PG8_SB(1, 0), b3, voffB);
            PG8_BAR; PG8_WAIT_L(0); PG8_MMA(0, 1, At, B1); PG8_BAR;
            PG8_LDA(At, 1, 1); PG8_STAGE(PG8_SA(1, 0), a3, voffA);
            PG8_BAR; PG8_WAIT_L(0); PG8_MMA(1, 0, At, B0); PG8_BAR; PG8_SCHED;
            PG8_STAGE(PG8_SB(1, 1), b3 + hstep, voffB);
            PG8_WAIT_V(6); PG8_BAR; PG8_MMA(1, 1, At, B1); PG8_BAR;
        }
        E(acc, cur, wr, wc, fr, fq);
        if (!has_next) break;
#pragma unroll
        for (int a = 0; a < 2; ++a)
#pragma unroll
            for (int b = 0; b < 2; ++b)
#pragma unroll
                for (int m = 0; m < 4; ++m)
#pragma unroll
                    for (int n = 0; n < 2; ++n) acc[a][b][m][n] = (f32x4){0.f, 0.f, 0.f, 0.f};
        cur = nxt; cA = nA; cB = nB; ++ui;
    }
    PG8_WAIT_V(0);
    if (wr == 0) PG8_BAR;
    PG8_BAR;
#undef PG8_SA
#undef PG8_SB
#undef PG8_STAGE
#undef PG8_LDA
#undef PG8_LDB
#undef PG8_MMA
#undef PG8_WAIT_V
#undef PG8_WAIT_L
#undef PG8_BAR
#undef PG8_SCHED
#undef PG8_PTRS
}
}
using pg8::Unit;

struct EpiF32 {
    float* C; int ldc;
    __device__ __forceinline__ static bool swap(const Unit&) { return false; }
    __device__ __forceinline__ void operator()(const f32x4 (&acc)[2][2][4][2], const Unit& u, int wr, int wc, int fr, int fq) const {
        const int row0 = u.pm * 256 + wr * 64 + fr, col0 = u.pn * 256 + wc * 32 + 4 * fq;
#pragma unroll
        for (int ai = 0; ai < 2; ++ai)
#pragma unroll
            for (int m = 0; m < 4; ++m) { float* rowp = C + (size_t)(row0 + ai * 128 + m * 16) * ldc + col0;
#pragma unroll
                for (int bj = 0; bj < 2; ++bj)
#pragma unroll
                    for (int n = 0; n < 2; ++n) *(f32x4*)(rowp + bj * 128 + n * 16) = acc[ai][bj][m][n]; }
    }
};
struct EpiB16 {
    bf16_t* C; int ldc;
    __device__ __forceinline__ static bool swap(const Unit&) { return false; }
    __device__ __forceinline__ void operator()(const f32x4 (&acc)[2][2][4][2], const Unit& u, int wr, int wc, int fr, int fq) const {
        const int row0 = u.pm * 256 + wr * 64 + fr, col0 = u.pn * 256 + wc * 32 + 4 * fq;
#pragma unroll
        for (int ai = 0; ai < 2; ++ai)
#pragma unroll
            for (int m = 0; m < 4; ++m) { bf16_t* rowp = C + (size_t)(row0 + ai * 128 + m * 16) * ldc + col0;
#pragma unroll
                for (int bj = 0; bj < 2; ++bj)
#pragma unroll
                    for (int n = 0; n < 2; ++n) *(u32x2*)(rowp + bj * 128 + n * 16) = pk4(acc[ai][bj][m][n]); }
    }
};
struct EpiGate {
    const float* X1; const bf16_t* PLE; float* O;
    __device__ __forceinline__ static bool swap(const Unit&) { return false; }
    __device__ __forceinline__ void operator()(const f32x4 (&acc)[2][2][4][2], const Unit& u, int wr, int wc, int fr, int fq) const {
        const int row0 = u.pm * 256 + wr * 64 + fr, col0 = u.pn * 256 + wc * 32 + 4 * fq;
#pragma unroll
        for (int ai = 0; ai < 2; ++ai)
#pragma unroll
            for (int m = 0; m < 4; ++m) { const size_t ro = (size_t)(row0 + ai * 128 + m * 16) * 1024 + col0;
#pragma unroll
                for (int bj = 0; bj < 2; ++bj)
#pragma unroll
                    for (int n = 0; n < 2; ++n) { const size_t o = ro + bj * 128 + n * 16; const f32x4 x1 = *(const f32x4*)(X1 + o), a = acc[ai][bj][m][n]; const u32x2 pw = *(const u32x2*)(PLE + o); const f32x4 pl = {bflo(pw.x), bfhi(pw.x), bflo(pw.y), bfhi(pw.y)}; f32x4 r;
#pragma unroll
                        for (int j = 0; j < 4; ++j) r[j] = x1[j] + sigmoid_f(a[j]) * pl[j];
                        *(f32x4*)(O + o) = r; } }
    }
};
struct EpiInAttn {
    bf16_t *Zq, *Zk, *Zg, *vTp, *vTs; const float* tab; float* out;
    __device__ __forceinline__ static bool swap(const Unit& u) { return u.pn == 5; }
    __device__ __forceinline__ void operator()(const f32x4 (&acc)[2][2][4][2], const Unit& u, int wr, int wc, int fr, int fq) const {
        const int pn = u.pn;
        if (pn < 5) {
            const bool isq = pn < 4;
            const int fi = 16 * (wc & 1) + 4 * fq;
#pragma unroll
            for (int ai = 0; ai < 2; ++ai)
#pragma unroll
                for (int m = 0; m < 4; ++m) {
                    const int r = u.pm * 256 + ai * 128 + wr * 64 + m * 16 + fr;
                    const int pi = r < MP ? (r & 4095) : 4096 + ((r - MP) & 7);
                    const f32x4 t0 = *(const f32x4*)(tab + ((size_t)pi * 32 + fi) * 2), t1 = *(const f32x4*)(tab + ((size_t)pi * 32 + fi) * 2 + 4);
                    const float cs[4] = {t0[0], t0[2], t1[0], t1[2]}, sn[4] = {t0[1], t0[3], t1[1], t1[3]};
#pragma unroll
                    for (int bj = 0; bj < 2; ++bj) {
                        const f32x4 x1 = acc[ai][bj][m][0], x2 = acc[ai][bj][m][1]; f32x4 o1, o2;
#pragma unroll
                        for (int j = 0; j < 4; ++j) { o1[j] = x1[j] * cs[j] - x2[j] * sn[j]; o2[j] = x2[j] * cs[j] + x1[j] * sn[j]; }
                        const int hh = 2 * bj + (wc >> 1), d1 = 16 * (wc & 1) + 4 * fq;
                        if (isq) {
                            bf16_t* p = Zq + (size_t)r * 1024 + pn * 256 + hh * 64 + d1;
                            *(u32x2*)p = pk4(o1 * 0.125f); *(u32x2*)(p + 32) = pk4(o2 * 0.125f);
                        } else {
                            bf16_t* p = Zk + (size_t)r * 256 + hh * 64 + d1;
                            *(u32x2*)p = pk4(o1); *(u32x2*)(p + 32) = pk4(o2);
                            if (r < MP) { const int t = r & 4095; if (t >= 3968) { float* dst = out + OFF_KWP + ((size_t)((r >> 12) * 128 + t - 3968) * 4 + hh) * 64 + d1; *(f32x4*)dst = o1; *(f32x4*)(dst + 32) = o2; } }
                            else { const int rs = r - MP; float* dst = out + OFF_KWS + ((size_t)((rs >> 3) * 128 + 120 + (rs & 7)) * 4 + hh) * 64 + d1; *(f32x4*)dst = o1; *(f32x4*)(dst + 32) = o2; }
                        }
                    }
                    asm volatile("" ::: "memory");
                }
        } else if (pn == 5) {
#pragma unroll
            for (int ai = 0; ai < 2; ++ai)
#pragma unroll
                for (int m = 0; m < 4; ++m) {
                    const int e = ai * 128 + wr * 64 + m * 16 + fr, kvh = e >> 6, d = e & 63;
#pragma unroll
                    for (int bj = 0; bj < 2; ++bj)
#pragma unroll
                        for (int n = 0; n < 2; ++n) {
                            const int tok = u.pm * 256 + bj * 128 + wc * 32 + n * 16 + 4 * fq; const f32x4 v = acc[ai][bj][m][n];
                            if (tok < MP) { const int b = tok >> 12, t = tok & 4095;
                                *(u32x2*)(vTp + ((size_t)((b * 4 + kvh) * 64 + d)) * 4096 + t) = pk4(v);
                                if (t >= 3968) {
#pragma unroll
                                    for (int jj = 0; jj < 4; ++jj) out[OFF_VWP + ((size_t)(b * 128 + t - 3968 + jj) * 4 + kvh) * 64 + d] = v[jj]; }
                            } else { const int ts = tok - MP, bs = ts >> 3, l0 = ts & 7;
                                *(u32x2*)(vTs + ((size_t)((bs * 4 + kvh) * 64 + d)) * 8 + l0) = pk4(v);
#pragma unroll
                                for (int jj = 0; jj < 4; ++jj) out[OFF_VWS + ((size_t)(bs * 128 + 120 + l0 + jj) * 4 + kvh) * 64 + d] = v[jj]; }
                        }
                }
        } else {
#pragma unroll
            for (int ai = 0; ai < 2; ++ai)
#pragma unroll
                for (int m = 0; m < 4; ++m) { const int r = u.pm * 256 + ai * 128 + wr * 64 + m * 16 + fr;
#pragma unroll
                    for (int bj = 0; bj < 2; ++bj)
#pragma unroll
                        for (int n = 0; n < 2; ++n) { const f32x4 a = acc[ai][bj][m][n]; f32x4 s;
#pragma unroll
                            for (int j = 0; j < 4; ++j) s[j] = silu_f(a[j]);
                            *(u32x2*)(Zg + (size_t)r * 1024 + (pn - 6) * 256 + bj * 128 + wc * 32 + n * 16 + 4 * fq) = pk4(s); } }
        }
    }
};
struct EpiInRet {
    bf16_t *Zq, *Zk, *Zg, *vTp, *vTs; const float* tab;
    __device__ __forceinline__ static bool swap(const Unit& u) { return u.pn >= 8 && u.pn < 16; }
    __device__ __forceinline__ void operator()(const f32x4 (&acc)[2][2][4][2], const Unit& u, int wr, int wc, int fr, int fq) const {
        const int pn = u.pn;
        if (pn < 8) {
            const bool isq = pn < 4; const float sc = isq ? 1.f : 0.0625f;
            bf16_t* Z = isq ? Zq : Zk; const int hc = (pn & 3) * 256;
#pragma unroll
            for (int ai = 0; ai < 2; ++ai)
#pragma unroll
                for (int m = 0; m < 4; ++m) {
                    const int r = u.pm * 256 + ai * 128 + wr * 64 + m * 16 + fr;
                    const int pi = r < MP ? (r & 4095) : 4096 + ((r - MP) & 7);
#pragma unroll
                    for (int n = 0; n < 2; ++n) {
                        const int d = wc * 32 + n * 16 + 4 * fq;
                        const f32x4 t0 = *(const f32x4*)(tab + ((size_t)pi * 128 + d) * 2), t1 = *(const f32x4*)(tab + ((size_t)pi * 128 + d) * 2 + 4);
                        const float cs[4] = {t0[0], t0[2], t1[0], t1[2]}, sn[4] = {t0[1], t0[3], t1[1], t1[3]};
                        const f32x4 x1 = acc[ai][0][m][n], x2 = acc[ai][1][m][n]; f32x4 o1, o2;
#pragma unroll
                        for (int j = 0; j < 4; ++j) { o1[j] = (x1[j] * cs[j] - x2[j] * sn[j]) * sc; o2[j] = (x2[j] * cs[j] + x1[j] * sn[j]) * sc; }
                        bf16_t* p = Z + (size_t)r * 1024 + hc + d;
                        *(u32x2*)p = pk4(o1); *(u32x2*)(p + 128) = pk4(o2);
                    }
                }
        } else if (pn < 16) {
#pragma unroll
            for (int ai = 0; ai < 2; ++ai)
#pragma unroll
                for (int m = 0; m < 4; ++m) {
                    const int eg = (pn - 8) * 256 + ai * 128 + wr * 64 + m * 16 + fr, h = eg >> 9, e = eg & 511;
#pragma unroll
                    for (int bj = 0; bj < 2; ++bj)
#pragma unroll
                        for (int n = 0; n < 2; ++n) {
                            const int tok = u.pm * 256 + bj * 128 + wc * 32 + n * 16 + 4 * fq; const u32x2 w = pk4(acc[ai][bj][m][n]);
                            if (tok < MP) { const int b = tok >> 12, t = tok & 4095; *(u32x2*)(vTp + ((size_t)((b * 4 + h) * 512 + e)) * 4096 + t) = w; }
                            else { const int ts = tok - MP, bs = ts >> 3, l0 = ts & 7; *(u32x2*)(vTs + ((size_t)((bs * 4 + h) * 512 + e)) * 8 + l0) = w; }
                        }
                }
        } else {
#pragma unroll
            for (int ai = 0; ai < 2; ++ai)
#pragma unroll
                for (int m = 0; m < 4; ++m) { const int r = u.pm * 256 + ai * 128 + wr * 64 + m * 16 + fr;
#pragma unroll
                    for (int bj = 0; bj < 2; ++bj)
#pragma unroll
                        for (int n = 0; n < 2; ++n) { const f32x4 a = acc[ai][bj][m][n]; f32x4 s;
#pragma unroll
                            for (int j = 0; j < 4; ++j) s[j] = silu_f(a[j]);
                            *(u32x2*)(Zg + (size_t)r * 2048 + (pn - 16) * 256 + bj * 128 + wc * 32 + n * 16 + 4 * fq) = pk4(s); } }
        }
    }
};

__device__ __forceinline__ void transpose_tile(const float* __restrict__ W, bf16_t* __restrict__ Wt, int K, int N, bool perm, int tile, LAS float* T) {
    const int tid = otid(), ntn = N >> 6;
    const int n0 = (tile % ntn) * 64, k0 = (tile / ntn) * 64, nn = tid & 63;
    const int nd = n0 + nn; int ns = nd;
    if (perm && nd < 1280) { const int p = nd & 63; ns = (nd - p) + (p >> 5) * 16 + (p & 15) + ((p >> 4) & 1) * 32; }
#pragma unroll
    for (int i = 0; i < 8; ++i) { const int kk = (tid >> 6) + 8 * i; T[kk * 65 + nn] = W[(size_t)(k0 + kk) * N + ns]; }
    __syncthreads();
    const int kk2 = (tid & 31) * 2;
#pragma unroll
    for (int i = 0; i < 4; ++i) { const int n2 = (tid >> 5) + 16 * i; *(unsigned*)(Wt + (size_t)(n0 + n2) * K + k0 + kk2) = cvt_pk_bf16(T[kk2 * 65 + n2], T[(kk2 + 1) * 65 + n2]); }
    __syncthreads();
}

__device__ __forceinline__ void rms_rows(const float* __restrict__ Xa, const float* __restrict__ Xb, const float* __restrict__ g, bf16_t* __restrict__ H, int G) {
    const int tid_o = otid(), wave = tid_o >> 6, lane = tid_o & 63;
    for (int row = blockIdx.x * 8 + wave; row < MT; row += G * 8) {
        const float* x = row < MP ? Xa + (size_t)row * 1024 : Xb + (size_t)(row - MP) * 1024;
        f32x4 v[4]; float ss = 0.f;
#pragma unroll
        for (int i = 0; i < 4; ++i) { v[i] = *(const f32x4*)(x + lane * 4 + 256 * i); ss += v[i][0] * v[i][0] + v[i][1] * v[i][1] + v[i][2] * v[i][2] + v[i][3] * v[i][3]; }
        ss = wave_sum(ss);
        const float rr = rsqrtf(ss * (1.f / 1024.f) + EPS);
#pragma unroll
        for (int i = 0; i < 4; ++i) { const f32x4 gg = *(const f32x4*)(g + lane * 4 + 256 * i); *(u32x2*)(H + (size_t)row * 1024 + lane * 4 + 256 * i) = pk4(v[i] * rr * gg); }
    }
}
__device__ __forceinline__ void resid_rows(const float* __restrict__ Xa, const float* __restrict__ Xb, const bf16_t* __restrict__ Y, const float* __restrict__ g, float* __restrict__ X1, bf16_t* __restrict__ H, int G) {
    const int tid_o = otid(), wave = tid_o >> 6, lane = tid_o & 63;
    for (int row = blockIdx.x * 8 + wave; row < MT; row += G * 8) {
        const float* x = row < MP ? Xa + (size_t)row * 1024 : Xb + (size_t)(row - MP) * 1024;
        const bf16_t* y = Y + (size_t)row * 1024;
        f32x4 v[4]; float ss = 0.f;
#pragma unroll
        for (int i = 0; i < 4; ++i) { const u32x2 yw = *(const u32x2*)(y + lane * 4 + 256 * i); v[i] = (f32x4){bflo(yw.x), bfhi(yw.x), bflo(yw.y), bfhi(yw.y)}; ss += v[i][0] * v[i][0] + v[i][1] * v[i][1] + v[i][2] * v[i][2] + v[i][3] * v[i][3]; }
        ss = wave_sum(ss);
        const float rr = rsqrtf(ss * (1.f / 1024.f) + EPS);
#pragma unroll
        for (int i = 0; i < 4; ++i) { const int c = lane * 4 + 256 * i; const f32x4 gg = *(const f32x4*)(g + c), xx = *(const f32x4*)(x + c); const f32x4 o = xx + v[i] * rr * gg;
            *(f32x4*)(X1 + (size_t)row * 1024 + c) = o; *(u32x2*)(H + (size_t)row * 1024 + c) = pk4(o); }
    }
}


struct SkF32 { float* C; __device__ __forceinline__ void operator()(int row, int col, f32x4 v) const { *(f32x4*)(C + (size_t)row * 1024 + col) = v; } };
struct SkB16 { bf16_t* C; __device__ __forceinline__ void operator()(int row, int col, f32x4 v) const { *(u32x2*)(C + (size_t)row * 1024 + col) = pk4(v); } };
struct SkGate { const float* X1; const bf16_t* PLE; float* O;
    __device__ __forceinline__ void operator()(int row, int col, f32x4 a) const { const size_t o = (size_t)row * 1024 + col; const f32x4 x1 = *(const f32x4*)(X1 + o); const u32x2 pw = *(const u32x2*)(PLE + o); const f32x4 pl = {bflo(pw.x), bfhi(pw.x), bflo(pw.y), bfhi(pw.y)}; f32x4 r;
#pragma unroll
        for (int j = 0; j < 4; ++j) r[j] = x1[j] + sigmoid_f(a[j]) * pl[j];
        *(f32x4*)(O + o) = r; } };
template <class Epi>
__device__ __forceinline__ void skinny_gemm(LAS unsigned char* lds, const bf16_t* __restrict__ A, const bf16_t* __restrict__ Bt, int K, const Epi& E, int G) {
    LAS float* red = (LAS float*)lds;
    const int tid = otid(), w = tid >> 6, lane = tid & 63, l16 = lane & 15, g = lane >> 4;
    const int KS = K >> 3, nks = KS >> 5;
    for (int u = blockIdx.x; u < 256; u += G) {
        const int row0 = (u >> 4) * 64, col0 = (u & 15) * 64;
        const bf16_t* ap = A + (size_t)(row0 + l16) * K + w * KS + 8 * g;
        const bf16_t* bp = Bt + (size_t)(col0 + l16) * K + w * KS + 8 * g;
        f32x4 acc[4][4];
#pragma unroll
        for (int mt = 0; mt < 4; ++mt)
#pragma unroll
            for (int nt = 0; nt < 4; ++nt) acc[mt][nt] = (f32x4){0.f, 0.f, 0.f, 0.f};
#pragma unroll 4
        for (int ks = 0; ks < nks; ++ks) {
            bf16x8 af[4], bf[4];
#pragma unroll
            for (int t = 0; t < 4; ++t) { af[t] = *(const bf16x8*)(ap + (size_t)(16 * t) * K + 32 * ks); bf[t] = *(const bf16x8*)(bp + (size_t)(16 * t) * K + 32 * ks); }
#pragma unroll
            for (int mt = 0; mt < 4; ++mt)
#pragma unroll
                for (int nt = 0; nt < 4; ++nt) acc[mt][nt] = __builtin_amdgcn_mfma_f32_16x16x32_bf16(bf[nt], af[mt], acc[mt][nt], 0, 0, 0);
        }
        __syncthreads();
#pragma unroll
        for (int mt = 0; mt < 4; ++mt)
#pragma unroll
            for (int nt = 0; nt < 4; ++nt) *(LAS f32x4*)(red + (w * 64 + 16 * mt + l16) * 68 + 16 * nt + 4 * g) = acc[mt][nt];
        __syncthreads();
#pragma unroll
        for (int j = 0; j < 2; ++j) { const int q = tid + 512 * j, row = q >> 4, c4 = (q & 15) * 4; f32x4 sum = *(const LAS f32x4*)(red + row * 68 + c4);
#pragma unroll
            for (int ww = 1; ww < 8; ++ww) sum += *(const LAS f32x4*)(red + (ww * 64 + row) * 68 + c4);
            E(row0 + row, col0 + c4, sum); }
    }
}

__device__ __forceinline__ void attn_prompt(LAS unsigned char* lds, const bf16_t* __restrict__ Zq, const bf16_t* __restrict__ Zk, const bf16_t* __restrict__ Zg, const bf16_t* __restrict__ vTp,
                                            const float* __restrict__ sinks, bf16_t* __restrict__ OG, int G) {
    LAS bf16_t* Ks = (LAS bf16_t*)lds;
    LAS bf16_t* Vt = (LAS bf16_t*)(lds + 256 * 72 * 2);
    const int tid = otid(), w = tid >> 6, lane = tid & 63, l16 = lane & 15, g = lane >> 4;
    for (int it = blockIdx.x; it < 512; it += G) {
        const int kvh = it & 3, nb = (it >> 2) & 31, b = it >> 7;
        __syncthreads();
#pragma unroll
        for (int i = 0; i < 4; ++i) { const int ch = tid + 512 * i, s = ch >> 3, c8 = ch & 7, t = (nb - 1) * 128 + s;
            u32x4 val = {0u, 0u, 0u, 0u}; if (t >= 0) val = *(const u32x4*)(Zk + (size_t)(b * 4096 + t) * 256 + kvh * 64 + c8 * 8);
            *(LAS u32x4*)(Ks + s * 72 + c8 * 8) = val; }
#pragma unroll
        for (int i = 0; i < 4; ++i) { const int ch = tid + 512 * i, d = ch >> 5, s0 = (ch & 31) * 8, t0 = (nb - 1) * 128 + s0;
            u32x4 val = {0u, 0u, 0u, 0u}; if (t0 >= 0) val = *(const u32x4*)(vTp + ((size_t)((b * 4 + kvh) * 64 + d)) * 4096 + t0);
            *(LAS u32x4*)(Vt + d * 264 + s0) = val; }
        __syncthreads();
        const int head = kvh * 4 + (w >> 1);
        const float sk = sinks[head];
        for (int qi = 0; qi < 4; ++qi) {
            const int qt = (w & 1) * 4 + qi;
            const size_t tq = (size_t)b * 4096 + nb * 128 + qt * 16 + l16;
            bf16x8 qf[2];
#pragma unroll
            for (int ks = 0; ks < 2; ++ks) qf[ks] = *(const bf16x8*)(Zq + tq * 1024 + head * 64 + ks * 32 + g * 8);
            f32x4 sa[9];
#pragma unroll
            for (int j = 0; j < 9; ++j) { sa[j] = (f32x4){0.f, 0.f, 0.f, 0.f};
#pragma unroll
                for (int ks = 0; ks < 2; ++ks) { const bf16x8 kf = *(const LAS bf16x8*)(Ks + (16 * (qt + j) + l16) * 72 + ks * 32 + g * 8);
                    sa[j] = __builtin_amdgcn_mfma_f32_16x16x32_bf16(kf, qf[ks], sa[j], 0, 0, 0); } }
            float mx = sk;
#pragma unroll
            for (int j = 0; j < 9; ++j)
#pragma unroll
                for (int r = 0; r < 4; ++r) {
                    bool vis = true;
                    if (j == 0) vis = (4 * g + r) > l16;
                    if (j == 8) vis = (4 * g + r) <= l16;
                    if (nb == 0 && (qt + j) < 8) vis = false;
                    sa[j][r] = vis ? sa[j][r] : -1e30f;
                    mx = fmaxf(mx, sa[j][r]);
                }
            mx = fmaxf(mx, __shfl_xor(mx, 16, 64)); mx = fmaxf(mx, __shfl_xor(mx, 32, 64));
            float sum = 0.f;
#pragma unroll
            for (int j = 0; j < 9; ++j)
#pragma unroll
                for (int r = 0; r < 4; ++r) { const float p = __expf(sa[j][r] - mx); sa[j][r] = p; sum += p; }
            sum += __shfl_xor(sum, 16, 64); sum += __shfl_xor(sum, 32, 64);
            const float inv = 1.f / (sum + __expf(sk - mx));
            f32x4 oa[4];
#pragma unroll
            for (int dt = 0; dt < 4; ++dt) oa[dt] = (f32x4){0.f, 0.f, 0.f, 0.f};
#pragma unroll
            for (int u = 0; u < 5; ++u) {
                u32x4 pw; pw.x = cvt_pk_bf16(sa[2 * u][0], sa[2 * u][1]); pw.y = cvt_pk_bf16(sa[2 * u][2], sa[2 * u][3]);
                if (u < 4) { pw.z = cvt_pk_bf16(sa[2 * u + 1][0], sa[2 * u + 1][1]); pw.w = cvt_pk_bf16(sa[2 * u + 1][2], sa[2 * u + 1][3]); } else { pw.z = 0u; pw.w = 0u; }
                const bf16x8 pf = __builtin_bit_cast(bf16x8, pw);
                const int k0 = 16 * (qt + 2 * u) + 4 * g, k1 = (u < 4) ? k0 + 16 : k0;
#pragma unroll
                for (int dt = 0; dt < 4; ++dt) {
                    const u32x2 v0 = *(const LAS u32x2*)(Vt + (16 * dt + l16) * 264 + k0), v1 = *(const LAS u32x2*)(Vt + (16 * dt + l16) * 264 + k1);
                    u32x4 vw; vw.x = v0.x; vw.y = v0.y; vw.z = v1.x; vw.w = v1.y;
                    oa[dt] = __builtin_amdgcn_mfma_f32_16x16x32_bf16(__builtin_bit_cast(bf16x8, vw), pf, oa[dt], 0, 0, 0);
                }
            }
#pragma unroll
            for (int dt = 0; dt < 4; ++dt) {
                const size_t o = tq * 1024 + head * 64 + 16 * dt + 4 * g;
                const u32x2 gw = *(const u32x2*)(Zg + o);
                f32x4 r; r[0] = oa[dt][0] * inv * bflo(gw.x); r[1] = oa[dt][1] * inv * bfhi(gw.x); r[2] = oa[dt][2] * inv * bflo(gw.y); r[3] = oa[dt][3] * inv * bfhi(gw.y);
                *(u32x2*)(OG + o) = pk4(r);
            }
        }
    }
}

__device__ __forceinline__ void attn_sample(LAS unsigned char* lds, const Params& P, const bf16_t* __restrict__ Zq, const bf16_t* __restrict__ Zk, const bf16_t* __restrict__ Zg, const bf16_t* __restrict__ vTs,
                                            bf16_t* __restrict__ OG, int G) {
    LAS float* Kc = (LAS float*)lds;
    LAS float* Vc = Kc + 136 * 68;
    LAS float* Qs = Vc + 136 * 68;
    LAS float* Sc = Qs + 32 * 68;
    const int tid = otid();
    for (int it = blockIdx.x; it < 512; it += G) {
        const int bs = it >> 2, kvh = it & 3;
        __syncthreads();
#pragma unroll
        for (int i = 0; i < 4; ++i) { const int ch = tid + 512 * i, j = ch >> 4, d4 = (ch & 15) * 4;
            const size_t src = ((size_t)(bs * 128 + j) * 4 + kvh) * 64 + d4;
            const f32x4 kv = *(const f32x4*)(P.cache_k + src), vv = *(const f32x4*)(P.cache_v + src);
            *(LAS f32x4*)(Kc + j * 68 + d4) = kv; *(LAS f32x4*)(Vc + j * 68 + d4) = vv;
            if (j >= 8) { const size_t dst = ((size_t)(bs * 128 + j - 8) * 4 + kvh) * 64 + d4; *(f32x4*)(P.out + OFF_KWS + dst) = kv; *(f32x4*)(P.out + OFF_VWS + dst) = vv; } }
        { const int l = tid >> 6, d = tid & 63;
          Kc[(128 + l) * 68 + d] = bf2f(Zk[(size_t)(MP + bs * 8 + l) * 256 + kvh * 64 + d]);
          Vc[(128 + l) * 68 + d] = bf2f(vTs[((size_t)((bs * 4 + kvh) * 64 + d)) * 8 + l]); }
#pragma unroll
        for (int i = 0; i < 4; ++i) { const int e = tid + 512 * i, rr = e >> 6, d = e & 63, hq = rr >> 3, l = rr & 7;
            Qs[rr * 68 + d] = bf2f(Zq[(size_t)(MP + bs * 8 + l) * 1024 + (kvh * 4 + hq) * 64 + d]); }
        __syncthreads();
        const int rr = tid >> 4, kl = tid & 15, l = rr & 7, hq = rr >> 3, head = kvh * 4 + hq;
        const float sk = P.sinks[head];
        float mx = sk;
#pragma unroll 1
        for (int m = 0; m < 9; ++m) {
            const int key = kl + 16 * m;
            if (key < 136) {
                float dot = -1e30f;
                const bool vis = key < 128 ? (key > l) : ((key - 128) <= l);
                if (vis) { float a = 0.f;
#pragma unroll
                    for (int d4 = 0; d4 < 16; ++d4) { const f32x4 q = *(const LAS f32x4*)(Qs + rr * 68 + d4 * 4), k = *(const LAS f32x4*)(Kc + key * 68 + d4 * 4); a += q[0] * k[0] + q[1] * k[1] + q[2] * k[2] + q[3] * k[3]; }
                    dot = a; }
                Sc[rr * 140 + key] = dot; mx = fmaxf(mx, dot);
            }
        }
#pragma unroll
        for (int o = 1; o < 16; o <<= 1) mx = fmaxf(mx, __shfl_xor(mx, o, 64));
        float sum = 0.f;
#pragma unroll 1
        for (int m = 0; m < 9; ++m) { const int key = kl + 16 * m;
            if (key < 136) { const float sv = Sc[rr * 140 + key]; const float p = sv > -1e29f ? __expf(sv - mx) : 0.f; sum += p; Sc[rr * 140 + key] = p; } }
#pragma unroll
        for (int o = 1; o < 16; o <<= 1) sum += __shfl_xor(sum, o, 64);
        const float inv = 1.f / (sum + __expf(sk - mx));
        __syncthreads();
        f32x4 o = {0.f, 0.f, 0.f, 0.f};
        for (int key = 0; key < 136; ++key) { const float p = Sc[rr * 140 + key]; const f32x4 v = *(const LAS f32x4*)(Vc + key * 68 + kl * 4); o += v * p; }
        const size_t oo = (size_t)(MP + bs * 8 + l) * 1024 + head * 64 + kl * 4;
        const u32x2 gw = *(const u32x2*)(Zg + oo);
        f32x4 r; r[0] = o[0] * inv * bflo(gw.x); r[1] = o[1] * inv * bfhi(gw.x); r[2] = o[2] * inv * bflo(gw.y); r[3] = o[3] * inv * bfhi(gw.y);
        *(u32x2*)(OG + oo) = pk4(r);
    }
}

__device__ __forceinline__ void ret_A(LAS unsigned char* lds, const bf16_t* __restrict__ Zq, const bf16_t* __restrict__ Zk, bf16_t* __restrict__ ABUF, bf16_t* __restrict__ KDT, int G) {
    LAS bf16_t* Qs = (LAS bf16_t*)lds;
    LAS bf16_t* Ks = (LAS bf16_t*)(lds + 128 * 264 * 2);
    const int tid = otid(), w = tid >> 6, lane = tid & 63, l16 = lane & 15, g = lane >> 4;
    for (int it = blockIdx.x; it < 512; it += G) {
        const int c = it & 31, h = (it >> 5) & 3, b = it >> 7;
        const float lg = ret_lg(h);
        const size_t tok0 = (size_t)b * 4096 + c * 128;
        __syncthreads();
#pragma unroll
        for (int i = 0; i < 8; ++i) { const int ch = tid + 512 * i, s = ch >> 5, c8 = (ch & 31) * 8; const size_t src = (tok0 + s) * 1024 + h * 256 + c8;
            *(LAS u32x4*)(Qs + s * 264 + c8) = *(const u32x4*)(Zq + src); *(LAS u32x4*)(Ks + s * 264 + c8) = *(const u32x4*)(Zk + src); }
        __syncthreads();
        const int i_row = 16 * w + l16;
#pragma unroll
        for (int nt = 0; nt < 8; ++nt) {
            f32x4 a = {0.f, 0.f, 0.f, 0.f};
            if (nt <= w) {
#pragma unroll
                for (int ks = 0; ks < 8; ++ks) { const bf16x8 kf = *(const LAS bf16x8*)(Ks + (16 * nt + l16) * 264 + ks * 32 + g * 8), qf = *(const LAS bf16x8*)(Qs + i_row * 264 + ks * 32 + g * 8);
                    a = __builtin_amdgcn_mfma_f32_16x16x32_bf16(kf, qf, a, 0, 0, 0); }
#pragma unroll
                for (int r = 0; r < 4; ++r) { const int s = 16 * nt + 4 * g + r; a[r] = (s <= i_row) ? a[r] * __expf((float)(i_row - s) * lg) : 0.f; }
            }
            *(u32x2*)(ABUF + ((size_t)it * 128 + i_row) * 128 + 16 * nt + 4 * g) = pk4(a);
        }
        { const int d = tid & 255, sg0 = tid >> 8;
#pragma unroll
          for (int k = 0; k < 8; ++k) { const int s0 = 8 * (sg0 + 2 * k); float v[8];
#pragma unroll
              for (int jj = 0; jj < 8; ++jj) v[jj] = bf2f(Ks[(s0 + jj) * 264 + d]) * __expf((float)(127 - s0 - jj) * lg);
              u32x4 wv; wv.x = cvt_pk_bf16(v[0], v[1]); wv.y = cvt_pk_bf16(v[2], v[3]); wv.z = cvt_pk_bf16(v[4], v[5]); wv.w = cvt_pk_bf16(v[6], v[7]);
              *(u32x4*)(KDT + ((size_t)it * 256 + d) * 128 + s0) = wv; } }
    }
}

__device__ __forceinline__ void ret_scan_unit(LAS unsigned char* lds, int u, const bf16_t* __restrict__ vTp, const bf16_t* __restrict__ KDT, bf16_t* __restrict__ SC, float* __restrict__ out) {
    LAS bf16_t* VT = (LAS bf16_t*)lds;
    const int tid = otid(), w = tid >> 6, lane = tid & 63, l16 = lane & 15, g = lane >> 4;
    const int xcd = u & 7, jj = u >> 3, bh = xcd * 2 + (jj >> 3), es = jj & 7, h = bh & 3;
    const float lg = ret_lg(h), g128 = __expf(128.f * lg);
    __syncthreads();
    const bf16_t* vrow = vTp + ((size_t)bh * 512 + es * 64 + (tid >> 3)) * 4096 + (tid & 7) * 16;
    LAS bf16_t* vdst = VT + (tid >> 3) * 136 + (tid & 7) * 16;
    { const u32x4 a = *(const u32x4*)vrow, bq = *(const u32x4*)(vrow + 8); *(LAS u32x4*)vdst = a; *(LAS u32x4*)(vdst + 8) = bq; }
    f32x4 sacc[2][4];
#pragma unroll
    for (int dt = 0; dt < 2; ++dt)
#pragma unroll
        for (int et = 0; et < 4; ++et) sacc[dt][et] = (f32x4){0.f, 0.f, 0.f, 0.f};
    const bf16_t* kptr = KDT + ((size_t)bh * 32 * 256 + 32 * w + l16) * 128 + 8 * g;
    bf16_t* scp = SC + (((size_t)bh * 32) * 512 + es * 64 + l16) * 256 + 32 * w + 4 * g;
    bf16x8 kf[2][4], kn[2][4];
#pragma unroll
    for (int dt = 0; dt < 2; ++dt)
#pragma unroll
        for (int ks = 0; ks < 4; ++ks) { kf[dt][ks] = *(const bf16x8*)(kptr + dt * 2048 + 32 * ks); kn[dt][ks] = kf[dt][ks]; }
    __syncthreads();
    for (int c = 0; c < 32; ++c) {
        const int buf = c & 1;
        u32x4 nv0 = {0u, 0u, 0u, 0u}, nv1 = {0u, 0u, 0u, 0u};
        if (c < 31) { nv0 = *(const u32x4*)(vrow + (c + 1) * 128); nv1 = *(const u32x4*)(vrow + (c + 1) * 128 + 8);
#pragma unroll
            for (int dt = 0; dt < 2; ++dt)
#pragma unroll
                for (int ks = 0; ks < 4; ++ks) kn[dt][ks] = *(const bf16x8*)(kptr + (size_t)(c + 1) * 256 * 128 + dt * 2048 + 32 * ks); }
        asm volatile("" ::: "memory");
        const LAS bf16_t* VTb = VT + buf * 64 * 136;
#pragma unroll
        for (int dt = 0; dt < 2; ++dt)
#pragma unroll
            for (int et = 0; et < 4; ++et) sacc[dt][et] *= g128;
#pragma unroll
        for (int et = 0; et < 4; ++et)
#pragma unroll
            for (int ks = 0; ks < 4; ++ks) { const bf16x8 vf = *(const LAS bf16x8*)(VTb + (16 * et + l16) * 136 + 32 * ks + 8 * g);
#pragma unroll
                for (int dt = 0; dt < 2; ++dt) sacc[dt][et] = __builtin_amdgcn_mfma_f32_16x16x32_bf16(kf[dt][ks], vf, sacc[dt][et], 0, 0, 0); }
        if (c < 31) {
#pragma unroll
            for (int dt = 0; dt < 2; ++dt)
#pragma unroll
                for (int et = 0; et < 4; ++et) *(u32x2*)(scp + (size_t)(c + 1) * 512 * 256 + (size_t)(16 * et) * 256 + 16 * dt) = pk4(sacc[dt][et]);
            LAS bf16_t* d2 = vdst + (buf ^ 1) * 64 * 136; *(LAS u32x4*)d2 = nv0; *(LAS u32x4*)(d2 + 8) = nv1;
        }
        lds_barrier();
#pragma unroll
        for (int dt = 0; dt < 2; ++dt)
#pragma unroll
            for (int ks = 0; ks < 4; ++ks) kf[dt][ks] = kn[dt][ks];
    }
#pragma unroll
    for (int dt = 0; dt < 2; ++dt)
#pragma unroll
        for (int et = 0; et < 4; ++et)
#pragma unroll
            for (int r = 0; r < 4; ++r) out[OFF_RSP + ((size_t)bh * 256 + 32 * w + 16 * dt + 4 * g + r) * 512 + es * 64 + 16 * et + l16] = sacc[dt][et][r];
}

__device__ __forceinline__ void ret_out_items(LAS unsigned char* lds, const bf16_t* __restrict__ Zq, const bf16_t* __restrict__ vTp, const bf16_t* __restrict__ ABUF, const bf16_t* __restrict__ SC, bf16_t* __restrict__ ORET, int G) {
    LAS bf16_t* VS = (LAS bf16_t*)lds;
    LAS bf16_t* SS = (LAS bf16_t*)(lds + 2 * 64 * 136 * 2);
    for (int it = blockIdx.x; it < 512; it += G) {
        const int tid = otid(), w = tid >> 6, lane = tid & 63, l16 = lane & 15, g = lane >> 4;
        const int bh = it >> 5, c = it & 31, b = bh >> 2, h = bh & 3;
        const float lg = ret_lg(h), gi = __expf((float)(16 * w + l16 + 1) * lg);
        bf16x8 af[4], qf[8];
        { const bf16_t* aptr = ABUF + (((size_t)bh * 32 + c) * 128 + 16 * w + l16) * 128 + 8 * g;
          const bf16_t* qptr = Zq + ((size_t)b * 4096 + c * 128 + 16 * w + l16) * 1024 + h * 256 + 8 * g;
#pragma unroll
          for (int ks = 0; ks < 4; ++ks) af[ks] = *(const bf16x8*)(aptr + 32 * ks);
#pragma unroll
          for (int kd = 0; kd < 8; ++kd) qf[kd] = *(const bf16x8*)(qptr + 32 * kd); }
        const bf16_t* vsrc = vTp + ((size_t)bh * 512 + (tid >> 4)) * 4096 + c * 128 + (tid & 15) * 8;
        const bf16_t* ssrc = SC + (((size_t)bh * 32 + c) * 512 + (tid >> 5)) * 256 + (tid & 31) * 8;
        LAS bf16_t* vd = VS + (tid >> 4) * 136 + (tid & 15) * 8; LAS bf16_t* sd = SS + (tid >> 5) * 264 + (tid & 31) * 8;
        bf16_t* optr = ORET + ((size_t)b * 4096 + c * 128 + 16 * w + l16) * 2048 + h * 512 + 4 * g;
        u32x4 rv[2], rs[4];
#pragma unroll
        for (int j = 0; j < 2; ++j) rv[j] = *(const u32x4*)(vsrc + (size_t)(32 * j) * 4096);
#pragma unroll
        for (int j = 0; j < 4; ++j) rs[j] = *(const u32x4*)(ssrc + (size_t)(16 * j) * 256);
        __syncthreads();
#pragma unroll
        for (int j = 0; j < 2; ++j) *(LAS u32x4*)(vd + 32 * j * 136) = rv[j];
#pragma unroll
        for (int j = 0; j < 4; ++j) *(LAS u32x4*)(sd + 16 * j * 264) = rs[j];
        __syncthreads();
        for (int es = 0; es < 8; ++es) {
            const int buf = es & 1;
            if (es < 7) {
#pragma unroll
                for (int j = 0; j < 2; ++j) rv[j] = *(const u32x4*)(vsrc + (size_t)((es + 1) * 64 + 32 * j) * 4096);
#pragma unroll
                for (int j = 0; j < 4; ++j) rs[j] = *(const u32x4*)(ssrc + (size_t)((es + 1) * 64 + 16 * j) * 256);
            }
            asm volatile("" ::: "memory");
            const LAS bf16_t* VSb = VS + buf * 64 * 136; const LAS bf16_t* SSb = SS + buf * 64 * 264;
#pragma unroll
            for (int et = 0; et < 4; ++et) {
                f32x4 oin = {0.f, 0.f, 0.f, 0.f}, ocr = {0.f, 0.f, 0.f, 0.f};
#pragma unroll
                for (int ks = 0; ks < 4; ++ks) { const bf16x8 vf = *(const LAS bf16x8*)(VSb + (16 * et + l16) * 136 + 32 * ks + 8 * g); oin = __builtin_amdgcn_mfma_f32_16x16x32_bf16(vf, af[ks], oin, 0, 0, 0); }
                if (c > 0) {
#pragma unroll
                    for (int kd = 0; kd < 8; ++kd) { const bf16x8 sf = *(const LAS bf16x8*)(SSb + (16 * et + l16) * 264 + 32 * kd + 8 * g); ocr = __builtin_amdgcn_mfma_f32_16x16x32_bf16(sf, qf[kd], ocr, 0, 0, 0); }
                }
                *(u32x2*)(optr + es * 64 + 16 * et) = pk4(oin + ocr * gi);
            }
            if (es < 7) {
#pragma unroll
                for (int j = 0; j < 2; ++j) *(LAS u32x4*)(vd + ((buf ^ 1) * 64 + 32 * j) * 136) = rv[j];
#pragma unroll
                for (int j = 0; j < 4; ++j) *(LAS u32x4*)(sd + ((buf ^ 1) * 64 + 16 * j) * 264) = rs[j];
            }
            lds_barrier();
        }
    }
}

__device__ __forceinline__ void ret_sample(LAS unsigned char* lds, const Params& P, const bf16_t* __restrict__ Zq, const bf16_t* __restrict__ Zk, const bf16_t* __restrict__ vTs, bf16_t* __restrict__ ORET, unsigned* ctr, unsigned* done, unsigned target) {
    LAS float* qs = (LAS float*)lds;
    LAS float* kds = qs + 2048;
    LAS float* A8 = kds + 2048;
    LAS float* red = A8 + 64;
    volatile LAS int* slot = (volatile LAS int*)(lds + LDS_BYTES - 32);
    for (;;) {
        const int tid = otid();
        __syncthreads();
        if (tid == 0) *slot = (done && xb_ld(done) >= target) ? 512 : (int)atomicAdd(ctr, 1u);
        __syncthreads();
        const int it = *slot;
        if (it >= 512) break;
        const int bs = it >> 2, h = it & 3;
        const float lg = ret_lg(h), g8 = __expf(8.f * lg), ig8 = __expf(-8.f * lg);
#pragma unroll
        for (int k = 0; k < 4; ++k) { const int e = tid + 512 * k, i = e >> 8, d = e & 255; const size_t src = (size_t)(MP + bs * 8 + i) * 1024 + h * 256 + d;
            qs[d * 8 + i] = bf2f(Zq[src]) * __expf((float)(i + 1) * lg); kds[d * 8 + i] = bf2f(Zk[src]) * __expf((float)(7 - i) * lg); }
        __syncthreads();
        if (tid < 64) { const int i = tid >> 3, s = tid & 7; float a = 0.f;
            if (s <= i) { for (int d = 0; d < 256; ++d) a += qs[d * 8 + i] * kds[d * 8 + s]; a *= ig8; }
            A8[tid] = a; }
        const int eg = tid & 127, dp = tid >> 7, e0 = 4 * eg;
        f32x4 vq[8];
#pragma unroll
        for (int jj = 0; jj < 4; ++jj) { const u32x4 wv = *(const u32x4*)(vTs + ((size_t)((bs * 4 + h) * 512 + e0 + jj)) * 8);
            vq[0][jj] = bflo(wv.x); vq[1][jj] = bfhi(wv.x); vq[2][jj] = bflo(wv.y); vq[3][jj] = bfhi(wv.y); vq[4][jj] = bflo(wv.z); vq[5][jj] = bfhi(wv.z); vq[6][jj] = bflo(wv.w); vq[7][jj] = bfhi(wv.w); }
        f32x4 cr[8];
#pragma unroll
        for (int i = 0; i < 8; ++i) cr[i] = (f32x4){0.f, 0.f, 0.f, 0.f};
        const size_t sbase = ((size_t)(bs * 4 + h) * 256 + dp * 64) * 512 + e0;
        const float* __restrict__ sp = P.state_ret + sbase; float* __restrict__ op = P.out + OFF_RSS + sbase;
        f32x4 sta[8];
#pragma unroll
        for (int j = 0; j < 8; ++j) sta[j] = __builtin_nontemporal_load((const f32x4*)(sp + (size_t)j * 512));
#pragma unroll 1
        for (int d0 = 0; d0 < 64; d0 += 8) {
            const bool more = d0 + 8 < 64;
#pragma unroll
            for (int j = 0; j < 8; ++j) {
                const int d = dp * 64 + d0 + j; const f32x4 st = sta[j];
                if (more) sta[j] = __builtin_nontemporal_load((const f32x4*)(sp + (size_t)(d0 + 8 + j) * 512));
                const f32x4 qa = *(const LAS f32x4*)(qs + d * 8), qb = *(const LAS f32x4*)(qs + d * 8 + 4), ka = *(const LAS f32x4*)(kds + d * 8), kb = *(const LAS f32x4*)(kds + d * 8 + 4);
                const float q8[8] = {qa[0], qa[1], qa[2], qa[3], qb[0], qb[1], qb[2], qb[3]}, k8[8] = {ka[0], ka[1], ka[2], ka[3], kb[0], kb[1], kb[2], kb[3]};
                f32x4 ns = st * g8;
#pragma unroll
                for (int s2 = 0; s2 < 8; ++s2) ns += vq[s2] * k8[s2];
                __builtin_nontemporal_store(ns, (f32x4*)(op + (size_t)(d0 + j) * 512));
#pragma unroll
                for (int i = 0; i < 8; ++i) cr[i] += st * q8[i];
                asm volatile("" ::: "memory");
            }
        }
#pragma unroll
        for (int i = 0; i < 8; ++i) *(LAS f32x4*)(red + (dp * 8 + i) * 512 + e0) = cr[i];
        __syncthreads();
        { const int i = tid >> 6, e8 = (tid & 63) * 8;
          float o[8];
#pragma unroll
          for (int jj = 0; jj < 8; ++jj) o[jj] = red[(0 * 8 + i) * 512 + e8 + jj] + red[(1 * 8 + i) * 512 + e8 + jj] + red[(2 * 8 + i) * 512 + e8 + jj] + red[(3 * 8 + i) * 512 + e8 + jj];
#pragma unroll
          for (int jj = 0; jj < 8; ++jj) { const u32x4 wv = *(const u32x4*)(vTs + ((size_t)((bs * 4 + h) * 512 + e8 + jj)) * 8);
              const float v8[8] = {bflo(wv.x), bfhi(wv.x), bflo(wv.y), bfhi(wv.y), bflo(wv.z), bfhi(wv.z), bflo(wv.w), bfhi(wv.w)};
#pragma unroll
              for (int s = 0; s < 8; ++s) o[jj] += A8[i * 8 + s] * v8[s]; }
          bf16_t* dst = ORET + (size_t)(MP + bs * 8 + i) * 2048 + h * 512 + e8;
          u32x4 ow; ow.x = cvt_pk_bf16(o[0], o[1]); ow.y = cvt_pk_bf16(o[2], o[3]); ow.z = cvt_pk_bf16(o[4], o[5]); ow.w = cvt_pk_bf16(o[6], o[7]); *(u32x4*)dst = ow; }
    }
}

__device__ __forceinline__ void ret_gnorm(const bf16_t* __restrict__ ORET, const bf16_t* __restrict__ Zg, bf16_t* __restrict__ OG, int G) {
    const int tid_o = otid(), wave = tid_o >> 6, lane = tid_o & 63;
    for (int task = blockIdx.x * 8 + wave; task < MT * 4; task += G * 8) {
        const size_t o = (size_t)(task >> 2) * 2048 + (task & 3) * 512 + lane * 8;
        const u32x4 ow = *(const u32x4*)(ORET + o); const f32x4 a = {bflo(ow.x), bfhi(ow.x), bflo(ow.y), bfhi(ow.y)}, b = {bflo(ow.z), bfhi(ow.z), bflo(ow.w), bfhi(ow.w)};
        const float mu = wave_sum(a[0] + a[1] + a[2] + a[3] + b[0] + b[1] + b[2] + b[3]) * (1.f / 512.f);
        const f32x4 da = a - mu, db = b - mu;
        const float var = wave_sum(da[0] * da[0] + da[1] * da[1] + da[2] * da[2] + da[3] * da[3] + db[0] * db[0] + db[1] * db[1] + db[2] * db[2] + db[3] * db[3]) * (1.f / 512.f);
        const float rs = rsqrtf(var + EPS);
        const u32x4 gw = *(const u32x4*)(Zg + o);
        u32x4 r;
        r.x = cvt_pk_bf16(da[0] * rs * bflo(gw.x), da[1] * rs * bfhi(gw.x)); r.y = cvt_pk_bf16(da[2] * rs * bflo(gw.y), da[3] * rs * bfhi(gw.y));
        r.z = cvt_pk_bf16(db[0] * rs * bflo(gw.z), db[1] * rs * bfhi(gw.z)); r.w = cvt_pk_bf16(db[2] * rs * bflo(gw.w), db[3] * rs * bfhi(gw.w));
        *(u32x4*)(OG + o) = r;
    }
}

__global__ void __launch_bounds__(NT) hybrid_fwd(Params P) {
    extern __shared__ __attribute__((aligned(16))) unsigned char lds_raw[];
    LAS unsigned char* lds = (LAS unsigned char*)lds_raw;
    cg::grid_group grid = cg::this_grid();
    const int G = gridDim.x, tid = threadIdx.x;
    unsigned char* ws = P.ws;
    bf16_t* WT_IN_ATTN = (bf16_t*)(ws + WS_WT_IN_ATTN); bf16_t* WT_OUT_ATTN = (bf16_t*)(ws + WS_WT_OUT_ATTN); bf16_t* WT_IN_RET = (bf16_t*)(ws + WS_WT_IN_RET); bf16_t* WT_OUT_RET = (bf16_t*)(ws + WS_WT_OUT_RET);
    bf16_t* WT_GATE = (bf16_t*)(ws + WS_WT_GATE); bf16_t* WT_PLE = (bf16_t*)(ws + WS_WT_PLE);
    float* TABA = (float*)(ws + WS_TABA); float* TABR = (float*)(ws + WS_TABR);
    bf16_t* H = (bf16_t*)(ws + WS_H); bf16_t* PB = (bf16_t*)(ws + WS_PB);
    bf16_t* PLE = (bf16_t*)(ws + WS_PLE); bf16_t* Y = (bf16_t*)(ws + WS_Y); float* X1 = (float*)(ws + WS_X1); float* X2 = (float*)(ws + WS_X2);
    bf16_t* OG = (bf16_t*)(ws + WS_OG); bf16_t* ZQ = (bf16_t*)(ws + WS_ZQ); bf16_t* ZK = (bf16_t*)(ws + WS_ZK); bf16_t* ZG = (bf16_t*)(ws + WS_ZG);
    bf16_t* VTP = (bf16_t*)(ws + WS_VTP); bf16_t* VTS = (bf16_t*)(ws + WS_VTS); bf16_t* ABUF = (bf16_t*)(ws + WS_ABUF); bf16_t* KDT = (bf16_t*)(ws + WS_KDT); bf16_t* ORET = (bf16_t*)(ws + WS_ORET);
    bf16_t* SC = (bf16_t*)(ws + WS_Y);
    pg8::StaticOrder SO;
    volatile LAS unsigned* bst = (volatile LAS unsigned*)(lds + LDS_BYTES - 16);
    if (tid < 4) bst[tid] = 0u;
    __syncthreads();
    const XcdBarrier xbar = xcd_barrier_post((unsigned*)(ws + WS_BAR), bst);
#define GSYNC() xcd_barrier(xbar)

for (int rep_ = 0; rep_ < REP_P0; ++rep_) {
    {
        LAS float* T = (LAS float*)lds;
        const int ttid = otid(), nn = ttid & 63, kq = ttid >> 6, kk2 = (ttid & 31) * 2, nq = ttid >> 5;
#define TILE_DESC(t_, W_, Wt_, K_, N_, perm_, tl_) do { \
        if ((t_) < 640) { W_ = P.w_in_attn; Wt_ = WT_IN_ATTN; K_ = 1024; N_ = 2560; perm_ = true; tl_ = (t_); } \
        else if ((t_) < 896) { W_ = P.w_out_attn; Wt_ = WT_OUT_ATTN; K_ = 1024; N_ = 1024; perm_ = false; tl_ = (t_) - 640; } \
        else if ((t_) < 2432) { W_ = P.w_in_ret; Wt_ = WT_IN_RET; K_ = 1024; N_ = 6144; perm_ = false; tl_ = (t_) - 896; } \
        else if ((t_) < 2944) { W_ = P.w_out_ret; Wt_ = WT_OUT_RET; K_ = 2048; N_ = 1024; perm_ = false; tl_ = (t_) - 2432; } \
        else if ((t_) < 3200) { W_ = P.w_gate; Wt_ = WT_GATE; K_ = 1024; N_ = 1024; perm_ = false; tl_ = (t_) - 2944; } \
        else if ((t_) < 3456) { W_ = P.w_gate + 1024 * 1024; Wt_ = WT_GATE + 1024 * 1024; K_ = 1024; N_ = 1024; perm_ = false; tl_ = (t_) - 3200; } \
        else if ((t_) < 3520) { W_ = P.w_ple; Wt_ = WT_PLE; K_ = 256; N_ = 1024; perm_ = false; tl_ = (t_) - 3456; } \
        else { W_ = P.w_ple + 256 * 1024; Wt_ = WT_PLE + 1024 * 256; K_ = 256; N_ = 1024; perm_ = false; tl_ = (t_) - 3520; } } while (0)
#define TILE_LOAD(W_, N_, perm_, tl_, r_) do { const int ntn_ = (N_) >> 6, n0_ = ((tl_) % ntn_) * 64, k0_ = ((tl_) / ntn_) * 64, nd_ = n0_ + nn; int ns_ = nd_; \
        if ((perm_) && nd_ < 1280) { const int p_ = nd_ & 63; ns_ = (nd_ - p_) + (p_ >> 5) * 16 + (p_ & 15) + ((p_ >> 4) & 1) * 32; } \
        _Pragma("unroll") for (int i_ = 0; i_ < 8; ++i_) r_[i_] = (W_)[(size_t)(k0_ + kq + 8 * i_) * (N_) + ns_]; } while (0)
        float r[8];
        const float* Wc; bf16_t* Wtc; int Kc, Nc, tlc; bool pc;
        int t = blockIdx.x;
        if (t < 3584) { TILE_DESC(t, Wc, Wtc, Kc, Nc, pc, tlc); TILE_LOAD(Wc, Nc, pc, tlc, r); }
        for (; t < 3584; t += G) {
            __syncthreads();
#pragma unroll
            for (int i = 0; i < 8; ++i) T[(kq + 8 * i) * 65 + nn] = r[i];
            __syncthreads();
            const int ntn = Nc >> 6, n0 = (tlc % ntn) * 64, k0 = (tlc / ntn) * 64; bf16_t* Wto = Wtc; const int Ko = Kc;
            if (t + G < 3584) { TILE_DESC(t + G, Wc, Wtc, Kc, Nc, pc, tlc); TILE_LOAD(Wc, Nc, pc, tlc, r); }
#pragma unroll
            for (int i = 0; i < 4; ++i) { const int n2 = nq + 16 * i; *(unsigned*)(Wto + (size_t)(n0 + n2) * Ko + k0 + kk2) = cvt_pk_bf16(T[kk2 * 65 + n2], T[(kk2 + 1) * 65 + n2]); }
        }
        __syncthreads();
#undef TILE_DESC
#undef TILE_LOAD
    }
    for (int e = blockIdx.x * NT + tid; e < 4104 * 160; e += G * NT) {
        const int pi = e / 160, f = e % 160; const int pos = pi < 4096 ? pi : 16384 + (pi - 4096);
        if (f < 32) { const float inv = powf(10000.f, -(float)f / 32.f), ang = (float)pos * inv; TABA[((size_t)pi * 32 + f) * 2] = cosf(ang); TABA[((size_t)pi * 32 + f) * 2 + 1] = sinf(ang); }
        else { const int f2 = f - 32; const float inv = powf(10000.f, -(float)f2 / 128.f), ang = (float)pos * inv; TABR[((size_t)pi * 128 + f2) * 2] = cosf(ang); TABR[((size_t)pi * 128 + f2) * 2 + 1] = sinf(ang); }
    }
    for (int e = blockIdx.x * NT + tid; e < 2 * MT * 64; e += G * NT) {
        const int i = e / (MT * 64), rem = e % (MT * 64), row = rem >> 6, c4 = (rem & 63) * 4;
        const float* src = row < MP ? P.p_prompt + ((size_t)i * MP + row) * 256 + c4 : P.p_sample + ((size_t)i * MS + row - MP) * 256 + c4;
        *(u32x2*)(PB + ((size_t)i * MT + row) * 256 + c4) = pk4(*(const f32x4*)src);
    }
    rms_rows(P.x_prompt, P.x_sample, P.pre_norm, H, G);
}
    if (P.ws == nullptr) grid.sync();
    GSYNC();

for (int rep_ = 0; rep_ < REP_GIN; ++rep_) {
    { pg8::Gemm g{H, WT_IN_ATTN, MT, 2560, 1024}; SO.init(MT, 2560, G, blockIdx.x);
      EpiInAttn E{ZQ, ZK, ZG, VTP, VTS, TABA, P.out}; pg8::gemm_phase(lds, g, SO, E); }
    { pg8::Gemm g{PB, WT_PLE, MP, 1024, 256}; SO.init(MP, 1024, G, blockIdx.x);
      EpiB16 E{PLE, 1024}; pg8::gemm_phase(lds, g, SO, E);
      skinny_gemm(lds, PB + (size_t)MP * 256, WT_PLE, 256, SkB16{PLE + (size_t)MP * 1024}, G); }
}
    GSYNC();

for (int rep_ = 0; rep_ < REP_ATT; ++rep_) {
    attn_prompt(lds, ZQ, ZK, ZG, VTP, P.sinks, OG, G);
    attn_sample(lds, P, ZQ, ZK, ZG, VTS, OG, G);
}
    GSYNC();

for (int rep_ = 0; rep_ < REP_GN1; ++rep_) {
    { pg8::Gemm g{OG, WT_OUT_ATTN, MP, 1024, 1024}; SO.init(MP, 1024, G, blockIdx.x); EpiB16 E{Y, 1024}; pg8::gemm_phase(lds, g, SO, E);
      skinny_gemm(lds, OG + (size_t)MP * 1024, WT_OUT_ATTN, 1024, SkB16{Y + (size_t)MP * 1024}, G); }
}
    GSYNC();
for (int rep_ = 0; rep_ < REP_ROW; ++rep_) {
    resid_rows(P.x_prompt, P.x_sample, Y, P.post_norm, X1, H, G);
}
    GSYNC();
for (int rep_ = 0; rep_ < REP_GN1; ++rep_) {
    { pg8::Gemm g{H, WT_GATE, MP, 1024, 1024}; SO.init(MP, 1024, G, blockIdx.x); EpiGate E{X1, PLE, X2}; pg8::gemm_phase(lds, g, SO, E);
      skinny_gemm(lds, H + (size_t)MP * 1024, WT_GATE, 1024, SkGate{X1 + (size_t)MP * 1024, PLE + (size_t)MP * 1024, X2 + (size_t)MP * 1024}, G); }
}
    GSYNC();
for (int rep_ = 0; rep_ < REP_ROW; ++rep_) {
    rms_rows(X2, X2 + (size_t)MP * 1024, P.pre_norm + 1024, H, G);
}
    GSYNC();
for (int rep_ = 0; rep_ < REP_GIN; ++rep_) {
    { pg8::Gemm g{H, WT_IN_RET, MT, 6144, 1024}; SO.init(MT, 6144, G, blockIdx.x);
      EpiInRet E{ZQ, ZK, ZG, VTP, VTS, TABR}; pg8::gemm_phase(lds, g, SO, E); }
    { pg8::Gemm g{PB + (size_t)MT * 256, WT_PLE + 1024 * 256, MP, 1024, 256}; SO.init(MP, 1024, G, blockIdx.x);
      EpiB16 E{PLE, 1024}; pg8::gemm_phase(lds, g, SO, E);
      skinny_gemm(lds, PB + (size_t)MT * 256 + (size_t)MP * 256, WT_PLE + 1024 * 256, 256, SkB16{PLE + (size_t)MP * 1024}, G); }
}
    GSYNC();
for (int rep_ = 0; rep_ < REP_RA; ++rep_) {
    ret_A(lds, ZQ, ZK, ABUF, KDT, G);
}
    GSYNC();
    { unsigned* ctr = (unsigned*)(ws + WS_BAR + 14336); unsigned* done = ctr + 64;
      const unsigned nscan = G < 128 ? (unsigned)G : 128u;
      if (blockIdx.x < 128) { for (int rep_ = 0; rep_ < REP_SCAN; ++rep_) for (int u = blockIdx.x; u < 128; u += G) ret_scan_unit(lds, u, VTP, KDT, SC, P.out); if (tid == 0) xb_add(done, 1u); }
      else ret_sample(lds, P, ZQ, ZK, VTS, ORET, ctr, done, nscan);
      GSYNC();
      for (int rep_ = 0; rep_ < REP_R3; ++rep_) ret_out_items(lds, ZQ, VTP, ABUF, SC, ORET, G);
      ret_sample(lds, P, ZQ, ZK, VTS, ORET, ctr, nullptr, 0u); }
for (int rep_ = 0; rep_ < REP_SYNC; ++rep_) GSYNC();
    GSYNC();
for (int rep_ = 0; rep_ < REP_ROW; ++rep_) {
    ret_gnorm(ORET, ZG, OG, G);
}
    GSYNC();
for (int rep_ = 0; rep_ < REP_GN1; ++rep_) {
    { pg8::Gemm g{OG, WT_OUT_RET, MP, 1024, 2048}; SO.init(MP, 1024, G, blockIdx.x); EpiB16 E{Y, 1024}; pg8::gemm_phase(lds, g, SO, E);
      skinny_gemm(lds, OG + (size_t)MP * 2048, WT_OUT_RET, 2048, SkB16{Y + (size_t)MP * 1024}, G); }
}
    GSYNC();
for (int rep_ = 0; rep_ < REP_ROW; ++rep_) {
    resid_rows(X2, X2 + (size_t)MP * 1024, Y, P.post_norm + 1024, X1, H, G);
}
    GSYNC();
for (int rep_ = 0; rep_ < REP_GN1; ++rep_) {
    { pg8::Gemm g{H, WT_GATE + 1024 * 1024, MP, 1024, 1024}; SO.init(MP, 1024, G, blockIdx.x); EpiGate E{X1, PLE, P.out}; pg8::gemm_phase(lds, g, SO, E);
      skinny_gemm(lds, H + (size_t)MP * 1024, WT_GATE + 1024 * 1024, 1024, SkGate{X1 + (size_t)MP * 1024, PLE + (size_t)MP * 1024, P.out + (size_t)MP * 1024}, G); }
}
}

extern "C" void kernel_launch(void* const* d_in, const int* in_sizes, int n_in, void* d_out, int out_size, void* d_ws, size_t ws_size, hipStream_t stream) {
    static int grid_blocks = 0;
    if (!grid_blocks) {
        int dev = 0, cus = 0, per_cu = 0;
        hipGetDevice(&dev);
        hipDeviceGetAttribute(&cus, hipDeviceAttributeMultiprocessorCount, dev);
        hipFuncSetAttribute((const void*)hybrid_fwd, hipFuncAttributeMaxDynamicSharedMemorySize, LDS_BYTES);
        hipOccupancyMaxActiveBlocksPerMultiprocessor(&per_cu, (const void*)hybrid_fwd, NT, LDS_BYTES);
        if (per_cu < 1) per_cu = 1;
        if (per_cu > 1) per_cu = 1;
        grid_blocks = cus * per_cu;
        if (ws_size < WS_END) fprintf(stderr, "kernel_launch: workspace too small: %zu < %zu\n", ws_size, (size_t)WS_END);
    }
    Params p{};
    p.x_prompt = (const float*)d_in[0]; p.x_sample = (const float*)d_in[1]; p.cache_k = (const float*)d_in[2]; p.cache_v = (const float*)d_in[3]; p.state_ret = (const float*)d_in[4];
    p.p_prompt = (const float*)d_in[5]; p.p_sample = (const float*)d_in[6]; p.pre_norm = (const float*)d_in[7]; p.post_norm = (const float*)d_in[8]; p.w_in_attn = (const float*)d_in[9];
    p.sinks = (const float*)d_in[10]; p.w_out_attn = (const float*)d_in[11]; p.w_in_ret = (const float*)d_in[12]; p.w_out_ret = (const float*)d_in[13]; p.w_ple = (const float*)d_in[14]; p.w_gate = (const float*)d_in[15];
    p.out = (float*)d_out; p.ws = (unsigned char*)d_ws;
    (void)hipMemsetAsync((unsigned char*)d_ws + WS_BAR, 0, 16384, stream);
    void* args[] = {&p};
    hipError_t e = hipLaunchCooperativeKernel((const void*)hybrid_fwd, dim3(grid_blocks), dim3(NT), args, LDS_BYTES, stream);
    if (e != hipSuccess) fprintf(stderr, "cooperative launch failed: %s (grid %d)\n", hipGetErrorString(e), grid_blocks);
}
```

```cpp
#include <hip/hip_runtime.h>
#include <hip/hip_cooperative_groups.h>
#include <cstdio>
#include <cstdint>
namespace cg = cooperative_groups;

#define LAS __attribute__((address_space(3)))
typedef unsigned short bf16_t;
typedef short bf16x8 __attribute__((ext_vector_type(8)));
typedef float f32x4 __attribute__((ext_vector_type(4)));
typedef float f32x2 __attribute__((ext_vector_type(2)));
typedef unsigned u32x2 __attribute__((ext_vector_type(2)));
typedef unsigned u32x4 __attribute__((ext_vector_type(4)));

constexpr int MP = 16384, MS = 1024, MT = MP + MS;
constexpr int NT = 512;
#define REP_P0 1
#define REP_GIN 1
#define REP_ATT 1
#define REP_RA 1
#define REP_SYNC 0
#define REP_R3 1
#define REP_SCAN 1
#define REP_ROW 1
#define REP_GN1 1
constexpr int LDS_BYTES = 140 * 1024;
constexpr float EPS = 1e-6f;

constexpr size_t OFF_YP = 0, OFF_YS = 16777216, OFF_KWP = 17825792, OFF_VWP = 17956864, OFF_KWS = 18087936, OFF_VWS = 22282240, OFF_RSP = 26476544, OFF_RSS = 28573696;

constexpr size_t al256(size_t x) { return (x + 255) & ~(size_t)255; }
constexpr size_t WS_WT_IN_ATTN = 0;
constexpr size_t WS_WT_OUT_ATTN = WS_WT_IN_ATTN + (size_t)2560 * 1024 * 2;
constexpr size_t WS_WT_IN_RET = WS_WT_OUT_ATTN + (size_t)1024 * 1024 * 2;
constexpr size_t WS_WT_OUT_RET = WS_WT_IN_RET + (size_t)6144 * 1024 * 2;
constexpr size_t WS_WT_GATE = WS_WT_OUT_RET + (size_t)1024 * 2048 * 2;
constexpr size_t WS_WT_PLE = WS_WT_GATE + (size_t)2 * 1024 * 1024 * 2;
constexpr size_t WS_TABA = WS_WT_PLE + (size_t)2 * 1024 * 256 * 2;
constexpr size_t WS_TABR = WS_TABA + (size_t)4104 * 32 * 8;
constexpr size_t WS_H = al256(WS_TABR + (size_t)4104 * 128 * 8);
constexpr size_t WS_PB = WS_H + (size_t)MT * 1024 * 2;
constexpr size_t WS_PLE = WS_PB + (size_t)2 * MT * 256 * 2;
constexpr size_t WS_Y = WS_PLE + (size_t)MT * 1024 * 4;
constexpr size_t WS_X1 = WS_Y + (size_t)MT * 1024 * 4;
constexpr size_t WS_X2 = WS_X1 + (size_t)MT * 1024 * 4;
constexpr size_t WS_OG = WS_X2 + (size_t)MT * 1024 * 4;
constexpr size_t WS_ZQ = WS_OG + (size_t)MT * 2048 * 2;
constexpr size_t WS_ZK = WS_ZQ + (size_t)MT * 1024 * 2;
constexpr size_t WS_ZG = WS_ZK + (size_t)MT * 1024 * 2;
constexpr size_t WS_VTP = WS_ZG + (size_t)MT * 2048 * 2;
constexpr size_t WS_VTS = WS_VTP + (size_t)16 * 512 * 4096 * 2;
constexpr size_t WS_ABUF = WS_VTS + (size_t)128 * 4 * 512 * 8 * 2;
constexpr size_t WS_KDT = WS_ABUF + (size_t)512 * 128 * 128 * 2;
constexpr size_t WS_ORET = WS_KDT + (size_t)512 * 256 * 128 * 2;
constexpr size_t WS_BAR = WS_ORET + (size_t)MT * 2048 * 4;
constexpr size_t WS_END = WS_BAR + 16384;

struct Params {
    const float *x_prompt, *x_sample, *cache_k, *cache_v, *state_ret, *p_prompt, *p_sample, *pre_norm, *post_norm, *w_in_attn, *sinks, *w_out_attn, *w_in_ret, *w_out_ret, *w_ple, *w_gate;
    float* out; unsigned char* ws;
};

__device__ __forceinline__ unsigned cvt_pk_bf16(float lo, float hi) { unsigned r; asm volatile("v_cvt_pk_bf16_f32 %0, %1, %2" : "=v"(r) : "v"(lo), "v"(hi)); return r; }
__device__ __forceinline__ u32x2 pk4(f32x4 v) { u32x2 w; w.x = cvt_pk_bf16(v[0], v[1]); w.y = cvt_pk_bf16(v[2], v[3]); return w; }
__device__ __forceinline__ float bf2f(bf16_t b) { return __uint_as_float(((unsigned)b) << 16); }
__device__ __forceinline__ float bflo(unsigned w) { return __uint_as_float(w << 16); }
__device__ __forceinline__ float bfhi(unsigned w) { return __uint_as_float(w & 0xffff0000u); }
__device__ __forceinline__ float silu_f(float x) { return x / (1.f + __expf(-x)); }
__device__ __forceinline__ float sigmoid_f(float x) { return 1.f / (1.f + __expf(-x)); }
__device__ __forceinline__ float wave_sum(float v) {
#pragma unroll
    for (int o = 32; o >= 1; o >>= 1) v += __shfl_xor(v, o, 64);
    return v;
}
__device__ __forceinline__ int otid() { int t = threadIdx.x; asm volatile("" : "+v"(t)); return t; }
__device__ __forceinline__ void lds_barrier() { asm volatile("s_waitcnt lgkmcnt(0)" ::: "memory"); __builtin_amdgcn_s_barrier(); asm volatile("" ::: "memory"); }
__device__ __forceinline__ float ret_lg(int h) { return h == 0 ? -3.1748698315e-02f : h == 1 ? -1.5748356968e-02f : h == 2 ? -7.8431774610e-03f : -3.9138993211e-03f; }

#define XB_TMO      128
#define XB_XCNT(j)  (256  + 64 * (j))
#define XB_XSUB(j)  (1280 + 64 * (j))
#define XB_XGEN(j)  (2304 + 64 * (j))
#define XB_TOP      3328
#define XB_TOPGEN   3392
#define XCD_BAR_WORDS 3456
#define XB_SPIN_CAP (1u << 18)

__device__ __forceinline__ unsigned xb_ld(unsigned* p)              { return __hip_atomic_load(p, __ATOMIC_RELAXED, __HIP_MEMORY_SCOPE_AGENT); }
__device__ __forceinline__ unsigned xb_add(unsigned* p, unsigned v) { return __hip_atomic_fetch_add(p, v, __ATOMIC_RELAXED, __HIP_MEMORY_SCOPE_AGENT); }
__device__ __forceinline__ unsigned xb_xcc_id() { return (unsigned)__builtin_amdgcn_s_getreg((3 << 11) | 20) & 0xFu; }
#define XB_SPIN(cond, bar) do { unsigned _sp = 0; while (cond) { __builtin_amdgcn_s_sleep(1); \
    if ((++_sp & 255u) == 0u) { if (xb_ld(&(bar)[XB_TMO])) break; if (_sp > XB_SPIN_CAP) { atomicAdd(&(bar)[XB_TMO], 1u); break; } } } } while (0)

struct XcdBarrier {
    unsigned* bar; unsigned x;
    volatile LAS unsigned* st;
};

__device__ __forceinline__ XcdBarrier xcd_barrier_post(unsigned* bar, volatile LAS unsigned* st) {
    XcdBarrier b; b.bar = bar; b.x = xb_xcc_id(); b.st = st;
    if (threadIdx.x == 0) (void)xb_add(&bar[XB_XCNT(b.x)], 1u);
    return b;
}
__device__ __forceinline__ void xcd_barrier_complete(unsigned* bar, unsigned x, unsigned& nloc, unsigned& nx) {
    const unsigned G = gridDim.x * gridDim.y * gridDim.z;
    unsigned sum, cnt, mine, sp = 0u;
    for (;;) {
        sum = 0u; cnt = 0u; mine = 0u;
#pragma unroll
        for (unsigned j = 0; j < 16; ++j) { const unsigned c = xb_ld(&bar[XB_XCNT(j)]); sum += c; cnt += (c > 0u) ? 1u : 0u; mine = (j == x) ? c : mine; }
        if (sum == G) break;
        __builtin_amdgcn_s_sleep(1);
        if ((++sp & 255u) == 0u) { if (xb_ld(&bar[XB_TMO])) break; if (sp > XB_SPIN_CAP) { atomicAdd(&bar[XB_TMO], 1u); break; } }
    }
    nloc = mine > 0u ? mine : 1u; nx = cnt > 0u ? cnt : 1u;
}

__device__ __forceinline__ void xcd_barrier(const XcdBarrier& b) {
    asm volatile("s_waitcnt vmcnt(0)" ::: "memory");
    __syncthreads();
    if (threadIdx.x == 0) {
        unsigned* bar = b.bar;
        __builtin_amdgcn_s_waitcnt(0);
        unsigned nloc = b.st[0], nx = b.st[1];
        if (nloc == 0u) { xcd_barrier_complete(bar, b.x, nloc, nx); b.st[0] = nloc; b.st[1] = nx; }
        const unsigned old = xb_add(&bar[XB_XSUB(b.x)], 1u);
        const unsigned gen = old / nloc;
        if (old + 1u == (gen + 1u) * nloc) {
            __builtin_amdgcn_fence(__ATOMIC_RELEASE, "agent");
            asm volatile("s_waitcnt vmcnt(0)" ::: "memory");
            const unsigned og = xb_add(&bar[XB_TOP], 1u);
            const unsigned tg = og / nx;
            if (og + 1u == (tg + 1u) * nx) xb_add(&bar[XB_TOPGEN], 1u);
            else XB_SPIN(xb_ld(&bar[XB_TOPGEN]) == tg, bar);
            __builtin_amdgcn_fence(__ATOMIC_ACQUIRE, "agent");
            xb_add(&bar[XB_XGEN(b.x)], 1u);
            asm volatile("s_waitcnt vmcnt(0)" ::: "memory");
        } else {
            XB_SPIN(xb_ld(&bar[XB_XGEN(b.x)]) == gen, bar);
            __builtin_amdgcn_fence(__ATOMIC_ACQUIRE, "agent");
            asm volatile("s_waitcnt vmcnt(0)" ::: "memory");
        }
    }
    __syncthreads();
}

namespace pg8 {
constexpr int BM = 256, BK = 64, HALF = 128, HTB = HALF * BK * 2, STAGE_BYTES = 8 * HTB, NXCD = 8, WGM = 8;
__host__ __device__ __forceinline__ int lds_byte(int r, int c) { const int st = (r >> 4) * 2 + (c >> 5), rr = r & 15, cc = c & 31, ob = rr * 64 + cc * 2; return st * 1024 + (ob ^ (((ob >> 9) & 1) << 5)); }
__host__ __device__ __forceinline__ void stage_rc(int b, int& R, int& C) { const int st = b / 1024, sb = b % 1024, swz = sb ^ (((sb >> 9) & 1) << 5); R = (st >> 1) * 16 + swz / 64; C = (st & 1) * 32 + (swz % 64) / 2; }
struct Unit { int pm, pn; };
struct Gemm { const bf16_t* A; const bf16_t* Bt; int M, N, K; };
struct StaticOrder {
    int nM, nN, nwg, G, c;
    __host__ __device__ void init(int M, int N, int G_, int c_) { nM = M / BM; nN = N / BM; nwg = nM * nN; G = G_; c = c_; }
    __host__ __device__ bool next(int i, Unit& u) const {
        const long L = (long)i * G + c; if (L >= nwg) return false;
        int wgid = (int)L; { const int q = nwg / NXCD, r = nwg % NXCD, xcd = wgid % NXCD, off = wgid / NXCD; wgid = (xcd < r ? xcd * (q + 1) : r * (q + 1) + (xcd - r) * q) + off; }
        const int nig = WGM * nN, gid = wgid / nig, fm = gid * WGM, gsz = (nM - fm) < WGM ? (nM - fm) : WGM;
        u.pm = fm + ((wgid % nig) % gsz); u.pn = (wgid % nig) / gsz; return true;
    }
};

template <class Epi>
__device__ __forceinline__ void gemm_phase(LAS unsigned char* lds, const Gemm g, const StaticOrder& S, const Epi& E) {
    const int tid = otid(), wid = __builtin_amdgcn_readfirstlane(tid >> 6), lane = tid & 63, wr = wid >> 2, wc = wid & 3, fr = lane & 15, fq = lane >> 4;
    const int K = g.K, nt = K / BK;
    unsigned voffA[2], voffB[2];
#pragma unroll
    for (int i = 0; i < 2; ++i) { int R, C; stage_rc(tid * 16 + i * 8192, R, C); voffA[i] = (unsigned)(R * K + C) * 2u; voffB[i] = voffA[i]; }
    const size_t kstep = (size_t)(BK * 2);
    const size_t hstep = (size_t)HALF * K * 2;
    const size_t tstep = 2 * hstep;
    const unsigned ldsw = (unsigned)wid * 1024u;
    const int aoff = lds_byte(wr * 64 + fr, fq * 8), boff = lds_byte(wc * 32 + fr, fq * 8);
#define PG8_SA(b, h) (((b) * 2 + (h)) * HTB)
#define PG8_SB(b, h) ((4 + (b) * 2 + (h)) * HTB)
#define PG8_STAGE(bufoff, gbase, voff) do { _Pragma("unroll") for (int _i = 0; _i < 2; ++_i) \
        __builtin_amdgcn_global_load_lds((const unsigned*)((const char*)(gbase) + (voff)[_i]), (LAS unsigned*)(lds + (bufoff) + ldsw + _i * 8192), 16, 0, 0); } while (0)
#define PG8_LDA(dst, b, h) do { _Pragma("unroll") for (int m = 0; m < 4; ++m) _Pragma("unroll") for (int k = 0; k < 2; ++k) dst[m][k] = *(const LAS bf16x8*)(lds + PG8_SA(b, h) + aoff + m * 2048 + k * 1024); } while (0)
#define PG8_LDB(dst, b, h) do { _Pragma("unroll") for (int n = 0; n < 2; ++n) _Pragma("unroll") for (int k = 0; k < 2; ++k) dst[n][k] = *(const LAS bf16x8*)(lds + PG8_SB(b, h) + boff + n * 2048 + k * 1024); } while (0)
#define PG8_MMA(ai, bj, At, Bt) do { __builtin_amdgcn_s_setprio(1); _Pragma("unroll") for (int m = 0; m < 4; ++m) _Pragma("unroll") for (int n = 0; n < 2; ++n) _Pragma("unroll") for (int k = 0; k < 2; ++k) \
        acc[ai][bj][m][n] = __builtin_amdgcn_mfma_f32_16x16x32_bf16(Bt[n][k], At[m][k], acc[ai][bj][m][n], 0, 0, 0); __builtin_amdgcn_s_setprio(0); } while (0)
#define PG8_WAIT_V(n) asm volatile("s_waitcnt vmcnt(" #n ")" ::: "memory")
#define PG8_WAIT_L(n) asm volatile("s_waitcnt lgkmcnt(" #n ")" ::: "memory")
#define PG8_BAR __builtin_amdgcn_s_barrier()
#define PG8_SCHED __builtin_amdgcn_sched_barrier(0)
#define PG8_PTRS(u, pa, pb) do { const char* _a = (const char*)g.A + (size_t)(u).pm * tstep; const char* _b = (const char*)g.Bt + (size_t)(u).pn * tstep; if (Epi::swap(u)) { pa = _b; pb = _a; } else { pa = _a; pb = _b; } } while (0)
    Unit cur, nxt; int ui = 0;
    if (!S.next(0, cur)) return;
    f32x4 acc[2][2][4][2];
#pragma unroll
    for (int a = 0; a < 2; ++a)
#pragma unroll
        for (int b = 0; b < 2; ++b)
#pragma unroll
            for (int m = 0; m < 4; ++m)
#pragma unroll
                for (int n = 0; n < 2; ++n) acc[a][b][m][n] = (f32x4){0.f, 0.f, 0.f, 0.f};
    bf16x8 At[4][2], B0[2][2], B1[2][2];
    const char* cA; const char* cB;
    PG8_PTRS(cur, cA, cB);
    PG8_STAGE(PG8_SB(0, 0), cB, voffB); PG8_STAGE(PG8_SA(0, 0), cA, voffA); PG8_STAGE(PG8_SB(0, 1), cB + hstep, voffB); PG8_STAGE(PG8_SA(0, 1), cA + hstep, voffA);
    if (wr == 1) PG8_BAR;
    PG8_WAIT_V(4); PG8_BAR;
    PG8_STAGE(PG8_SB(1, 0), cB + kstep, voffB); PG8_STAGE(PG8_SA(1, 0), cA + kstep, voffA); PG8_STAGE(PG8_SB(1, 1), cB + hstep + kstep, voffB);
    PG8_WAIT_V(6); PG8_BAR;
    for (;;) {
        const bool has_next = S.next(ui + 1, nxt);
        const char* nA = cA; const char* nB = cB;
        if (has_next) PG8_PTRS(nxt, nA, nB);
        for (int t = 0; t < nt; t += 2) {
            const bool last = (t == nt - 2);
            const char* a1 = cA + (size_t)(t + 1) * kstep;
            const char* a2 = last ? nA : cA + (size_t)(t + 2) * kstep; const char* b2 = last ? nB : cB + (size_t)(t + 2) * kstep;
            const char* a3 = a2 + kstep; const char* b3 = b2 + kstep;
            PG8_LDB(B0, 0, 0); PG8_SCHED; PG8_LDA(At, 0, 0); PG8_STAGE(PG8_SA(1, 1), a1 + hstep, voffA);
            PG8_WAIT_L(8); PG8_BAR; PG8_WAIT_L(0); PG8_MMA(0, 0, At, B0); PG8_BAR; PG8_SCHED;
            PG8_LDB(B1, 0, 1); PG8_STAGE(PG8_SB(0, 0), b2, voffB);
            PG8_BAR; PG8_WAIT_L(0); PG8_MMA(0, 1, At, B1); PG8_BAR;
            PG8_LDA(At, 0, 1); PG8_STAGE(PG8_SA(0, 0), a2, voffA);
            PG8_BAR; PG8_WAIT_L(0); PG8_MMA(1, 0, At, B0); PG8_BAR; PG8_SCHED;
            PG8_STAGE(PG8_SB(0, 1), b2 + hstep, voffB);
            PG8_WAIT_V(6); PG8_BAR; PG8_MMA(1, 1, At, B1); PG8_BAR;
            PG8_LDB(B0, 1, 0); PG8_SCHED; PG8_LDA(At, 1, 0); PG8_STAGE(PG8_SA(0, 1), a2 + hstep, voffA);
            PG8_WAIT_L(8); PG8_BAR; PG8_WAIT_L(0); PG8_MMA(0, 0, At, B0); PG8_BAR; PG8_SCHED;
            PG8_LDB(B1, 1, 1); PG8_STAGE(PG8_SB(1, 0), b3, voffB);
            PG8_BAR; PG8_WAIT_L(0); PG8_MMA(0, 1, At, B1); PG8_BAR;
            PG8_LDA(At, 1, 1); PG8_STAGE(PG8_SA(1, 0), a3, voffA);
            PG8_BAR; PG8_WAIT_L(0); PG8_MMA(1, 0, At, B0); PG8_BAR; PG8_SCHED;
            PG8_STAGE(PG8_SB(1, 1), b3 + hstep, voffB);
            PG8_WAIT_V(6); PG8_BAR; PG8_MMA(1, 1, At, B1); PG8_BAR;
        }
        E(acc, cur, wr, wc, fr, fq);
        if (!has_next) break;
#pragma unroll
        for (int a = 0; a < 2; ++a)
#pragma unroll
            for (int b = 0; b < 2; ++b)
#pragma unroll
                for (int m = 0; m < 4; ++m)
#pragma unroll
                    for (int n = 0; n < 2; ++n) acc[a][b][m][n] = (f32x4){0.f, 0.f, 0.f, 0.f};
        cur = nxt; cA = nA; cB = nB; ++ui;
    }
    PG8_WAIT_V(0);
    if (wr == 0) PG8_BAR;
    PG8_BAR;
#undef PG8_SA
#undef PG8_SB
#undef PG8_STAGE
#undef PG8_LDA
#undef PG8_LDB
#undef PG8_MMA
#undef PG8_WAIT_V
#undef PG8_WAIT_L
#undef PG8_BAR
#undef PG8_SCHED
#undef PG8_PTRS
}
}
using pg8::Unit;

struct EpiF32 {
    float* C; int ldc;
    __device__ __forceinline__ static bool swap(const Unit&) { return false; }
    __device__ __forceinline__ void operator()(const f32x4 (&acc)[2][2][4][2], const Unit& u, int wr, int wc, int fr, int fq) const {
        const int row0 = u.pm * 256 + wr * 64 + fr, col0 = u.pn * 256 + wc * 32 + 4 * fq;
#pragma unroll
        for (int ai = 0; ai < 2; ++ai)
#pragma unroll
            for (int m = 0; m < 4; ++m) { float* rowp = C + (size_t)(row0 + ai * 128 + m * 16) * ldc + col0;
#pragma unroll
                for (int bj = 0; bj < 2; ++bj)
#pragma unroll
                    for (int n = 0; n < 2; ++n) *(f32x4*)(rowp + bj * 128 + n * 16) = acc[ai][bj][m][n]; }
    }
};
struct EpiB16 {
    bf16_t* C; int ldc;
    __device__ __forceinline__ static bool swap(const Unit&) { return false; }
    __device__ __forceinline__ void operator()(const f32x4 (&acc)[2][2][4][2], const Unit& u, int wr, int wc, int fr, int fq) const {
        const int row0 = u.pm * 256 + wr * 64 + fr, col0 = u.pn * 256 + wc * 32 + 4 * fq;
#pragma unroll
        for (int ai = 0; ai < 2; ++ai)
#pragma unroll
            for (int m = 0; m < 4; ++m) { bf16_t* rowp = C + (size_t)(row0 + ai * 128 + m * 16) * ldc + col0;
#pragma unroll
                for (int bj = 0; bj < 2; ++bj)
#pragma unroll
                    for (int n = 0; n < 2; ++n) *(u32x2*)(rowp + bj * 128 + n * 16) = pk4(acc[ai][bj][m][n]); }
    }
};
template <bool OB16> struct EpiGate {
    const bf16_t* X1; const bf16_t* PLE; float* O; bf16_t* Ob;
    __device__ __forceinline__ static bool swap(const Unit&) { return false; }
    __device__ __forceinline__ void operator()(const f32x4 (&acc)[2][2][4][2], const Unit& u, int wr, int wc, int fr, int fq) const {
        const int row0 = u.pm * 256 + wr * 64 + fr, col0 = u.pn * 256 + wc * 32 + 4 * fq;
#pragma unroll
        for (int ai = 0; ai < 2; ++ai)
#pragma unroll
            for (int m = 0; m < 4; ++m) { const size_t ro = (size_t)(row0 + ai * 128 + m * 16) * 1024 + col0;
#pragma unroll
                for (int bj = 0; bj < 2; ++bj)
#pragma unroll
                    for (int n = 0; n < 2; ++n) { const size_t o = ro + bj * 128 + n * 16; const f32x4 a = acc[ai][bj][m][n]; const u32x2 xw = *(const u32x2*)(X1 + o), pw = *(const u32x2*)(PLE + o);
                        const f32x4 x1 = {bflo(xw.x), bfhi(xw.x), bflo(xw.y), bfhi(xw.y)}, pl = {bflo(pw.x), bfhi(pw.x), bflo(pw.y), bfhi(pw.y)}; f32x4 r;
#pragma unroll
                        for (int j = 0; j < 4; ++j) r[j] = x1[j] + sigmoid_f(a[j]) * pl[j];
                        if (OB16) *(u32x2*)(Ob + o) = pk4(r); else *(f32x4*)(O + o) = r; } }
    }
};
struct EpiInAttn {
    bf16_t *Zq, *Zk, *Zg, *vTp, *vTs; const float* tab; float* out;
    __device__ __forceinline__ static bool swap(const Unit& u) { return u.pn == 5; }
    __device__ __forceinline__ void operator()(const f32x4 (&acc)[2][2][4][2], const Unit& u, int wr, int wc, int fr, int fq) const {
        const int pn = u.pn;
        if (pn < 5) {
            const bool isq = pn < 4;
            const int fi = 16 * (wc & 1) + 4 * fq;
#pragma unroll
            for (int ai = 0; ai < 2; ++ai)
#pragma unroll
                for (int m = 0; m < 4; ++m) {
                    const int r = u.pm * 256 + ai * 128 + wr * 64 + m * 16 + fr;
                    const int pi = r < MP ? (r & 4095) : 4096 + ((r - MP) & 7);
                    const f32x4 t0 = *(const f32x4*)(tab + ((size_t)pi * 32 + fi) * 2), t1 = *(const f32x4*)(tab + ((size_t)pi * 32 + fi) * 2 + 4);
                    const float cs[4] = {t0[0], t0[2], t1[0], t1[2]}, sn[4] = {t0[1], t0[3], t1[1], t1[3]};
#pragma unroll
                    for (int bj = 0; bj < 2; ++bj) {
                        const f32x4 x1 = acc[ai][bj][m][0], x2 = acc[ai][bj][m][1]; f32x4 o1, o2;
#pragma unroll
                        for (int j = 0; j < 4; ++j) { o1[j] = x1[j] * cs[j] - x2[j] * sn[j]; o2[j] = x2[j] * cs[j] + x1[j] * sn[j]; }
                        const int hh = 2 * bj + (wc >> 1), d1 = 16 * (wc & 1) + 4 * fq;
                        if (isq) {
                            bf16_t* p = Zq + (size_t)r * 1024 + pn * 256 + hh * 64 + d1;
                            *(u32x2*)p = pk4(o1 * 0.125f); *(u32x2*)(p + 32) = pk4(o2 * 0.125f);
                        } else {
                            bf16_t* p = Zk + (size_t)r * 256 + hh * 64 + d1;
                            *(u32x2*)p = pk4(o1); *(u32x2*)(p + 32) = pk4(o2);
                            if (r < MP) { const int t = r & 4095; if (t >= 3968) { float* dst = out + OFF_KWP + ((size_t)((r >> 12) * 128 + t - 3968) * 4 + hh) * 64 + d1; *(f32x4*)dst = o1; *(f32x4*)(dst + 32) = o2; } }
                            else { const int rs = r - MP; float* dst = out + OFF_KWS + ((size_t)((rs >> 3) * 128 + 120 + (rs & 7)) * 4 + hh) * 64 + d1; *(f32x4*)dst = o1; *(f32x4*)(dst + 32) = o2; }
                        }
                    }
                    asm volatile("" ::: "memory");
                }
        } else if (pn == 5) {
#pragma unroll
            for (int ai = 0; ai < 2; ++ai)
#pragma unroll
                for (int m = 0; m < 4; ++m) {
                    const int e = ai * 128 + wr * 64 + m * 16 + fr, kvh = e >> 6, d = e & 63;
#pragma unroll
                    for (int bj = 0; bj < 2; ++bj)
#pragma unroll
                        for (int n = 0; n < 2; ++n) {
                            const int tok = u.pm * 256 + bj * 128 + wc * 32 + n * 16 + 4 * fq; const f32x4 v = acc[ai][bj][m][n];
                            if (tok < MP) { const int b = tok >> 12, t = tok & 4095;
                                *(u32x2*)(vTp + ((size_t)((b * 4 + kvh) * 64 + d)) * 4096 + t) = pk4(v);
                                if (t >= 3968) {
#pragma unroll
                                    for (int jj = 0; jj < 4; ++jj) out[OFF_VWP + ((size_t)(b * 128 + t - 3968 + jj) * 4 + kvh) * 64 + d] = v[jj]; }
                            } else { const int ts = tok - MP, bs = ts >> 3, l0 = ts & 7;
                                *(u32x2*)(vTs + ((size_t)((bs * 4 + kvh) * 64 + d)) * 8 + l0) = pk4(v);
#pragma unroll
                                for (int jj = 0; jj < 4; ++jj) out[OFF_VWS + ((size_t)(bs * 128 + 120 + l0 + jj) * 4 + kvh) * 64 + d] = v[jj]; }
                        }
                }
        } else {
#pragma unroll
            for (int ai = 0; ai < 2; ++ai)
#pragma unroll
                for (int m = 0; m < 4; ++m) { const int r = u.pm * 256 + ai * 128 + wr * 64 + m * 16 + fr;
#pragma unroll
                    for (int bj = 0; bj < 2; ++bj)
#pragma unroll
                        for (int n = 0; n < 2; ++n) { const f32x4 a = acc[ai][bj][m][n]; f32x4 s;
#pragma unroll
                            for (int j = 0; j < 4; ++j) s[j] = silu_f(a[j]);
                            *(u32x2*)(Zg + (size_t)r * 1024 + (pn - 6) * 256 + bj * 128 + wc * 32 + n * 16 + 4 * fq) = pk4(s); } }
        }
    }
};
struct EpiInRet {
    bf16_t *Zq, *Zk, *Zg, *vTp, *vTs; const float* tab;
    __device__ __forceinline__ static bool swap(const Unit& u) { return u.pn >= 8 && u.pn < 16; }
    __device__ __forceinline__ void operator()(const f32x4 (&acc)[2][2][4][2], const Unit& u, int wr, int wc, int fr, int fq) const {
        const int pn = u.pn;
        if (pn < 8) {
            const bool isq = pn < 4; const float sc = isq ? 1.f : 0.0625f;
            bf16_t* Z = isq ? Zq : Zk; const int hc = (pn & 3) * 256;
#pragma unroll
            for (int ai = 0; ai < 2; ++ai)
#pragma unroll
                for (int m = 0; m < 4; ++m) {
                    const int r = u.pm * 256 + ai * 128 + wr * 64 + m * 16 + fr;
                    const int pi = r < MP ? (r & 4095) : 4096 + ((r - MP) & 7);
#pragma unroll
                    for (int n = 0; n < 2; ++n) {
                        const int d = wc * 32 + n * 16 + 4 * fq;
                        const f32x4 t0 = *(const f32x4*)(tab + ((size_t)pi * 128 + d) * 2), t1 = *(const f32x4*)(tab + ((size_t)pi * 128 + d) * 2 + 4);
                        const float cs[4] = {t0[0], t0[2], t1[0], t1[2]}, sn[4] = {t0[1], t0[3], t1[1], t1[3]};
                        const f32x4 x1 = acc[ai][0][m][n], x2 = acc[ai][1][m][n]; f32x4 o1, o2;
#pragma unroll
                        for (int j = 0; j < 4; ++j) { o1[j] = (x1[j] * cs[j] - x2[j] * sn[j]) * sc; o2[j] = (x2[j] * cs[j] + x1[j] * sn[j]) * sc; }
                        bf16_t* p = Z + (size_t)r * 1024 + hc + d;
                        *(u32x2*)p = pk4(o1); *(u32x2*)(p + 128) = pk4(o2);
                    }
                }
        } else if (pn < 16) {
#pragma unroll
            for (int ai = 0; ai < 2; ++ai)
#pragma unroll
                for (int m = 0; m < 4; ++m) {
                    const int eg = (pn - 8) * 256 + ai * 128 + wr * 64 + m * 16 + fr, h = eg >> 9, e = eg & 511;
#pragma unroll
                    for (int bj = 0; bj < 2; ++bj)
#pragma unroll
                        for (int n = 0; n < 2; ++n) {
                            const int tok = u.pm * 256 + bj * 128 + wc * 32 + n * 16 + 4 * fq; const u32x2 w = pk4(acc[ai][bj][m][n]);
                            if (tok < MP) { const int b = tok >> 12, t = tok & 4095; *(u32x2*)(vTp + ((size_t)((b * 4 + h) * 512 + e)) * 4096 + t) = w; }
                            else { const int ts = tok - MP, bs = ts >> 3, l0 = ts & 7; *(u32x2*)(vTs + ((size_t)((bs * 4 + h) * 512 + e)) * 8 + l0) = w; }
                        }
                }
        } else {
#pragma unroll
            for (int ai = 0; ai < 2; ++ai)
#pragma unroll
                for (int m = 0; m < 4; ++m) { const int r = u.pm * 256 + ai * 128 + wr * 64 + m * 16 + fr;
#pragma unroll
                    for (int bj = 0; bj < 2; ++bj)
#pragma unroll
                        for (int n = 0; n < 2; ++n) { const f32x4 a = acc[ai][bj][m][n]; f32x4 s;
#pragma unroll
                            for (int j = 0; j < 4; ++j) s[j] = silu_f(a[j]);
                            *(u32x2*)(Zg + (size_t)r * 2048 + (pn - 16) * 256 + bj * 128 + wc * 32 + n * 16 + 4 * fq) = pk4(s); } }
        }
    }
};

__device__ __forceinline__ void transpose_tile(const float* __restrict__ W, bf16_t* __restrict__ Wt, int K, int N, bool perm, int tile, LAS float* T) {
    const int tid = otid(), ntn = N >> 6;
    const int n0 = (tile % ntn) * 64, k0 = (tile / ntn) * 64, nn = tid & 63;
    const int nd = n0 + nn; int ns = nd;
    if (perm && nd < 1280) { const int p = nd & 63; ns = (nd - p) + (p >> 5) * 16 + (p & 15) + ((p >> 4) & 1) * 32; }
#pragma unroll
    for (int i = 0; i < 8; ++i) { const int kk = (tid >> 6) + 8 * i; T[kk * 65 + nn] = W[(size_t)(k0 + kk) * N + ns]; }
    __syncthreads();
    const int kk2 = (tid & 31) * 2;
#pragma unroll
    for (int i = 0; i < 4; ++i) { const int n2 = (tid >> 5) + 16 * i; *(unsigned*)(Wt + (size_t)(n0 + n2) * K + k0 + kk2) = cvt_pk_bf16(T[kk2 * 65 + n2], T[(kk2 + 1) * 65 + n2]); }
    __syncthreads();
}

__device__ __forceinline__ void rms_rows(const float* __restrict__ Xa, const float* __restrict__ Xb, const float* __restrict__ g, bf16_t* __restrict__ H, int G) {
    const int tid_o = otid(), wave = tid_o >> 6, lane = tid_o & 63;
    for (int row = blockIdx.x * 8 + wave; row < MT; row += G * 8) {
        const float* x = row < MP ? Xa + (size_t)row * 1024 : Xb + (size_t)(row - MP) * 1024;
        f32x4 v[4]; float ss = 0.f;
#pragma unroll
        for (int i = 0; i < 4; ++i) { v[i] = *(const f32x4*)(x + lane * 4 + 256 * i); ss += v[i][0] * v[i][0] + v[i][1] * v[i][1] + v[i][2] * v[i][2] + v[i][3] * v[i][3]; }
        ss = wave_sum(ss);
        const float rr = rsqrtf(ss * (1.f / 1024.f) + EPS);
#pragma unroll
        for (int i = 0; i < 4; ++i) { const f32x4 gg = *(const f32x4*)(g + lane * 4 + 256 * i); *(u32x2*)(H + (size_t)row * 1024 + lane * 4 + 256 * i) = pk4(v[i] * rr * gg); }
    }
}
__device__ __forceinline__ void rms_rows_b16(const bf16_t* __restrict__ X, const float* __restrict__ g, bf16_t* __restrict__ H, int G) {
    const int tid_o = otid(), wave = tid_o >> 6, lane = tid_o & 63;
    for (int row = blockIdx.x * 8 + wave; row < MT; row += G * 8) {
        const u32x4 a = *(const u32x4*)(X + (size_t)row * 1024 + lane * 8), b = *(const u32x4*)(X + (size_t)row * 1024 + 512 + lane * 8);
        const float v[16] = {bflo(a.x), bfhi(a.x), bflo(a.y), bfhi(a.y), bflo(a.z), bfhi(a.z), bflo(a.w), bfhi(a.w), bflo(b.x), bfhi(b.x), bflo(b.y), bfhi(b.y), bflo(b.z), bfhi(b.z), bflo(b.w), bfhi(b.w)};
        float ss = 0.f;
#pragma unroll
        for (int i = 0; i < 16; ++i) ss += v[i] * v[i];
        ss = wave_sum(ss);
        const float rr = rsqrtf(ss * (1.f / 1024.f) + EPS);
#pragma unroll
        for (int hh = 0; hh < 2; ++hh) { const int c = hh * 512 + lane * 8; const f32x4 g0 = *(const f32x4*)(g + c), g1 = *(const f32x4*)(g + c + 4); u32x4 o;
            o.x = cvt_pk_bf16(v[hh * 8 + 0] * rr * g0[0], v[hh * 8 + 1] * rr * g0[1]); o.y = cvt_pk_bf16(v[hh * 8 + 2] * rr * g0[2], v[hh * 8 + 3] * rr * g0[3]);
            o.z = cvt_pk_bf16(v[hh * 8 + 4] * rr * g1[0], v[hh * 8 + 5] * rr * g1[1]); o.w = cvt_pk_bf16(v[hh * 8 + 6] * rr * g1[2], v[hh * 8 + 7] * rr * g1[3]);
            *(u32x4*)(H + (size_t)row * 1024 + c) = o; }
    }
}
template <bool XB16>
__device__ __forceinline__ void resid_rows(const float* __restrict__ Xa, const float* __restrict__ Xb, const bf16_t* __restrict__ Xh, const bf16_t* __restrict__ Y, const float* __restrict__ g, bf16_t* __restrict__ H, int G) {
    const int tid_o = otid(), wave = tid_o >> 6, lane = tid_o & 63;
    for (int row = blockIdx.x * 8 + wave; row < MT; row += G * 8) {
        const bf16_t* y = Y + (size_t)row * 1024;
        f32x4 v[4]; float ss = 0.f;
#pragma unroll
        for (int i = 0; i < 4; ++i) { const u32x2 yw = *(const u32x2*)(y + lane * 4 + 256 * i); v[i] = (f32x4){bflo(yw.x), bfhi(yw.x), bflo(yw.y), bfhi(yw.y)}; ss += v[i][0] * v[i][0] + v[i][1] * v[i][1] + v[i][2] * v[i][2] + v[i][3] * v[i][3]; }
        ss = wave_sum(ss);
        const float rr = rsqrtf(ss * (1.f / 1024.f) + EPS);
#pragma unroll
        for (int i = 0; i < 4; ++i) { const int c = lane * 4 + 256 * i; const f32x4 gg = *(const f32x4*)(g + c); f32x4 xx;
            if (XB16) { const u32x2 xw = *(const u32x2*)(Xh + (size_t)row * 1024 + c); xx = (f32x4){bflo(xw.x), bfhi(xw.x), bflo(xw.y), bfhi(xw.y)}; }
            else xx = *(const f32x4*)((row < MP ? Xa + (size_t)row * 1024 : Xb + (size_t)(row - MP) * 1024) + c);
            *(u32x2*)(H + (size_t)row * 1024 + c) = pk4(xx + v[i] * rr * gg); }
    }
}

struct SkF32 { float* C; __device__ __forceinline__ void operator()(int row, int col, f32x4 v) const { *(f32x4*)(C + (size_t)row * 1024 + col) = v; } };
struct SkB16 { bf16_t* C; __device__ __forceinline__ void operator()(int row, int col, f32x4 v) const { *(u32x2*)(C + (size_t)row * 1024 + col) = pk4(v); } };
template <bool OB16> struct SkGate { const bf16_t* X1; const bf16_t* PLE; float* O; bf16_t* Ob;
    __device__ __forceinline__ void operator()(int row, int col, f32x4 a) const { const size_t o = (size_t)row * 1024 + col; const u32x2 xw = *(const u32x2*)(X1 + o), pw = *(const u32x2*)(PLE + o);
        const f32x4 x1 = {bflo(xw.x), bfhi(xw.x), bflo(xw.y), bfhi(xw.y)}, pl = {bflo(pw.x), bfhi(pw.x), bflo(pw.y), bfhi(pw.y)}; f32x4 r;
#pragma unroll
        for (int j = 0; j < 4; ++j) r[j] = x1[j] + sigmoid_f(a[j]) * pl[j];
        if (OB16) *(u32x2*)(Ob + o) = pk4(r); else *(f32x4*)(O + o) = r; } };
template <class Epi>
__device__ __forceinline__ void skinny_gemm(LAS unsigned char* lds, const bf16_t* __restrict__ A, const bf16_t* __restrict__ Bt, int K, const Epi& E, int G) {
    LAS float* red = (LAS float*)lds;
    const int tid = otid(), w = tid >> 6, lane = tid & 63, l16 = lane & 15, g = lane >> 4;
    const int KS = K >> 3, nks = KS >> 5;
    for (int u = blockIdx.x; u < 256; u += G) {
        const int row0 = (u >> 4) * 64, col0 = (u & 15) * 64;
        const bf16_t* ap = A + (size_t)(row0 + l16) * K + w * KS + 8 * g;
        const bf16_t* bp = Bt + (size_t)(col0 + l16) * K + w * KS + 8 * g;
        f32x4 acc[4][4];
#pragma unroll
        for (int mt = 0; mt < 4; ++mt)
#pragma unroll
            for (int nt = 0; nt < 4; ++nt) acc[mt][nt] = (f32x4){0.f, 0.f, 0.f, 0.f};
#pragma unroll 4
        for (int ks = 0; ks < nks; ++ks) {
            bf16x8 af[4], bf[4];
#pragma unroll
            for (int t = 0; t < 4; ++t) { af[t] = *(const bf16x8*)(ap + (size_t)(16 * t) * K + 32 * ks); bf[t] = *(const bf16x8*)(bp + (size_t)(16 * t) * K + 32 * ks); }
#pragma unroll
            for (int mt = 0; mt < 4; ++mt)
#pragma unroll
                for (int nt = 0; nt < 4; ++nt) acc[mt][nt] = __builtin_amdgcn_mfma_f32_16x16x32_bf16(bf[nt], af[mt], acc[mt][nt], 0, 0, 0);
        }
        __syncthreads();
#pragma unroll
        for (int mt = 0; mt < 4; ++mt)
#pragma unroll
            for (int nt = 0; nt < 4; ++nt) *(LAS f32x4*)(red + (w * 64 + 16 * mt + l16) * 68 + 16 * nt + 4 * g) = acc[mt][nt];
        __syncthreads();
#pragma unroll
        for (int j = 0; j < 2; ++j) { const int q = tid + 512 * j, row = q >> 4, c4 = (q & 15) * 4; f32x4 sum = *(const LAS f32x4*)(red + row * 68 + c4);
#pragma unroll
            for (int ww = 1; ww < 8; ++ww) sum += *(const LAS f32x4*)(red + (ww * 64 + row) * 68 + c4);
            E(row0 + row, col0 + c4, sum); }
    }
}

__device__ __forceinline__ void attn_prompt(LAS unsigned char* lds, const bf16_t* __restrict__ Zq, const bf16_t* __restrict__ Zk, const bf16_t* __restrict__ Zg, const bf16_t* __restrict__ vTp,
                                            const float* __restrict__ sinks, bf16_t* __restrict__ OG, int G) {
    LAS bf16_t* Ks = (LAS bf16_t*)lds;
    LAS bf16_t* Vt = (LAS bf16_t*)(lds + 256 * 72 * 2);
    const int tid = otid(), w = tid >> 6, lane = tid & 63, l16 = lane & 15, g = lane >> 4;
    for (int it = blockIdx.x; it < 512; it += G) {
        const int kvh = it & 3, nb = (it >> 2) & 31, b = it >> 7;
        __syncthreads();
#pragma unroll
        for (int i = 0; i < 4; ++i) { const int ch = tid + 512 * i, s = ch >> 3, c8 = ch & 7, t = (nb - 1) * 128 + s;
            u32x4 val = {0u, 0u, 0u, 0u}; if (t >= 0) val = *(const u32x4*)(Zk + (size_t)(b * 4096 + t) * 256 + kvh * 64 + c8 * 8);
            *(LAS u32x4*)(Ks + s * 72 + c8 * 8) = val; }
#pragma unroll
        for (int i = 0; i < 4; ++i) { const int ch = tid + 512 * i, d = ch >> 5, s0 = (ch & 31) * 8, t0 = (nb - 1) * 128 + s0;
            u32x4 val = {0u, 0u, 0u, 0u}; if (t0 >= 0) val = *(const u32x4*)(vTp + ((size_t)((b * 4 + kvh) * 64 + d)) * 4096 + t0);
            *(LAS u32x4*)(Vt + d * 264 + s0) = val; }
        __syncthreads();
        const int head = kvh * 4 + (w >> 1);
        const float sk = sinks[head];
        for (int qi = 0; qi < 4; ++qi) {
            const int qt = (w & 1) * 4 + qi;
            const size_t tq = (size_t)b * 4096 + nb * 128 + qt * 16 + l16;
            bf16x8 qf[2];
#pragma unroll
            for (int ks = 0; ks < 2; ++ks) qf[ks] = *(const bf16x8*)(Zq + tq * 1024 + head * 64 + ks * 32 + g * 8);
            f32x4 sa[9];
#pragma unroll
            for (int j = 0; j < 9; ++j) { sa[j] = (f32x4){0.f, 0.f, 0.f, 0.f};
#pragma unroll
                for (int ks = 0; ks < 2; ++ks) { const bf16x8 kf = *(const LAS bf16x8*)(Ks + (16 * (qt + j) + l16) * 72 + ks * 32 + g * 8);
                    sa[j] = __builtin_amdgcn_mfma_f32_16x16x32_bf16(kf, qf[ks], sa[j], 0, 0, 0); } }
            float mx = sk;
#pragma unroll
            for (int j = 0; j < 9; ++j)
#pragma unroll
                for (int r = 0; r < 4; ++r) {
                    bool vis = true;
                    if (j == 0) vis = (4 * g + r) > l16;
                    if (j == 8) vis = (4 * g + r) <= l16;
                    if (nb == 0 && (qt + j) < 8) vis = false;
                    sa[j][r] = vis ? sa[j][r] : -1e30f;
                    mx = fmaxf(mx, sa[j][r]);
                }
            mx = fmaxf(mx, __shfl_xor(mx, 16, 64)); mx = fmaxf(mx, __shfl_xor(mx, 32, 64));
            float sum = 0.f;
#pragma unroll
            for (int j = 0; j < 9; ++j)
#pragma unroll
                for (int r = 0; r < 4; ++r) { const float p = __expf(sa[j][r] - mx); sa[j][r] = p; sum += p; }
            sum += __shfl_xor(sum, 16, 64); sum += __shfl_xor(sum, 32, 64);
            const float inv = 1.f / (sum + __expf(sk - mx));
            f32x4 oa[4];
#pragma unroll
            for (int dt = 0; dt < 4; ++dt) oa[dt] = (f32x4){0.f, 0.f, 0.f, 0.f};
#pragma unroll
            for (int u = 0; u < 5; ++u) {
                u32x4 pw; pw.x = cvt_pk_bf16(sa[2 * u][0], sa[2 * u][1]); pw.y = cvt_pk_bf16(sa[2 * u][2], sa[2 * u][3]);
                if (u < 4) { pw.z = cvt_pk_bf16(sa[2 * u + 1][0], sa[2 * u + 1][1]); pw.w = cvt_pk_bf16(sa[2 * u + 1][2], sa[2 * u + 1][3]); } else { pw.z = 0u; pw.w = 0u; }
                const bf16x8 pf = __builtin_bit_cast(bf16x8, pw);
                const int k0 = 16 * (qt + 2 * u) + 4 * g, k1 = (u < 4) ? k0 + 16 : k0;
#pragma unroll
                for (int dt = 0; dt < 4; ++dt) {
                    const u32x2 v0 = *(const LAS u32x2*)(Vt + (16 * dt + l16) * 264 + k0), v1 = *(const LAS u32x2*)(Vt + (16 * dt + l16) * 264 + k1);
                    u32x4 vw; vw.x = v0.x; vw.y = v0.y; vw.z = v1.x; vw.w = v1.y;
                    oa[dt] = __builtin_amdgcn_mfma_f32_16x16x32_bf16(__builtin_bit_cast(bf16x8, vw), pf, oa[dt], 0, 0, 0);
                }
            }
#pragma unroll
            for (int dt = 0; dt < 4; ++dt) {
                const size_t o = tq * 1024 + head * 64 + 16 * dt + 4 * g;
                const u32x2 gw = *(const u32x2*)(Zg + o);
                f32x4 r; r[0] = oa[dt][0] * inv * bflo(gw.x); r[1] = oa[dt][1] * inv * bfhi(gw.x); r[2] = oa[dt][2] * inv * bflo(gw.y); r[3] = oa[dt][3] * inv * bfhi(gw.y);
                *(u32x2*)(OG + o) = pk4(r);
            }
        }
    }
}

__device__ __forceinline__ void attn_sample(LAS unsigned char* lds, const Params& P, const bf16_t* __restrict__ Zq, const bf16_t* __restrict__ Zk, const bf16_t* __restrict__ Zg, const bf16_t* __restrict__ vTs,
                                            bf16_t* __restrict__ OG, int G) {
    LAS float* Kc = (LAS float*)lds;
    LAS float* Vc = Kc + 136 * 68;
    LAS float* Qs = Vc + 136 * 68;
    LAS float* Sc = Qs + 32 * 68;
    const int tid = otid();
    for (int it = blockIdx.x; it < 512; it += G) {
        const int bs = it >> 2, kvh = it & 3;
        __syncthreads();
#pragma unroll
        for (int i = 0; i < 4; ++i) { const int ch = tid + 512 * i, j = ch >> 4, d4 = (ch & 15) * 4;
            const size_t src = ((size_t)(bs * 128 + j) * 4 + kvh) * 64 + d4;
            const f32x4 kv = *(const f32x4*)(P.cache_k + src), vv = *(const f32x4*)(P.cache_v + src);
            *(LAS f32x4*)(Kc + j * 68 + d4) = kv; *(LAS f32x4*)(Vc + j * 68 + d4) = vv;
            if (j >= 8) { const size_t dst = ((size_t)(bs * 128 + j - 8) * 4 + kvh) * 64 + d4; *(f32x4*)(P.out + OFF_KWS + dst) = kv; *(f32x4*)(P.out + OFF_VWS + dst) = vv; } }
        { const int l = tid >> 6, d = tid & 63;
          Kc[(128 + l) * 68 + d] = bf2f(Zk[(size_t)(MP + bs * 8 + l) * 256 + kvh * 64 + d]);
          Vc[(128 + l) * 68 + d] = bf2f(vTs[((size_t)((bs * 4 + kvh) * 64 + d)) * 8 + l]); }
#pragma unroll
        for (int i = 0; i < 4; ++i) { const int e = tid + 512 * i, rr = e >> 6, d = e & 63, hq = rr >> 3, l = rr & 7;
            Qs[rr * 68 + d] = bf2f(Zq[(size_t)(MP + bs * 8 + l) * 1024 + (kvh * 4 + hq) * 64 + d]); }
        __syncthreads();
        const int rr = tid >> 4, kl = tid & 15, l = rr & 7, hq = rr >> 3, head = kvh * 4 + hq;
        const float sk = P.sinks[head];
        float mx = sk;
#pragma unroll 1
        for (int m = 0; m < 9; ++m) {
            const int key = kl + 16 * m;
            if (key < 136) {
                float dot = -1e30f;
                const bool vis = key < 128 ? (key > l) : ((key - 128) <= l);
                if (vis) { float a = 0.f;
#pragma unroll
                    for (int d4 = 0; d4 < 16; ++d4) { const f32x4 q = *(const LAS f32x4*)(Qs + rr * 68 + d4 * 4), k = *(const LAS f32x4*)(Kc + key * 68 + d4 * 4); a += q[0] * k[0] + q[1] * k[1] + q[2] * k[2] + q[3] * k[3]; }
                    dot = a; }
                Sc[rr * 140 + key] = dot; mx = fmaxf(mx, dot);
            }
        }
#pragma unroll
        for (int o = 1; o < 16; o <<= 1) mx = fmaxf(mx, __shfl_xor(mx, o, 64));
        float sum = 0.f;
#pragma unroll 1
        for (int m = 0; m < 9; ++m) { const int key = kl + 16 * m;
            if (key < 136) { const float sv = Sc[rr * 140 + key]; const float p = sv > -1e29f ? __expf(sv - mx) : 0.f; sum += p; Sc[rr * 140 + key] = p; } }
#pragma unroll
        for (int o = 1; o < 16; o <<= 1) sum += __shfl_xor(sum, o, 64);
        const float inv = 1.f / (sum + __expf(sk - mx));
        __syncthreads();
        f32x4 o = {0.f, 0.f, 0.f, 0.f};
        for (int key = 0; key < 136; ++key) { const float p = Sc[rr * 140 + key]; const f32x4 v = *(const LAS f32x4*)(Vc + key * 68 + kl * 4); o += v * p; }
        const size_t oo = (size_t)(MP + bs * 8 + l) * 1024 + head * 64 + kl * 4;
        const u32x2 gw = *(const u32x2*)(Zg + oo);
        f32x4 r; r[0] = o[0] * inv * bflo(gw.x); r[1] = o[1] * inv * bfhi(gw.x); r[2] = o[2] * inv * bflo(gw.y); r[3] = o[3] * inv * bfhi(gw.y);
        *(u32x2*)(OG + oo) = pk4(r);
    }
}

__device__ __forceinline__ void ret_A(LAS unsigned char* lds, const bf16_t* __restrict__ Zq, const bf16_t* __restrict__ Zk, bf16_t* __restrict__ ABUF, bf16_t* __restrict__ KDT, int G) {
    LAS bf16_t* Qs = (LAS bf16_t*)lds;
    LAS bf16_t* Ks = (LAS bf16_t*)(lds + 128 * 264 * 2);
    const int tid = otid(), w = tid >> 6, lane = tid & 63, l16 = lane & 15, g = lane >> 4;
    for (int it = blockIdx.x; it < 512; it += G) {
        const int c = it & 31, h = (it >> 5) & 3, b = it >> 7;
        const float lg = ret_lg(h);
        const size_t tok0 = (size_t)b * 4096 + c * 128;
        __syncthreads();
#pragma unroll
        for (int i = 0; i < 8; ++i) { const int ch = tid + 512 * i, s = ch >> 5, c8 = (ch & 31) * 8; const size_t src = (tok0 + s) * 1024 + h * 256 + c8;
            *(LAS u32x4*)(Qs + s * 264 + c8) = *(const u32x4*)(Zq + src); *(LAS u32x4*)(Ks + s * 264 + c8) = *(const u32x4*)(Zk + src); }
        __syncthreads();
        const int i_row = 16 * w + l16;
#pragma unroll
        for (int nt = 0; nt < 8; ++nt) {
            f32x4 a = {0.f, 0.f, 0.f, 0.f};
            if (nt <= w) {
#pragma unroll
                for (int ks = 0; ks < 8; ++ks) { const bf16x8 kf = *(const LAS bf16x8*)(Ks + (16 * nt + l16) * 264 + ks * 32 + g * 8), qf = *(const LAS bf16x8*)(Qs + i_row * 264 + ks * 32 + g * 8);
                    a = __builtin_amdgcn_mfma_f32_16x16x32_bf16(kf, qf, a, 0, 0, 0); }
#pragma unroll
                for (int r = 0; r < 4; ++r) { const int s = 16 * nt + 4 * g + r; a[r] = (s <= i_row) ? a[r] * __expf((float)(i_row - s) * lg) : 0.f; }
            }
            *(u32x2*)(ABUF + ((size_t)it * 128 + i_row) * 128 + 16 * nt + 4 * g) = pk4(a);
        }
        { const int d = tid & 255, sg0 = tid >> 8;
#pragma unroll
          for (int k = 0; k < 8; ++k) { const int s0 = 8 * (sg0 + 2 * k); float v[8];
#pragma unroll
              for (int jj = 0; jj < 8; ++jj) v[jj] = bf2f(Ks[(s0 + jj) * 264 + d]) * __expf((float)(127 - s0 - jj) * lg);
              u32x4 wv; wv.x = cvt_pk_bf16(v[0], v[1]); wv.y = cvt_pk_bf16(v[2], v[3]); wv.z = cvt_pk_bf16(v[4], v[5]); wv.w = cvt_pk_bf16(v[6], v[7]);
              *(u32x4*)(KDT + ((size_t)it * 256 + d) * 128 + s0) = wv; } }
    }
}

__device__ __forceinline__ void ret_scan_unit(LAS unsigned char* lds, int u, const bf16_t* __restrict__ vTp, const bf16_t* __restrict__ KDT, bf16_t* __restrict__ SC, float* __restrict__ out) {
    LAS bf16_t* VT = (LAS bf16_t*)lds;
    const int tid = otid(), w = tid >> 6, lane = tid & 63, l16 = lane & 15, g = lane >> 4;
    const int xcd = u & 7, jj = u >> 3, bh = xcd * 2 + (jj >> 3), es = jj & 7, h = bh & 3;
    const float lg = ret_lg(h), g128 = __expf(128.f * lg);
    __syncthreads();
    const bf16_t* vrow = vTp + ((size_t)bh * 512 + es * 64 + (tid >> 3)) * 4096 + (tid & 7) * 16;
    LAS bf16_t* vdst = VT + (tid >> 3) * 136 + (tid & 7) * 16;
    { const u32x4 a = *(const u32x4*)vrow, bq = *(const u32x4*)(vrow + 8); *(LAS u32x4*)vdst = a; *(LAS u32x4*)(vdst + 8) = bq; }
    f32x4 sacc[2][4];
#pragma unroll
    for (int dt = 0; dt < 2; ++dt)
#pragma unroll
        for (int et = 0; et < 4; ++et) sacc[dt][et] = (f32x4){0.f, 0.f, 0.f, 0.f};
    const bf16_t* kptr = KDT + ((size_t)bh * 32 * 256 + 32 * w + l16) * 128 + 8 * g;
    bf16_t* scp = SC + (((size_t)bh * 32) * 512 + es * 64 + l16) * 256 + 32 * w + 4 * g;
    bf16x8 kf[2][4], kn[2][4];
#pragma unroll
    for (int dt = 0; dt < 2; ++dt)
#pragma unroll
        for (int ks = 0; ks < 4; ++ks) { kf[dt][ks] = *(const bf16x8*)(kptr + dt * 2048 + 32 * ks); kn[dt][ks] = kf[dt][ks]; }
    __syncthreads();
    for (int c = 0; c < 32; ++c) {
        const int buf = c & 1;
        u32x4 nv0 = {0u, 0u, 0u, 0u}, nv1 = {0u, 0u, 0u, 0u};
        if (c < 31) { nv0 = *(const u32x4*)(vrow + (c + 1) * 128); nv1 = *(const u32x4*)(vrow + (c + 1) * 128 + 8);
#pragma unroll
            for (int dt = 0; dt < 2; ++dt)
#pragma unroll
                for (int ks = 0; ks < 4; ++ks) kn[dt][ks] = *(const bf16x8*)(kptr + (size_t)(c + 1) * 256 * 128 + dt * 2048 + 32 * ks); }
        asm volatile("" ::: "memory");
        const LAS bf16_t* VTb = VT + buf * 64 * 136;
#pragma unroll
        for (int dt = 0; dt < 2; ++dt)
#pragma unroll
            for (int et = 0; et < 4; ++et) sacc[dt][et] *= g128;
#pragma unroll
        for (int et = 0; et < 4; ++et)
#pragma unroll
            for (int ks = 0; ks < 4; ++ks) { const bf16x8 vf = *(const LAS bf16x8*)(VTb + (16 * et + l16) * 136 + 32 * ks + 8 * g);
#pragma unroll
                for (int dt = 0; dt < 2; ++dt) sacc[dt][et] = __builtin_amdgcn_mfma_f32_16x16x32_bf16(kf[dt][ks], vf, sacc[dt][et], 0, 0, 0); }
        if (c < 31) {
#pragma unroll
            for (int dt = 0; dt < 2; ++dt)
#pragma unroll
                for (int et = 0; et < 4; ++et) *(u32x2*)(scp + (size_t)(c + 1) * 512 * 256 + (size_t)(16 * et) * 256 + 16 * dt) = pk4(sacc[dt][et]);
            LAS bf16_t* d2 = vdst + (buf ^ 1) * 64 * 136; *(LAS u32x4*)d2 = nv0; *(LAS u32x4*)(d2 + 8) = nv1;
        }
        lds_barrier();
#pragma unroll
        for (int dt = 0; dt < 2; ++dt)
#pragma unroll
            for (int ks = 0; ks < 4; ++ks) kf[dt][ks] = kn[dt][ks];
    }
#pragma unroll
    for (int dt = 0; dt < 2; ++dt)
#pragma unroll
        for (int et = 0; et < 4; ++et)
#pragma unroll
            for (int r = 0; r < 4; ++r) out[OFF_RSP + ((size_t)bh * 256 + 32 * w + 16 * dt + 4 * g + r) * 512 + es * 64 + 16 * et + l16] = sacc[dt][et][r];
}

__device__ __forceinline__ void ret_out_items(LAS unsigned char* lds, const bf16_t* __restrict__ Zq, const bf16_t* __restrict__ vTp, const bf16_t* __restrict__ ABUF, const bf16_t* __restrict__ SC, bf16_t* __restrict__ ORET, int G) {
    LAS bf16_t* VS = (LAS bf16_t*)lds;
    LAS bf16_t* SS = (LAS bf16_t*)(lds + 2 * 64 * 136 * 2);
    for (int it = blockIdx.x; it < 512; it += G) {
        const int tid = otid(), w = tid >> 6, lane = tid & 63, l16 = lane & 15, g = lane >> 4;
        const int bh = it >> 5, c = it & 31, b = bh >> 2, h = bh & 3;
        const float lg = ret_lg(h), gi = __expf((float)(16 * w + l16 + 1) * lg);
        bf16x8 af[4], qf[8];
        { const bf16_t* aptr = ABUF + (((size_t)bh * 32 + c) * 128 + 16 * w + l16) * 128 + 8 * g;
          const bf16_t* qptr = Zq + ((size_t)b * 4096 + c * 128 + 16 * w + l16) * 1024 + h * 256 + 8 * g;
#pragma unroll
          for (int ks = 0; ks < 4; ++ks) af[ks] = *(const bf16x8*)(aptr + 32 * ks);
#pragma unroll
          for (int kd = 0; kd < 8; ++kd) qf[kd] = *(const bf16x8*)(qptr + 32 * kd); }
        const bf16_t* vsrc = vTp + ((size_t)bh * 512 + (tid >> 4)) * 4096 + c * 128 + (tid & 15) * 8;
        const bf16_t* ssrc = SC + (((size_t)bh * 32 + c) * 512 + (tid >> 5)) * 256 + (tid & 31) * 8;
        LAS bf16_t* vd = VS + (tid >> 4) * 136 + (tid & 15) * 8; LAS bf16_t* sd = SS + (tid >> 5) * 264 + (tid & 31) * 8;
        bf16_t* optr = ORET + ((size_t)b * 4096 + c * 128 + 16 * w + l16) * 2048 + h * 512 + 4 * g;
        u32x4 rv[2], rs[4];
#pragma unroll
        for (int j = 0; j < 2; ++j) rv[j] = *(const u32x4*)(vsrc + (size_t)(32 * j) * 4096);
#pragma unroll
        for (int j = 0; j < 4; ++j) rs[j] = *(const u32x4*)(ssrc + (size_t)(16 * j) * 256);
        __syncthreads();
#pragma unroll
        for (int j = 0; j < 2; ++j) *(LAS u32x4*)(vd + 32 * j * 136) = rv[j];
#pragma unroll
        for (int j = 0; j < 4; ++j) *(LAS u32x4*)(sd + 16 * j * 264) = rs[j];
        __syncthreads();
        for (int es = 0; es < 8; ++es) {
            const int buf = es & 1;
            if (es < 7) {
#pragma unroll
                for (int j = 0; j < 2; ++j) rv[j] = *(const u32x4*)(vsrc + (size_t)((es + 1) * 64 + 32 * j) * 4096);
#pragma unroll
                for (int j = 0; j < 4; ++j) rs[j] = *(const u32x4*)(ssrc + (size_t)((es + 1) * 64 + 16 * j) * 256);
            }
            asm volatile("" ::: "memory");
            const LAS bf16_t* VSb = VS + buf * 64 * 136; const LAS bf16_t* SSb = SS + buf * 64 * 264;
#pragma unroll
            for (int et = 0; et < 4; ++et) {
                f32x4 oin = {0.f, 0.f, 0.f, 0.f}, ocr = {0.f, 0.f, 0.f, 0.f};
#pragma unroll
                for (int ks = 0; ks < 4; ++ks) { const bf16x8 vf = *(const LAS bf16x8*)(VSb + (16 * et + l16) * 136 + 32 * ks + 8 * g); oin = __builtin_amdgcn_mfma_f32_16x16x32_bf16(vf, af[ks], oin, 0, 0, 0); }
                if (c > 0) {
#pragma unroll
                    for (int kd = 0; kd < 8; ++kd) { const bf16x8 sf = *(const LAS bf16x8*)(SSb + (16 * et + l16) * 264 + 32 * kd + 8 * g); ocr = __builtin_amdgcn_mfma_f32_16x16x32_bf16(sf, qf[kd], ocr, 0, 0, 0); }
                }
                *(u32x2*)(optr + es * 64 + 16 * et) = pk4(oin + ocr * gi);
            }
            if (es < 7) {
#pragma unroll
                for (int j = 0; j < 2; ++j) *(LAS u32x4*)(vd + ((buf ^ 1) * 64 + 32 * j) * 136) = rv[j];
#pragma unroll
                for (int j = 0; j < 4; ++j) *(LAS u32x4*)(sd + ((buf ^ 1) * 64 + 16 * j) * 264) = rs[j];
            }
            lds_barrier();
        }
    }
}

__device__ __forceinline__ void ret_sample(LAS unsigned char* lds, const Params& P, const bf16_t* __restrict__ Zq, const bf16_t* __restrict__ Zk, const bf16_t* __restrict__ vTs, bf16_t* __restrict__ ORET, unsigned* ctr, unsigned* done, unsigned target) {
    LAS float* qs = (LAS float*)lds;
    LAS float* kds = qs + 2048;
    LAS float* A8 = kds + 2048;
    LAS float* red = A8 + 64;
    volatile LAS int* slot = (volatile LAS int*)(lds + LDS_BYTES - 32);
    for (;;) {
        const int tid = otid();
        __syncthreads();
        if (tid == 0) *slot = (done && xb_ld(done) >= target) ? 512 : (int)atomicAdd(ctr, 1u);
        __syncthreads();
        const int it = *slot;
        if (it >= 512) break;
        const int bs = it >> 2, h = it & 3;
        const float lg = ret_lg(h), g8 = __expf(8.f * lg), ig8 = __expf(-8.f * lg);
#pragma unroll
        for (int k = 0; k < 4; ++k) { const int e = tid + 512 * k, i = e >> 8, d = e & 255; const size_t src = (size_t)(MP + bs * 8 + i) * 1024 + h * 256 + d;
            qs[d * 8 + i] = bf2f(Zq[src]) * __expf((float)(i + 1) * lg); kds[d * 8 + i] = bf2f(Zk[src]) * __expf((float)(7 - i) * lg); }
        __syncthreads();
        if (tid < 64) { const int i = tid >> 3, s = tid & 7; float a = 0.f;
            if (s <= i) { for (int d = 0; d < 256; ++d) a += qs[d * 8 + i] * kds[d * 8 + s]; a *= ig8; }
            A8[tid] = a; }
        const int eg = tid & 127, dp = tid >> 7, e0 = 4 * eg;
        f32x4 vq[8];
#pragma unroll
        for (int jj = 0; jj < 4; ++jj) { const u32x4 wv = *(const u32x4*)(vTs + ((size_t)((bs * 4 + h) * 512 + e0 + jj)) * 8);
            vq[0][jj] = bflo(wv.x); vq[1][jj] = bfhi(wv.x); vq[2][jj] = bflo(wv.y); vq[3][jj] = bfhi(wv.y); vq[4][jj] = bflo(wv.z); vq[5][jj] = bfhi(wv.z); vq[6][jj] = bflo(wv.w); vq[7][jj] = bfhi(wv.w); }
        f32x4 cr[8];
#pragma unroll
        for (int i = 0; i < 8; ++i) cr[i] = (f32x4){0.f, 0.f, 0.f, 0.f};
        const size_t sbase = ((size_t)(bs * 4 + h) * 256 + dp * 64) * 512 + e0;
        const float* __restrict__ sp = P.state_ret + sbase; float* __restrict__ op = P.out + OFF_RSS + sbase;
        f32x4 sta[8];
#pragma unroll
        for (int j = 0; j < 8; ++j) sta[j] = __builtin_nontemporal_load((const f32x4*)(sp + (size_t)j * 512));
#pragma unroll 1
        for (int d0 = 0; d0 < 64; d0 += 8) {
            const bool more = d0 + 8 < 64;
#pragma unroll
            for (int j = 0; j < 8; ++j) {
                const int d = dp * 64 + d0 + j; const f32x4 st = sta[j];
                if (more) sta[j] = __builtin_nontemporal_load((const f32x4*)(sp + (size_t)(d0 + 8 + j) * 512));
                const f32x4 qa = *(const LAS f32x4*)(qs + d * 8), qb = *(const LAS f32x4*)(qs + d * 8 + 4), ka = *(const LAS f32x4*)(kds + d * 8), kb = *(const LAS f32x4*)(kds + d * 8 + 4);
                const float q8[8] = {qa[0], qa[1], qa[2], qa[3], qb[0], qb[1], qb[2], qb[3]}, k8[8] = {ka[0], ka[1], ka[2], ka[3], kb[0], kb[1], kb[2], kb[3]};
                f32x4 ns = st * g8;
#pragma unroll
                for (int s2 = 0; s2 < 8; ++s2) ns += vq[s2] * k8[s2];
                __builtin_nontemporal_store(ns, (f32x4*)(op + (size_t)(d0 + j) * 512));
#pragma unroll
                for (int i = 0; i < 8; ++i) cr[i] += st * q8[i];
                asm volatile("" ::: "memory");
            }
        }
#pragma unroll
        for (int i = 0; i < 8; ++i) *(LAS f32x4*)(red + (dp * 8 + i) * 512 + e0) = cr[i];
        __syncthreads();
        { const int i = tid >> 6, e8 = (tid & 63) * 8;
          float o[8];
#pragma unroll
          for (int jj = 0; jj < 8; ++jj) o[jj] = red[(0 * 8 + i) * 512 + e8 + jj] + red[(1 * 8 + i) * 512 + e8 + jj] + red[(2 * 8 + i) * 512 + e8 + jj] + red[(3 * 8 + i) * 512 + e8 + jj];
#pragma unroll
          for (int jj = 0; jj < 8; ++jj) { const u32x4 wv = *(const u32x4*)(vTs + ((size_t)((bs * 4 + h) * 512 + e8 + jj)) * 8);
              const float v8[8] = {bflo(wv.x), bfhi(wv.x), bflo(wv.y), bfhi(wv.y), bflo(wv.z), bfhi(wv.z), bflo(wv.w), bfhi(wv.w)};
#pragma unroll
              for (int s = 0; s < 8; ++s) o[jj] += A8[i * 8 + s] * v8[s]; }
          bf16_t* dst = ORET + (size_t)(MP + bs * 8 + i) * 2048 + h * 512 + e8;
          u32x4 ow; ow.x = cvt_pk_bf16(o[0], o[1]); ow.y = cvt_pk_bf16(o[2], o[3]); ow.z = cvt_pk_bf16(o[4], o[5]); ow.w = cvt_pk_bf16(o[6], o[7]); *(u32x4*)dst = ow; }
    }
}

__device__ __forceinline__ void ret_gnorm(const bf16_t* __restrict__ ORET, const bf16_t* __restrict__ Zg, bf16_t* __restrict__ OG, int G) {
    const int tid_o = otid(), wave = tid_o >> 6, lane = tid_o & 63;
    for (int task = blockIdx.x * 8 + wave; task < MT * 4; task += G * 8) {
        const size_t o = (size_t)(task >> 2) * 2048 + (task & 3) * 512 + lane * 8;
        const u32x4 ow = *(const u32x4*)(ORET + o); const f32x4 a = {bflo(ow.x), bfhi(ow.x), bflo(ow.y), bfhi(ow.y)}, b = {bflo(ow.z), bfhi(ow.z), bflo(ow.w), bfhi(ow.w)};
        const float mu = wave_sum(a[0] + a[1] + a[2] + a[3] + b[0] + b[1] + b[2] + b[3]) * (1.f / 512.f);
        const f32x4 da = a - mu, db = b - mu;
        const float var = wave_sum(da[0] * da[0] + da[1] * da[1] + da[2] * da[2] + da[3] * da[3] + db[0] * db[0] + db[1] * db[1] + db[2] * db[2] + db[3] * db[3]) * (1.f / 512.f);
        const float rs = rsqrtf(var + EPS);
        const u32x4 gw = *(const u32x4*)(Zg + o);
        u32x4 r;
        r.x = cvt_pk_bf16(da[0] * rs * bflo(gw.x), da[1] * rs * bfhi(gw.x)); r.y = cvt_pk_bf16(da[2] * rs * bflo(gw.y), da[3] * rs * bfhi(gw.y));
        r.z = cvt_pk_bf16(db[0] * rs * bflo(gw.z), db[1] * rs * bfhi(gw.z)); r.w = cvt_pk_bf16(db[2] * rs * bflo(gw.w), db[3] * rs * bfhi(gw.w));
        *(u32x4*)(OG + o) = r;
    }
}

__global__ void __launch_bounds__(NT) hybrid_fwd(Params P) {
    extern __shared__ __attribute__((aligned(16))) unsigned char lds_raw[];
    LAS unsigned char* lds = (LAS unsigned char*)lds_raw;
    cg::grid_group grid = cg::this_grid();
    const int G = gridDim.x, tid = threadIdx.x;
    unsigned char* ws = P.ws;
    bf16_t* WT_IN_ATTN = (bf16_t*)(ws + WS_WT_IN_ATTN); bf16_t* WT_OUT_ATTN = (bf16_t*)(ws + WS_WT_OUT_ATTN); bf16_t* WT_IN_RET = (bf16_t*)(ws + WS_WT_IN_RET); bf16_t* WT_OUT_RET = (bf16_t*)(ws + WS_WT_OUT_RET);
    bf16_t* WT_GATE = (bf16_t*)(ws + WS_WT_GATE); bf16_t* WT_PLE = (bf16_t*)(ws + WS_WT_PLE);
    float* TABA = (float*)(ws + WS_TABA); float* TABR = (float*)(ws + WS_TABR);
    bf16_t* H = (bf16_t*)(ws + WS_H); bf16_t* PB = (bf16_t*)(ws + WS_PB);
    bf16_t* PLE = (bf16_t*)(ws + WS_PLE); bf16_t* Y = (bf16_t*)(ws + WS_Y); bf16_t* X2 = (bf16_t*)(ws + WS_X2);
    bf16_t* OG = (bf16_t*)(ws + WS_OG); bf16_t* ZQ = (bf16_t*)(ws + WS_ZQ); bf16_t* ZK = (bf16_t*)(ws + WS_ZK); bf16_t* ZG = (bf16_t*)(ws + WS_ZG);
    bf16_t* VTP = (bf16_t*)(ws + WS_VTP); bf16_t* VTS = (bf16_t*)(ws + WS_VTS); bf16_t* ABUF = (bf16_t*)(ws + WS_ABUF); bf16_t* KDT = (bf16_t*)(ws + WS_KDT); bf16_t* ORET = (bf16_t*)(ws + WS_ORET);
    bf16_t* SC = (bf16_t*)(ws + WS_Y);
    pg8::StaticOrder SO;
    volatile LAS unsigned* bst = (volatile LAS unsigned*)(lds + LDS_BYTES - 16);
    if (tid < 4) bst[tid] = 0u;
    __syncthreads();
    const XcdBarrier xbar = xcd_barrier_post((unsigned*)(ws + WS_BAR), bst);
#define GSYNC() xcd_barrier(xbar)

for (int rep_ = 0; rep_ < REP_P0; ++rep_) {
    {
        LAS float* T = (LAS float*)lds;
        const int ttid = otid(), nn = ttid & 63, kq = ttid >> 6, kk2 = (ttid & 31) * 2, nq = ttid >> 5;
#define TILE_DESC(t_, W_, Wt_, K_, N_, perm_, tl_) do { \
        if ((t_) < 640) { W_ = P.w_in_attn; Wt_ = WT_IN_ATTN; K_ = 1024; N_ = 2560; perm_ = true; tl_ = (t_); } \
        else if ((t_) < 896) { W_ = P.w_out_attn; Wt_ = WT_OUT_ATTN; K_ = 1024; N_ = 1024; perm_ = false; tl_ = (t_) - 640; } \
        else if ((t_) < 2432) { W_ = P.w_in_ret; Wt_ = WT_IN_RET; K_ = 1024; N_ = 6144; perm_ = false; tl_ = (t_) - 896; } \
        else if ((t_) < 2944) { W_ = P.w_out_ret; Wt_ = WT_OUT_RET; K_ = 2048; N_ = 1024; perm_ = false; tl_ = (t_) - 2432; } \
        else if ((t_) < 3200) { W_ = P.w_gate; Wt_ = WT_GATE; K_ = 1024; N_ = 1024; perm_ = false; tl_ = (t_) - 2944; } \
        else if ((t_) < 3456) { W_ = P.w_gate + 1024 * 1024; Wt_ = WT_GATE + 1024 * 1024; K_ = 1024; N_ = 1024; perm_ = false; tl_ = (t_) - 3200; } \
        else if ((t_) < 3520) { W_ = P.w_ple; Wt_ = WT_PLE; K_ = 256; N_ = 1024; perm_ = false; tl_ = (t_) - 3456; } \
        else { W_ = P.w_ple + 256 * 1024; Wt_ = WT_PLE + 1024 * 256; K_ = 256; N_ = 1024; perm_ = false; tl_ = (t_) - 3520; } } while (0)
#define TILE_LOAD(W_, N_, perm_, tl_, r_) do { const int ntn_ = (N_) >> 6, n0_ = ((tl_) % ntn_) * 64, k0_ = ((tl_) / ntn_) * 64, nd_ = n0_ + nn; int ns_ = nd_; \
        if ((perm_) && nd_ < 1280) { const int p_ = nd_ & 63; ns_ = (nd_ - p_) + (p_ >> 5) * 16 + (p_ & 15) + ((p_ >> 4) & 1) * 32; } \
        _Pragma("unroll") for (int i_ = 0; i_ < 8; ++i_) r_[i_] = (W_)[(size_t)(k0_ + kq + 8 * i_) * (N_) + ns_]; } while (0)
        float r[8];
        const float* Wc; bf16_t* Wtc; int Kc, Nc, tlc; bool pc;
        int t = blockIdx.x;
        if (t < 3584) { TILE_DESC(t, Wc, Wtc, Kc, Nc, pc, tlc); TILE_LOAD(Wc, Nc, pc, tlc, r); }
        for (; t < 3584; t += G) {
            __syncthreads();
#pragma unroll
            for (int i = 0; i < 8; ++i) T[(kq + 8 * i) * 65 + nn] = r[i];
            __syncthreads();
            const int ntn = Nc >> 6, n0 = (tlc % ntn) * 64, k0 = (tlc / ntn) * 64; bf16_t* Wto = Wtc; const int Ko = Kc;
            if (t + G < 3584) { TILE_DESC(t + G, Wc, Wtc, Kc, Nc, pc, tlc); TILE_LOAD(Wc, Nc, pc, tlc, r); }
#pragma unroll
            for (int i = 0; i < 4; ++i) { const int n2 = nq + 16 * i; *(unsigned*)(Wto + (size_t)(n0 + n2) * Ko + k0 + kk2) = cvt_pk_bf16(T[kk2 * 65 + n2], T[(kk2 + 1) * 65 + n2]); }
        }
        __syncthreads();
#undef TILE_DESC
#undef TILE_LOAD
    }
    for (int e = blockIdx.x * NT + tid; e < 4104 * 160; e += G * NT) {
        const int pi = e / 160, f = e % 160; const int pos = pi < 4096 ? pi : 16384 + (pi - 4096);
        if (f < 32) { const float inv = powf(10000.f, -(float)f / 32.f), ang = (float)pos * inv; TABA[((size_t)pi * 32 + f) * 2] = cosf(ang); TABA[((size_t)pi * 32 + f) * 2 + 1] = sinf(ang); }
        else { const int f2 = f - 32; const float inv = powf(10000.f, -(float)f2 / 128.f), ang = (float)pos * inv; TABR[((size_t)pi * 128 + f2) * 2] = cosf(ang); TABR[((size_t)pi * 128 + f2) * 2 + 1] = sinf(ang); }
    }
    for (int e = blockIdx.x * NT + tid; e < 2 * MT * 64; e += G * NT) {
        const int i = e / (MT * 64), rem = e % (MT * 64), row = rem >> 6, c4 = (rem & 63) * 4;
        const float* src = row < MP ? P.p_prompt + ((size_t)i * MP + row) * 256 + c4 : P.p_sample + ((size_t)i * MS + row - MP) * 256 + c4;
        *(u32x2*)(PB + ((size_t)i * MT + row) * 256 + c4) = pk4(*(const f32x4*)src);
    }
    rms_rows(P.x_prompt, P.x_sample, P.pre_norm, H, G);
}
    if (P.ws == nullptr) grid.sync();
    GSYNC();

for (int rep_ = 0; rep_ < REP_GIN; ++rep_) {
    { pg8::Gemm g{H, WT_IN_ATTN, MT, 2560, 1024}; SO.init(MT, 2560, G, blockIdx.x);
      EpiInAttn E{ZQ, ZK, ZG, VTP, VTS, TABA, P.out}; pg8::gemm_phase(lds, g, SO, E); }
    { pg8::Gemm g{PB, WT_PLE, MP, 1024, 256}; SO.init(MP, 1024, G, blockIdx.x);
      EpiB16 E{PLE, 1024}; pg8::gemm_phase(lds, g, SO, E);
      skinny_gemm(lds, PB + (size_t)MP * 256, WT_PLE, 256, SkB16{PLE + (size_t)MP * 1024}, G); }
}
    GSYNC();

for (int rep_ = 0; rep_ < REP_ATT; ++rep_) {
    attn_prompt(lds, ZQ, ZK, ZG, VTP, P.sinks, OG, G);
    attn_sample(lds, P, ZQ, ZK, ZG, VTS, OG, G);
}
    GSYNC();

for (int rep_ = 0; rep_ < REP_GN1; ++rep_) {
    { pg8::Gemm g{OG, WT_OUT_ATTN, MP, 1024, 1024}; SO.init(MP, 1024, G, blockIdx.x); EpiB16 E{Y, 1024}; pg8::gemm_phase(lds, g, SO, E);
      skinny_gemm(lds, OG + (size_t)MP * 1024, WT_OUT_ATTN, 1024, SkB16{Y + (size_t)MP * 1024}, G); }
}
    GSYNC();
for (int rep_ = 0; rep_ < REP_ROW; ++rep_) {
    resid_rows<false>(P.x_prompt, P.x_sample, nullptr, Y, P.post_norm, H, G);
}
    GSYNC();
for (int rep_ = 0; rep_ < REP_GN1; ++rep_) {
    { pg8::Gemm g{H, WT_GATE, MP, 1024, 1024}; SO.init(MP, 1024, G, blockIdx.x); EpiGate<true> E{H, PLE, nullptr, X2}; pg8::gemm_phase(lds, g, SO, E);
      skinny_gemm(lds, H + (size_t)MP * 1024, WT_GATE, 1024, SkGate<true>{H + (size_t)MP * 1024, PLE + (size_t)MP * 1024, nullptr, X2 + (size_t)MP * 1024}, G); }
}
    GSYNC();
for (int rep_ = 0; rep_ < REP_ROW; ++rep_) {
    rms_rows_b16(X2, P.pre_norm + 1024, H, G);
}
    GSYNC();
for (int rep_ = 0; rep_ < REP_GIN; ++rep_) {
    { pg8::Gemm g{H, WT_IN_RET, MT, 6144, 1024}; SO.init(MT, 6144, G, blockIdx.x);
      EpiInRet E{ZQ, ZK, ZG, VTP, VTS, TABR}; pg8::gemm_phase(lds, g, SO, E); }
    { pg8::Gemm g{PB + (size_t)MT * 256, WT_PLE + 1024 * 256, MP, 1024, 256}; SO.init(MP, 1024, G, blockIdx.x);
      EpiB16 E{PLE, 1024}; pg8::gemm_phase(lds, g, SO, E);
      skinny_gemm(lds, PB + (size_t)MT * 256 + (size_t)MP * 256, WT_PLE + 1024 * 256, 256, SkB16{PLE + (size_t)MP * 1024}, G); }
}
    GSYNC();
for (int rep_ = 0; rep_ < REP_RA; ++rep_) {
    ret_A(lds, ZQ, ZK, ABUF, KDT, G);
}
    GSYNC();
    { unsigned* ctr = (unsigned*)(ws + WS_BAR + 14336); unsigned* done = ctr + 64;
      const unsigned nscan = G < 128 ? (unsigned)G : 128u;
      if (blockIdx.x < 128) { for (int rep_ = 0; rep_ < REP_SCAN; ++rep_) for (int u = blockIdx.x; u < 128; u += G) ret_scan_unit(lds, u, VTP, KDT, SC, P.out); if (tid == 0) xb_add(done, 1u); }
      else ret_sample(lds, P, ZQ, ZK, VTS, ORET, ctr, done, nscan);
      GSYNC();
      for (int rep_ = 0; rep_ < REP_R3; ++rep_) ret_out_items(lds, ZQ, VTP, ABUF, SC, ORET, G);
      ret_sample(lds, P, ZQ, ZK, VTS, ORET, ctr, nullptr, 0u); }
for (int rep_ = 0; rep_ < REP_SYNC; ++rep_) GSYNC();
    GSYNC();
for (int rep_ = 0; rep_ < REP_ROW; ++rep_) {
    ret_gnorm(ORET, ZG, OG, G);
}
    GSYNC();
for (int rep_ = 0; rep_ < REP_GN1; ++rep_) {
    { pg8::Gemm g{OG, WT_OUT_RET, MP, 1024, 2048}; SO.init(MP, 1024, G, blockIdx.x); EpiB16 E{Y, 1024}; pg8::gemm_phase(lds, g, SO, E);
      skinny_gemm(lds, OG + (size_t)MP * 2048, WT_OUT_RET, 2048, SkB16{Y + (size_t)MP * 1024}, G); }
}
    GSYNC();
for (int rep_ = 0; rep_ < REP_ROW; ++rep_) {
    resid_rows<true>(nullptr, nullptr, X2, Y, P.post_norm + 1024, H, G);
}
    GSYNC();
for (int rep_ = 0; rep_ < REP_GN1; ++rep_) {
    { pg8::Gemm g{H, WT_GATE + 1024 * 1024, MP, 1024, 1024}; SO.init(MP, 1024, G, blockIdx.x); EpiGate<false> E{H, PLE, P.out, nullptr}; pg8::gemm_phase(lds, g, SO, E);
      skinny_gemm(lds, H + (size_t)MP * 1024, WT_GATE + 1024 * 1024, 1024, SkGate<false>{H + (size_t)MP * 1024, PLE + (size_t)MP * 1024, P.out + (size_t)MP * 1024, nullptr}, G); }
}
}

extern "C" void kernel_launch(void* const* d_in, const int* in_sizes, int n_in, void* d_out, int out_size, void* d_ws, size_t ws_size, hipStream_t stream) {
    static int grid_blocks = 0;
    if (!grid_blocks) {
        int dev = 0, cus = 0, per_cu = 0;
        hipGetDevice(&dev);
        hipDeviceGetAttribute(&cus, hipDeviceAttributeMultiprocessorCount, dev);
        hipFuncSetAttribute((const void*)hybrid_fwd, hipFuncAttributeMaxDynamicSharedMemorySize, LDS_BYTES);
        hipOccupancyMaxActiveBlocksPerMultiprocessor(&per_cu, (const void*)hybrid_fwd, NT, LDS_BYTES);
        if (per_cu < 1) per_cu = 1;
        if (per_cu > 1) per_cu = 1;
        grid_blocks = cus * per_cu;
        if (ws_size < WS_END) fprintf(stderr, "kernel_launch: workspace too small: %zu < %zu\n", ws_size, (size_t)WS_END);
    }
    Params p{};
    p.x_prompt = (const float*)d_in[0]; p.x_sample = (const float*)d_in[1]; p.cache_k = (const float*)d_in[2]; p.cache_v = (const float*)d_in[3]; p.state_ret = (const float*)d_in[4];
    p.p_prompt = (const float*)d_in[5]; p.p_sample = (const float*)d_in[6]; p.pre_norm = (const float*)d_in[7]; p.post_norm = (const float*)d_in[8]; p.w_in_attn = (const float*)d_in[9];
    p.sinks = (const float*)d_in[10]; p.w_out_attn = (const float*)d_in[11]; p.w_in_ret = (const float*)d_in[12]; p.w_out_ret = (const float*)d_in[13]; p.w_ple = (const float*)d_in[14]; p.w_gate = (const float*)d_in[15];
    p.out = (float*)d_out; p.ws = (unsigned char*)d_ws;
    (void)hipMemsetAsync((unsigned char*)d_ws + WS_BAR, 0, 16384, stream);
    void* args[] = {&p};
    hipError_t e = hipLaunchCooperativeKernel((const void*)hybrid_fwd, dim3(grid_blocks), dim3(NT), args, LDS_BYTES, stream);
    if (e != hipSuccess) fprintf(stderr, "cooperative launch failed: %s (grid %d)\n", hipGetErrorString(e), grid_blocks);
}
```

```cpp
#include <hip/hip_runtime.h>
#include <hip/hip_cooperative_groups.h>
#include <cstdio>
#include <cstdint>
namespace cg = cooperative_groups;

#define LAS __attribute__((address_space(3)))
typedef unsigned short bf16_t;
typedef short bf16x8 __attribute__((ext_vector_type(8)));
typedef float f32x4 __attribute__((ext_vector_type(4)));
typedef float f32x2 __attribute__((ext_vector_type(2)));
typedef unsigned u32x2 __attribute__((ext_vector_type(2)));
typedef unsigned u32x4 __attribute__((ext_vector_type(4)));

constexpr int MP = 16384, MS = 1024, MT = MP + MS;
constexpr int NT = 512;
#define REP_P0 1
#define REP_GIN 1
#define REP_ATT 1
#define REP_RA 1
#define REP_SYNC 0
#define REP_R3 1
#define REP_SCAN 1
#define REP_ROW 1
#define REP_GN1 1
constexpr int LDS_BYTES = 140 * 1024;
constexpr float EPS = 1e-6f;

constexpr size_t OFF_YP = 0, OFF_YS = 16777216, OFF_KWP = 17825792, OFF_VWP = 17956864, OFF_KWS = 18087936, OFF_VWS = 22282240, OFF_RSP = 26476544, OFF_RSS = 28573696;

constexpr size_t al256(size_t x) { return (x + 255) & ~(size_t)255; }
constexpr size_t WS_WT_IN_ATTN = 0;
constexpr size_t WS_WT_OUT_ATTN = WS_WT_IN_ATTN + (size_t)2560 * 1024 * 2;
constexpr size_t WS_WT_IN_RET = WS_WT_OUT_ATTN + (size_t)1024 * 1024 * 2;
constexpr size_t WS_WT_OUT_RET = WS_WT_IN_RET + (size_t)6144 * 1024 * 2;
constexpr size_t WS_WT_GATE = WS_WT_OUT_RET + (size_t)1024 * 2048 * 2;
constexpr size_t WS_WT_PLE = WS_WT_GATE + (size_t)2 * 1024 * 1024 * 2;
constexpr size_t WS_TABA = WS_WT_PLE + (size_t)2 * 1024 * 256 * 2;
constexpr size_t WS_TABR = WS_TABA + (size_t)4104 * 32 * 8;
constexpr size_t WS_H = al256(WS_TABR + (size_t)4104 * 128 * 8);
constexpr size_t WS_PB = WS_H + (size_t)MT * 1024 * 2;
constexpr size_t WS_PLE = WS_PB + (size_t)2 * MT * 256 * 2;
constexpr size_t WS_Y = WS_PLE + (size_t)MT * 1024 * 4;
constexpr size_t WS_X1 = WS_Y + (size_t)MT * 1024 * 4;
constexpr size_t WS_X2 = WS_X1 + (size_t)MT * 1024 * 4;
constexpr size_t WS_OG = WS_X2 + (size_t)MT * 1024 * 4;
constexpr size_t WS_ZQ = WS_OG + (size_t)MT * 2048 * 2;
constexpr size_t WS_ZK = WS_ZQ + (size_t)MT * 1024 * 2;
constexpr size_t WS_ZG = WS_ZK + (size_t)MT * 1024 * 2;
constexpr size_t WS_VTP = WS_ZG + (size_t)MT * 2048 * 2;
constexpr size_t WS_VTS = WS_VTP + (size_t)16 * 512 * 4096 * 2;
constexpr size_t WS_ABUF = WS_VTS + (size_t)128 * 4 * 512 * 8 * 2;
constexpr size_t WS_KDT = WS_ABUF + (size_t)512 * 128 * 128 * 2;
constexpr size_t WS_ORET = WS_KDT + (size_t)512 * 256 * 128 * 2;
constexpr size_t WS_BAR = WS_ORET + (size_t)MT * 2048 * 4;
constexpr size_t WS_END = WS_BAR + 16384;

struct Params {
    const float *x_prompt, *x_sample, *cache_k, *cache_v, *state_ret, *p_prompt, *p_sample, *pre_norm, *post_norm, *w_in_attn, *sinks, *w_out_attn, *w_in_ret, *w_out_ret, *w_ple, *w_gate;
    float* out; unsigned char* ws;
};

__device__ __forceinline__ unsigned cvt_pk_bf16(float lo, float hi) { unsigned r; asm volatile("v_cvt_pk_bf16_f32 %0, %1, %2" : "=v"(r) : "v"(lo), "v"(hi)); return r; }
__device__ __forceinline__ u32x2 pk4(f32x4 v) { u32x2 w; w.x = cvt_pk_bf16(v[0], v[1]); w.y = cvt_pk_bf16(v[2], v[3]); return w; }
__device__ __forceinline__ float bf2f(bf16_t b) { return __uint_as_float(((unsigned)b) << 16); }
__device__ __forceinline__ float bflo(unsigned w) { return __uint_as_float(w << 16); }
__device__ __forceinline__ float bfhi(unsigned w) { return __uint_as_float(w & 0xffff0000u); }
__device__ __forceinline__ float silu_f(float x) { return x / (1.f + __expf(-x)); }
__device__ __forceinline__ float sigmoid_f(float x) { return 1.f / (1.f + __expf(-x)); }
__device__ __forceinline__ float wave_sum(float v) {
#pragma unroll
    for (int o = 32; o >= 1; o >>= 1) v += __shfl_xor(v, o, 64);
    return v;
}
__device__ __forceinline__ int otid() { int t = threadIdx.x; asm volatile("" : "+v"(t)); return t; }
__device__ __forceinline__ void lds_barrier() { asm volatile("s_waitcnt lgkmcnt(0)" ::: "memory"); __builtin_amdgcn_s_barrier(); asm volatile("" ::: "memory"); }
__device__ __forceinline__ float ret_lg(int h) { return h == 0 ? -3.1748698315e-02f : h == 1 ? -1.5748356968e-02f : h == 2 ? -7.8431774610e-03f : -3.9138993211e-03f; }

#define XB_TMO      128
#define XB_XCNT(j)  (256  + 64 * (j))
#define XB_XSUB(j)  (1280 + 64 * (j))
#define XB_XGEN(j)  (2304 + 64 * (j))
#define XB_TOP      3328
#define XB_TOPGEN   3392
#define XCD_BAR_WORDS 3456
#define XB_SPIN_CAP (1u << 18)

__device__ __forceinline__ unsigned xb_ld(unsigned* p)              { return __hip_atomic_load(p, __ATOMIC_RELAXED, __HIP_MEMORY_SCOPE_AGENT); }
__device__ __forceinline__ unsigned xb_add(unsigned* p, unsigned v) { return __hip_atomic_fetch_add(p, v, __ATOMIC_RELAXED, __HIP_MEMORY_SCOPE_AGENT); }
__device__ __forceinline__ unsigned xb_xcc_id() { return (unsigned)__builtin_amdgcn_s_getreg((3 << 11) | 20) & 0xFu; }
#define XB_SPIN(cond, bar) do { unsigned _sp = 0; while (cond) { __builtin_amdgcn_s_sleep(1); \
    if ((++_sp & 255u) == 0u) { if (xb_ld(&(bar)[XB_TMO])) break; if (_sp > XB_SPIN_CAP) { atomicAdd(&(bar)[XB_TMO], 1u); break; } } } } while (0)

struct XcdBarrier {
    unsigned* bar; unsigned x;
    volatile LAS unsigned* st;
};

__device__ __forceinline__ XcdBarrier xcd_barrier_post(unsigned* bar, volatile LAS unsigned* st) {
    XcdBarrier b; b.bar = bar; b.x = xb_xcc_id(); b.st = st;
    if (threadIdx.x == 0) (void)xb_add(&bar[XB_XCNT(b.x)], 1u);
    return b;
}
__device__ __forceinline__ void xcd_barrier_complete(unsigned* bar, unsigned x, unsigned& nloc, unsigned& nx) {
    const unsigned G = gridDim.x * gridDim.y * gridDim.z;
    unsigned sum, cnt, mine, sp = 0u;
    for (;;) {
        sum = 0u; cnt = 0u; mine = 0u;
#pragma unroll
        for (unsigned j = 0; j < 16; ++j) { const unsigned c = xb_ld(&bar[XB_XCNT(j)]); sum += c; cnt += (c > 0u) ? 1u : 0u; mine = (j == x) ? c : mine; }
        if (sum == G) break;
        __builtin_amdgcn_s_sleep(1);
        if ((++sp & 255u) == 0u) { if (xb_ld(&bar[XB_TMO])) break; if (sp > XB_SPIN_CAP) { atomicAdd(&bar[XB_TMO], 1u); break; } }
    }
    nloc = mine > 0u ? mine : 1u; nx = cnt > 0u ? cnt : 1u;
}

__device__ __forceinline__ void xcd_barrier(const XcdBarrier& b) {
    asm volatile("s_waitcnt vmcnt(0)" ::: "memory");
    __syncthreads();
    if (threadIdx.x == 0) {
        unsigned* bar = b.bar;
        __builtin_amdgcn_s_waitcnt(0);
        unsigned nloc = b.st[0], nx = b.st[1];
        if (nloc == 0u) { xcd_barrier_complete(bar, b.x, nloc, nx); b.st[0] = nloc; b.st[1] = nx; }
        const unsigned old = xb_add(&bar[XB_XSUB(b.x)], 1u);
        const unsigned gen = old / nloc;
        if (old + 1u == (gen + 1u) * nloc) {
            __builtin_amdgcn_fence(__ATOMIC_RELEASE, "agent");
            asm volatile("s_waitcnt vmcnt(0)" ::: "memory");
            const unsigned og = xb_add(&bar[XB_TOP], 1u);
            const unsigned tg = og / nx;
            if (og + 1u == (tg + 1u) * nx) xb_add(&bar[XB_TOPGEN], 1u);
            else XB_SPIN(xb_ld(&bar[XB_TOPGEN]) == tg, bar);
            __builtin_amdgcn_fence(__ATOMIC_ACQUIRE, "agent");
            xb_add(&bar[XB_XGEN(b.x)], 1u);
            asm volatile("s_waitcnt vmcnt(0)" ::: "memory");
        } else {
            XB_SPIN(xb_ld(&bar[XB_XGEN(b.x)]) == gen, bar);
            __builtin_amdgcn_fence(__ATOMIC_ACQUIRE, "agent");
            asm volatile("s_waitcnt vmcnt(0)" ::: "memory");
        }
    }
    __syncthreads();
}

namespace pg8 {
constexpr int BM = 256, BK = 64, HALF = 128, HTB = HALF * BK * 2, STAGE_BYTES = 8 * HTB, NXCD = 8, WGM = 8;
__host__ __device__ __forceinline__ int lds_byte(int r, int c) { const int st = (r >> 4) * 2 + (c >> 5), rr = r & 15, cc = c & 31, ob = rr * 64 + cc * 2; return st * 1024 + (ob ^ (((ob >> 9) & 1) << 5)); }
__host__ __device__ __forceinline__ void stage_rc(int b, int& R, int& C) { const int st = b / 1024, sb = b % 1024, swz = sb ^ (((sb >> 9) & 1) << 5); R = (st >> 1) * 16 + swz / 64; C = (st & 1) * 32 + (swz % 64) / 2; }
struct Unit { int pm, pn; };
struct Gemm { const bf16_t* A; const bf16_t* Bt; int M, N, K; };
struct StaticOrder {
    int nM, nN, nwg, G, c;
    __host__ __device__ void init(int M, int N, int G_, int c_) { nM = M / BM; nN = N / BM; nwg = nM * nN; G = G_; c = c_; }
    __host__ __device__ bool next(int i, Unit& u) const {
        const long L = (long)i * G + c; if (L >= nwg) return false;
        int wgid = (int)L; { const int q = nwg / NXCD, r = nwg % NXCD, xcd = wgid % NXCD, off = wgid / NXCD; wgid = (xcd < r ? xcd * (q + 1) : r * (q + 1) + (xcd - r) * q) + off; }
        const int nig = WGM * nN, gid = wgid / nig, fm = gid * WGM, gsz = (nM - fm) < WGM ? (nM - fm) : WGM;
        u.pm = fm + ((wgid % nig) % gsz); u.pn = (wgid % nig) / gsz; return true;
    }
};

template <class Epi>
__device__ __forceinline__ void gemm_phase(LAS unsigned char* lds, const Gemm g, const StaticOrder& S, const Epi& E) {
    const int tid = otid(), wid = __builtin_amdgcn_readfirstlane(tid >> 6), lane = tid & 63, wr = wid >> 2, wc = wid & 3, fr = lane & 15, fq = lane >> 4;
    const int K = g.K, nt = K / BK;
    unsigned voffA[2], voffB[2];
#pragma unroll
    for (int i = 0; i < 2; ++i) { int R, C; stage_rc(tid * 16 + i * 8192, R, C); voffA[i] = (unsigned)(R * K + C) * 2u; voffB[i] = voffA[i]; }
    const size_t kstep = (size_t)(BK * 2);
    const size_t hstep = (size_t)HALF * K * 2;
    const size_t tstep = 2 * hstep;
    const unsigned ldsw = (unsigned)wid * 1024u;
    const int aoff = lds_byte(wr * 64 + fr, fq * 8), boff = lds_byte(wc * 32 + fr, fq * 8);
#define PG8_SA(b, h) (((b) * 2 + (h)) * HTB)
#define PG8_SB(b, h) ((4 + (b) * 2 + (h)) * HTB)
#define PG8_STAGE(bufoff, gbase, voff) do { _Pragma("unroll") for (int _i = 0; _i < 2; ++_i) \
        __builtin_amdgcn_global_load_lds((const unsigned*)((const char*)(gbase) + (voff)[_i]), (LAS unsigned*)(lds + (bufoff) + ldsw + _i * 8192), 16, 0, 0); } while (0)
#define PG8_LDA(dst, b, h) do { _Pragma("unroll") for (int m = 0; m < 4; ++m) _Pragma("unroll") for (int k = 0; k < 2; ++k) dst[m][k] = *(const LAS bf16x8*)(lds + PG8_SA(b, h) + aoff + m * 2048 + k * 1024); } while (0)
#define PG8_LDB(dst, b, h) do { _Pragma("unroll") for (int n = 0; n < 2; ++n) _Pragma("unroll") for (int k = 0; k < 2; ++k) dst[n][k] = *(const LAS bf16x8*)(lds + PG8_SB(b, h) + boff + n * 2048 + k * 1024); } while (0)
#define PG8_MMA(ai, bj, At, Bt) do { __builtin_amdgcn_s_setprio(1); _Pragma("unroll") for (int m = 0; m < 4; ++m) _Pragma("unroll") for (int n = 0; n < 2; ++n) _Pragma("unroll") for (int k = 0; k < 2; ++k) \
        acc[ai][bj][m][n] = __builtin_amdgcn_mfma_f32_16x16x32_bf16(Bt[n][k], At[m][k], acc[ai][bj][m][n], 0, 0, 0); __builtin_amdgcn_s_setprio(0); } while (0)
#define PG8_WAIT_V(n) asm volatile("s_waitcnt vmcnt(" #n ")" ::: "memory")
#define PG8_WAIT_L(n) asm volatile("s_waitcnt lgkmcnt(" #n ")" ::: "memory")
#define PG8_BAR __builtin_amdgcn_s_barrier()
#define PG8_SCHED __builtin_amdgcn_sched_barrier(0)
#define PG8_PTRS(u, pa, pb) do { const char* _a = (const char*)g.A + (size_t)(u).pm * tstep; const char* _b = (const char*)g.Bt + (size_t)(u).pn * tstep; if (Epi::swap(u)) { pa = _b; pb = _a; } else { pa = _a; pb = _b; } } while (0)
    Unit cur, nxt; int ui = 0;
    if (!S.next(0, cur)) return;
    f32x4 acc[2][2][4][2];
#pragma unroll
    for (int a = 0; a < 2; ++a)
#pragma unroll
        for (int b = 0; b < 2; ++b)
#pragma unroll
            for (int m = 0; m < 4; ++m)
#pragma unroll
                for (int n = 0; n < 2; ++n) acc[a][b][m][n] = (f32x4){0.f, 0.f, 0.f, 0.f};
    bf16x8 At[4][2], B0[2][2], B1[2][2];
    const char* cA; const char* cB;
    PG8_PTRS(cur, cA, cB);
    PG8_STAGE(PG8_SB(0, 0), cB, voffB); PG8_STAGE(PG8_SA(0, 0), cA, voffA); PG8_STAGE(PG8_SB(0, 1), cB + hstep, voffB); PG8_STAGE(PG8_SA(0, 1), cA + hstep, voffA);
    if (wr == 1) PG8_BAR;
    PG8_WAIT_V(4); PG8_BAR;
    PG8_STAGE(PG8_SB(1, 0), cB + kstep, voffB); PG8_STAGE(PG8_SA(1, 0), cA + kstep, voffA); PG8_STAGE(PG8_SB(1, 1), cB + hstep + kstep, voffB);
    PG8_WAIT_V(6); PG8_BAR;
    for (;;) {
        const bool has_next = S.next(ui + 1, nxt);
        const char* nA = cA; const char* nB = cB;
        if (has_next) PG8_PTRS(nxt, nA, nB);
        for (int t = 0; t < nt; t += 2) {
            const bool last = (t == nt - 2);
            const char* a1 = cA + (size_t)(t + 1) * kstep;
            const char* a2 = last ? nA : cA + (size_t)(t + 2) * kstep; const char* b2 = last ? nB : cB + (size_t)(t + 2) * kstep;
            const char* a3 = a2 + kstep; const char* b3 = b2 + kstep;
            PG8_LDB(B0, 0, 0); PG8_SCHED; PG8_LDA(At, 0, 0); PG8_STAGE(PG8_SA(1, 1), a1 + hstep, voffA);
            PG8_WAIT_L(8); PG8_BAR; PG8_WAIT_L(0); PG8_MMA(0, 0, At, B0); PG8_BAR; PG8_SCHED;
            PG8_LDB(B1, 0, 1); PG8_STAGE(PG8_SB(0, 0), b2, voffB);
            PG8_BAR; PG8_WAIT_L(0); PG8_MMA(0, 1, At, B1); PG8_BAR;
            PG8_LDA(At, 0, 1); PG8_STAGE(PG8_SA(0, 0), a2, voffA);
            PG8_BAR; PG8_WAIT_L(0); PG8_MMA(1, 0, At, B0); PG8_BAR; PG8_SCHED;
            PG8_STAGE(PG8_SB(0, 1), b2 + hstep, voffB);
            PG8_WAIT_V(6); PG8_BAR; PG8_MMA(1, 1, At, B1); PG8_BAR;
            PG8_LDB(B0, 1, 0); PG8_SCHED; PG8_LDA(At, 1, 0); PG8_STAGE(PG8_SA(0, 1), a2 + hstep, voffA);
            PG8_WAIT_L(8); PG8_BAR; PG8_WAIT_L(0); PG8_MMA(0, 0, At, B0); PG8_BAR; PG8_SCHED;
            PG8_LDB(B1, 1, 1); PG8_STAGE(PG8_SB(1, 0), b3, voffB);
            PG8_BAR; PG8_WAIT_L(0); PG8_MMA(0, 1, At, B1); PG8_BAR;
            PG8_LDA(At, 1, 1); PG8_STAGE(PG8_SA(1, 0), a3, voffA);
            PG8_BAR; PG8_WAIT_L(0); PG8_MMA(1, 0, At, B0); PG8_BAR; PG8_SCHED;
            PG8_STAGE(PG8_SB(1, 1), b3 + hstep, voffB);
            PG8_WAIT_V(6); PG8_BAR; PG8_MMA(1, 1, At, B1); PG8_BAR;
        }
        E(acc, cur, wr, wc, fr, fq);
        if (!has_next) break;
#pragma unroll
        for (int a = 0; a < 2; ++a)
#pragma unroll
            for (int b = 0; b < 2; ++b)
#pragma unroll
                for (int m = 0; m < 4; ++m)
#pragma unroll
                    for (int n = 0; n < 2; ++n) acc[a][b][m][n] = (f32x4){0.f, 0.f, 0.f, 0.f};
        cur = nxt; cA = nA; cB = nB; ++ui;
    }
    PG8_WAIT_V(0);
    if (wr == 0) PG8_BAR;
    PG8_BAR;
#undef PG8_SA
#undef PG8_SB
#undef PG8_STAGE
#undef PG8_LDA
#undef PG8_LDB
#undef PG8_MMA
#undef PG8_WAIT_V
#undef PG8_WAIT_L
#undef PG8_BAR
#undef PG8_SCHED
#undef PG8_PTRS
}
}
using pg8::Unit;

struct EpiF32 {
    float* C; int ldc;
    __device__ __forceinline__ static bool swap(const Unit&) { return false; }
    __device__ __forceinline__ void operator()(const f32x4 (&acc)[2][2][4][2], const Unit& u, int wr, int wc, int fr, int fq) const {
        const int row0 = u.pm * 256 + wr * 64 + fr, col0 = u.pn * 256 + wc * 32 + 4 * fq;
#pragma unroll
        for (int ai = 0; ai < 2; ++ai)
#pragma unroll
            for (int m = 0; m < 4; ++m) { float* rowp = C + (size_t)(row0 + ai * 128 + m * 16) * ldc + col0;
#pragma unroll
                for (int bj = 0; bj < 2; ++bj)
#pragma unroll
                    for (int n = 0; n < 2; ++n) *(f32x4*)(rowp + bj * 128 + n * 16) = acc[ai][bj][m][n]; }
    }
};
struct EpiB16 {
    bf16_t* C; int ldc;
    __device__ __forceinline__ static bool swap(const Unit&) { return false; }
    __device__ __forceinline__ void operator()(const f32x4 (&acc)[2][2][4][2], const Unit& u, int wr, int wc, int fr, int fq) const {
        const int row0 = u.pm * 256 + wr * 64 + fr, col0 = u.pn * 256 + wc * 32 + 4 * fq;
#pragma unroll
        for (int ai = 0; ai < 2; ++ai)
#pragma unroll
            for (int m = 0; m < 4; ++m) { bf16_t* rowp = C + (size_t)(row0 + ai * 128 + m * 16) * ldc + col0;
#pragma unroll
                for (int bj = 0; bj < 2; ++bj)
#pragma unroll
                    for (int n = 0; n < 2; ++n) *(u32x2*)(rowp + bj * 128 + n * 16) = pk4(acc[ai][bj][m][n]); }
    }
};
template <bool OB16> struct EpiGate {
    const bf16_t* X1; const bf16_t* PLE; float* O; bf16_t* Ob;
    __device__ __forceinline__ static bool swap(const Unit&) { return false; }
    __device__ __forceinline__ void operator()(const f32x4 (&acc)[2][2][4][2], const Unit& u, int wr, int wc, int fr, int fq) const {
        const int row0 = u.pm * 256 + wr * 64 + fr, col0 = u.pn * 256 + wc * 32 + 4 * fq;
#pragma unroll
        for (int ai = 0; ai < 2; ++ai)
#pragma unroll
            for (int m = 0; m < 4; ++m) { const size_t ro = (size_t)(row0 + ai * 128 + m * 16) * 1024 + col0;
#pragma unroll
                for (int bj = 0; bj < 2; ++bj)
#pragma unroll
                    for (int n = 0; n < 2; ++n) { const size_t o = ro + bj * 128 + n * 16; const f32x4 a = acc[ai][bj][m][n]; const u32x2 xw = *(const u32x2*)(X1 + o), pw = *(const u32x2*)(PLE + o);
                        const f32x4 x1 = {bflo(xw.x), bfhi(xw.x), bflo(xw.y), bfhi(xw.y)}, pl = {bflo(pw.x), bfhi(pw.x), bflo(pw.y), bfhi(pw.y)}; f32x4 r;
#pragma unroll
                        for (int j = 0; j < 4; ++j) r[j] = x1[j] + sigmoid_f(a[j]) * pl[j];
                        if (OB16) *(u32x2*)(Ob + o) = pk4(r); else *(f32x4*)(O + o) = r; } }
    }
};
struct EpiInAttn {
    bf16_t *Zq, *Zk, *Zg, *vTp, *vTs; const float* tab; float* out;
    __device__ __forceinline__ static bool swap(const Unit& u) { return u.pn == 5; }
    __device__ __forceinline__ void operator()(const f32x4 (&acc)[2][2][4][2], const Unit& u, int wr, int wc, int fr, int fq) const {
        const int pn = u.pn;
        if (pn < 5) {
            const bool isq = pn < 4;
            const int fi = 16 * (wc & 1) + 4 * fq;
#pragma unroll
            for (int ai = 0; ai < 2; ++ai)
#pragma unroll
                for (int m = 0; m < 4; ++m) {
                    const int r = u.pm * 256 + ai * 128 + wr * 64 + m * 16 + fr;
                    const int pi = r < MP ? (r & 4095) : 4096 + ((r - MP) & 7);
                    const f32x4 t0 = *(const f32x4*)(tab + ((size_t)pi * 32 + fi) * 2), t1 = *(const f32x4*)(tab + ((size_t)pi * 32 + fi) * 2 + 4);
                    const float cs[4] = {t0[0], t0[2], t1[0], t1[2]}, sn[4] = {t0[1], t0[3], t1[1], t1[3]};
#pragma unroll
                    for (int bj = 0; bj < 2; ++bj) {
                        const f32x4 x1 = acc[ai][bj][m][0], x2 = acc[ai][bj][m][1]; f32x4 o1, o2;
#pragma unroll
                        for (int j = 0; j < 4; ++j) { o1[j] = x1[j] * cs[j] - x2[j] * sn[j]; o2[j] = x2[j] * cs[j] + x1[j] * sn[j]; }
                        const int hh = 2 * bj + (wc >> 1), d1 = 16 * (wc & 1) + 4 * fq;
                        if (isq) {
                            bf16_t* p = Zq + (size_t)r * 1024 + pn * 256 + hh * 64 + d1;
                            *(u32x2*)p = pk4(o1 * 0.125f); *(u32x2*)(p + 32) = pk4(o2 * 0.125f);
                        } else {
                            bf16_t* p = Zk + (size_t)r * 256 + hh * 64 + d1;
                            *(u32x2*)p = pk4(o1); *(u32x2*)(p + 32) = pk4(o2);
                            if (r < MP) { const int t = r & 4095; if (t >= 3968) { float* dst = out + OFF_KWP + ((size_t)((r >> 12) * 128 + t - 3968) * 4 + hh) * 64 + d1; *(f32x4*)dst = o1; *(f32x4*)(dst + 32) = o2; } }
                            else { const int rs = r - MP; float* dst = out + OFF_KWS + ((size_t)((rs >> 3) * 128 + 120 + (rs & 7)) * 4 + hh) * 64 + d1; *(f32x4*)dst = o1; *(f32x4*)(dst + 32) = o2; }
                        }
                    }
                    asm volatile("" ::: "memory");
                }
        } else if (pn == 5) {
#pragma unroll
            for (int ai = 0; ai < 2; ++ai)
#pragma unroll
                for (int m = 0; m < 4; ++m) {
                    const int e = ai * 128 + wr * 64 + m * 16 + fr, kvh = e >> 6, d = e & 63;
#pragma unroll
                    for (int bj = 0; bj < 2; ++bj)
#pragma unroll
                        for (int n = 0; n < 2; ++n) {
                            const int tok = u.pm * 256 + bj * 128 + wc * 32 + n * 16 + 4 * fq; const f32x4 v = acc[ai][bj][m][n];
                            if (tok < MP) { const int b = tok >> 12, t = tok & 4095;
                                *(u32x2*)(vTp + ((size_t)((b * 4 + kvh) * 64 + d)) * 4096 + t) = pk4(v);
                                if (t >= 3968) {
#pragma unroll
                                    for (int jj = 0; jj < 4; ++jj) out[OFF_VWP + ((size_t)(b * 128 + t - 3968 + jj) * 4 + kvh) * 64 + d] = v[jj]; }
                            } else { const int ts = tok - MP, bs = ts >> 3, l0 = ts & 7;
                                *(u32x2*)(vTs + ((size_t)((bs * 4 + kvh) * 64 + d)) * 8 + l0) = pk4(v);
#pragma unroll
                                for (int jj = 0; jj < 4; ++jj) out[OFF_VWS + ((size_t)(bs * 128 + 120 + l0 + jj) * 4 + kvh) * 64 + d] = v[jj]; }
                        }
                }
        } else {
#pragma unroll
            for (int ai = 0; ai < 2; ++ai)
#pragma unroll
                for (int m = 0; m < 4; ++m) { const int r = u.pm * 256 + ai * 128 + wr * 64 + m * 16 + fr;
#pragma unroll
                    for (int bj = 0; bj < 2; ++bj)
#pragma unroll
                        for (int n = 0; n < 2; ++n) { const f32x4 a = acc[ai][bj][m][n]; f32x4 s;
#pragma unroll
                            for (int j = 0; j < 4; ++j) s[j] = silu_f(a[j]);
                            *(u32x2*)(Zg + (size_t)r * 1024 + (pn - 6) * 256 + bj * 128 + wc * 32 + n * 16 + 4 * fq) = pk4(s); } }
        }
    }
};
struct EpiInRet {
    bf16_t *Zq, *Zk, *Zg, *vTp, *vTs; const float* tab;
    __device__ __forceinline__ static bool swap(const Unit& u) { return u.pn >= 8 && u.pn < 16; }
    __device__ __forceinline__ void operator()(const f32x4 (&acc)[2][2][4][2], const Unit& u, int wr, int wc, int fr, int fq) const {
        const int pn = u.pn;
        if (pn < 8) {
            const bool isq = pn < 4; const float sc = isq ? 1.f : 0.0625f;
            bf16_t* Z = isq ? Zq : Zk; const int hc = (pn & 3) * 256;
#pragma unroll
            for (int ai = 0; ai < 2; ++ai)
#pragma unroll
                for (int m = 0; m < 4; ++m) {
                    const int r = u.pm * 256 + ai * 128 + wr * 64 + m * 16 + fr;
                    const int pi = r < MP ? (r & 4095) : 4096 + ((r - MP) & 7);
#pragma unroll
                    for (int n = 0; n < 2; ++n) {
                        const int d = wc * 32 + n * 16 + 4 * fq;
                        const f32x4 t0 = *(const f32x4*)(tab + ((size_t)pi * 128 + d) * 2), t1 = *(const f32x4*)(tab + ((size_t)pi * 128 + d) * 2 + 4);
                        const float cs[4] = {t0[0], t0[2], t1[0], t1[2]}, sn[4] = {t0[1], t0[3], t1[1], t1[3]};
                        const f32x4 x1 = acc[ai][0][m][n], x2 = acc[ai][1][m][n]; f32x4 o1, o2;
#pragma unroll
                        for (int j = 0; j < 4; ++j) { o1[j] = (x1[j] * cs[j] - x2[j] * sn[j]) * sc; o2[j] = (x2[j] * cs[j] + x1[j] * sn[j]) * sc; }
                        bf16_t* p = Z + (size_t)r * 1024 + hc + d;
                        *(u32x2*)p = pk4(o1); *(u32x2*)(p + 128) = pk4(o2);
                    }
                }
        } else if (pn < 16) {
#pragma unroll
            for (int ai = 0; ai < 2; ++ai)
#pragma unroll
                for (int m = 0; m < 4; ++m) {
                    const int eg = (pn - 8) * 256 + ai * 128 + wr * 64 + m * 16 + fr, h = eg >> 9, e = eg & 511;
#pragma unroll
                    for (int bj = 0; bj < 2; ++bj)
#pragma unroll
                        for (int n = 0; n < 2; ++n) {
                            const int tok = u.pm * 256 + bj * 128 + wc * 32 + n * 16 + 4 * fq; const u32x2 w = pk4(acc[ai][bj][m][n]);
                            if (tok < MP) { const int b = tok >> 12, t = tok & 4095; *(u32x2*)(vTp + ((size_t)((b * 4 + h) * 512 + e)) * 4096 + t) = w; }
                            else { const int ts = tok - MP, bs = ts >> 3, l0 = ts & 7; *(u32x2*)(vTs + ((size_t)((bs * 4 + h) * 512 + e)) * 8 + l0) = w; }
                        }
                }
        } else {
#pragma unroll
            for (int ai = 0; ai < 2; ++ai)
#pragma unroll
                for (int m = 0; m < 4; ++m) { const int r = u.pm * 256 + ai * 128 + wr * 64 + m * 16 + fr;
#pragma unroll
                    for (int bj = 0; bj < 2; ++bj)
#pragma unroll
                        for (int n = 0; n < 2; ++n) { const f32x4 a = acc[ai][bj][m][n]; f32x4 s;
#pragma unroll
                            for (int j = 0; j < 4; ++j) s[j] = silu_f(a[j]);
                            *(u32x2*)(Zg + (size_t)r * 2048 + (pn - 16) * 256 + bj * 128 + wc * 32 + n * 16 + 4 * fq) = pk4(s); } }
        }
    }
};

__device__ __forceinline__ void transpose_tile(const float* __restrict__ W, bf16_t* __restrict__ Wt, int K, int N, bool perm, int tile, LAS float* T) {
    const int tid = otid(), ntn = N >> 6;
    const int n0 = (tile % ntn) * 64, k0 = (tile / ntn) * 64, nn = tid & 63;
    const int nd = n0 + nn; int ns = nd;
    if (perm && nd < 1280) { const int p = nd & 63; ns = (nd - p) + (p >> 5) * 16 + (p & 15) + ((p >> 4) & 1) * 32; }
#pragma unroll
    for (int i = 0; i < 8; ++i) { const int kk = (tid >> 6) + 8 * i; T[kk * 65 + nn] = W[(size_t)(k0 + kk) * N + ns]; }
    __syncthreads();
    const int kk2 = (tid & 31) * 2;
#pragma unroll
    for (int i = 0; i < 4; ++i) { const int n2 = (tid >> 5) + 16 * i; *(unsigned*)(Wt + (size_t)(n0 + n2) * K + k0 + kk2) = cvt_pk_bf16(T[kk2 * 65 + n2], T[(kk2 + 1) * 65 + n2]); }
    __syncthreads();
}

__device__ __forceinline__ void rms_rows(const float* __restrict__ Xa, const float* __restrict__ Xb, const float* __restrict__ g, bf16_t* __restrict__ H, int G) {
    const int tid_o = otid(), wave = tid_o >> 6, lane = tid_o & 63;
    for (int row = blockIdx.x * 8 + wave; row < MT; row += G * 8) {
        const float* x = row < MP ? Xa + (size_t)row * 1024 : Xb + (size_t)(row - MP) * 1024;
        f32x4 v[4]; float ss = 0.f;
#pragma unroll
        for (int i = 0; i < 4; ++i) { v[i] = *(const f32x4*)(x + lane * 4 + 256 * i); ss += v[i][0] * v[i][0] + v[i][1] * v[i][1] + v[i][2] * v[i][2] + v[i][3] * v[i][3]; }
        ss = wave_sum(ss);
        const float rr = rsqrtf(ss * (1.f / 1024.f) + EPS);
#pragma unroll
        for (int i = 0; i < 4; ++i) { const f32x4 gg = *(const f32x4*)(g + lane * 4 + 256 * i); *(u32x2*)(H + (size_t)row * 1024 + lane * 4 + 256 * i) = pk4(v[i] * rr * gg); }
    }
}
__device__ __forceinline__ void rms_rows_b16(const bf16_t* __restrict__ X, const float* __restrict__ g, bf16_t* __restrict__ H, int G) {
    const int tid_o = otid(), wave = tid_o >> 6, lane = tid_o & 63;
    for (int row = blockIdx.x * 8 + wave; row < MT; row += G * 8) {
        const u32x4 a = *(const u32x4*)(X + (size_t)row * 1024 + lane * 8), b = *(const u32x4*)(X + (size_t)row * 1024 + 512 + lane * 8);
        const float v[16] = {bflo(a.x), bfhi(a.x), bflo(a.y), bfhi(a.y), bflo(a.z), bfhi(a.z), bflo(a.w), bfhi(a.w), bflo(b.x), bfhi(b.x), bflo(b.y), bfhi(b.y), bflo(b.z), bfhi(b.z), bflo(b.w), bfhi(b.w)};
        float ss = 0.f;
#pragma unroll
        for (int i = 0; i < 16; ++i) ss += v[i] * v[i];
        ss = wave_sum(ss);
        const float rr = rsqrtf(ss * (1.f / 1024.f) + EPS);
#pragma unroll
        for (int hh = 0; hh < 2; ++hh) { const int c = hh * 512 + lane * 8; const f32x4 g0 = *(const f32x4*)(g + c), g1 = *(const f32x4*)(g + c + 4); u32x4 o;
            o.x = cvt_pk_bf16(v[hh * 8 + 0] * rr * g0[0], v[hh * 8 + 1] * rr * g0[1]); o.y = cvt_pk_bf16(v[hh * 8 + 2] * rr * g0[2], v[hh * 8 + 3] * rr * g0[3]);
            o.z = cvt_pk_bf16(v[hh * 8 + 4] * rr * g1[0], v[hh * 8 + 5] * rr * g1[1]); o.w = cvt_pk_bf16(v[hh * 8 + 6] * rr * g1[2], v[hh * 8 + 7] * rr * g1[3]);
            *(u32x4*)(H + (size_t)row * 1024 + c) = o; }
    }
}
template <bool XB16>
__device__ __forceinline__ void resid_rows(const float* __restrict__ Xa, const float* __restrict__ Xb, const bf16_t* __restrict__ Xh, const bf16_t* __restrict__ Y, const float* __restrict__ g, bf16_t* __restrict__ H, int G) {
    const int tid_o = otid(), wave = tid_o >> 6, lane = tid_o & 63;
    for (int row = blockIdx.x * 8 + wave; row < MT; row += G * 8) {
        const bf16_t* y = Y + (size_t)row * 1024;
        f32x4 v[4]; float ss = 0.f;
#pragma unroll
        for (int i = 0; i < 4; ++i) { const u32x2 yw = *(const u32x2*)(y + lane * 4 + 256 * i); v[i] = (f32x4){bflo(yw.x), bfhi(yw.x), bflo(yw.y), bfhi(yw.y)}; ss += v[i][0] * v[i][0] + v[i][1] * v[i][1] + v[i][2] * v[i][2] + v[i][3] * v[i][3]; }
        ss = wave_sum(ss);
        const float rr = rsqrtf(ss * (1.f / 1024.f) + EPS);
#pragma unroll
        for (int i = 0; i < 4; ++i) { const int c = lane * 4 + 256 * i; const f32x4 gg = *(const f32x4*)(g + c); f32x4 xx;
            if (XB16) { const u32x2 xw = *(const u32x2*)(Xh + (size_t)row * 1024 + c); xx = (f32x4){bflo(xw.x), bfhi(xw.x), bflo(xw.y), bfhi(xw.y)}; }
            else xx = *(const f32x4*)((row < MP ? Xa + (size_t)row * 1024 : Xb + (size_t)(row - MP) * 1024) + c);
            *(u32x2*)(H + (size_t)row * 1024 + c) = pk4(xx + v[i] * rr * gg); }
    }
}

struct SkF32 { float* C; __device__ __forceinline__ void operator()(int row, int col, f32x4 v) const { *(f32x4*)(C + (size_t)row * 1024 + col) = v; } };
struct SkB16 { bf16_t* C; __device__ __forceinline__ void operator()(int row, int col, f32x4 v) const { *(u32x2*)(C + (size_t)row * 1024 + col) = pk4(v); } };
template <bool OB16> struct SkGate { const bf16_t* X1; const bf16_t* PLE; float* O; bf16_t* Ob;
    __device__ __forceinline__ void operator()(int row, int col, f32x4 a) const { const size_t o = (size_t)row * 1024 + col; const u32x2 xw = *(const u32x2*)(X1 + o), pw = *(const u32x2*)(PLE + o);
        const f32x4 x1 = {bflo(xw.x), bfhi(xw.x), bflo(xw.y), bfhi(xw.y)}, pl = {bflo(pw.x), bfhi(pw.x), bflo(pw.y), bfhi(pw.y)}; f32x4 r;
#pragma unroll
        for (int j = 0; j < 4; ++j) r[j] = x1[j] + sigmoid_f(a[j]) * pl[j];
        if (OB16) *(u32x2*)(Ob + o) = pk4(r); else *(f32x4*)(O + o) = r; } };
template <class Epi>
__device__ __forceinline__ void skinny_gemm(LAS unsigned char* lds, const bf16_t* __restrict__ A, const bf16_t* __restrict__ Bt, int K, const Epi& E, int G) {
    LAS float* red = (LAS float*)lds;
    const int tid = otid(), w = tid >> 6, lane = tid & 63, l16 = lane & 15, g = lane >> 4;
    const int KS = K >> 3, nks = KS >> 5;
    for (int u = blockIdx.x; u < 256; u += G) {
        const int row0 = (u >> 4) * 64, col0 = (u & 15) * 64;
        const bf16_t* ap = A + (size_t)(row0 + l16) * K + w * KS + 8 * g;
        const bf16_t* bp = Bt + (size_t)(col0 + l16) * K + w * KS + 8 * g;
        f32x4 acc[4][4];
#pragma unroll
        for (int mt = 0; mt < 4; ++mt)
#pragma unroll
            for (int nt = 0; nt < 4; ++nt) acc[mt][nt] = (f32x4){0.f, 0.f, 0.f, 0.f};
#pragma unroll 4
        for (int ks = 0; ks < nks; ++ks) {
            bf16x8 af[4], bf[4];
#pragma unroll
            for (int t = 0; t < 4; ++t) { af[t] = *(const bf16x8*)(ap + (size_t)(16 * t) * K + 32 * ks); bf[t] = *(const bf16x8*)(bp + (size_t)(16 * t) * K + 32 * ks); }
#pragma unroll
            for (int mt = 0; mt < 4; ++mt)
#pragma unroll
                for (int nt = 0; nt < 4; ++nt) acc[mt][nt] = __builtin_amdgcn_mfma_f32_16x16x32_bf16(bf[nt], af[mt], acc[mt][nt], 0, 0, 0);
        }
        __syncthreads();
#pragma unroll
        for (int mt = 0; mt < 4; ++mt)
#pragma unroll
            for (int nt = 0; nt < 4; ++nt) *(LAS f32x4*)(red + (w * 64 + 16 * mt + l16) * 68 + 16 * nt + 4 * g) = acc[mt][nt];
        __syncthreads();
#pragma unroll
        for (int j = 0; j < 2; ++j) { const int q = tid + 512 * j, row = q >> 4, c4 = (q & 15) * 4; f32x4 sum = *(const LAS f32x4*)(red + row * 68 + c4);
#pragma unroll
            for (int ww = 1; ww < 8; ++ww) sum += *(const LAS f32x4*)(red + (ww * 64 + row) * 68 + c4);
            E(row0 + row, col0 + c4, sum); }
    }
}

__device__ __forceinline__ void attn_prompt(LAS unsigned char* lds, const bf16_t* __restrict__ Zq, const bf16_t* __restrict__ Zk, const bf16_t* __restrict__ Zg, const bf16_t* __restrict__ vTp,
                                            const float* __restrict__ sinks, bf16_t* __restrict__ OG, int G) {
    LAS bf16_t* Ks = (LAS bf16_t*)lds;
    LAS bf16_t* Vt = (LAS bf16_t*)(lds + 256 * 72 * 2);
    const int tid = otid(), w = tid >> 6, lane = tid & 63, l16 = lane & 15, g = lane >> 4;
    for (int it = blockIdx.x; it < 512; it += G) {
        const int kvh = it & 3, nb = (it >> 2) & 31, b = it >> 7;
        __syncthreads();
#pragma unroll
        for (int i = 0; i < 4; ++i) { const int ch = tid + 512 * i, s = ch >> 3, c8 = ch & 7, t = (nb - 1) * 128 + s;
            u32x4 val = {0u, 0u, 0u, 0u}; if (t >= 0) val = *(const u32x4*)(Zk + (size_t)(b * 4096 + t) * 256 + kvh * 64 + c8 * 8);
            *(LAS u32x4*)(Ks + s * 72 + c8 * 8) = val; }
#pragma unroll
        for (int i = 0; i < 4; ++i) { const int ch = tid + 512 * i, d = ch >> 5, s0 = (ch & 31) * 8, t0 = (nb - 1) * 128 + s0;
            u32x4 val = {0u, 0u, 0u, 0u}; if (t0 >= 0) val = *(const u32x4*)(vTp + ((size_t)((b * 4 + kvh) * 64 + d)) * 4096 + t0);
            *(LAS u32x4*)(Vt + d * 264 + s0) = val; }
        __syncthreads();
        const int head = kvh * 4 + (w >> 1);
        const float sk = sinks[head];
        for (int qi = 0; qi < 4; ++qi) {
            const int qt = (w & 1) * 4 + qi;
            const size_t tq = (size_t)b * 4096 + nb * 128 + qt * 16 + l16;
            bf16x8 qf[2];
#pragma unroll
            for (int ks = 0; ks < 2; ++ks) qf[ks] = *(const bf16x8*)(Zq + tq * 1024 + head * 64 + ks * 32 + g * 8);
            f32x4 sa[9];
#pragma unroll
            for (int j = 0; j < 9; ++j) { sa[j] = (f32x4){0.f, 0.f, 0.f, 0.f};
#pragma unroll
                for (int ks = 0; ks < 2; ++ks) { const bf16x8 kf = *(const LAS bf16x8*)(Ks + (16 * (qt + j) + l16) * 72 + ks * 32 + g * 8);
                    sa[j] = __builtin_amdgcn_mfma_f32_16x16x32_bf16(kf, qf[ks], sa[j], 0, 0, 0); } }
            float mx = sk;
#pragma unroll
            for (int j = 0; j < 9; ++j)
#pragma unroll
                for (int r = 0; r < 4; ++r) {
                    bool vis = true;
                    if (j == 0) vis = (4 * g + r) > l16;
                    if (j == 8) vis = (4 * g + r) <= l16;
                    if (nb == 0 && (qt + j) < 8) vis = false;
                    sa[j][r] = vis ? sa[j][r] : -1e30f;
                    mx = fmaxf(mx, sa[j][r]);
                }
            mx = fmaxf(mx, __shfl_xor(mx, 16, 64)); mx = fmaxf(mx, __shfl_xor(mx, 32, 64));
            float sum = 0.f;
#pragma unroll
            for (int j = 0; j < 9; ++j)
#pragma unroll
                for (int r = 0; r < 4; ++r) { const float p = __expf(sa[j][r] - mx); sa[j][r] = p; sum += p; }
            sum += __shfl_xor(sum, 16, 64); sum += __shfl_xor(sum, 32, 64);
            const float inv = 1.f / (sum + __expf(sk - mx));
            f32x4 oa[4];
#pragma unroll
            for (int dt = 0; dt < 4; ++dt) oa[dt] = (f32x4){0.f, 0.f, 0.f, 0.f};
#pragma unroll
            for (int u = 0; u < 5; ++u) {
                u32x4 pw; pw.x = cvt_pk_bf16(sa[2 * u][0], sa[2 * u][1]); pw.y = cvt_pk_bf16(sa[2 * u][2], sa[2 * u][3]);
                if (u < 4) { pw.z = cvt_pk_bf16(sa[2 * u + 1][0], sa[2 * u + 1][1]); pw.w = cvt_pk_bf16(sa[2 * u + 1][2], sa[2 * u + 1][3]); } else { pw.z = 0u; pw.w = 0u; }
                const bf16x8 pf = __builtin_bit_cast(bf16x8, pw);
                const int k0 = 16 * (qt + 2 * u) + 4 * g, k1 = (u < 4) ? k0 + 16 : k0;
#pragma unroll
                for (int dt = 0; dt < 4; ++dt) {
                    const u32x2 v0 = *(const LAS u32x2*)(Vt + (16 * dt + l16) * 264 + k0), v1 = *(const LAS u32x2*)(Vt + (16 * dt + l16) * 264 + k1);
                    u32x4 vw; vw.x = v0.x; vw.y = v0.y; vw.z = v1.x; vw.w = v1.y;
                    oa[dt] = __builtin_amdgcn_mfma_f32_16x16x32_bf16(__builtin_bit_cast(bf16x8, vw), pf, oa[dt], 0, 0, 0);
                }
            }
#pragma unroll
            for (int dt = 0; dt < 4; ++dt) {
                const size_t o = tq * 1024 + head * 64 + 16 * dt + 4 * g;
                const u32x2 gw = *(const u32x2*)(Zg + o);
                f32x4 r; r[0] = oa[dt][0] * inv * bflo(gw.x); r[1] = oa[dt][1] * inv * bfhi(gw.x); r[2] = oa[dt][2] * inv * bflo(gw.y); r[3] = oa[dt][3] * inv * bfhi(gw.y);
                *(u32x2*)(OG + o) = pk4(r);
            }
        }
    }
}

__device__ __forceinline__ void attn_sample(LAS unsigned char* lds, const Params& P, const bf16_t* __restrict__ Zq, const bf16_t* __restrict__ Zk, const bf16_t* __restrict__ Zg, const bf16_t* __restrict__ vTs,
                                            bf16_t* __restrict__ OG, int G) {
    constexpr int KS_B = 144 * 72 * 2, VT_B = 64 * 152 * 2, SLOT_B = KS_B + VT_B;
    for (int pr = blockIdx.x; pr < 256; pr += G) {
        const int tid = otid(), w = tid >> 6, lane = tid & 63, l16 = lane & 15, g = lane >> 4;
        __syncthreads();
#pragma unroll
        for (int sl = 0; sl < 2; ++sl) {
            const int it = 2 * pr + sl, bs = it >> 2, kvh = it & 3;
            LAS bf16_t* Ks = (LAS bf16_t*)(lds + sl * SLOT_B); LAS bf16_t* Vt = (LAS bf16_t*)(lds + sl * SLOT_B + KS_B);
#pragma unroll
            for (int i = 0; i < 4; ++i) { const int ch = tid + 512 * i, j = ch >> 4, d4 = (ch & 15) * 4;
                const size_t src = ((size_t)(bs * 128 + j) * 4 + kvh) * 64 + d4;
                const f32x4 kv = *(const f32x4*)(P.cache_k + src), vv = *(const f32x4*)(P.cache_v + src);
                if (j >= 8) { const size_t dst = ((size_t)(bs * 128 + j - 8) * 4 + kvh) * 64 + d4; *(f32x4*)(P.out + OFF_KWS + dst) = kv; *(f32x4*)(P.out + OFF_VWS + dst) = vv; }
                *(LAS u32x2*)(Ks + j * 72 + d4) = pk4(kv);
                const u32x2 vw = pk4(vv);
                Vt[(d4 + 0) * 152 + j] = (bf16_t)(vw.x & 0xffffu); Vt[(d4 + 1) * 152 + j] = (bf16_t)(vw.x >> 16); Vt[(d4 + 2) * 152 + j] = (bf16_t)(vw.y & 0xffffu); Vt[(d4 + 3) * 152 + j] = (bf16_t)(vw.y >> 16); }
            { const int l = tid >> 6, d = tid & 63;
              Ks[(128 + l) * 72 + d] = Zk[(size_t)(MP + bs * 8 + l) * 256 + kvh * 64 + d]; Ks[(136 + l) * 72 + d] = 0; }
            if (tid < 64) { const u32x4 nv = *(const u32x4*)(vTs + ((size_t)((bs * 4 + kvh) * 64 + tid)) * 8);
                *(LAS u32x4*)(Vt + tid * 152 + 128) = nv; *(LAS u32x4*)(Vt + tid * 152 + 136) = (u32x4){0u, 0u, 0u, 0u}; *(LAS u32x4*)(Vt + tid * 152 + 144) = (u32x4){0u, 0u, 0u, 0u}; }
        }
        __syncthreads();
        if (w < 4) {
            const int sl = w >> 1, t = w & 1, it = 2 * pr + sl, bs = it >> 2, kvh = it & 3;
            const LAS bf16_t* Ks = (const LAS bf16_t*)(lds + sl * SLOT_B); const LAS bf16_t* Vt = (const LAS bf16_t*)(lds + sl * SLOT_B + KS_B);
            const int hq = 2 * t + (l16 >> 3), l = l16 & 7, head = kvh * 4 + hq;
            const size_t tq = (size_t)(MP + bs * 8 + l);
            const float sk = P.sinks[head];
            bf16x8 qf[2];
#pragma unroll
            for (int ks = 0; ks < 2; ++ks) qf[ks] = *(const bf16x8*)(Zq + tq * 1024 + head * 64 + ks * 32 + g * 8);
            f32x4 sa[9];
#pragma unroll
            for (int j = 0; j < 9; ++j) { sa[j] = (f32x4){0.f, 0.f, 0.f, 0.f};
#pragma unroll
                for (int ks = 0; ks < 2; ++ks) { const bf16x8 kf = *(const LAS bf16x8*)(Ks + (16 * j + l16) * 72 + ks * 32 + g * 8);
                    sa[j] = __builtin_amdgcn_mfma_f32_16x16x32_bf16(kf, qf[ks], sa[j], 0, 0, 0); } }
            float mx = sk;
#pragma unroll
            for (int j = 0; j < 9; ++j)
#pragma unroll
                for (int r = 0; r < 4; ++r) { const int key = 16 * j + 4 * g + r;
                    const bool vis = (j < 8) ? (key > l) : (key - 128 <= l);
                    sa[j][r] = vis ? sa[j][r] : -1e30f; mx = fmaxf(mx, sa[j][r]); }
            mx = fmaxf(mx, __shfl_xor(mx, 16, 64)); mx = fmaxf(mx, __shfl_xor(mx, 32, 64));
            float sum = 0.f;
#pragma unroll
            for (int j = 0; j < 9; ++j)
#pragma unroll
                for (int r = 0; r < 4; ++r) { const float p = __expf(sa[j][r] - mx); sa[j][r] = p; sum += p; }
            sum += __shfl_xor(sum, 16, 64); sum += __shfl_xor(sum, 32, 64);
            const float inv = 1.f / (sum + __expf(sk - mx));
            f32x4 oa[4];
#pragma unroll
            for (int dt = 0; dt < 4; ++dt) oa[dt] = (f32x4){0.f, 0.f, 0.f, 0.f};
#pragma unroll
            for (int u = 0; u < 5; ++u) {
                u32x4 pw; pw.x = cvt_pk_bf16(sa[2 * u][0], sa[2 * u][1]); pw.y = cvt_pk_bf16(sa[2 * u][2], sa[2 * u][3]);
                if (u < 4) { pw.z = cvt_pk_bf16(sa[2 * u + 1][0], sa[2 * u + 1][1]); pw.w = cvt_pk_bf16(sa[2 * u + 1][2], sa[2 * u + 1][3]); } else { pw.z = 0u; pw.w = 0u; }
                const bf16x8 pf = __builtin_bit_cast(bf16x8, pw);
                const int k0 = 32 * u + 4 * g, k1 = (u < 4) ? k0 + 16 : k0;
#pragma unroll
                for (int dt = 0; dt < 4; ++dt) {
                    const u32x2 v0 = *(const LAS u32x2*)(Vt + (16 * dt + l16) * 152 + k0), v1 = *(const LAS u32x2*)(Vt + (16 * dt + l16) * 152 + k1);
                    u32x4 vw; vw.x = v0.x; vw.y = v0.y; vw.z = v1.x; vw.w = v1.y;
                    oa[dt] = __builtin_amdgcn_mfma_f32_16x16x32_bf16(__builtin_bit_cast(bf16x8, vw), pf, oa[dt], 0, 0, 0);
                }
            }
#pragma unroll
            for (int dt = 0; dt < 4; ++dt) {
                const size_t o = tq * 1024 + head * 64 + 16 * dt + 4 * g;
                const u32x2 gw = *(const u32x2*)(Zg + o);
                f32x4 r; r[0] = oa[dt][0] * inv * bflo(gw.x); r[1] = oa[dt][1] * inv * bfhi(gw.x); r[2] = oa[dt][2] * inv * bflo(gw.y); r[3] = oa[dt][3] * inv * bfhi(gw.y);
                *(u32x2*)(OG + o) = pk4(r);
            }
        }
    }
}

__device__ __forceinline__ void ret_A(LAS unsigned char* lds, const bf16_t* __restrict__ Zq, const bf16_t* __restrict__ Zk, bf16_t* __restrict__ ABUF, bf16_t* __restrict__ KDT, int G) {
    LAS bf16_t* Qs = (LAS bf16_t*)lds;
    LAS bf16_t* Ks = (LAS bf16_t*)(lds + 128 * 264 * 2);
    const int tid = otid(), w = tid >> 6, lane = tid & 63, l16 = lane & 15, g = lane >> 4;
    for (int it = blockIdx.x; it < 512; it += G) {
        const int c = it & 31, h = (it >> 5) & 3, b = it >> 7;
        const float lg = ret_lg(h);
        const size_t tok0 = (size_t)b * 4096 + c * 128;
        __syncthreads();
#pragma unroll
        for (int i = 0; i < 8; ++i) { const int ch = tid + 512 * i, s = ch >> 5, c8 = (ch & 31) * 8; const size_t src = (tok0 + s) * 1024 + h * 256 + c8;
            *(LAS u32x4*)(Qs + s * 264 + c8) = *(const u32x4*)(Zq + src); *(LAS u32x4*)(Ks + s * 264 + c8) = *(const u32x4*)(Zk + src); }
        __syncthreads();
        const int i_row = 16 * w + l16;
#pragma unroll
        for (int nt = 0; nt < 8; ++nt) {
            f32x4 a = {0.f, 0.f, 0.f, 0.f};
            if (nt <= w) {
#pragma unroll
                for (int ks = 0; ks < 8; ++ks) { const bf16x8 kf = *(const LAS bf16x8*)(Ks + (16 * nt + l16) * 264 + ks * 32 + g * 8), qf = *(const LAS bf16x8*)(Qs + i_row * 264 + ks * 32 + g * 8);
                    a = __builtin_amdgcn_mfma_f32_16x16x32_bf16(kf, qf, a, 0, 0, 0); }
#pragma unroll
                for (int r = 0; r < 4; ++r) { const int s = 16 * nt + 4 * g + r; a[r] = (s <= i_row) ? a[r] * __expf((float)(i_row - s) * lg) : 0.f; }
            }
            *(u32x2*)(ABUF + ((size_t)it * 128 + i_row) * 128 + 16 * nt + 4 * g) = pk4(a);
        }
        { const int d = tid & 255, sg0 = tid >> 8;
#pragma unroll
          for (int k = 0; k < 8; ++k) { const int s0 = 8 * (sg0 + 2 * k); float v[8];
#pragma unroll
              for (int jj = 0; jj < 8; ++jj) v[jj] = bf2f(Ks[(s0 + jj) * 264 + d]) * __expf((float)(127 - s0 - jj) * lg);
              u32x4 wv; wv.x = cvt_pk_bf16(v[0], v[1]); wv.y = cvt_pk_bf16(v[2], v[3]); wv.z = cvt_pk_bf16(v[4], v[5]); wv.w = cvt_pk_bf16(v[6], v[7]);
              *(u32x4*)(KDT + ((size_t)it * 256 + d) * 128 + s0) = wv; } }
    }
}

__device__ __forceinline__ void ret_scan_unit(LAS unsigned char* lds, int u, const bf16_t* __restrict__ vTp, const bf16_t* __restrict__ KDT, bf16_t* __restrict__ SC, float* __restrict__ out) {
    LAS bf16_t* VT = (LAS bf16_t*)lds;
    LAS bf16_t* ST = (LAS bf16_t*)(lds + 2 * 64 * 136 * 2);
    const int tid = otid(), w = tid >> 6, lane = tid & 63, l16 = lane & 15, g = lane >> 4;
    const int xcd = u & 7, jj = u >> 3, bh = xcd * 2 + (jj >> 3), es = jj & 7, h = bh & 3;
    const float lg = ret_lg(h), g128 = __expf(128.f * lg);
    __syncthreads();
    const bf16_t* vrow = vTp + ((size_t)bh * 512 + es * 64 + (tid >> 3)) * 4096 + (tid & 7) * 16;
    LAS bf16_t* vdst = VT + (tid >> 3) * 136 + (tid & 7) * 16;
    { const u32x4 a = *(const u32x4*)vrow, bq = *(const u32x4*)(vrow + 8); *(LAS u32x4*)vdst = a; *(LAS u32x4*)(vdst + 8) = bq; }
    f32x4 sacc[2][4];
#pragma unroll
    for (int dt = 0; dt < 2; ++dt)
#pragma unroll
        for (int et = 0; et < 4; ++et) sacc[dt][et] = (f32x4){0.f, 0.f, 0.f, 0.f};
    const bf16_t* kptr = KDT + ((size_t)bh * 32 * 256 + 32 * w + l16) * 128 + 8 * g;
    bf16_t* scp = SC + (((size_t)bh * 32) * 512 + es * 64 + (tid >> 5)) * 256 + (tid & 31) * 8;
    bf16x8 kf[2][4], kn[2][4];
#pragma unroll
    for (int dt = 0; dt < 2; ++dt)
#pragma unroll
        for (int ks = 0; ks < 4; ++ks) { kf[dt][ks] = *(const bf16x8*)(kptr + dt * 2048 + 32 * ks); kn[dt][ks] = kf[dt][ks]; }
    __syncthreads();
    for (int c = 0; c < 32; ++c) {
        const int buf = c & 1;
        u32x4 nv0 = {0u, 0u, 0u, 0u}, nv1 = {0u, 0u, 0u, 0u};
        if (c < 31) { nv0 = *(const u32x4*)(vrow + (c + 1) * 128); nv1 = *(const u32x4*)(vrow + (c + 1) * 128 + 8);
#pragma unroll
            for (int dt = 0; dt < 2; ++dt)
#pragma unroll
                for (int ks = 0; ks < 4; ++ks) kn[dt][ks] = *(const bf16x8*)(kptr + (size_t)(c + 1) * 256 * 128 + dt * 2048 + 32 * ks); }
        if (c > 0) {
#pragma unroll
            for (int k = 0; k < 4; ++k) { const u32x4 sv = *(const LAS u32x4*)(ST + (((c - 1) & 1) * 64 + (tid >> 5) + 16 * k) * 264 + (tid & 31) * 8);
                *(u32x4*)(scp + (size_t)c * 512 * 256 + (size_t)(16 * k) * 256) = sv; } }
        asm volatile("" ::: "memory");
        const LAS bf16_t* VTb = VT + buf * 64 * 136;
#pragma unroll
        for (int dt = 0; dt < 2; ++dt)
#pragma unroll
            for (int et = 0; et < 4; ++et) sacc[dt][et] *= g128;
#pragma unroll
        for (int et = 0; et < 4; ++et)
#pragma unroll
            for (int ks = 0; ks < 4; ++ks) { const bf16x8 vf = *(const LAS bf16x8*)(VTb + (16 * et + l16) * 136 + 32 * ks + 8 * g);
#pragma unroll
                for (int dt = 0; dt < 2; ++dt) sacc[dt][et] = __builtin_amdgcn_mfma_f32_16x16x32_bf16(kf[dt][ks], vf, sacc[dt][et], 0, 0, 0); }
        if (c < 31) {
#pragma unroll
            for (int dt = 0; dt < 2; ++dt)
#pragma unroll
                for (int et = 0; et < 4; ++et) *(LAS u32x2*)(ST + (buf * 64 + 16 * et + l16) * 264 + 32 * w + 16 * dt + 4 * g) = pk4(sacc[dt][et]);
            LAS bf16_t* d2 = vdst + (buf ^ 1) * 64 * 136; *(LAS u32x4*)d2 = nv0; *(LAS u32x4*)(d2 + 8) = nv1;
        }
        lds_barrier();
#pragma unroll
        for (int dt = 0; dt < 2; ++dt)
#pragma unroll
            for (int ks = 0; ks < 4; ++ks) kf[dt][ks] = kn[dt][ks];
    }
#pragma unroll
    for (int dt = 0; dt < 2; ++dt)
#pragma unroll
        for (int et = 0; et < 4; ++et)
#pragma unroll
            for (int r = 0; r < 4; ++r) out[OFF_RSP + ((size_t)bh * 256 + 32 * w + 16 * dt + 4 * g + r) * 512 + es * 64 + 16 * et + l16] = sacc[dt][et][r];
}

__device__ __forceinline__ void ret_out_items(LAS unsigned char* lds, const bf16_t* __restrict__ Zq, const bf16_t* __restrict__ vTp, const bf16_t* __restrict__ ABUF, const bf16_t* __restrict__ SC, bf16_t* __restrict__ ORET, int G) {
    LAS bf16_t* VS = (LAS bf16_t*)lds;
    LAS bf16_t* SS = (LAS bf16_t*)(lds + 2 * 64 * 136 * 2);
    for (int it = blockIdx.x; it < 512; it += G) {
        const int tid = otid(), w = tid >> 6, lane = tid & 63, l16 = lane & 15, g = lane >> 4;
        const int bh = it >> 5, c = it & 31, b = bh >> 2, h = bh & 3;
        const float lg = ret_lg(h), gi = __expf((float)(16 * w + l16 + 1) * lg);
        bf16x8 af[4], qf[8];
        { const bf16_t* aptr = ABUF + (((size_t)bh * 32 + c) * 128 + 16 * w + l16) * 128 + 8 * g;
          const bf16_t* qptr = Zq + ((size_t)b * 4096 + c * 128 + 16 * w + l16) * 1024 + h * 256 + 8 * g;
#pragma unroll
          for (int ks = 0; ks < 4; ++ks) af[ks] = *(const bf16x8*)(aptr + 32 * ks);
#pragma unroll
          for (int kd = 0; kd < 8; ++kd) qf[kd] = *(const bf16x8*)(qptr + 32 * kd); }
        const bf16_t* vsrc = vTp + ((size_t)bh * 512 + (tid >> 4)) * 4096 + c * 128 + (tid & 15) * 8;
        const bf16_t* ssrc = SC + (((size_t)bh * 32 + c) * 512 + (tid >> 5)) * 256 + (tid & 31) * 8;
        LAS bf16_t* vd = VS + (tid >> 4) * 136 + (tid & 15) * 8; LAS bf16_t* sd = SS + (tid >> 5) * 264 + (tid & 31) * 8;
        LAS bf16_t* OW = (LAS bf16_t*)(lds + 2 * 64 * 136 * 2 + 2 * 64 * 264 * 2) + w * (16 * 72);
        bf16_t* optr = ORET + ((size_t)b * 4096 + c * 128 + 16 * w + (lane >> 3)) * 2048 + h * 512 + (lane & 7) * 8;
        u32x4 rv[2], rs[4];
#pragma unroll
        for (int j = 0; j < 2; ++j) rv[j] = *(const u32x4*)(vsrc + (size_t)(32 * j) * 4096);
#pragma unroll
        for (int j = 0; j < 4; ++j) rs[j] = *(const u32x4*)(ssrc + (size_t)(16 * j) * 256);
        __syncthreads();
#pragma unroll
        for (int j = 0; j < 2; ++j) *(LAS u32x4*)(vd + 32 * j * 136) = rv[j];
#pragma unroll
        for (int j = 0; j < 4; ++j) *(LAS u32x4*)(sd + 16 * j * 264) = rs[j];
        __syncthreads();
        for (int es = 0; es < 8; ++es) {
            const int buf = es & 1;
            if (es < 7) {
#pragma unroll
                for (int j = 0; j < 2; ++j) rv[j] = *(const u32x4*)(vsrc + (size_t)((es + 1) * 64 + 32 * j) * 4096);
#pragma unroll
                for (int j = 0; j < 4; ++j) rs[j] = *(const u32x4*)(ssrc + (size_t)((es + 1) * 64 + 16 * j) * 256);
            }
            asm volatile("" ::: "memory");
            const LAS bf16_t* VSb = VS + buf * 64 * 136; const LAS bf16_t* SSb = SS + buf * 64 * 264;
#pragma unroll
            for (int et = 0; et < 4; ++et) {
                f32x4 oin = {0.f, 0.f, 0.f, 0.f}, ocr = {0.f, 0.f, 0.f, 0.f};
#pragma unroll
                for (int ks = 0; ks < 4; ++ks) { const bf16x8 vf = *(const LAS bf16x8*)(VSb + (16 * et + l16) * 136 + 32 * ks + 8 * g); oin = __builtin_amdgcn_mfma_f32_16x16x32_bf16(vf, af[ks], oin, 0, 0, 0); }
                if (c > 0) {
#pragma unroll
                    for (int kd = 0; kd < 8; ++kd) { const bf16x8 sf = *(const LAS bf16x8*)(SSb + (16 * et + l16) * 264 + 32 * kd + 8 * g); ocr = __builtin_amdgcn_mfma_f32_16x16x32_bf16(sf, qf[kd], ocr, 0, 0, 0); }
                }
                *(LAS u32x2*)(OW + l16 * 72 + 16 * et + 4 * g) = pk4(oin + ocr * gi);
            }
            asm volatile("s_waitcnt lgkmcnt(0)" ::: "memory");
#pragma unroll
            for (int k = 0; k < 2; ++k) { const u32x4 ov = *(const LAS u32x4*)(OW + ((lane >> 3) + 8 * k) * 72 + (lane & 7) * 8); *(u32x4*)(optr + (size_t)(8 * k) * 2048 + es * 64) = ov; }
            asm volatile("" ::: "memory");
            if (es < 7) {
#pragma unroll
                for (int j = 0; j < 2; ++j) *(LAS u32x4*)(vd + ((buf ^ 1) * 64 + 32 * j) * 136) = rv[j];
#pragma unroll
                for (int j = 0; j < 4; ++j) *(LAS u32x4*)(sd + ((buf ^ 1) * 64 + 16 * j) * 264) = rs[j];
            }
            lds_barrier();
        }
    }
}

__device__ __forceinline__ void ret_sample(LAS unsigned char* lds, const Params& P, const bf16_t* __restrict__ Zq, const bf16_t* __restrict__ Zk, const bf16_t* __restrict__ vTs, bf16_t* __restrict__ ORET, unsigned* ctr, unsigned* done, unsigned target) {
    LAS float* qs = (LAS float*)lds;
    LAS float* kds = qs + 2048;
    LAS float* A8 = kds + 2048;
    LAS float* red = A8 + 64;
    volatile LAS int* slot = (volatile LAS int*)(lds + LDS_BYTES - 32);
    for (;;) {
        const int tid = otid();
        __syncthreads();
        if (tid == 0) *slot = (done && xb_ld(done) >= target) ? 512 : (int)atomicAdd(ctr, 1u);
        __syncthreads();
        const int it = *slot;
        if (it >= 512) break;
        const int bs = it >> 2, h = it & 3;
        const float lg = ret_lg(h), g8 = __expf(8.f * lg), ig8 = __expf(-8.f * lg);
#pragma unroll
        for (int k = 0; k < 4; ++k) { const int e = tid + 512 * k, i = e >> 8, d = e & 255; const size_t src = (size_t)(MP + bs * 8 + i) * 1024 + h * 256 + d;
            qs[d * 8 + i] = bf2f(Zq[src]) * __expf((float)(i + 1) * lg); kds[d * 8 + i] = bf2f(Zk[src]) * __expf((float)(7 - i) * lg); }
        __syncthreads();
        if (tid < 64) { const int i = tid >> 3, s = tid & 7; float a = 0.f;
            if (s <= i) { for (int d = 0; d < 256; ++d) a += qs[d * 8 + i] * kds[d * 8 + s]; a *= ig8; }
            A8[tid] = a; }
        const int eg = tid & 127, dp = tid >> 7, e0 = 4 * eg;
        f32x4 vq[8];
#pragma unroll
        for (int jj = 0; jj < 4; ++jj) { const u32x4 wv = *(const u32x4*)(vTs + ((size_t)((bs * 4 + h) * 512 + e0 + jj)) * 8);
            vq[0][jj] = bflo(wv.x); vq[1][jj] = bfhi(wv.x); vq[2][jj] = bflo(wv.y); vq[3][jj] = bfhi(wv.y); vq[4][jj] = bflo(wv.z); vq[5][jj] = bfhi(wv.z); vq[6][jj] = bflo(wv.w); vq[7][jj] = bfhi(wv.w); }
        f32x4 cr[8];
#pragma unroll
        for (int i = 0; i < 8; ++i) cr[i] = (f32x4){0.f, 0.f, 0.f, 0.f};
        const size_t sbase = ((size_t)(bs * 4 + h) * 256 + dp * 64) * 512 + e0;
        const float* __restrict__ sp = P.state_ret + sbase; float* __restrict__ op = P.out + OFF_RSS + sbase;
        f32x4 sta[8];
#pragma unroll
        for (int j = 0; j < 8; ++j) sta[j] = __builtin_nontemporal_load((const f32x4*)(sp + (size_t)j * 512));
#pragma unroll 1
        for (int d0 = 0; d0 < 64; d0 += 8) {
            const bool more = d0 + 8 < 64;
#pragma unroll
            for (int j = 0; j < 8; ++j) {
                const int d = dp * 64 + d0 + j; const f32x4 st = sta[j];
                if (more) sta[j] = __builtin_nontemporal_load((const f32x4*)(sp + (size_t)(d0 + 8 + j) * 512));
                const f32x4 qa = *(const LAS f32x4*)(qs + d * 8), qb = *(const LAS f32x4*)(qs + d * 8 + 4), ka = *(const LAS f32x4*)(kds + d * 8), kb = *(const LAS f32x4*)(kds + d * 8 + 4);
                const float q8[8] = {qa[0], qa[1], qa[2], qa[3], qb[0], qb[1], qb[2], qb[3]}, k8[8] = {ka[0], ka[1], ka[2], ka[3], kb[0], kb[1], kb[2], kb[3]};
                f32x4 ns = st * g8;
#pragma unroll
                for (int s2 = 0; s2 < 8; ++s2) ns += vq[s2] * k8[s2];
                __builtin_nontemporal_store(ns, (f32x4*)(op + (size_t)(d0 + j) * 512));
#pragma unroll
                for (int i = 0; i < 8; ++i) cr[i] += st * q8[i];
                asm volatile("" ::: "memory");
            }
        }
#pragma unroll
        for (int i = 0; i < 8; ++i) *(LAS f32x4*)(red + (dp * 8 + i) * 512 + e0) = cr[i];
        __syncthreads();
        { const int i = tid >> 6, e8 = (tid & 63) * 8;
          float o[8];
#pragma unroll
          for (int jj = 0; jj < 8; ++jj) o[jj] = red[(0 * 8 + i) * 512 + e8 + jj] + red[(1 * 8 + i) * 512 + e8 + jj] + red[(2 * 8 + i) * 512 + e8 + jj] + red[(3 * 8 + i) * 512 + e8 + jj];
#pragma unroll
          for (int jj = 0; jj < 8; ++jj) { const u32x4 wv = *(const u32x4*)(vTs + ((size_t)((bs * 4 + h) * 512 + e8 + jj)) * 8);
              const float v8[8] = {bflo(wv.x), bfhi(wv.x), bflo(wv.y), bfhi(wv.y), bflo(wv.z), bfhi(wv.z), bflo(wv.w), bfhi(wv.w)};
#pragma unroll
              for (int s = 0; s < 8; ++s) o[jj] += A8[i * 8 + s] * v8[s]; }
          bf16_t* dst = ORET + (size_t)(MP + bs * 8 + i) * 2048 + h * 512 + e8;
          u32x4 ow; ow.x = cvt_pk_bf16(o[0], o[1]); ow.y = cvt_pk_bf16(o[2], o[3]); ow.z = cvt_pk_bf16(o[4], o[5]); ow.w = cvt_pk_bf16(o[6], o[7]); *(u32x4*)dst = ow; }
    }
}

__device__ __forceinline__ void ret_gnorm(const bf16_t* __restrict__ ORET, const bf16_t* __restrict__ Zg, bf16_t* __restrict__ OG, int G) {
    const int tid_o = otid(), wave = tid_o >> 6, lane = tid_o & 63;
    for (int task = blockIdx.x * 8 + wave; task < MT * 4; task += G * 8) {
        const size_t o = (size_t)(task >> 2) * 2048 + (task & 3) * 512 + lane * 8;
        const u32x4 ow = *(const u32x4*)(ORET + o); const f32x4 a = {bflo(ow.x), bfhi(ow.x), bflo(ow.y), bfhi(ow.y)}, b = {bflo(ow.z), bfhi(ow.z), bflo(ow.w), bfhi(ow.w)};
        const float mu = wave_sum(a[0] + a[1] + a[2] + a[3] + b[0] + b[1] + b[2] + b[3]) * (1.f / 512.f);
        const f32x4 da = a - mu, db = b - mu;
        const float var = wave_sum(da[0] * da[0] + da[1] * da[1] + da[2] * da[2] + da[3] * da[3] + db[0] * db[0] + db[1] * db[1] + db[2] * db[2] + db[3] * db[3]) * (1.f / 512.f);
        const float rs = rsqrtf(var + EPS);
        const u32x4 gw = *(const u32x4*)(Zg + o);
        u32x4 r;
        r.x = cvt_pk_bf16(da[0] * rs * bflo(gw.x), da[1] * rs * bfhi(gw.x)); r.y = cvt_pk_bf16(da[2] * rs * bflo(gw.y), da[3] * rs * bfhi(gw.y));
        r.z = cvt_pk_bf16(db[0] * rs * bflo(gw.z), db[1] * rs * bfhi(gw.z)); r.w = cvt_pk_bf16(db[2] * rs * bflo(gw.w), db[3] * rs * bfhi(gw.w));
        *(u32x4*)(OG + o) = r;
    }
}

__global__ void __launch_bounds__(NT) hybrid_fwd(Params P) {
    extern __shared__ __attribute__((aligned(16))) unsigned char lds_raw[];
    LAS unsigned char* lds = (LAS unsigned char*)lds_raw;
    cg::grid_group grid = cg::this_grid();
    const int G = gridDim.x, tid = threadIdx.x;
    unsigned char* ws = P.ws;
    bf16_t* WT_IN_ATTN = (bf16_t*)(ws + WS_WT_IN_ATTN); bf16_t* WT_OUT_ATTN = (bf16_t*)(ws + WS_WT_OUT_ATTN); bf16_t* WT_IN_RET = (bf16_t*)(ws + WS_WT_IN_RET); bf16_t* WT_OUT_RET = (bf16_t*)(ws + WS_WT_OUT_RET);
    bf16_t* WT_GATE = (bf16_t*)(ws + WS_WT_GATE); bf16_t* WT_PLE = (bf16_t*)(ws + WS_WT_PLE);
    float* TABA = (float*)(ws + WS_TABA); float* TABR = (float*)(ws + WS_TABR);
    bf16_t* H = (bf16_t*)(ws + WS_H); bf16_t* PB = (bf16_t*)(ws + WS_PB);
    bf16_t* PLE = (bf16_t*)(ws + WS_PLE); bf16_t* Y = (bf16_t*)(ws + WS_Y); bf16_t* X2 = (bf16_t*)(ws + WS_X2);
    bf16_t* OG = (bf16_t*)(ws + WS_OG); bf16_t* ZQ = (bf16_t*)(ws + WS_ZQ); bf16_t* ZK = (bf16_t*)(ws + WS_ZK); bf16_t* ZG = (bf16_t*)(ws + WS_ZG);
    bf16_t* VTP = (bf16_t*)(ws + WS_VTP); bf16_t* VTS = (bf16_t*)(ws + WS_VTS); bf16_t* ABUF = (bf16_t*)(ws + WS_ABUF); bf16_t* KDT = (bf16_t*)(ws + WS_KDT); bf16_t* ORET = (bf16_t*)(ws + WS_ORET);
    bf16_t* SC = (bf16_t*)(ws + WS_Y);
    pg8::StaticOrder SO;
    volatile LAS unsigned* bst = (volatile LAS unsigned*)(lds + LDS_BYTES - 16);
    if (tid < 4) bst[tid] = 0u;
    __syncthreads();
    const XcdBarrier xbar = xcd_barrier_post((unsigned*)(ws + WS_BAR), bst);
#define GSYNC() xcd_barrier(xbar)

for (int rep_ = 0; rep_ < REP_P0; ++rep_) {
    {
        LAS float* T = (LAS float*)lds;
        const int ttid = otid(), nn = ttid & 63, kq = ttid >> 6, kk2 = (ttid & 31) * 2, nq = ttid >> 5;
#define TILE_DESC(t_, W_, Wt_, K_, N_, perm_, tl_) do { \
        if ((t_) < 640) { W_ = P.w_in_attn; Wt_ = WT_IN_ATTN; K_ = 1024; N_ = 2560; perm_ = true; tl_ = (t_); } \
        else if ((t_) < 896) { W_ = P.w_out_attn; Wt_ = WT_OUT_ATTN; K_ = 1024; N_ = 1024; perm_ = false; tl_ = (t_) - 640; } \
        else if ((t_) < 2432) { W_ = P.w_in_ret; Wt_ = WT_IN_RET; K_ = 1024; N_ = 6144; perm_ = false; tl_ = (t_) - 896; } \
        else if ((t_) < 2944) { W_ = P.w_out_ret; Wt_ = WT_OUT_RET; K_ = 2048; N_ = 1024; perm_ = false; tl_ = (t_) - 2432; } \
        else if ((t_) < 3200) { W_ = P.w_gate; Wt_ = WT_GATE; K_ = 1024; N_ = 1024; perm_ = false; tl_ = (t_) - 2944; } \
        else if ((t_) < 3456) { W_ = P.w_gate + 1024 * 1024; Wt_ = WT_GATE + 1024 * 1024; K_ = 1024; N_ = 1024; perm_ = false; tl_ = (t_) - 3200; } \
        else if ((t_) < 3520) { W_ = P.w_ple; Wt_ = WT_PLE; K_ = 256; N_ = 1024; perm_ = false; tl_ = (t_) - 3456; } \
        else { W_ = P.w_ple + 256 * 1024; Wt_ = WT_PLE + 1024 * 256; K_ = 256; N_ = 1024; perm_ = false; tl_ = (t_) - 3520; } } while (0)
#define TILE_LOAD(W_, N_, perm_, tl_, r_) do { const int ntn_ = (N_) >> 6, n0_ = ((tl_) % ntn_) * 64, k0_ = ((tl_) / ntn_) * 64, nd_ = n0_ + nn; int ns_ = nd_; \
        if ((perm_) && nd_ < 1280) { const int p_ = nd_ & 63; ns_ = (nd_ - p_) + (p_ >> 5) * 16 + (p_ & 15) + ((p_ >> 4) & 1) * 32; } \
        _Pragma("unroll") for (int i_ = 0; i_ < 8; ++i_) r_[i_] = (W_)[(size_t)(k0_ + kq + 8 * i_) * (N_) + ns_]; } while (0)
        float r[8];
        const float* Wc; bf16_t* Wtc; int Kc, Nc, tlc; bool pc;
        int t = blockIdx.x;
        if (t < 3584) { TILE_DESC(t, Wc, Wtc, Kc, Nc, pc, tlc); TILE_LOAD(Wc, Nc, pc, tlc, r); }
        for (; t < 3584; t += G) {
            __syncthreads();
#pragma unroll
            for (int i = 0; i < 8; ++i) T[(kq + 8 * i) * 65 + nn] = r[i];
            __syncthreads();
            const int ntn = Nc >> 6, n0 = (tlc % ntn) * 64, k0 = (tlc / ntn) * 64; bf16_t* Wto = Wtc; const int Ko = Kc;
            if (t + G < 3584) { TILE_DESC(t + G, Wc, Wtc, Kc, Nc, pc, tlc); TILE_LOAD(Wc, Nc, pc, tlc, r); }
#pragma unroll
            for (int i = 0; i < 4; ++i) { const int n2 = nq + 16 * i; *(unsigned*)(Wto + (size_t)(n0 + n2) * Ko + k0 + kk2) = cvt_pk_bf16(T[kk2 * 65 + n2], T[(kk2 + 1) * 65 + n2]); }
        }
        __syncthreads();
#undef TILE_DESC
#undef TILE_LOAD
    }
    for (int e = blockIdx.x * NT + tid; e < 4104 * 160; e += G * NT) {
        const int pi = e / 160, f = e % 160; const int pos = pi < 4096 ? pi : 16384 + (pi - 4096);
        if (f < 32) { const float inv = powf(10000.f, -(float)f / 32.f), ang = (float)pos * inv; TABA[((size_t)pi * 32 + f) * 2] = cosf(ang); TABA[((size_t)pi * 32 + f) * 2 + 1] = sinf(ang); }
        else { const int f2 = f - 32; const float inv = powf(10000.f, -(float)f2 / 128.f), ang = (float)pos * inv; TABR[((size_t)pi * 128 + f2) * 2] = cosf(ang); TABR[((size_t)pi * 128 + f2) * 2 + 1] = sinf(ang); }
    }
    for (int e = blockIdx.x * NT + tid; e < 2 * MT * 64; e += G * NT) {
        const int i = e / (MT * 64), rem = e % (MT * 64), row = rem >> 6, c4 = (rem & 63) * 4;
        const float* src = row < MP ? P.p_prompt + ((size_t)i * MP + row) * 256 + c4 : P.p_sample + ((size_t)i * MS + row - MP) * 256 + c4;
        *(u32x2*)(PB + ((size_t)i * MT + row) * 256 + c4) = pk4(*(const f32x4*)src);
    }
    rms_rows(P.x_prompt, P.x_sample, P.pre_norm, H, G);
}
    if (P.ws == nullptr) grid.sync();
    GSYNC();

for (int rep_ = 0; rep_ < REP_GIN; ++rep_) {
    { pg8::Gemm g{H, WT_IN_ATTN, MT, 2560, 1024}; SO.init(MT, 2560, G, blockIdx.x);
      EpiInAttn E{ZQ, ZK, ZG, VTP, VTS, TABA, P.out}; pg8::gemm_phase(lds, g, SO, E); }
    { pg8::Gemm g{PB, WT_PLE, MP, 1024, 256}; SO.init(MP, 1024, G, blockIdx.x);
      EpiB16 E{PLE, 1024}; pg8::gemm_phase(lds, g, SO, E);
      skinny_gemm(lds, PB + (size_t)MP * 256, WT_PLE, 256, SkB16{PLE + (size_t)MP * 1024}, G); }
}
    GSYNC();

for (int rep_ = 0; rep_ < REP_ATT; ++rep_) {
    attn_prompt(lds, ZQ, ZK, ZG, VTP, P.sinks, OG, G);
    attn_sample(lds, P, ZQ, ZK, ZG, VTS, OG, G);
}
    GSYNC();

for (int rep_ = 0; rep_ < REP_GN1; ++rep_) {
    { pg8::Gemm g{OG, WT_OUT_ATTN, MP, 1024, 1024}; SO.init(MP, 1024, G, blockIdx.x); EpiB16 E{Y, 1024}; pg8::gemm_phase(lds, g, SO, E);
      skinny_gemm(lds, OG + (size_t)MP * 1024, WT_OUT_ATTN, 1024, SkB16{Y + (size_t)MP * 1024}, G); }
}
    GSYNC();
for (int rep_ = 0; rep_ < REP_ROW; ++rep_) {
    resid_rows<false>(P.x_prompt, P.x_sample, nullptr, Y, P.post_norm, H, G);
}
    GSYNC();
for (int rep_ = 0; rep_ < REP_GN1; ++rep_) {
    { pg8::Gemm g{H, WT_GATE, MP, 1024, 1024}; SO.init(MP, 1024, G, blockIdx.x); EpiGate<true> E{H, PLE, nullptr, X2}; pg8::gemm_phase(lds, g, SO, E);
      skinny_gemm(lds, H + (size_t)MP * 1024, WT_GATE, 1024, SkGate<true>{H + (size_t)MP * 1024, PLE + (size_t)MP * 1024, nullptr, X2 + (size_t)MP * 1024}, G); }
}
    GSYNC();
for (int rep_ = 0; rep_ < REP_ROW; ++rep_) {
    rms_rows_b16(X2, P.pre_norm + 1024, H, G);
}
    GSYNC();
for (int rep_ = 0; rep_ < REP_GIN; ++rep_) {
    { pg8::Gemm g{H, WT_IN_RET, MT, 6144, 1024}; SO.init(MT, 6144, G, blockIdx.x);
      EpiInRet E{ZQ, ZK, ZG, VTP, VTS, TABR}; pg8::gemm_phase(lds, g, SO, E); }
    { pg8::Gemm g{PB + (size_t)MT * 256, WT_PLE + 1024 * 256, MP, 1024, 256}; SO.init(MP, 1024, G, blockIdx.x);
      EpiB16 E{PLE, 1024}; pg8::gemm_phase(lds, g, SO, E);
      skinny_gemm(lds, PB + (size_t)MT * 256 + (size_t)MP * 256, WT_PLE + 1024 * 256, 256, SkB16{PLE + (size_t)MP * 1024}, G); }
}
    GSYNC();
for (int rep_ = 0; rep_ < REP_RA; ++rep_) {
    ret_A(lds, ZQ, ZK, ABUF, KDT, G);
}
    GSYNC();
    { unsigned* ctr = (unsigned*)(ws + WS_BAR + 14336); unsigned* done = ctr + 64;
      const unsigned nscan = G < 128 ? (unsigned)G : 128u;
      if (blockIdx.x < 128) { for (int rep_ = 0; rep_ < REP_SCAN; ++rep_) for (int u = blockIdx.x; u < 128; u += G) ret_scan_unit(lds, u, VTP, KDT, SC, P.out); if (tid == 0) xb_add(done, 1u); }
      else ret_sample(lds, P, ZQ, ZK, VTS, ORET, ctr, done, nscan);
      GSYNC();
      for (int rep_ = 0; rep_ < REP_R3; ++rep_) ret_out_items(lds, ZQ, VTP, ABUF, SC, ORET, G);
      ret_sample(lds, P, ZQ, ZK, VTS, ORET, ctr, nullptr, 0u); }
for (int rep_ = 0; rep_ < REP_SYNC; ++rep_) GSYNC();
    GSYNC();
for (int rep_ = 0; rep_ < REP_ROW; ++rep_) {
    ret_gnorm(ORET, ZG, OG, G);
}
    GSYNC();
for (int rep_ = 0; rep_ < REP_GN1; ++rep_) {
    { pg8::Gemm g{OG, WT_OUT_RET, MP, 1024, 2048}; SO.init(MP, 1024, G, blockIdx.x); EpiB16 E{Y, 1024}; pg8::gemm_phase(lds, g, SO, E);
      skinny_gemm(lds, OG + (size_t)MP * 2048, WT_OUT_RET, 2048, SkB16{Y + (size_t)MP * 1024}, G); }
}
    GSYNC();
for (int rep_ = 0; rep_ < REP_ROW; ++rep_) {
    resid_rows<true>(nullptr, nullptr, X2, Y, P.post_norm + 1024, H, G);
}
    GSYNC();
for (int rep_ = 0; rep_ < REP_GN1; ++rep_) {
    { pg8::Gemm g{H, WT_GATE + 1024 * 1024, MP, 1024, 1024}; SO.init(MP, 1024, G, blockIdx.x); EpiGate<false> E{H, PLE, P.out, nullptr}; pg8::gemm_phase(lds, g, SO, E);
      skinny_gemm(lds, H + (size_t)MP * 1024, WT_GATE + 1024 * 1024, 1024, SkGate<false>{H + (size_t)MP * 1024, PLE + (size_t)MP * 1024, P.out + (size_t)MP * 1024, nullptr}, G); }
}
}

extern "C" void kernel_launch(void* const* d_in, const int* in_sizes, int n_in, void* d_out, int out_size, void* d_ws, size_t ws_size, hipStream_t stream) {
    static int grid_blocks = 0;
    if (!grid_blocks) {
        int dev = 0, cus = 0, per_cu = 0;
        hipGetDevice(&dev);
        hipDeviceGetAttribute(&cus, hipDeviceAttributeMultiprocessorCount, dev);
        hipFuncSetAttribute((const void*)hybrid_fwd, hipFuncAttributeMaxDynamicSharedMemorySize, LDS_BYTES);
        hipOccupancyMaxActiveBlocksPerMultiprocessor(&per_cu, (const void*)hybrid_fwd, NT, LDS_BYTES);
        if (per_cu < 1) per_cu = 1;
        if (per_cu > 1) per_cu = 1;
        grid_blocks = cus * per_cu;
        if (ws_size < WS_END) fprintf(stderr, "kernel_launch: workspace too small: %zu < %zu\n", ws_size, (size_t)WS_END);
    }
    Params p{};
    p.x_prompt = (const float*)d_in[0]; p.x_sample = (const float*)d_in[1]; p.cache_k = (const float*)d_in[2]; p.cache_v = (const float*)d_in[3]; p.state_ret = (const float*)d_in[4];
    p.p_prompt = (const float*)d_in[5]; p.p_sample = (const float*)d_in[6]; p.pre_norm = (const float*)d_in[7]; p.post_norm = (const float*)d_in[8]; p.w_in_attn = (const float*)d_in[9];
    p.sinks = (const float*)d_in[10]; p.w_out_attn = (const float*)d_in[11]; p.w_in_ret = (const float*)d_in[12]; p.w_out_ret = (const float*)d_in[13]; p.w_ple = (const float*)d_in[14]; p.w_gate = (const float*)d_in[15];
    p.out = (float*)d_out; p.ws = (unsigned char*)d_ws;
    (void)hipMemsetAsync((unsigned char*)d_ws + WS_BAR, 0, 16384, stream);
    void* args[] = {&p};
    hipError_t e = hipLaunchCooperativeKernel((const void*)hybrid_fwd, dim3(grid_blocks), dim3(NT), args, LDS_BYTES, stream);
    if (e != hipSuccess) fprintf(stderr, "cooperative launch failed: %s (grid %d)\n", hipGetErrorString(e), grid_blocks);
}
```

```cpp
#include <hip/hip_runtime.h>
#include <hip/hip_cooperative_groups.h>
#include <cstdio>
#include <cstdint>
namespace cg = cooperative_groups;

#define LAS __attribute__((address_space(3)))
typedef unsigned short bf16_t;
typedef short bf16x8 __attribute__((ext_vector_type(8)));
typedef float f32x4 __attribute__((ext_vector_type(4)));
typedef float f32x2 __attribute__((ext_vector_type(2)));
typedef unsigned u32x2 __attribute__((ext_vector_type(2)));
typedef unsigned u32x4 __attribute__((ext_vector_type(4)));

constexpr int MP = 16384, MS = 1024, MT = MP + MS;
constexpr int NT = 512;
#define REP_P0 1
#define REP_GIN 1
#define REP_ATT 1
#define REP_RA 1
#define REP_SYNC 0
#define REP_R3 1
#define REP_SCAN 1
#define REP_ROW 1
#define REP_GN1 1
constexpr int LDS_BYTES = 140 * 1024;
constexpr float EPS = 1e-6f;

constexpr size_t OFF_YP = 0, OFF_YS = 16777216, OFF_KWP = 17825792, OFF_VWP = 17956864, OFF_KWS = 18087936, OFF_VWS = 22282240, OFF_RSP = 26476544, OFF_RSS = 28573696;

constexpr size_t al256(size_t x) { return (x + 255) & ~(size_t)255; }
constexpr size_t WS_WT_IN_ATTN = 0;
constexpr size_t WS_WT_OUT_ATTN = WS_WT_IN_ATTN + (size_t)2560 * 1024 * 2;
constexpr size_t WS_WT_IN_RET = WS_WT_OUT_ATTN + (size_t)1024 * 1024 * 2;
constexpr size_t WS_WT_OUT_RET = WS_WT_IN_RET + (size_t)6144 * 1024 * 2;
constexpr size_t WS_WT_GATE = WS_WT_OUT_RET + (size_t)1024 * 2048 * 2;
constexpr size_t WS_WT_PLE = WS_WT_GATE + (size_t)2 * 1024 * 1024 * 2;
constexpr size_t WS_TABA = WS_WT_PLE + (size_t)2 * 1024 * 256 * 2;
constexpr size_t WS_TABR = WS_TABA + (size_t)4104 * 32 * 8;
constexpr size_t WS_H = al256(WS_TABR + (size_t)4104 * 128 * 8);
constexpr size_t WS_PB = WS_H + (size_t)MT * 1024 * 2;
constexpr size_t WS_PLE = WS_PB + (size_t)2 * MT * 256 * 2;
constexpr size_t WS_Y = WS_PLE + (size_t)MT * 1024 * 4;
constexpr size_t WS_X1 = WS_Y + (size_t)MT * 1024 * 4;
constexpr size_t WS_X2 = WS_X1 + (size_t)MT * 1024 * 4;
constexpr size_t WS_OG = WS_X2 + (size_t)MT * 1024 * 4;
constexpr size_t WS_ZQ = WS_OG + (size_t)MT * 2048 * 2;
constexpr size_t WS_ZK = WS_ZQ + (size_t)MT * 1024 * 2;
constexpr size_t WS_ZG = WS_ZK + (size_t)MT * 1024 * 2;
constexpr size_t WS_VTP = WS_ZG + (size_t)MT * 2048 * 2;
constexpr size_t WS_VTS = WS_VTP + (size_t)16 * 512 * 4096 * 2;
constexpr size_t WS_ABUF = WS_VTS + (size_t)128 * 4 * 512 * 8 * 2;
constexpr size_t WS_KDT = WS_ABUF + (size_t)512 * 128 * 128 * 2;
constexpr size_t WS_ORET = WS_KDT + (size_t)512 * 256 * 128 * 2;
constexpr size_t WS_BAR = WS_ORET + (size_t)MT * 2048 * 4;
constexpr size_t WS_END = WS_BAR + 16384;

struct Params {
    const float *x_prompt, *x_sample, *cache_k, *cache_v, *state_ret, *p_prompt, *p_sample, *pre_norm, *post_norm, *w_in_attn, *sinks, *w_out_attn, *w_in_ret, *w_out_ret, *w_ple, *w_gate;
    float* out; unsigned char* ws;
};

__device__ __forceinline__ unsigned cvt_pk_bf16(float lo, float hi) { unsigned r; asm volatile("v_cvt_pk_bf16_f32 %0, %1, %2" : "=v"(r) : "v"(lo), "v"(hi)); return r; }
__device__ __forceinline__ u32x2 pk4(f32x4 v) { u32x2 w; w.x = cvt_pk_bf16(v[0], v[1]); w.y = cvt_pk_bf16(v[2], v[3]); return w; }
__device__ __forceinline__ float bf2f(bf16_t b) { return __uint_as_float(((unsigned)b) << 16); }
__device__ __forceinline__ float bflo(unsigned w) { return __uint_as_float(w << 16); }
__device__ __forceinline__ float bfhi(unsigned w) { return __uint_as_float(w & 0xffff0000u); }
__device__ __forceinline__ float silu_f(float x) { return x / (1.f + __expf(-x)); }
__device__ __forceinline__ float sigmoid_f(float x) { return 1.f / (1.f + __expf(-x)); }
__device__ __forceinline__ float wave_sum(float v) {
#pragma unroll
    for (int o = 32; o >= 1; o >>= 1) v += __shfl_xor(v, o, 64);
    return v;
}
__device__ __forceinline__ int otid() { int t = threadIdx.x; asm volatile("" : "+v"(t)); return t; }
__device__ __forceinline__ void lds_barrier() { asm volatile("s_waitcnt lgkmcnt(0)" ::: "memory"); __builtin_amdgcn_s_barrier(); asm volatile("" ::: "memory"); }
__device__ __forceinline__ float ret_lg(int h) { return h == 0 ? -3.1748698315e-02f : h == 1 ? -1.5748356968e-02f : h == 2 ? -7.8431774610e-03f : -3.9138993211e-03f; }

#define XB_TMO      128
#define XB_XCNT(j)  (256  + 64 * (j))
#define XB_XSUB(j)  (1280 + 64 * (j))
#define XB_XGEN(j)  (2304 + 64 * (j))
#define XB_TOP      3328
#define XB_TOPGEN   3392
#define XCD_BAR_WORDS 3456
#define XB_SPIN_CAP (1u << 18)

__device__ __forceinline__ unsigned xb_ld(unsigned* p)              { return __hip_atomic_load(p, __ATOMIC_RELAXED, __HIP_MEMORY_SCOPE_AGENT); }
__device__ __forceinline__ unsigned xb_add(unsigned* p, unsigned v) { return __hip_atomic_fetch_add(p, v, __ATOMIC_RELAXED, __HIP_MEMORY_SCOPE_AGENT); }
__device__ __forceinline__ unsigned xb_xcc_id() { return (unsigned)__builtin_amdgcn_s_getreg((3 << 11) | 20) & 0xFu; }
#define XB_SPIN(cond, bar) do { unsigned _sp = 0; while (cond) { __builtin_amdgcn_s_sleep(1); \
    if ((++_sp & 255u) == 0u) { if (xb_ld(&(bar)[XB_TMO])) break; if (_sp > XB_SPIN_CAP) { atomicAdd(&(bar)[XB_TMO], 1u); break; } } } } while (0)

struct XcdBarrier {
    unsigned* bar; unsigned x;
    volatile LAS unsigned* st;
};

__device__ __forceinline__ XcdBarrier xcd_barrier_post(unsigned* bar, volatile LAS unsigned* st) {
    XcdBarrier b; b.bar = bar; b.x = xb_xcc_id(); b.st = st;
    if (threadIdx.x == 0) (void)xb_add(&bar[XB_XCNT(b.x)], 1u);
    return b;
}
__device__ __forceinline__ void xcd_barrier_complete(unsigned* bar, unsigned x, unsigned& nloc, unsigned& nx) {
    const unsigned G = gridDim.x * gridDim.y * gridDim.z;
    unsigned sum, cnt, mine, sp = 0u;
    for (;;) {
        sum = 0u; cnt = 0u; mine = 0u;
#pragma unroll
        for (unsigned j = 0; j < 16; ++j) { const unsigned c = xb_ld(&bar[XB_XCNT(j)]); sum += c; cnt += (c > 0u) ? 1u : 0u; mine = (j == x) ? c : mine; }
        if (sum == G) break;
        __builtin_amdgcn_s_sleep(1);
        if ((++sp & 255u) == 0u) { if (xb_ld(&bar[XB_TMO])) break; if (sp > XB_SPIN_CAP) { atomicAdd(&bar[XB_TMO], 1u); break; } }
    }
    nloc = mine > 0u ? mine : 1u; nx = cnt > 0u ? cnt : 1u;
}

__device__ __forceinline__ void xcd_barrier(const XcdBarrier& b) {
    asm volatile("s_waitcnt vmcnt(0)" ::: "memory");
    __syncthreads();
    if (threadIdx.x == 0) {
        unsigned* bar = b.bar;
        __builtin_amdgcn_s_waitcnt(0);
        unsigned nloc = b.st[0], nx = b.st[1];
        if (nloc == 0u) { xcd_barrier_complete(bar, b.x, nloc, nx); b.st[0] = nloc; b.st[1] = nx; }
        const unsigned old = xb_add(&bar[XB_XSUB(b.x)], 1u);
        const unsigned gen = old / nloc;
        if (old + 1u == (gen + 1u) * nloc) {
            __builtin_amdgcn_fence(__ATOMIC_RELEASE, "agent");
            asm volatile("s_waitcnt vmcnt(0)" ::: "memory");
            const unsigned og = xb_add(&bar[XB_TOP], 1u);
            const unsigned tg = og / nx;
            if (og + 1u == (tg + 1u) * nx) xb_add(&bar[XB_TOPGEN], 1u);
            else XB_SPIN(xb_ld(&bar[XB_TOPGEN]) == tg, bar);
            __builtin_amdgcn_fence(__ATOMIC_ACQUIRE, "agent");
            xb_add(&bar[XB_XGEN(b.x)], 1u);
            asm volatile("s_waitcnt vmcnt(0)" ::: "memory");
        } else {
            XB_SPIN(xb_ld(&bar[XB_XGEN(b.x)]) == gen, bar);
            __builtin_amdgcn_fence(__ATOMIC_ACQUIRE, "agent");
            asm volatile("s_waitcnt vmcnt(0)" ::: "memory");
        }
    }
    __syncthreads();
}

namespace pg8 {
constexpr int BM = 256, BK = 64, HALF = 128, HTB = HALF * BK * 2, STAGE_BYTES = 8 * HTB, NXCD = 8, WGM = 8;
__host__ __device__ __forceinline__ int lds_byte(int r, int c) { const int st = (r >> 4) * 2 + (c >> 5), rr = r & 15, cc = c & 31, ob = rr * 64 + cc * 2; return st * 1024 + (ob ^ (((ob >> 9) & 1) << 5)); }
__host__ __device__ __forceinline__ void stage_rc(int b, int& R, int& C) { const int st = b / 1024, sb = b % 1024, swz = sb ^ (((sb >> 9) & 1) << 5); R = (st >> 1) * 16 + swz / 64; C = (st & 1) * 32 + (swz % 64) / 2; }
struct Unit { int pm, pn; };
struct Gemm { const bf16_t* A; const bf16_t* Bt; int M, N, K; };
struct StaticOrder {
    int nM, nN, nwg, G, c;
    __host__ __device__ void init(int M, int N, int G_, int c_) { nM = M / BM; nN = N / BM; nwg = nM * nN; G = G_; c = c_; }
    __host__ __device__ bool next(int i, Unit& u) const {
        const long L = (long)i * G + c; if (L >= nwg) return false;
        int wgid = (int)L; { const int q = nwg / NXCD, r = nwg % NXCD, xcd = wgid % NXCD, off = wgid / NXCD; wgid = (xcd < r ? xcd * (q + 1) : r * (q + 1) + (xcd - r) * q) + off; }
        const int nig = WGM * nN, gid = wgid / nig, fm = gid * WGM, gsz = (nM - fm) < WGM ? (nM - fm) : WGM;
        u.pm = fm + ((wgid % nig) % gsz); u.pn = (wgid % nig) / gsz; return true;
    }
};

struct TailOrder {
    int first, nblk, nwg, c;
    __host__ __device__ void init(int M, int first_, int G_, int c_) { nwg = (M / BM) * 4; first = first_; nblk = G_ - first_; c = c_; }
    __host__ __device__ bool next(int i, Unit& u) const { if (c < first) return false; const int L = (c - first) + i * nblk; if (L >= nwg) return false; u.pm = L >> 2; u.pn = L & 3; return true; }
};

template <class Epi, class Sched>
__device__ __forceinline__ void gemm_phase(LAS unsigned char* lds, const Gemm g, const Sched& S, const Epi& E) {
    const int tid = otid(), wid = __builtin_amdgcn_readfirstlane(tid >> 6), lane = tid & 63, wr = wid >> 2, wc = wid & 3, fr = lane & 15, fq = lane >> 4;
    const int K = g.K, nt = K / BK;
    unsigned voffA[2], voffB[2];
#pragma unroll
    for (int i = 0; i < 2; ++i) { int R, C; stage_rc(tid * 16 + i * 8192, R, C); voffA[i] = (unsigned)(R * K + C) * 2u; voffB[i] = voffA[i]; }
    const size_t kstep = (size_t)(BK * 2);
    const size_t hstep = (size_t)HALF * K * 2;
    const size_t tstep = 2 * hstep;
    const unsigned ldsw = (unsigned)wid * 1024u;
    const int aoff = lds_byte(wr * 64 + fr, fq * 8), boff = lds_byte(wc * 32 + fr, fq * 8);
#define PG8_SA(b, h) (((b) * 2 + (h)) * HTB)
#define PG8_SB(b, h) ((4 + (b) * 2 + (h)) * HTB)
#define PG8_STAGE(bufoff, gbase, voff) do { _Pragma("unroll") for (int _i = 0; _i < 2; ++_i) \
        __builtin_amdgcn_global_load_lds((const unsigned*)((const char*)(gbase) + (voff)[_i]), (LAS unsigned*)(lds + (bufoff) + ldsw + _i * 8192), 16, 0, 0); } while (0)
#define PG8_LDA(dst, b, h) do { _Pragma("unroll") for (int m = 0; m < 4; ++m) _Pragma("unroll") for (int k = 0; k < 2; ++k) dst[m][k] = *(const LAS bf16x8*)(lds + PG8_SA(b, h) + aoff + m * 2048 + k * 1024); } while (0)
#define PG8_LDB(dst, b, h) do { _Pragma("unroll") for (int n = 0; n < 2; ++n) _Pragma("unroll") for (int k = 0; k < 2; ++k) dst[n][k] = *(const LAS bf16x8*)(lds + PG8_SB(b, h) + boff + n * 2048 + k * 1024); } while (0)
#define PG8_MMA(ai, bj, At, Bt) do { __builtin_amdgcn_s_setprio(1); _Pragma("unroll") for (int m = 0; m < 4; ++m) _Pragma("unroll") for (int n = 0; n < 2; ++n) _Pragma("unroll") for (int k = 0; k < 2; ++k) \
        acc[ai][bj][m][n] = __builtin_amdgcn_mfma_f32_16x16x32_bf16(Bt[n][k], At[m][k], acc[ai][bj][m][n], 0, 0, 0); __builtin_amdgcn_s_setprio(0); } while (0)
#define PG8_WAIT_V(n) asm volatile("s_waitcnt vmcnt(" #n ")" ::: "memory")
#define PG8_WAIT_L(n) asm volatile("s_waitcnt lgkmcnt(" #n ")" ::: "memory")
#define PG8_BAR __builtin_amdgcn_s_barrier()
#define PG8_SCHED __builtin_amdgcn_sched_barrier(0)
#define PG8_PTRS(u, pa, pb) do { const char* _a = (const char*)g.A + (size_t)(u).pm * tstep; const char* _b = (const char*)g.Bt + (size_t)(u).pn * tstep; if (Epi::swap(u)) { pa = _b; pb = _a; } else { pa = _a; pb = _b; } } while (0)
    Unit cur, nxt; int ui = 0;
    if (!S.next(0, cur)) return;
    f32x4 acc[2][2][4][2];
#pragma unroll
    for (int a = 0; a < 2; ++a)
#pragma unroll
        for (int b = 0; b < 2; ++b)
#pragma unroll
            for (int m = 0; m < 4; ++m)
#pragma unroll
                for (int n = 0; n < 2; ++n) acc[a][b][m][n] = (f32x4){0.f, 0.f, 0.f, 0.f};
    bf16x8 At[4][2], B0[2][2], B1[2][2];
    const char* cA; const char* cB;
    PG8_PTRS(cur, cA, cB);
    PG8_STAGE(PG8_SB(0, 0), cB, voffB); PG8_STAGE(PG8_SA(0, 0), cA, voffA); PG8_STAGE(PG8_SB(0, 1), cB + hstep, voffB); PG8_STAGE(PG8_SA(0, 1), cA + hstep, voffA);
    if (wr == 1) PG8_BAR;
    PG8_WAIT_V(4); PG8_BAR;
    PG8_STAGE(PG8_SB(1, 0), cB + kstep, voffB); PG8_STAGE(PG8_SA(1, 0), cA + kstep, voffA); PG8_STAGE(PG8_SB(1, 1), cB + hstep + kstep, voffB);
    PG8_WAIT_V(6); PG8_BAR;
    for (;;) {
        const bool has_next = S.next(ui + 1, nxt);
        const char* nA = cA; const char* nB = cB;
        if (has_next) PG8_PTRS(nxt, nA, nB);
        for (int t = 0; t < nt; t += 2) {
            const bool last = (t == nt - 2);
            const char* a1 = cA + (size_t)(t + 1) * kstep;
            const char* a2 = last ? nA : cA + (size_t)(t + 2) * kstep; const char* b2 = last ? nB : cB + (size_t)(t + 2) * kstep;
            const char* a3 = a2 + kstep; const char* b3 = b2 + kstep;
            PG8_LDB(B0, 0, 0); PG8_SCHED; PG8_LDA(At, 0, 0); PG8_STAGE(PG8_SA(1, 1), a1 + hstep, voffA);
            PG8_WAIT_L(8); PG8_BAR; PG8_WAIT_L(0); PG8_MMA(0, 0, At, B0); PG8_BAR; PG8_SCHED;
            PG8_LDB(B1, 0, 1); PG8_STAGE(PG8_SB(0, 0), b2, voffB);
            PG8_BAR; PG8_WAIT_L(0); PG8_MMA(0, 1, At, B1); PG8_BAR;
            PG8_LDA(At, 0, 1); PG8_STAGE(PG8_SA(0, 0), a2, voffA);
            PG8_BAR; PG8_WAIT_L(0); PG8_MMA(1, 0, At, B0); PG8_BAR; PG8_SCHED;
            PG8_STAGE(PG8_SB(0, 1), b2 + hstep, voffB);
            PG8_WAIT_V(6); PG8_BAR; PG8_MMA(1, 1, At, B1); PG8_BAR;
            PG8_LDB(B0, 1, 0); PG8_SCHED; PG8_LDA(At, 1, 0); PG8_STAGE(PG8_SA(0, 1), a2 + hstep, voffA);
            PG8_WAIT_L(8); PG8_BAR; PG8_WAIT_L(0); PG8_MMA(0, 0, At, B0); PG8_BAR; PG8_SCHED;
            PG8_LDB(B1, 1, 1); PG8_STAGE(PG8_SB(1, 0), b3, voffB);
            PG8_BAR; PG8_WAIT_L(0); PG8_MMA(0, 1, At, B1); PG8_BAR;
            PG8_LDA(At, 1, 1); PG8_STAGE(PG8_SA(1, 0), a3, voffA);
            PG8_BAR; PG8_WAIT_L(0); PG8_MMA(1, 0, At, B0); PG8_BAR; PG8_SCHED;
            PG8_STAGE(PG8_SB(1, 1), b3 + hstep, voffB);
            PG8_WAIT_V(6); PG8_BAR; PG8_MMA(1, 1, At, B1); PG8_BAR;
        }
        E(acc, cur, wr, wc, fr, fq);
        if (!has_next) break;
#pragma unroll
        for (int a = 0; a < 2; ++a)
#pragma unroll
            for (int b = 0; b < 2; ++b)
#pragma unroll
                for (int m = 0; m < 4; ++m)
#pragma unroll
                    for (int n = 0; n < 2; ++n) acc[a][b][m][n] = (f32x4){0.f, 0.f, 0.f, 0.f};
        cur = nxt; cA = nA; cB = nB; ++ui;
    }
    PG8_WAIT_V(0);
    if (wr == 0) PG8_BAR;
    PG8_BAR;
#undef PG8_SA
#undef PG8_SB
#undef PG8_STAGE
#undef PG8_LDA
#undef PG8_LDB
#undef PG8_MMA
#undef PG8_WAIT_V
#undef PG8_WAIT_L
#undef PG8_BAR
#undef PG8_SCHED
#undef PG8_PTRS
}
}
using pg8::Unit;

struct EpiF32 {
    float* C; int ldc;
    __device__ __forceinline__ static bool swap(const Unit&) { return false; }
    __device__ __forceinline__ void operator()(const f32x4 (&acc)[2][2][4][2], const Unit& u, int wr, int wc, int fr, int fq) const {
        const int row0 = u.pm * 256 + wr * 64 + fr, col0 = u.pn * 256 + wc * 32 + 4 * fq;
#pragma unroll
        for (int ai = 0; ai < 2; ++ai)
#pragma unroll
            for (int m = 0; m < 4; ++m) { float* rowp = C + (size_t)(row0 + ai * 128 + m * 16) * ldc + col0;
#pragma unroll
                for (int bj = 0; bj < 2; ++bj)
#pragma unroll
                    for (int n = 0; n < 2; ++n) *(f32x4*)(rowp + bj * 128 + n * 16) = acc[ai][bj][m][n]; }
    }
};
struct EpiB16 {
    bf16_t* C; int ldc;
    __device__ __forceinline__ static bool swap(const Unit&) { return false; }
    __device__ __forceinline__ void operator()(const f32x4 (&acc)[2][2][4][2], const Unit& u, int wr, int wc, int fr, int fq) const {
        const int row0 = u.pm * 256 + wr * 64 + fr, col0 = u.pn * 256 + wc * 32 + 4 * fq;
#pragma unroll
        for (int ai = 0; ai < 2; ++ai)
#pragma unroll
            for (int m = 0; m < 4; ++m) { bf16_t* rowp = C + (size_t)(row0 + ai * 128 + m * 16) * ldc + col0;
#pragma unroll
                for (int bj = 0; bj < 2; ++bj)
#pragma unroll
                    for (int n = 0; n < 2; ++n) *(u32x2*)(rowp + bj * 128 + n * 16) = pk4(acc[ai][bj][m][n]); }
    }
};
template <bool OB16> struct EpiGate {
    const bf16_t* X1; const bf16_t* PLE; float* O; bf16_t* Ob;
    __device__ __forceinline__ static bool swap(const Unit&) { return false; }
    __device__ __forceinline__ void operator()(const f32x4 (&acc)[2][2][4][2], const Unit& u, int wr, int wc, int fr, int fq) const {
        const int row0 = u.pm * 256 + wr * 64 + fr, col0 = u.pn * 256 + wc * 32 + 4 * fq;
#pragma unroll
        for (int ai = 0; ai < 2; ++ai)
#pragma unroll
            for (int m = 0; m < 4; ++m) { const size_t ro = (size_t)(row0 + ai * 128 + m * 16) * 1024 + col0;
#pragma unroll
                for (int bj = 0; bj < 2; ++bj)
#pragma unroll
                    for (int n = 0; n < 2; ++n) { const size_t o = ro + bj * 128 + n * 16; const f32x4 a = acc[ai][bj][m][n]; const u32x2 xw = *(const u32x2*)(X1 + o), pw = *(const u32x2*)(PLE + o);
                        const f32x4 x1 = {bflo(xw.x), bfhi(xw.x), bflo(xw.y), bfhi(xw.y)}, pl = {bflo(pw.x), bfhi(pw.x), bflo(pw.y), bfhi(pw.y)}; f32x4 r;
#pragma unroll
                        for (int j = 0; j < 4; ++j) r[j] = x1[j] + sigmoid_f(a[j]) * pl[j];
                        if (OB16) *(u32x2*)(Ob + o) = pk4(r); else *(f32x4*)(O + o) = r; } }
    }
};
struct EpiInAttn {
    bf16_t *Zq, *Zk, *Zg, *vTp, *vTs; const float* tab; float* out;
    __device__ __forceinline__ static bool swap(const Unit& u) { return u.pn == 5; }
    __device__ __forceinline__ void operator()(const f32x4 (&acc)[2][2][4][2], const Unit& u, int wr, int wc, int fr, int fq) const {
        const int pn = u.pn;
        if (pn < 5) {
            const bool isq = pn < 4;
            const int fi = 16 * (wc & 1) + 4 * fq;
#pragma unroll
            for (int ai = 0; ai < 2; ++ai)
#pragma unroll
                for (int m = 0; m < 4; ++m) {
                    const int r = u.pm * 256 + ai * 128 + wr * 64 + m * 16 + fr;
                    const int pi = r < MP ? (r & 4095) : 4096 + ((r - MP) & 7);
                    const f32x4 t0 = *(const f32x4*)(tab + ((size_t)pi * 32 + fi) * 2), t1 = *(const f32x4*)(tab + ((size_t)pi * 32 + fi) * 2 + 4);
                    const float cs[4] = {t0[0], t0[2], t1[0], t1[2]}, sn[4] = {t0[1], t0[3], t1[1], t1[3]};
#pragma unroll
                    for (int bj = 0; bj < 2; ++bj) {
                        const f32x4 x1 = acc[ai][bj][m][0], x2 = acc[ai][bj][m][1]; f32x4 o1, o2;
#pragma unroll
                        for (int j = 0; j < 4; ++j) { o1[j] = x1[j] * cs[j] - x2[j] * sn[j]; o2[j] = x2[j] * cs[j] + x1[j] * sn[j]; }
                        const int hh = 2 * bj + (wc >> 1), d1 = 16 * (wc & 1) + 4 * fq;
                        if (isq) {
                            bf16_t* p = Zq + (size_t)r * 1024 + pn * 256 + hh * 64 + d1;
                            *(u32x2*)p = pk4(o1 * 0.125f); *(u32x2*)(p + 32) = pk4(o2 * 0.125f);
                        } else {
                            bf16_t* p = Zk + (size_t)r * 256 + hh * 64 + d1;
                            *(u32x2*)p = pk4(o1); *(u32x2*)(p + 32) = pk4(o2);
                            if (r < MP) { const int t = r & 4095; if (t >= 3968) { float* dst = out + OFF_KWP + ((size_t)((r >> 12) * 128 + t - 3968) * 4 + hh) * 64 + d1; *(f32x4*)dst = o1; *(f32x4*)(dst + 32) = o2; } }
                            else { const int rs = r - MP; float* dst = out + OFF_KWS + ((size_t)((rs >> 3) * 128 + 120 + (rs & 7)) * 4 + hh) * 64 + d1; *(f32x4*)dst = o1; *(f32x4*)(dst + 32) = o2; }
                        }
                    }
                    asm volatile("" ::: "memory");
                }
        } else if (pn == 5) {
#pragma unroll
            for (int ai = 0; ai < 2; ++ai)
#pragma unroll
                for (int m = 0; m < 4; ++m) {
                    const int e = ai * 128 + wr * 64 + m * 16 + fr, kvh = e >> 6, d = e & 63;
#pragma unroll
                    for (int bj = 0; bj < 2; ++bj)
#pragma unroll
                        for (int n = 0; n < 2; ++n) {
                            const int tok = u.pm * 256 + bj * 128 + wc * 32 + n * 16 + 4 * fq; const f32x4 v = acc[ai][bj][m][n];
                            if (tok < MP) { const int b = tok >> 12, t = tok & 4095;
                                *(u32x2*)(vTp + ((size_t)((b * 4 + kvh) * 64 + d)) * 4096 + t) = pk4(v);
                                if (t >= 3968) {
#pragma unroll
                                    for (int jj = 0; jj < 4; ++jj) out[OFF_VWP + ((size_t)(b * 128 + t - 3968 + jj) * 4 + kvh) * 64 + d] = v[jj]; }
                            } else { const int ts = tok - MP, bs = ts >> 3, l0 = ts & 7;
                                *(u32x2*)(vTs + ((size_t)((bs * 4 + kvh) * 64 + d)) * 8 + l0) = pk4(v);
#pragma unroll
                                for (int jj = 0; jj < 4; ++jj) out[OFF_VWS + ((size_t)(bs * 128 + 120 + l0 + jj) * 4 + kvh) * 64 + d] = v[jj]; }
                        }
                }
        } else {
#pragma unroll
            for (int ai = 0; ai < 2; ++ai)
#pragma unroll
                for (int m = 0; m < 4; ++m) { const int r = u.pm * 256 + ai * 128 + wr * 64 + m * 16 + fr;
#pragma unroll
                    for (int bj = 0; bj < 2; ++bj)
#pragma unroll
                        for (int n = 0; n < 2; ++n) { const f32x4 a = acc[ai][bj][m][n]; f32x4 s;
#pragma unroll
                            for (int j = 0; j < 4; ++j) s[j] = silu_f(a[j]);
                            *(u32x2*)(Zg + (size_t)r * 1024 + (pn - 6) * 256 + bj * 128 + wc * 32 + n * 16 + 4 * fq) = pk4(s); } }
        }
    }
};
struct EpiInRet {
    bf16_t *Zq, *Zk, *Zg, *vTp, *vTs; const float* tab;
    __device__ __forceinline__ static bool swap(const Unit& u) { return u.pn >= 8 && u.pn < 16; }
    __device__ __forceinline__ void operator()(const f32x4 (&acc)[2][2][4][2], const Unit& u, int wr, int wc, int fr, int fq) const {
        const int pn = u.pn;
        if (pn < 8) {
            const bool isq = pn < 4; const float sc = isq ? 1.f : 0.0625f;
            bf16_t* Z = isq ? Zq : Zk; const int hc = (pn & 3) * 256;
#pragma unroll
            for (int ai = 0; ai < 2; ++ai)
#pragma unroll
                for (int m = 0; m < 4; ++m) {
                    const int r = u.pm * 256 + ai * 128 + wr * 64 + m * 16 + fr;
                    const int pi = r < MP ? (r & 4095) : 4096 + ((r - MP) & 7);
#pragma unroll
                    for (int n = 0; n < 2; ++n) {
                        const int d = wc * 32 + n * 16 + 4 * fq;
                        const f32x4 t0 = *(const f32x4*)(tab + ((size_t)pi * 128 + d) * 2), t1 = *(const f32x4*)(tab + ((size_t)pi * 128 + d) * 2 + 4);
                        const float cs[4] = {t0[0], t0[2], t1[0], t1[2]}, sn[4] = {t0[1], t0[3], t1[1], t1[3]};
                        const f32x4 x1 = acc[ai][0][m][n], x2 = acc[ai][1][m][n]; f32x4 o1, o2;
#pragma unroll
                        for (int j = 0; j < 4; ++j) { o1[j] = (x1[j] * cs[j] - x2[j] * sn[j]) * sc; o2[j] = (x2[j] * cs[j] + x1[j] * sn[j]) * sc; }
                        bf16_t* p = Z + (size_t)r * 1024 + hc + d;
                        *(u32x2*)p = pk4(o1); *(u32x2*)(p + 128) = pk4(o2);
                    }
                }
        } else if (pn < 16) {
#pragma unroll
            for (int ai = 0; ai < 2; ++ai)
#pragma unroll
                for (int m = 0; m < 4; ++m) {
                    const int eg = (pn - 8) * 256 + ai * 128 + wr * 64 + m * 16 + fr, h = eg >> 9, e = eg & 511;
#pragma unroll
                    for (int bj = 0; bj < 2; ++bj)
#pragma unroll
                        for (int n = 0; n < 2; ++n) {
                            const int tok = u.pm * 256 + bj * 128 + wc * 32 + n * 16 + 4 * fq; const u32x2 w = pk4(acc[ai][bj][m][n]);
                            if (tok < MP) { const int b = tok >> 12, t = tok & 4095; *(u32x2*)(vTp + ((size_t)((b * 4 + h) * 512 + e)) * 4096 + t) = w; }
                            else { const int ts = tok - MP, bs = ts >> 3, l0 = ts & 7; *(u32x2*)(vTs + ((size_t)((bs * 4 + h) * 512 + e)) * 8 + l0) = w; }
                        }
                }
        } else {
#pragma unroll
            for (int ai = 0; ai < 2; ++ai)
#pragma unroll
                for (int m = 0; m < 4; ++m) { const int r = u.pm * 256 + ai * 128 + wr * 64 + m * 16 + fr;
#pragma unroll
                    for (int bj = 0; bj < 2; ++bj)
#pragma unroll
                        for (int n = 0; n < 2; ++n) { const f32x4 a = acc[ai][bj][m][n]; f32x4 s;
#pragma unroll
                            for (int j = 0; j < 4; ++j) s[j] = silu_f(a[j]);
                            *(u32x2*)(Zg + (size_t)r * 2048 + (pn - 16) * 256 + bj * 128 + wc * 32 + n * 16 + 4 * fq) = pk4(s); } }
        }
    }
};

__device__ __forceinline__ void transpose_tile(const float* __restrict__ W, bf16_t* __restrict__ Wt, int K, int N, bool perm, int tile, LAS float* T) {
    const int tid = otid(), ntn = N >> 6;
    const int n0 = (tile % ntn) * 64, k0 = (tile / ntn) * 64, nn = tid & 63;
    const int nd = n0 + nn; int ns = nd;
    if (perm && nd < 1280) { const int p = nd & 63; ns = (nd - p) + (p >> 5) * 16 + (p & 15) + ((p >> 4) & 1) * 32; }
#pragma unroll
    for (int i = 0; i < 8; ++i) { const int kk = (tid >> 6) + 8 * i; T[kk * 65 + nn] = W[(size_t)(k0 + kk) * N + ns]; }
    __syncthreads();
    const int kk2 = (tid & 31) * 2;
#pragma unroll
    for (int i = 0; i < 4; ++i) { const int n2 = (tid >> 5) + 16 * i; *(unsigned*)(Wt + (size_t)(n0 + n2) * K + k0 + kk2) = cvt_pk_bf16(T[kk2 * 65 + n2], T[(kk2 + 1) * 65 + n2]); }
    __syncthreads();
}

__device__ __forceinline__ void rms_rows(const float* __restrict__ Xa, const float* __restrict__ Xb, const float* __restrict__ g, bf16_t* __restrict__ H, int G) {
    const int tid_o = otid(), wave = tid_o >> 6, lane = tid_o & 63;
    for (int row = blockIdx.x * 8 + wave; row < MT; row += G * 8) {
        const float* x = row < MP ? Xa + (size_t)row * 1024 : Xb + (size_t)(row - MP) * 1024;
        f32x4 v[4]; float ss = 0.f;
#pragma unroll
        for (int i = 0; i < 4; ++i) { v[i] = *(const f32x4*)(x + lane * 4 + 256 * i); ss += v[i][0] * v[i][0] + v[i][1] * v[i][1] + v[i][2] * v[i][2] + v[i][3] * v[i][3]; }
        ss = wave_sum(ss);
        const float rr = rsqrtf(ss * (1.f / 1024.f) + EPS);
#pragma unroll
        for (int i = 0; i < 4; ++i) { const f32x4 gg = *(const f32x4*)(g + lane * 4 + 256 * i); *(u32x2*)(H + (size_t)row * 1024 + lane * 4 + 256 * i) = pk4(v[i] * rr * gg); }
    }
}
__device__ __forceinline__ void rms_rows_b16(const bf16_t* __restrict__ X, const float* __restrict__ g, bf16_t* __restrict__ H, int G) {
    const int tid_o = otid(), wave = tid_o >> 6, lane = tid_o & 63;
    for (int row = blockIdx.x * 8 + wave; row < MT; row += G * 8) {
        const u32x4 a = *(const u32x4*)(X + (size_t)row * 1024 + lane * 8), b = *(const u32x4*)(X + (size_t)row * 1024 + 512 + lane * 8);
        const float v[16] = {bflo(a.x), bfhi(a.x), bflo(a.y), bfhi(a.y), bflo(a.z), bfhi(a.z), bflo(a.w), bfhi(a.w), bflo(b.x), bfhi(b.x), bflo(b.y), bfhi(b.y), bflo(b.z), bfhi(b.z), bflo(b.w), bfhi(b.w)};
        float ss = 0.f;
#pragma unroll
        for (int i = 0; i < 16; ++i) ss += v[i] * v[i];
        ss = wave_sum(ss);
        const float rr = rsqrtf(ss * (1.f / 1024.f) + EPS);
#pragma unroll
        for (int hh = 0; hh < 2; ++hh) { const int c = hh * 512 + lane * 8; const f32x4 g0 = *(const f32x4*)(g + c), g1 = *(const f32x4*)(g + c + 4); u32x4 o;
            o.x = cvt_pk_bf16(v[hh * 8 + 0] * rr * g0[0], v[hh * 8 + 1] * rr * g0[1]); o.y = cvt_pk_bf16(v[hh * 8 + 2] * rr * g0[2], v[hh * 8 + 3] * rr * g0[3]);
            o.z = cvt_pk_bf16(v[hh * 8 + 4] * rr * g1[0], v[hh * 8 + 5] * rr * g1[1]); o.w = cvt_pk_bf16(v[hh * 8 + 6] * rr * g1[2], v[hh * 8 + 7] * rr * g1[3]);
            *(u32x4*)(H + (size_t)row * 1024 + c) = o; }
    }
}
template <bool XB16>
__device__ __forceinline__ void resid_rows(const float* __restrict__ Xa, const float* __restrict__ Xb, const bf16_t* __restrict__ Xh, const bf16_t* __restrict__ Y, const float* __restrict__ g, bf16_t* __restrict__ H, int G) {
    const int tid_o = otid(), wave = tid_o >> 6, lane = tid_o & 63;
    for (int row = blockIdx.x * 8 + wave; row < MT; row += G * 8) {
        const bf16_t* y = Y + (size_t)row * 1024;
        f32x4 v[4]; float ss = 0.f;
#pragma unroll
        for (int i = 0; i < 4; ++i) { const u32x2 yw = *(const u32x2*)(y + lane * 4 + 256 * i); v[i] = (f32x4){bflo(yw.x), bfhi(yw.x), bflo(yw.y), bfhi(yw.y)}; ss += v[i][0] * v[i][0] + v[i][1] * v[i][1] + v[i][2] * v[i][2] + v[i][3] * v[i][3]; }
        ss = wave_sum(ss);
        const float rr = rsqrtf(ss * (1.f / 1024.f) + EPS);
#pragma unroll
        for (int i = 0; i < 4; ++i) { const int c = lane * 4 + 256 * i; const f32x4 gg = *(const f32x4*)(g + c); f32x4 xx;
            if (XB16) { const u32x2 xw = *(const u32x2*)(Xh + (size_t)row * 1024 + c); xx = (f32x4){bflo(xw.x), bfhi(xw.x), bflo(xw.y), bfhi(xw.y)}; }
            else xx = *(const f32x4*)((row < MP ? Xa + (size_t)row * 1024 : Xb + (size_t)(row - MP) * 1024) + c);
            *(u32x2*)(H + (size_t)row * 1024 + c) = pk4(xx + v[i] * rr * gg); }
    }
}

struct SkF32 { float* C; __device__ __forceinline__ void operator()(int row, int col, f32x4 v) const { *(f32x4*)(C + (size_t)row * 1024 + col) = v; } };
struct SkB16 { bf16_t* C; __device__ __forceinline__ void operator()(int row, int col, f32x4 v) const { *(u32x2*)(C + (size_t)row * 1024 + col) = pk4(v); } };
template <bool OB16> struct SkGate { const bf16_t* X1; const bf16_t* PLE; float* O; bf16_t* Ob;
    __device__ __forceinline__ void operator()(int row, int col, f32x4 a) const { const size_t o = (size_t)row * 1024 + col; const u32x2 xw = *(const u32x2*)(X1 + o), pw = *(const u32x2*)(PLE + o);
        const f32x4 x1 = {bflo(xw.x), bfhi(xw.x), bflo(xw.y), bfhi(xw.y)}, pl = {bflo(pw.x), bfhi(pw.x), bflo(pw.y), bfhi(pw.y)}; f32x4 r;
#pragma unroll
        for (int j = 0; j < 4; ++j) r[j] = x1[j] + sigmoid_f(a[j]) * pl[j];
        if (OB16) *(u32x2*)(Ob + o) = pk4(r); else *(f32x4*)(O + o) = r; } };
template <class Epi>
__device__ __forceinline__ void skinny_gemm(LAS unsigned char* lds, const bf16_t* __restrict__ A, const bf16_t* __restrict__ Bt, int K, const Epi& E, int G) {
    LAS float* red = (LAS float*)lds;
    const int tid = otid(), w = tid >> 6, lane = tid & 63, l16 = lane & 15, g = lane >> 4;
    const int KS = K >> 3, nks = KS >> 5;
    for (int u = blockIdx.x; u < 256; u += G) {
        const int row0 = (u >> 4) * 64, col0 = (u & 15) * 64;
        const bf16_t* ap = A + (size_t)(row0 + l16) * K + w * KS + 8 * g;
        const bf16_t* bp = Bt + (size_t)(col0 + l16) * K + w * KS + 8 * g;
        f32x4 acc[4][4];
#pragma unroll
        for (int mt = 0; mt < 4; ++mt)
#pragma unroll
            for (int nt = 0; nt < 4; ++nt) acc[mt][nt] = (f32x4){0.f, 0.f, 0.f, 0.f};
#pragma unroll 4
        for (int ks = 0; ks < nks; ++ks) {
            bf16x8 af[4], bf[4];
#pragma unroll
            for (int t = 0; t < 4; ++t) { af[t] = *(const bf16x8*)(ap + (size_t)(16 * t) * K + 32 * ks); bf[t] = *(const bf16x8*)(bp + (size_t)(16 * t) * K + 32 * ks); }
#pragma unroll
            for (int mt = 0; mt < 4; ++mt)
#pragma unroll
                for (int nt = 0; nt < 4; ++nt) acc[mt][nt] = __builtin_amdgcn_mfma_f32_16x16x32_bf16(bf[nt], af[mt], acc[mt][nt], 0, 0, 0);
        }
        __syncthreads();
#pragma unroll
        for (int mt = 0; mt < 4; ++mt)
#pragma unroll
            for (int nt = 0; nt < 4; ++nt) *(LAS f32x4*)(red + (w * 64 + 16 * mt + l16) * 68 + 16 * nt + 4 * g) = acc[mt][nt];
        __syncthreads();
#pragma unroll
        for (int j = 0; j < 2; ++j) { const int q = tid + 512 * j, row = q >> 4, c4 = (q & 15) * 4; f32x4 sum = *(const LAS f32x4*)(red + row * 68 + c4);
#pragma unroll
            for (int ww = 1; ww < 8; ++ww) sum += *(const LAS f32x4*)(red + (ww * 64 + row) * 68 + c4);
            E(row0 + row, col0 + c4, sum); }
    }
}

__device__ __forceinline__ void attn_prompt(LAS unsigned char* lds, const bf16_t* __restrict__ Zq, const bf16_t* __restrict__ Zk, const bf16_t* __restrict__ Zg, const bf16_t* __restrict__ vTp,
                                            const float* __restrict__ sinks, bf16_t* __restrict__ OG, int G) {
    LAS bf16_t* Ks = (LAS bf16_t*)lds;
    LAS bf16_t* Vt = (LAS bf16_t*)(lds + 256 * 72 * 2);
    const int tid = otid(), w = tid >> 6, lane = tid & 63, l16 = lane & 15, g = lane >> 4;
    for (int it = blockIdx.x; it < 512; it += G) {
        const int kvh = it & 3, nb = (it >> 2) & 31, b = it >> 7;
        __syncthreads();
#pragma unroll
        for (int i = 0; i < 4; ++i) { const int ch = tid + 512 * i, s = ch >> 3, c8 = ch & 7, t = (nb - 1) * 128 + s;
            u32x4 val = {0u, 0u, 0u, 0u}; if (t >= 0) val = *(const u32x4*)(Zk + (size_t)(b * 4096 + t) * 256 + kvh * 64 + c8 * 8);
            *(LAS u32x4*)(Ks + s * 72 + c8 * 8) = val; }
#pragma unroll
        for (int i = 0; i < 4; ++i) { const int ch = tid + 512 * i, d = ch >> 5, s0 = (ch & 31) * 8, t0 = (nb - 1) * 128 + s0;
            u32x4 val = {0u, 0u, 0u, 0u}; if (t0 >= 0) val = *(const u32x4*)(vTp + ((size_t)((b * 4 + kvh) * 64 + d)) * 4096 + t0);
            *(LAS u32x4*)(Vt + d * 264 + s0) = val; }
        __syncthreads();
        const int head = kvh * 4 + (w >> 1);
        const float sk = sinks[head];
        for (int qi = 0; qi < 4; ++qi) {
            const int qt = (w & 1) * 4 + qi;
            const size_t tq = (size_t)b * 4096 + nb * 128 + qt * 16 + l16;
            bf16x8 qf[2];
#pragma unroll
            for (int ks = 0; ks < 2; ++ks) qf[ks] = *(const bf16x8*)(Zq + tq * 1024 + head * 64 + ks * 32 + g * 8);
            f32x4 sa[9];
#pragma unroll
            for (int j = 0; j < 9; ++j) { sa[j] = (f32x4){0.f, 0.f, 0.f, 0.f};
#pragma unroll
                for (int ks = 0; ks < 2; ++ks) { const bf16x8 kf = *(const LAS bf16x8*)(Ks + (16 * (qt + j) + l16) * 72 + ks * 32 + g * 8);
                    sa[j] = __builtin_amdgcn_mfma_f32_16x16x32_bf16(kf, qf[ks], sa[j], 0, 0, 0); } }
            float mx = sk;
#pragma unroll
            for (int j = 0; j < 9; ++j)
#pragma unroll
                for (int r = 0; r < 4; ++r) {
                    bool vis = true;
                    if (j == 0) vis = (4 * g + r) > l16;
                    if (j == 8) vis = (4 * g + r) <= l16;
                    if (nb == 0 && (qt + j) < 8) vis = false;
                    sa[j][r] = vis ? sa[j][r] : -1e30f;
                    mx = fmaxf(mx, sa[j][r]);
                }
            mx = fmaxf(mx, __shfl_xor(mx, 16, 64)); mx = fmaxf(mx, __shfl_xor(mx, 32, 64));
            float sum = 0.f;
#pragma unroll
            for (int j = 0; j < 9; ++j)
#pragma unroll
                for (int r = 0; r < 4; ++r) { const float p = __expf(sa[j][r] - mx); sa[j][r] = p; sum += p; }
            sum += __shfl_xor(sum, 16, 64); sum += __shfl_xor(sum, 32, 64);
            const float inv = 1.f / (sum + __expf(sk - mx));
            f32x4 oa[4];
#pragma unroll
            for (int dt = 0; dt < 4; ++dt) oa[dt] = (f32x4){0.f, 0.f, 0.f, 0.f};
#pragma unroll
            for (int u = 0; u < 5; ++u) {
                u32x4 pw; pw.x = cvt_pk_bf16(sa[2 * u][0], sa[2 * u][1]); pw.y = cvt_pk_bf16(sa[2 * u][2], sa[2 * u][3]);
                if (u < 4) { pw.z = cvt_pk_bf16(sa[2 * u + 1][0], sa[2 * u + 1][1]); pw.w = cvt_pk_bf16(sa[2 * u + 1][2], sa[2 * u + 1][3]); } else { pw.z = 0u; pw.w = 0u; }
                const bf16x8 pf = __builtin_bit_cast(bf16x8, pw);
                const int k0 = 16 * (qt + 2 * u) + 4 * g, k1 = (u < 4) ? k0 + 16 : k0;
#pragma unroll
                for (int dt = 0; dt < 4; ++dt) {
                    const u32x2 v0 = *(const LAS u32x2*)(Vt + (16 * dt + l16) * 264 + k0), v1 = *(const LAS u32x2*)(Vt + (16 * dt + l16) * 264 + k1);
                    u32x4 vw; vw.x = v0.x; vw.y = v0.y; vw.z = v1.x; vw.w = v1.y;
                    oa[dt] = __builtin_amdgcn_mfma_f32_16x16x32_bf16(__builtin_bit_cast(bf16x8, vw), pf, oa[dt], 0, 0, 0);
                }
            }
#pragma unroll
            for (int dt = 0; dt < 4; ++dt) {
                const size_t o = tq * 1024 + head * 64 + 16 * dt + 4 * g;
                const u32x2 gw = *(const u32x2*)(Zg + o);
                f32x4 r; r[0] = oa[dt][0] * inv * bflo(gw.x); r[1] = oa[dt][1] * inv * bfhi(gw.x); r[2] = oa[dt][2] * inv * bflo(gw.y); r[3] = oa[dt][3] * inv * bfhi(gw.y);
                *(u32x2*)(OG + o) = pk4(r);
            }
        }
    }
}

__device__ __forceinline__ void attn_sample(LAS unsigned char* lds, const Params& P, const bf16_t* __restrict__ Zq, const bf16_t* __restrict__ Zk, const bf16_t* __restrict__ Zg, const bf16_t* __restrict__ vTs,
                                            bf16_t* __restrict__ OG, int G) {
    constexpr int KS_B = 144 * 72 * 2, VT_B = 64 * 152 * 2, SLOT_B = KS_B + VT_B;
    for (int pr = blockIdx.x; pr < 256; pr += G) {
        const int tid = otid(), w = tid >> 6, lane = tid & 63, l16 = lane & 15, g = lane >> 4;
        __syncthreads();
#pragma unroll
        for (int sl = 0; sl < 2; ++sl) {
            const int it = 2 * pr + sl, bs = it >> 2, kvh = it & 3;
            LAS bf16_t* Ks = (LAS bf16_t*)(lds + sl * SLOT_B); LAS bf16_t* Vt = (LAS bf16_t*)(lds + sl * SLOT_B + KS_B);
#pragma unroll
            for (int i = 0; i < 4; ++i) { const int ch = tid + 512 * i, j = ch >> 4, d4 = (ch & 15) * 4;
                const size_t src = ((size_t)(bs * 128 + j) * 4 + kvh) * 64 + d4;
                const f32x4 kv = *(const f32x4*)(P.cache_k + src), vv = *(const f32x4*)(P.cache_v + src);
                if (j >= 8) { const size_t dst = ((size_t)(bs * 128 + j - 8) * 4 + kvh) * 64 + d4; *(f32x4*)(P.out + OFF_KWS + dst) = kv; *(f32x4*)(P.out + OFF_VWS + dst) = vv; }
                *(LAS u32x2*)(Ks + j * 72 + d4) = pk4(kv);
                const u32x2 vw = pk4(vv);
                Vt[(d4 + 0) * 152 + j] = (bf16_t)(vw.x & 0xffffu); Vt[(d4 + 1) * 152 + j] = (bf16_t)(vw.x >> 16); Vt[(d4 + 2) * 152 + j] = (bf16_t)(vw.y & 0xffffu); Vt[(d4 + 3) * 152 + j] = (bf16_t)(vw.y >> 16); }
            { const int l = tid >> 6, d = tid & 63;
              Ks[(128 + l) * 72 + d] = Zk[(size_t)(MP + bs * 8 + l) * 256 + kvh * 64 + d]; Ks[(136 + l) * 72 + d] = 0; }
            if (tid < 64) { const u32x4 nv = *(const u32x4*)(vTs + ((size_t)((bs * 4 + kvh) * 64 + tid)) * 8);
                *(LAS u32x4*)(Vt + tid * 152 + 128) = nv; *(LAS u32x4*)(Vt + tid * 152 + 136) = (u32x4){0u, 0u, 0u, 0u}; *(LAS u32x4*)(Vt + tid * 152 + 144) = (u32x4){0u, 0u, 0u, 0u}; }
        }
        __syncthreads();
        if (w < 4) {
            const int sl = w >> 1, t = w & 1, it = 2 * pr + sl, bs = it >> 2, kvh = it & 3;
            const LAS bf16_t* Ks = (const LAS bf16_t*)(lds + sl * SLOT_B); const LAS bf16_t* Vt = (const LAS bf16_t*)(lds + sl * SLOT_B + KS_B);
            const int hq = 2 * t + (l16 >> 3), l = l16 & 7, head = kvh * 4 + hq;
            const size_t tq = (size_t)(MP + bs * 8 + l);
            const float sk = P.sinks[head];
            bf16x8 qf[2];
#pragma unroll
            for (int ks = 0; ks < 2; ++ks) qf[ks] = *(const bf16x8*)(Zq + tq * 1024 + head * 64 + ks * 32 + g * 8);
            f32x4 sa[9];
#pragma unroll
            for (int j = 0; j < 9; ++j) { sa[j] = (f32x4){0.f, 0.f, 0.f, 0.f};
#pragma unroll
                for (int ks = 0; ks < 2; ++ks) { const bf16x8 kf = *(const LAS bf16x8*)(Ks + (16 * j + l16) * 72 + ks * 32 + g * 8);
                    sa[j] = __builtin_amdgcn_mfma_f32_16x16x32_bf16(kf, qf[ks], sa[j], 0, 0, 0); } }
            float mx = sk;
#pragma unroll
            for (int j = 0; j < 9; ++j)
#pragma unroll
                for (int r = 0; r < 4; ++r) { const int key = 16 * j + 4 * g + r;
                    const bool vis = (j < 8) ? (key > l) : (key - 128 <= l);
                    sa[j][r] = vis ? sa[j][r] : -1e30f; mx = fmaxf(mx, sa[j][r]); }
            mx = fmaxf(mx, __shfl_xor(mx, 16, 64)); mx = fmaxf(mx, __shfl_xor(mx, 32, 64));
            float sum = 0.f;
#pragma unroll
            for (int j = 0; j < 9; ++j)
#pragma unroll
                for (int r = 0; r < 4; ++r) { const float p = __expf(sa[j][r] - mx); sa[j][r] = p; sum += p; }
            sum += __shfl_xor(sum, 16, 64); sum += __shfl_xor(sum, 32, 64);
            const float inv = 1.f / (sum + __expf(sk - mx));
            f32x4 oa[4];
#pragma unroll
            for (int dt = 0; dt < 4; ++dt) oa[dt] = (f32x4){0.f, 0.f, 0.f, 0.f};
#pragma unroll
            for (int u = 0; u < 5; ++u) {
                u32x4 pw; pw.x = cvt_pk_bf16(sa[2 * u][0], sa[2 * u][1]); pw.y = cvt_pk_bf16(sa[2 * u][2], sa[2 * u][3]);
                if (u < 4) { pw.z = cvt_pk_bf16(sa[2 * u + 1][0], sa[2 * u + 1][1]); pw.w = cvt_pk_bf16(sa[2 * u + 1][2], sa[2 * u + 1][3]); } else { pw.z = 0u; pw.w = 0u; }
                const bf16x8 pf = __builtin_bit_cast(bf16x8, pw);
                const int k0 = 32 * u + 4 * g, k1 = (u < 4) ? k0 + 16 : k0;
#pragma unroll
                for (int dt = 0; dt < 4; ++dt) {
                    const u32x2 v0 = *(const LAS u32x2*)(Vt + (16 * dt + l16) * 152 + k0), v1 = *(const LAS u32x2*)(Vt + (16 * dt + l16) * 152 + k1);
                    u32x4 vw; vw.x = v0.x; vw.y = v0.y; vw.z = v1.x; vw.w = v1.y;
                    oa[dt] = __builtin_amdgcn_mfma_f32_16x16x32_bf16(__builtin_bit_cast(bf16x8, vw), pf, oa[dt], 0, 0, 0);
                }
            }
#pragma unroll
            for (int dt = 0; dt < 4; ++dt) {
                const size_t o = tq * 1024 + head * 64 + 16 * dt + 4 * g;
                const u32x2 gw = *(const u32x2*)(Zg + o);
                f32x4 r; r[0] = oa[dt][0] * inv * bflo(gw.x); r[1] = oa[dt][1] * inv * bfhi(gw.x); r[2] = oa[dt][2] * inv * bflo(gw.y); r[3] = oa[dt][3] * inv * bfhi(gw.y);
                *(u32x2*)(OG + o) = pk4(r);
            }
        }
    }
}

__device__ __forceinline__ void ret_A(LAS unsigned char* lds, const bf16_t* __restrict__ Zq, const bf16_t* __restrict__ Zk, bf16_t* __restrict__ ABUF, bf16_t* __restrict__ KDT, int G) {
    LAS bf16_t* Qs = (LAS bf16_t*)lds;
    LAS bf16_t* Ks = (LAS bf16_t*)(lds + 128 * 264 * 2);
    const int tid = otid(), w = tid >> 6, lane = tid & 63, l16 = lane & 15, g = lane >> 4;
    for (int it = blockIdx.x; it < 512; it += G) {
        const int c = it & 31, h = (it >> 5) & 3, b = it >> 7;
        const float lg = ret_lg(h);
        const size_t tok0 = (size_t)b * 4096 + c * 128;
        __syncthreads();
#pragma unroll
        for (int i = 0; i < 8; ++i) { const int ch = tid + 512 * i, s = ch >> 5, c8 = (ch & 31) * 8; const size_t src = (tok0 + s) * 1024 + h * 256 + c8;
            *(LAS u32x4*)(Qs + s * 264 + c8) = *(const u32x4*)(Zq + src); *(LAS u32x4*)(Ks + s * 264 + c8) = *(const u32x4*)(Zk + src); }
        __syncthreads();
        const int i_row = 16 * w + l16;
#pragma unroll
        for (int nt = 0; nt < 8; ++nt) {
            f32x4 a = {0.f, 0.f, 0.f, 0.f};
            if (nt <= w) {
#pragma unroll
                for (int ks = 0; ks < 8; ++ks) { const bf16x8 kf = *(const LAS bf16x8*)(Ks + (16 * nt + l16) * 264 + ks * 32 + g * 8), qf = *(const LAS bf16x8*)(Qs + i_row * 264 + ks * 32 + g * 8);
                    a = __builtin_amdgcn_mfma_f32_16x16x32_bf16(kf, qf, a, 0, 0, 0); }
#pragma unroll
                for (int r = 0; r < 4; ++r) { const int s = 16 * nt + 4 * g + r; a[r] = (s <= i_row) ? a[r] * __expf((float)(i_row - s) * lg) : 0.f; }
            }
            *(u32x2*)(ABUF + ((size_t)it * 128 + i_row) * 128 + 16 * nt + 4 * g) = pk4(a);
        }
        { const int d = tid & 255, sg0 = tid >> 8;
#pragma unroll
          for (int k = 0; k < 8; ++k) { const int s0 = 8 * (sg0 + 2 * k); float v[8];
#pragma unroll
              for (int jj = 0; jj < 8; ++jj) v[jj] = bf2f(Ks[(s0 + jj) * 264 + d]) * __expf((float)(127 - s0 - jj) * lg);
              u32x4 wv; wv.x = cvt_pk_bf16(v[0], v[1]); wv.y = cvt_pk_bf16(v[2], v[3]); wv.z = cvt_pk_bf16(v[4], v[5]); wv.w = cvt_pk_bf16(v[6], v[7]);
              *(u32x4*)(KDT + ((size_t)it * 256 + d) * 128 + s0) = wv; } }
    }
}

__device__ __forceinline__ void ret_seq_unit(LAS unsigned char* lds, int u, const bf16_t* __restrict__ Zq, const bf16_t* __restrict__ vTp, const bf16_t* __restrict__ ABUF, const bf16_t* __restrict__ KDT,
                                             bf16_t* __restrict__ ORET, float* __restrict__ out) {
    LAS bf16_t* ST = (LAS bf16_t*)lds;
    LAS bf16_t* VT = (LAS bf16_t*)(lds + 2 * 64 * 264 * 2);
    const int tid = otid(), w = tid >> 6, lane = tid & 63, l16 = lane & 15, g = lane >> 4;
    const int xcd = u & 7, jj = u >> 3, bh = xcd * 2 + (jj >> 3), es = jj & 7, b = bh >> 2, h = bh & 3;
    const float lg = ret_lg(h), g128 = __expf(128.f * lg), gi = __expf((float)(16 * w + l16 + 1) * lg);
    __syncthreads();
    for (int e = tid; e < 64 * 264 / 2; e += NT) ((LAS unsigned*)ST)[e] = 0u;
    const bf16_t* vrow = vTp + ((size_t)bh * 512 + es * 64 + (tid >> 3)) * 4096 + (tid & 7) * 16;
    LAS bf16_t* vdst = VT + (tid >> 3) * 136 + (tid & 7) * 16;
    { const u32x4 a = *(const u32x4*)vrow, bq = *(const u32x4*)(vrow + 8); *(LAS u32x4*)vdst = a; *(LAS u32x4*)(vdst + 8) = bq; }
    f32x4 sacc[2][4];
#pragma unroll
    for (int dt = 0; dt < 2; ++dt)
#pragma unroll
        for (int et = 0; et < 4; ++et) sacc[dt][et] = (f32x4){0.f, 0.f, 0.f, 0.f};
    const bf16_t* aptr = ABUF + ((size_t)bh * 32 * 128 + 16 * w + l16) * 128 + 8 * g;
    const bf16_t* qptr = Zq + ((size_t)b * 4096 + 16 * w + l16) * 1024 + h * 256 + 8 * g;
    const bf16_t* kptr = KDT + ((size_t)bh * 32 * 256 + 32 * w + l16) * 128 + 8 * g;
    bf16_t* optr = ORET + ((size_t)b * 4096 + 16 * w + l16) * 2048 + h * 512 + es * 64 + 4 * g;
    bf16x8 af[4], qf[8], kf[2][4];
#pragma unroll
    for (int ks = 0; ks < 4; ++ks) af[ks] = *(const bf16x8*)(aptr + 32 * ks);
#pragma unroll
    for (int kd = 0; kd < 8; ++kd) qf[kd] = *(const bf16x8*)(qptr + 32 * kd);
    __syncthreads();
    for (int c = 0; c < 32; ++c) {
        const int buf = c & 1;
#pragma unroll
        for (int dt = 0; dt < 2; ++dt)
#pragma unroll
            for (int ks = 0; ks < 4; ++ks) kf[dt][ks] = *(const bf16x8*)(kptr + (size_t)c * 256 * 128 + dt * 2048 + 32 * ks);
        u32x4 nv0 = {0u, 0u, 0u, 0u}, nv1 = {0u, 0u, 0u, 0u};
        if (c < 31) { nv0 = *(const u32x4*)(vrow + (c + 1) * 128); nv1 = *(const u32x4*)(vrow + (c + 1) * 128 + 8); }
        const LAS bf16_t* VTb = VT + buf * 64 * 136; const LAS bf16_t* STb = ST + buf * 64 * 264;
#pragma unroll
        for (int et = 0; et < 4; ++et) {
            f32x4 oin = {0.f, 0.f, 0.f, 0.f}, ocr = {0.f, 0.f, 0.f, 0.f};
#pragma unroll
            for (int ks = 0; ks < 4; ++ks) { const bf16x8 vf = *(const LAS bf16x8*)(VTb + (16 * et + l16) * 136 + 32 * ks + 8 * g); oin = __builtin_amdgcn_mfma_f32_16x16x32_bf16(vf, af[ks], oin, 0, 0, 0); }
#pragma unroll
            for (int kd = 0; kd < 8; ++kd) { const bf16x8 sf = *(const LAS bf16x8*)(STb + (16 * et + l16) * 264 + 32 * kd + 8 * g); ocr = __builtin_amdgcn_mfma_f32_16x16x32_bf16(sf, qf[kd], ocr, 0, 0, 0); }
            *(u32x2*)(optr + (size_t)c * 128 * 2048 + 16 * et) = pk4(oin + ocr * gi);
        }
        if (c < 31) {
#pragma unroll
            for (int ks = 0; ks < 4; ++ks) af[ks] = *(const bf16x8*)(aptr + (size_t)(c + 1) * 128 * 128 + 32 * ks);
#pragma unroll
            for (int kd = 0; kd < 8; ++kd) qf[kd] = *(const bf16x8*)(qptr + (size_t)(c + 1) * 128 * 1024 + 32 * kd);
        }
#pragma unroll
        for (int dt = 0; dt < 2; ++dt)
#pragma unroll
            for (int et = 0; et < 4; ++et) sacc[dt][et] *= g128;
#pragma unroll
        for (int et = 0; et < 4; ++et)
#pragma unroll
            for (int ks = 0; ks < 4; ++ks) { const bf16x8 vf = *(const LAS bf16x8*)(VTb + (16 * et + l16) * 136 + 32 * ks + 8 * g);
#pragma unroll
                for (int dt = 0; dt < 2; ++dt) sacc[dt][et] = __builtin_amdgcn_mfma_f32_16x16x32_bf16(kf[dt][ks], vf, sacc[dt][et], 0, 0, 0); }
#pragma unroll
        for (int dt = 0; dt < 2; ++dt)
#pragma unroll
            for (int et = 0; et < 4; ++et) *(LAS u32x2*)(ST + ((buf ^ 1) * 64 + 16 * et + l16) * 264 + 32 * w + 16 * dt + 4 * g) = pk4(sacc[dt][et]);
        if (c < 31) { LAS bf16_t* d2 = vdst + (buf ^ 1) * 64 * 136; *(LAS u32x4*)d2 = nv0; *(LAS u32x4*)(d2 + 8) = nv1; }
        __syncthreads();
    }
#pragma unroll
    for (int dt = 0; dt < 2; ++dt)
#pragma unroll
        for (int et = 0; et < 4; ++et)
#pragma unroll
            for (int r = 0; r < 4; ++r) out[OFF_RSP + ((size_t)bh * 256 + 32 * w + 16 * dt + 4 * g + r) * 512 + es * 64 + 16 * et + l16] = sacc[dt][et][r];
}

__device__ __forceinline__ void ret_sample(LAS unsigned char* lds, const Params& P, const bf16_t* __restrict__ Zq, const bf16_t* __restrict__ Zk, const bf16_t* __restrict__ vTs, bf16_t* __restrict__ ORET, unsigned* ctr, unsigned* done, unsigned target) {
    LAS float* qs = (LAS float*)lds;
    LAS float* kds = qs + 2048;
    LAS float* A8 = kds + 2048;
    LAS float* red = A8 + 64;
    volatile LAS int* slot = (volatile LAS int*)(lds + LDS_BYTES - 32);
    for (;;) {
        const int tid = otid();
        __syncthreads();
        if (tid == 0) *slot = (done && xb_ld(done) >= target) ? 512 : (int)atomicAdd(ctr, 1u);
        __syncthreads();
        const int it = *slot;
        if (it >= 512) break;
        const int bs = it >> 2, h = it & 3;
        const float lg = ret_lg(h), g8 = __expf(8.f * lg), ig8 = __expf(-8.f * lg);
#pragma unroll
        for (int k = 0; k < 4; ++k) { const int e = tid + 512 * k, i = e >> 8, d = e & 255; const size_t src = (size_t)(MP + bs * 8 + i) * 1024 + h * 256 + d;
            qs[d * 8 + i] = bf2f(Zq[src]) * __expf((float)(i + 1) * lg); kds[d * 8 + i] = bf2f(Zk[src]) * __expf((float)(7 - i) * lg); }
        __syncthreads();
        if (tid < 64) { const int i = tid >> 3, s = tid & 7; float a = 0.f;
            if (s <= i) { for (int d = 0; d < 256; ++d) a += qs[d * 8 + i] * kds[d * 8 + s]; a *= ig8; }
            A8[tid] = a; }
        const int eg = tid & 127, dp = tid >> 7, e0 = 4 * eg;
        f32x4 vq[8];
#pragma unroll
        for (int jj = 0; jj < 4; ++jj) { const u32x4 wv = *(const u32x4*)(vTs + ((size_t)((bs * 4 + h) * 512 + e0 + jj)) * 8);
            vq[0][jj] = bflo(wv.x); vq[1][jj] = bfhi(wv.x); vq[2][jj] = bflo(wv.y); vq[3][jj] = bfhi(wv.y); vq[4][jj] = bflo(wv.z); vq[5][jj] = bfhi(wv.z); vq[6][jj] = bflo(wv.w); vq[7][jj] = bfhi(wv.w); }
        f32x4 cr[8];
#pragma unroll
        for (int i = 0; i < 8; ++i) cr[i] = (f32x4){0.f, 0.f, 0.f, 0.f};
        const size_t sbase = ((size_t)(bs * 4 + h) * 256 + dp * 64) * 512 + e0;
        const float* __restrict__ sp = P.state_ret + sbase; float* __restrict__ op = P.out + OFF_RSS + sbase;
        f32x4 sta[8];
#pragma unroll
        for (int j = 0; j < 8; ++j) sta[j] = __builtin_nontemporal_load((const f32x4*)(sp + (size_t)j * 512));
#pragma unroll 1
        for (int d0 = 0; d0 < 64; d0 += 8) {
            const bool more = d0 + 8 < 64;
#pragma unroll
            for (int j = 0; j < 8; ++j) {
                const int d = dp * 64 + d0 + j; const f32x4 st = sta[j];
                if (more) sta[j] = __builtin_nontemporal_load((const f32x4*)(sp + (size_t)(d0 + 8 + j) * 512));
                const f32x4 qa = *(const LAS f32x4*)(qs + d * 8), qb = *(const LAS f32x4*)(qs + d * 8 + 4), ka = *(const LAS f32x4*)(kds + d * 8), kb = *(const LAS f32x4*)(kds + d * 8 + 4);
                const float q8[8] = {qa[0], qa[1], qa[2], qa[3], qb[0], qb[1], qb[2], qb[3]}, k8[8] = {ka[0], ka[1], ka[2], ka[3], kb[0], kb[1], kb[2], kb[3]};
                f32x4 ns = st * g8;
#pragma unroll
                for (int s2 = 0; s2 < 8; ++s2) ns += vq[s2] * k8[s2];
                __builtin_nontemporal_store(ns, (f32x4*)(op + (size_t)(d0 + j) * 512));
#pragma unroll
                for (int i = 0; i < 8; ++i) cr[i] += st * q8[i];
                asm volatile("" ::: "memory");
            }
        }
#pragma unroll
        for (int i = 0; i < 8; ++i) *(LAS f32x4*)(red + (dp * 8 + i) * 512 + e0) = cr[i];
        __syncthreads();
        { const int i = tid >> 6, e8 = (tid & 63) * 8;
          float o[8];
#pragma unroll
          for (int jj = 0; jj < 8; ++jj) o[jj] = red[(0 * 8 + i) * 512 + e8 + jj] + red[(1 * 8 + i) * 512 + e8 + jj] + red[(2 * 8 + i) * 512 + e8 + jj] + red[(3 * 8 + i) * 512 + e8 + jj];
#pragma unroll
          for (int jj = 0; jj < 8; ++jj) { const u32x4 wv = *(const u32x4*)(vTs + ((size_t)((bs * 4 + h) * 512 + e8 + jj)) * 8);
              const float v8[8] = {bflo(wv.x), bfhi(wv.x), bflo(wv.y), bfhi(wv.y), bflo(wv.z), bfhi(wv.z), bflo(wv.w), bfhi(wv.w)};
#pragma unroll
              for (int s = 0; s < 8; ++s) o[jj] += A8[i * 8 + s] * v8[s]; }
          bf16_t* dst = ORET + (size_t)(MP + bs * 8 + i) * 2048 + h * 512 + e8;
          u32x4 ow; ow.x = cvt_pk_bf16(o[0], o[1]); ow.y = cvt_pk_bf16(o[2], o[3]); ow.z = cvt_pk_bf16(o[4], o[5]); ow.w = cvt_pk_bf16(o[6], o[7]); *(u32x4*)dst = ow; }
    }
}

__device__ __forceinline__ void ret_gnorm(const bf16_t* __restrict__ ORET, const bf16_t* __restrict__ Zg, bf16_t* __restrict__ OG, int G) {
    const int tid_o = otid(), wave = tid_o >> 6, lane = tid_o & 63;
    for (int task = blockIdx.x * 8 + wave; task < MT * 4; task += G * 8) {
        const size_t o = (size_t)(task >> 2) * 2048 + (task & 3) * 512 + lane * 8;
        const u32x4 ow = *(const u32x4*)(ORET + o); const f32x4 a = {bflo(ow.x), bfhi(ow.x), bflo(ow.y), bfhi(ow.y)}, b = {bflo(ow.z), bfhi(ow.z), bflo(ow.w), bfhi(ow.w)};
        const float mu = wave_sum(a[0] + a[1] + a[2] + a[3] + b[0] + b[1] + b[2] + b[3]) * (1.f / 512.f);
        const f32x4 da = a - mu, db = b - mu;
        const float var = wave_sum(da[0] * da[0] + da[1] * da[1] + da[2] * da[2] + da[3] * da[3] + db[0] * db[0] + db[1] * db[1] + db[2] * db[2] + db[3] * db[3]) * (1.f / 512.f);
        const float rs = rsqrtf(var + EPS);
        const u32x4 gw = *(const u32x4*)(Zg + o);
        u32x4 r;
        r.x = cvt_pk_bf16(da[0] * rs * bflo(gw.x), da[1] * rs * bfhi(gw.x)); r.y = cvt_pk_bf16(da[2] * rs * bflo(gw.y), da[3] * rs * bfhi(gw.y));
        r.z = cvt_pk_bf16(db[0] * rs * bflo(gw.z), db[1] * rs * bfhi(gw.z)); r.w = cvt_pk_bf16(db[2] * rs * bflo(gw.w), db[3] * rs * bfhi(gw.w));
        *(u32x4*)(OG + o) = r;
    }
}

__global__ void __launch_bounds__(NT) hybrid_fwd(Params P) {
    extern __shared__ __attribute__((aligned(16))) unsigned char lds_raw[];
    LAS unsigned char* lds = (LAS unsigned char*)lds_raw;
    cg::grid_group grid = cg::this_grid();
    const int G = gridDim.x, tid = threadIdx.x;
    unsigned char* ws = P.ws;
    bf16_t* WT_IN_ATTN = (bf16_t*)(ws + WS_WT_IN_ATTN); bf16_t* WT_OUT_ATTN = (bf16_t*)(ws + WS_WT_OUT_ATTN); bf16_t* WT_IN_RET = (bf16_t*)(ws + WS_WT_IN_RET); bf16_t* WT_OUT_RET = (bf16_t*)(ws + WS_WT_OUT_RET);
    bf16_t* WT_GATE = (bf16_t*)(ws + WS_WT_GATE); bf16_t* WT_PLE = (bf16_t*)(ws + WS_WT_PLE);
    float* TABA = (float*)(ws + WS_TABA); float* TABR = (float*)(ws + WS_TABR);
    bf16_t* H = (bf16_t*)(ws + WS_H); bf16_t* PB = (bf16_t*)(ws + WS_PB);
    bf16_t* PLE = (bf16_t*)(ws + WS_PLE); bf16_t* Y = (bf16_t*)(ws + WS_Y); bf16_t* X2 = (bf16_t*)(ws + WS_X2);
    bf16_t* OG = (bf16_t*)(ws + WS_OG); bf16_t* ZQ = (bf16_t*)(ws + WS_ZQ); bf16_t* ZK = (bf16_t*)(ws + WS_ZK); bf16_t* ZG = (bf16_t*)(ws + WS_ZG);
    bf16_t* VTP = (bf16_t*)(ws + WS_VTP); bf16_t* VTS = (bf16_t*)(ws + WS_VTS); bf16_t* ABUF = (bf16_t*)(ws + WS_ABUF); bf16_t* KDT = (bf16_t*)(ws + WS_KDT); bf16_t* ORET = (bf16_t*)(ws + WS_ORET);
    bf16_t* SC = (bf16_t*)(ws + WS_Y);
    pg8::StaticOrder SO;
    volatile LAS unsigned* bst = (volatile LAS unsigned*)(lds + LDS_BYTES - 16);
    if (tid < 4) bst[tid] = 0u;
    __syncthreads();
    const XcdBarrier xbar = xcd_barrier_post((unsigned*)(ws + WS_BAR), bst);
#define GSYNC() xcd_barrier(xbar)

for (int rep_ = 0; rep_ < REP_P0; ++rep_) {
    {
        LAS float* T = (LAS float*)lds;
        const int ttid = otid(), nn = ttid & 63, kq = ttid >> 6, kk2 = (ttid & 31) * 2, nq = ttid >> 5;
#define TILE_DESC(t_, W_, Wt_, K_, N_, perm_, tl_) do { \
        if ((t_) < 640) { W_ = P.w_in_attn; Wt_ = WT_IN_ATTN; K_ = 1024; N_ = 2560; perm_ = true; tl_ = (t_); } \
        else if ((t_) < 896) { W_ = P.w_out_attn; Wt_ = WT_OUT_ATTN; K_ = 1024; N_ = 1024; perm_ = false; tl_ = (t_) - 640; } \
        else if ((t_) < 2432) { W_ = P.w_in_ret; Wt_ = WT_IN_RET; K_ = 1024; N_ = 6144; perm_ = false; tl_ = (t_) - 896; } \
        else if ((t_) < 2944) { W_ = P.w_out_ret; Wt_ = WT_OUT_RET; K_ = 2048; N_ = 1024; perm_ = false; tl_ = (t_) - 2432; } \
        else if ((t_) < 3200) { W_ = P.w_gate; Wt_ = WT_GATE; K_ = 1024; N_ = 1024; perm_ = false; tl_ = (t_) - 2944; } \
        else if ((t_) < 3456) { W_ = P.w_gate + 1024 * 1024; Wt_ = WT_GATE + 1024 * 1024; K_ = 1024; N_ = 1024; perm_ = false; tl_ = (t_) - 3200; } \
        else if ((t_) < 3520) { W_ = P.w_ple; Wt_ = WT_PLE; K_ = 256; N_ = 1024; perm_ = false; tl_ = (t_) - 3456; } \
        else { W_ = P.w_ple + 256 * 1024; Wt_ = WT_PLE + 1024 * 256; K_ = 256; N_ = 1024; perm_ = false; tl_ = (t_) - 3520; } } while (0)
#define TILE_LOAD(W_, N_, perm_, tl_, r_) do { const int ntn_ = (N_) >> 6, n0_ = ((tl_) % ntn_) * 64, k0_ = ((tl_) / ntn_) * 64, nd_ = n0_ + nn; int ns_ = nd_; \
        if ((perm_) && nd_ < 1280) { const int p_ = nd_ & 63; ns_ = (nd_ - p_) + (p_ >> 5) * 16 + (p_ & 15) + ((p_ >> 4) & 1) * 32; } \
        _Pragma("unroll") for (int i_ = 0; i_ < 8; ++i_) r_[i_] = (W_)[(size_t)(k0_ + kq + 8 * i_) * (N_) + ns_]; } while (0)
        float r[8];
        const float* Wc; bf16_t* Wtc; int Kc, Nc, tlc; bool pc;
        int t = blockIdx.x;
        if (t < 3584) { TILE_DESC(t, Wc, Wtc, Kc, Nc, pc, tlc); TILE_LOAD(Wc, Nc, pc, tlc, r); }
        for (; t < 3584; t += G) {
            __syncthreads();
#pragma unroll
            for (int i = 0; i < 8; ++i) T[(kq + 8 * i) * 65 + nn] = r[i];
            __syncthreads();
            const int ntn = Nc >> 6, n0 = (tlc % ntn) * 64, k0 = (tlc / ntn) * 64; bf16_t* Wto = Wtc; const int Ko = Kc;
            if (t + G < 3584) { TILE_DESC(t + G, Wc, Wtc, Kc, Nc, pc, tlc); TILE_LOAD(Wc, Nc, pc, tlc, r); }
#pragma unroll
            for (int i = 0; i < 4; ++i) { const int n2 = nq + 16 * i; *(unsigned*)(Wto + (size_t)(n0 + n2) * Ko + k0 + kk2) = cvt_pk_bf16(T[kk2 * 65 + n2], T[(kk2 + 1) * 65 + n2]); }
        }
        __syncthreads();
#undef TILE_DESC
#undef TILE_LOAD
    }
    for (int e = blockIdx.x * NT + tid; e < 4104 * 160; e += G * NT) {
        const int pi = e / 160, f = e % 160; const int pos = pi < 4096 ? pi : 16384 + (pi - 4096);
        if (f < 32) { const float inv = powf(10000.f, -(float)f / 32.f), ang = (float)pos * inv; TABA[((size_t)pi * 32 + f) * 2] = cosf(ang); TABA[((size_t)pi * 32 + f) * 2 + 1] = sinf(ang); }
        else { const int f2 = f - 32; const float inv = powf(10000.f, -(float)f2 / 128.f), ang = (float)pos * inv; TABR[((size_t)pi * 128 + f2) * 2] = cosf(ang); TABR[((size_t)pi * 128 + f2) * 2 + 1] = sinf(ang); }
    }
    for (int e = blockIdx.x * NT + tid; e < 2 * MT * 64; e += G * NT) {
        const int i = e / (MT * 64), rem = e % (MT * 64), row = rem >> 6, c4 = (rem & 63) * 4;
        const float* src = row < MP ? P.p_prompt + ((size_t)i * MP + row) * 256 + c4 : P.p_sample + ((size_t)i * MS + row - MP) * 256 + c4;
        *(u32x2*)(PB + ((size_t)i * MT + row) * 256 + c4) = pk4(*(const f32x4*)src);
    }
    rms_rows(P.x_prompt, P.x_sample, P.pre_norm, H, G);
}
    if (P.ws == nullptr) grid.sync();
    GSYNC();

for (int rep_ = 0; rep_ < REP_GIN; ++rep_) {
    { pg8::Gemm g{H, WT_IN_ATTN, MT, 2560, 1024}; SO.init(MT, 2560, G, blockIdx.x);
      EpiInAttn E{ZQ, ZK, ZG, VTP, VTS, TABA, P.out}; pg8::gemm_phase(lds, g, SO, E); }
    { pg8::Gemm g{PB, WT_PLE, MP, 1024, 256}; EpiB16 E{PLE, 1024};
      if (G == 256) { pg8::TailOrder TO; TO.init(MP, 680 - 512, G, blockIdx.x); pg8::gemm_phase(lds, g, TO, E); }
      else { SO.init(MP, 1024, G, blockIdx.x); pg8::gemm_phase(lds, g, SO, E); }
      skinny_gemm(lds, PB + (size_t)MP * 256, WT_PLE, 256, SkB16{PLE + (size_t)MP * 1024}, G); }
}
    GSYNC();

for (int rep_ = 0; rep_ < REP_ATT; ++rep_) {
    attn_prompt(lds, ZQ, ZK, ZG, VTP, P.sinks, OG, G);
    attn_sample(lds, P, ZQ, ZK, ZG, VTS, OG, G);
}
    GSYNC();

for (int rep_ = 0; rep_ < REP_GN1; ++rep_) {
    { pg8::Gemm g{OG, WT_OUT_ATTN, MP, 1024, 1024}; SO.init(MP, 1024, G, blockIdx.x); EpiB16 E{Y, 1024}; pg8::gemm_phase(lds, g, SO, E);
      skinny_gemm(lds, OG + (size_t)MP * 1024, WT_OUT_ATTN, 1024, SkB16{Y + (size_t)MP * 1024}, G); }
}
    GSYNC();
for (int rep_ = 0; rep_ < REP_ROW; ++rep_) {
    resid_rows<false>(P.x_prompt, P.x_sample, nullptr, Y, P.post_norm, H, G);
}
    GSYNC();
for (int rep_ = 0; rep_ < REP_GN1; ++rep_) {
    { pg8::Gemm g{H, WT_GATE, MP, 1024, 1024}; SO.init(MP, 1024, G, blockIdx.x); EpiGate<true> E{H, PLE, nullptr, X2}; pg8::gemm_phase(lds, g, SO, E);
      skinny_gemm(lds, H + (size_t)MP * 1024, WT_GATE, 1024, SkGate<true>{H + (size_t)MP * 1024, PLE + (size_t)MP * 1024, nullptr, X2 + (size_t)MP * 1024}, G); }
}
    GSYNC();
for (int rep_ = 0; rep_ < REP_ROW; ++rep_) {
    rms_rows_b16(X2, P.pre_norm + 1024, H, G);
}
    GSYNC();
for (int rep_ = 0; rep_ < REP_GIN; ++rep_) {
    { pg8::Gemm g{H, WT_IN_RET, MT, 6144, 1024}; SO.init(MT, 6144, G, blockIdx.x);
      EpiInRet E{ZQ, ZK, ZG, VTP, VTS, TABR}; pg8::gemm_phase(lds, g, SO, E); }
    { pg8::Gemm g{PB + (size_t)MT * 256, WT_PLE + 1024 * 256, MP, 1024, 256}; EpiB16 E{PLE, 1024};
      if (G == 256) { pg8::TailOrder TO; TO.init(MP, 1632 - 6 * 256, G, blockIdx.x); pg8::gemm_phase(lds, g, TO, E); }
      else { SO.init(MP, 1024, G, blockIdx.x); pg8::gemm_phase(lds, g, SO, E); }
      skinny_gemm(lds, PB + (size_t)MT * 256 + (size_t)MP * 256, WT_PLE + 1024 * 256, 256, SkB16{PLE + (size_t)MP * 1024}, G); }
}
    GSYNC();
for (int rep_ = 0; rep_ < REP_RA; ++rep_) {
    ret_A(lds, ZQ, ZK, ABUF, KDT, G);
}
    GSYNC();
    { unsigned* ctr = (unsigned*)(ws + WS_BAR + 14336);
      if (blockIdx.x < 128) for (int u = blockIdx.x; u < 128; u += G) ret_seq_unit(lds, u, ZQ, VTP, ABUF, KDT, ORET, P.out);
      ret_sample(lds, P, ZQ, ZK, VTS, ORET, ctr, nullptr, 0u); }
for (int rep_ = 0; rep_ < REP_SYNC; ++rep_) GSYNC();
    GSYNC();
for (int rep_ = 0; rep_ < REP_ROW; ++rep_) {
    ret_gnorm(ORET, ZG, OG, G);
}
    GSYNC();
for (int rep_ = 0; rep_ < REP_GN1; ++rep_) {
    { pg8::Gemm g{OG, WT_OUT_RET, MP, 1024, 2048}; SO.init(MP, 1024, G, blockIdx.x); EpiB16 E{Y, 1024}; pg8::gemm_phase(lds, g, SO, E);
      skinny_gemm(lds, OG + (size_t)MP * 2048, WT_OUT_RET, 2048, SkB16{Y + (size_t)MP * 1024}, G); }
}
    GSYNC();
for (int rep_ = 0; rep_ < REP_ROW; ++rep_) {
    resid_rows<true>(nullptr, nullptr, X2, Y, P.post_norm + 1024, H, G);
}
    GSYNC();
for (int rep_ = 0; rep_ < REP_GN1; ++rep_) {
    { pg8::Gemm g{H, WT_GATE + 1024 * 1024, MP, 1024, 1024}; SO.init(MP, 1024, G, blockIdx.x); EpiGate<false> E{H, PLE, P.out, nullptr}; pg8::gemm_phase(lds, g, SO, E);
      skinny_gemm(lds, H + (size_t)MP * 1024, WT_GATE + 1024 * 1024, 1024, SkGate<false>{H + (size_t)MP * 1024, PLE + (size_t)MP * 1024, P.out + (size_t)MP * 1024, nullptr}, G); }
}
}

extern "C" void kernel_launch(void* const* d_in, const int* in_sizes, int n_in, void* d_out, int out_size, void* d_ws, size_t ws_size, hipStream_t stream) {
    static int grid_blocks = 0;
    if (!grid_blocks) {
        int dev = 0, cus = 0, per_cu = 0;
        hipGetDevice(&dev);
        hipDeviceGetAttribute(&cus, hipDeviceAttributeMultiprocessorCount, dev);
        hipFuncSetAttribute((const void*)hybrid_fwd, hipFuncAttributeMaxDynamicSharedMemorySize, LDS_BYTES);
        hipOccupancyMaxActiveBlocksPerMultiprocessor(&per_cu, (const void*)hybrid_fwd, NT, LDS_BYTES);
        if (per_cu < 1) per_cu = 1;
        if (per_cu > 1) per_cu = 1;
        grid_blocks = cus * per_cu;
        if (ws_size < WS_END) fprintf(stderr, "kernel_launch: workspace too small: %zu < %zu\n", ws_size, (size_t)WS_END);
    }
    Params p{};
    p.x_prompt = (const float*)d_in[0]; p.x_sample = (const float*)d_in[1]; p.cache_k = (const float*)d_in[2]; p.cache_v = (const float*)d_in[3]; p.state_ret = (const float*)d_in[4];
    p.p_prompt = (const float*)d_in[5]; p.p_sample = (const float*)d_in[6]; p.pre_norm = (const float*)d_in[7]; p.post_norm = (const float*)d_in[8]; p.w_in_attn = (const float*)d_in[9];
    p.sinks = (const float*)d_in[10]; p.w_out_attn = (const float*)d_in[11]; p.w_in_ret = (const float*)d_in[12]; p.w_out_ret = (const float*)d_in[13]; p.w_ple = (const float*)d_in[14]; p.w_gate = (const float*)d_in[15];
    p.out = (float*)d_out; p.ws = (unsigned char*)d_ws;
    (void)hipMemsetAsync((unsigned char*)d_ws + WS_BAR, 0, 16384, stream);
    void* args[] = {&p};
    hipError_t e = hipLaunchCooperativeKernel((const void*)hybrid_fwd, dim3(grid_blocks), dim3(NT), args, LDS_BYTES, stream);
    if (e != hipSuccess) fprintf(stderr, "cooperative launch failed: %s (grid %d)\n", hipGetErrorString(e), grid_blocks);
}
```

```cpp
#include <hip/hip_runtime.h>
#include <hip/hip_cooperative_groups.h>
#include <cstdio>
#include <cstdint>
namespace cg = cooperative_groups;

#define LAS __attribute__((address_space(3)))
typedef unsigned short bf16_t;
typedef short bf16x8 __attribute__((ext_vector_type(8)));
typedef float f32x4 __attribute__((ext_vector_type(4)));
typedef float f32x2 __attribute__((ext_vector_type(2)));
typedef unsigned u32x2 __attribute__((ext_vector_type(2)));
typedef unsigned u32x4 __attribute__((ext_vector_type(4)));

constexpr int MP = 16384, MS = 1024, MT = MP + MS;
constexpr int NT = 512;
#define REP_P0 1
#define REP_GIN 1
#define REP_ATT 1
#define REP_RA 1
#define REP_SYNC 0
#define REP_R3 1
#define REP_SCAN 1
#define REP_ROW 1
#define REP_GN1 1
constexpr int LDS_BYTES = 140 * 1024;
constexpr float EPS = 1e-6f;

constexpr size_t OFF_YP = 0, OFF_YS = 16777216, OFF_KWP = 17825792, OFF_VWP = 17956864, OFF_KWS = 18087936, OFF_VWS = 22282240, OFF_RSP = 26476544, OFF_RSS = 28573696;

constexpr size_t al256(size_t x) { return (x + 255) & ~(size_t)255; }
constexpr size_t WS_WT_IN_ATTN = 0;
constexpr size_t WS_WT_OUT_ATTN = WS_WT_IN_ATTN + (size_t)2560 * 1024 * 2;
constexpr size_t WS_WT_IN_RET = WS_WT_OUT_ATTN + (size_t)1024 * 1024 * 2;
constexpr size_t WS_WT_OUT_RET = WS_WT_IN_RET + (size_t)6144 * 1024 * 2;
constexpr size_t WS_WT_GATE = WS_WT_OUT_RET + (size_t)1024 * 2048 * 2;
constexpr size_t WS_WT_PLE = WS_WT_GATE + (size_t)2 * 1024 * 1024 * 2;
constexpr size_t WS_TABA = WS_WT_PLE + (size_t)2 * 1024 * 256 * 2;
constexpr size_t WS_TABR = WS_TABA + (size_t)4104 * 32 * 8;
constexpr size_t WS_H = al256(WS_TABR + (size_t)4104 * 128 * 8);
constexpr size_t WS_PB = WS_H + (size_t)MT * 1024 * 2;
constexpr size_t WS_PLE = WS_PB + (size_t)2 * MT * 256 * 2;
constexpr size_t WS_Y = WS_PLE + (size_t)MT * 1024 * 4;
constexpr size_t WS_X1 = WS_Y + (size_t)MT * 1024 * 4;
constexpr size_t WS_X2 = WS_X1 + (size_t)MT * 1024 * 4;
constexpr size_t WS_OG = WS_X2 + (size_t)MT * 1024 * 4;
constexpr size_t WS_ZQ = WS_OG + (size_t)MT * 2048 * 2;
constexpr size_t WS_ZK = WS_ZQ + (size_t)MT * 1024 * 2;
constexpr size_t WS_ZG = WS_ZK + (size_t)MT * 1024 * 2;
constexpr size_t WS_VTP = WS_ZG + (size_t)MT * 2048 * 2;
constexpr size_t WS_VTS = WS_VTP + (size_t)16 * 512 * 4096 * 2;
constexpr size_t WS_ABUF = WS_VTS + (size_t)128 * 4 * 512 * 8 * 2;
constexpr size_t WS_KDT = WS_ABUF + (size_t)512 * 128 * 128 * 2;
constexpr size_t WS_ORET = WS_KDT + (size_t)512 * 256 * 128 * 2;
constexpr size_t WS_BAR = WS_ORET + (size_t)MT * 2048 * 4;
constexpr size_t WS_END = WS_BAR + 16384;

struct Params {
    const float *x_prompt, *x_sample, *cache_k, *cache_v, *state_ret, *p_prompt, *p_sample, *pre_norm, *post_norm, *w_in_attn, *sinks, *w_out_attn, *w_in_ret, *w_out_ret, *w_ple, *w_gate;
    float* out; unsigned char* ws;
};

__device__ __forceinline__ unsigned cvt_pk_bf16(float lo, float hi) { unsigned r; asm volatile("v_cvt_pk_bf16_f32 %0, %1, %2" : "=v"(r) : "v"(lo), "v"(hi)); return r; }
__device__ __forceinline__ u32x2 pk4(f32x4 v) { u32x2 w; w.x = cvt_pk_bf16(v[0], v[1]); w.y = cvt_pk_bf16(v[2], v[3]); return w; }
__device__ __forceinline__ float bf2f(bf16_t b) { return __uint_as_float(((unsigned)b) << 16); }
__device__ __forceinline__ float bflo(unsigned w) { return __uint_as_float(w << 16); }
__device__ __forceinline__ float bfhi(unsigned w) { return __uint_as_float(w & 0xffff0000u); }
__device__ __forceinline__ float silu_f(float x) { return x / (1.f + __expf(-x)); }
__device__ __forceinline__ float sigmoid_f(float x) { return 1.f / (1.f + __expf(-x)); }
__device__ __forceinline__ float wave_sum(float v) {
#pragma unroll
    for (int o = 32; o >= 1; o >>= 1) v += __shfl_xor(v, o, 64);
    return v;
}
__device__ __forceinline__ int otid() { int t = threadIdx.x; asm volatile("" : "+v"(t)); return t; }
__device__ __forceinline__ void lds_barrier() { asm volatile("s_waitcnt lgkmcnt(0)" ::: "memory"); __builtin_amdgcn_s_barrier(); asm volatile("" ::: "memory"); }
__device__ __forceinline__ float ret_lg(int h) { return h == 0 ? -3.1748698315e-02f : h == 1 ? -1.5748356968e-02f : h == 2 ? -7.8431774610e-03f : -3.9138993211e-03f; }

#define XB_TMO      128
#define XB_XCNT(j)  (256  + 64 * (j))
#define XB_XSUB(j)  (1280 + 64 * (j))
#define XB_XGEN(j)  (2304 + 64 * (j))
#define XB_TOP      3328
#define XB_TOPGEN   3392
#define XCD_BAR_WORDS 3456
#define XB_SPIN_CAP (1u << 18)

__device__ __forceinline__ unsigned xb_ld(unsigned* p)              { return __hip_atomic_load(p, __ATOMIC_RELAXED, __HIP_MEMORY_SCOPE_AGENT); }
__device__ __forceinline__ unsigned xb_add(unsigned* p, unsigned v) { return __hip_atomic_fetch_add(p, v, __ATOMIC_RELAXED, __HIP_MEMORY_SCOPE_AGENT); }
__device__ __forceinline__ unsigned xb_xcc_id() { return (unsigned)__builtin_amdgcn_s_getreg((3 << 11) | 20) & 0xFu; }
#define XB_SPIN(cond, bar) do { unsigned _sp = 0; while (cond) { __builtin_amdgcn_s_sleep(1); \
    if ((++_sp & 255u) == 0u) { if (xb_ld(&(bar)[XB_TMO])) break; if (_sp > XB_SPIN_CAP) { atomicAdd(&(bar)[XB_TMO], 1u); break; } } } } while (0)

struct XcdBarrier {
    unsigned* bar; unsigned x;
    volatile LAS unsigned* st;
};

__device__ __forceinline__ XcdBarrier xcd_barrier_post(unsigned* bar, volatile LAS unsigned* st) {
    XcdBarrier b; b.bar = bar; b.x = xb_xcc_id(); b.st = st;
    if (threadIdx.x == 0) (void)xb_add(&bar[XB_XCNT(b.x)], 1u);
    return b;
}
__device__ __forceinline__ void xcd_barrier_complete(unsigned* bar, unsigned x, unsigned& nloc, unsigned& nx) {
    const unsigned G = gridDim.x * gridDim.y * gridDim.z;
    unsigned sum, cnt, mine, sp = 0u;
    for (;;) {
        sum = 0u; cnt = 0u; mine = 0u;
#pragma unroll
        for (unsigned j = 0; j < 16; ++j) { const unsigned c = xb_ld(&bar[XB_XCNT(j)]); sum += c; cnt += (c > 0u) ? 1u : 0u; mine = (j == x) ? c : mine; }
        if (sum == G) break;
        __builtin_amdgcn_s_sleep(1);
        if ((++sp & 255u) == 0u) { if (xb_ld(&bar[XB_TMO])) break; if (sp > XB_SPIN_CAP) { atomicAdd(&bar[XB_TMO], 1u); break; } }
    }
    nloc = mine > 0u ? mine : 1u; nx = cnt > 0u ? cnt : 1u;
}

__device__ __forceinline__ void xcd_barrier(const XcdBarrier& b) {
    asm volatile("s_waitcnt vmcnt(0)" ::: "memory");
    __syncthreads();
    if (threadIdx.x == 0) {
        unsigned* bar = b.bar;
        __builtin_amdgcn_s_waitcnt(0);
        unsigned nloc = b.st[0], nx = b.st[1];
        if (nloc == 0u) { xcd_barrier_complete(bar, b.x, nloc, nx); b.st[0] = nloc; b.st[1] = nx; }
        const unsigned old = xb_add(&bar[XB_XSUB(b.x)], 1u);
        const unsigned gen = old / nloc;
        if (old + 1u == (gen + 1u) * nloc) {
            __builtin_amdgcn_fence(__ATOMIC_RELEASE, "agent");
            asm volatile("s_waitcnt vmcnt(0)" ::: "memory");
            const unsigned og = xb_add(&bar[XB_TOP], 1u);
            const unsigned tg = og / nx;
            if (og + 1u == (tg + 1u) * nx) xb_add(&bar[XB_TOPGEN], 1u);
            else XB_SPIN(xb_ld(&bar[XB_TOPGEN]) == tg, bar);
            __builtin_amdgcn_fence(__ATOMIC_ACQUIRE, "agent");
            xb_add(&bar[XB_XGEN(b.x)], 1u);
            asm volatile("s_waitcnt vmcnt(0)" ::: "memory");
        } else {
            XB_SPIN(xb_ld(&bar[XB_XGEN(b.x)]) == gen, bar);
            __builtin_amdgcn_fence(__ATOMIC_ACQUIRE, "agent");
            asm volatile("s_waitcnt vmcnt(0)" ::: "memory");
        }
    }
    __syncthreads();
}

namespace pg8 {
constexpr int BM = 256, BK = 64, HALF = 128, HTB = HALF * BK * 2, STAGE_BYTES = 8 * HTB, NXCD = 8, WGM = 8;
__host__ __device__ __forceinline__ int lds_byte(int r, int c) { const int st = (r >> 4) * 2 + (c >> 5), rr = r & 15, cc = c & 31, ob = rr * 64 + cc * 2; return st * 1024 + (ob ^ (((ob >> 9) & 1) << 5)); }
__host__ __device__ __forceinline__ void stage_rc(int b, int& R, int& C) { const int st = b / 1024, sb = b % 1024, swz = sb ^ (((sb >> 9) & 1) << 5); R = (st >> 1) * 16 + swz / 64; C = (st & 1) * 32 + (swz % 64) / 2; }
struct Unit { int pm, pn; };
struct Gemm { const bf16_t* A; const bf16_t* Bt; int M, N, K; };
struct StaticOrder {
    int nM, nN, nwg, G, c;
    __host__ __device__ void init(int M, int N, int G_, int c_) { nM = M / BM; nN = N / BM; nwg = nM * nN; G = G_; c = c_; }
    __host__ __device__ bool next(int i, Unit& u) const {
        const long L = (long)i * G + c; if (L >= nwg) return false;
        int wgid = (int)L; { const int q = nwg / NXCD, r = nwg % NXCD, xcd = wgid % NXCD, off = wgid / NXCD; wgid = (xcd < r ? xcd * (q + 1) : r * (q + 1) + (xcd - r) * q) + off; }
        const int nig = WGM * nN, gid = wgid / nig, fm = gid * WGM, gsz = (nM - fm) < WGM ? (nM - fm) : WGM;
        u.pm = fm + ((wgid % nig) % gsz); u.pn = (wgid % nig) / gsz; return true;
    }
};

struct TailOrder {
    int first, nblk, nwg, c;
    __host__ __device__ void init(int M, int first_, int G_, int c_) { nwg = (M / BM) * 4; first = first_; nblk = G_ - first_; c = c_; }
    __host__ __device__ bool next(int i, Unit& u) const { if (c < first) return false; const int L = (c - first) + i * nblk; if (L >= nwg) return false; u.pm = L >> 2; u.pn = L & 3; return true; }
};

template <class Epi, class Sched>
__device__ __forceinline__ void gemm_phase(LAS unsigned char* lds, const Gemm g, const Sched& S, const Epi& E) {
    const int tid = otid(), wid = __builtin_amdgcn_readfirstlane(tid >> 6), lane = tid & 63, wr = wid >> 2, wc = wid & 3, fr = lane & 15, fq = lane >> 4;
    const int K = g.K, nt = K / BK;
    unsigned voffA[2], voffB[2];
#pragma unroll
    for (int i = 0; i < 2; ++i) { int R, C; stage_rc(tid * 16 + i * 8192, R, C); voffA[i] = (unsigned)(R * K + C) * 2u; voffB[i] = voffA[i]; }
    const size_t kstep = (size_t)(BK * 2);
    const size_t hstep = (size_t)HALF * K * 2;
    const size_t tstep = 2 * hstep;
    const unsigned ldsw = (unsigned)wid * 1024u;
    const int aoff = lds_byte(wr * 64 + fr, fq * 8), boff = lds_byte(wc * 32 + fr, fq * 8);
#define PG8_SA(b, h) (((b) * 2 + (h)) * HTB)
#define PG8_SB(b, h) ((4 + (b) * 2 + (h)) * HTB)
#define PG8_STAGE(bufoff, gbase, voff) do { _Pragma("unroll") for (int _i = 0; _i < 2; ++_i) \
        __builtin_amdgcn_global_load_lds((const unsigned*)((const char*)(gbase) + (voff)[_i]), (LAS unsigned*)(lds + (bufoff) + ldsw + _i * 8192), 16, 0, 0); } while (0)
#define PG8_LDA(dst, b, h) do { _Pragma("unroll") for (int m = 0; m < 4; ++m) _Pragma("unroll") for (int k = 0; k < 2; ++k) dst[m][k] = *(const LAS bf16x8*)(lds + PG8_SA(b, h) + aoff + m * 2048 + k * 1024); } while (0)
#define PG8_LDB(dst, b, h) do { _Pragma("unroll") for (int n = 0; n < 2; ++n) _Pragma("unroll") for (int k = 0; k < 2; ++k) dst[n][k] = *(const LAS bf16x8*)(lds + PG8_SB(b, h) + boff + n * 2048 + k * 1024); } while (0)
#define PG8_MMA(ai, bj, At, Bt) do { __builtin_amdgcn_s_setprio(1); _Pragma("unroll") for (int m = 0; m < 4; ++m) _Pragma("unroll") for (int n = 0; n < 2; ++n) _Pragma("unroll") for (int k = 0; k < 2; ++k) \
        acc[ai][bj][m][n] = __builtin_amdgcn_mfma_f32_16x16x32_bf16(Bt[n][k], At[m][k], acc[ai][bj][m][n], 0, 0, 0); __builtin_amdgcn_s_setprio(0); } while (0)
#define PG8_WAIT_V(n) asm volatile("s_waitcnt vmcnt(" #n ")" ::: "memory")
#define PG8_WAIT_L(n) asm volatile("s_waitcnt lgkmcnt(" #n ")" ::: "memory")
#define PG8_BAR __builtin_amdgcn_s_barrier()
#define PG8_SCHED __builtin_amdgcn_sched_barrier(0)
#define PG8_PTRS(u, pa, pb) do { const char* _a = (const char*)g.A + (size_t)(u).pm * tstep; const char* _b = (const char*)g.Bt + (size_t)(u).pn * tstep; if (Epi::swap(u)) { pa = _b; pb = _a; } else { pa = _a; pb = _b; } } while (0)
    Unit cur, nxt; int ui = 0;
    if (!S.next(0, cur)) return;
    f32x4 acc[2][2][4][2];
#pragma unroll
    for (int a = 0; a < 2; ++a)
#pragma unroll
        for (int b = 0; b < 2; ++b)
#pragma unroll
            for (int m = 0; m < 4; ++m)
#pragma unroll
                for (int n = 0; n < 2; ++n) acc[a][b][m][n] = (f32x4){0.f, 0.f, 0.f, 0.f};
    bf16x8 At[4][2], B0[2][2], B1[2][2];
    const char* cA; const char* cB;
    PG8_PTRS(cur, cA, cB);
    PG8_STAGE(PG8_SB(0, 0), cB, voffB); PG8_STAGE(PG8_SA(0, 0), cA, voffA); PG8_STAGE(PG8_SB(0, 1), cB + hstep, voffB); PG8_STAGE(PG8_SA(0, 1), cA + hstep, voffA);
    if (wr == 1) PG8_BAR;
    PG8_WAIT_V(4); PG8_BAR;
    PG8_STAGE(PG8_SB(1, 0), cB + kstep, voffB); PG8_STAGE(PG8_SA(1, 0), cA + kstep, voffA); PG8_STAGE(PG8_SB(1, 1), cB + hstep + kstep, voffB);
    PG8_WAIT_V(6); PG8_BAR;
    for (;;) {
        const bool has_next = S.next(ui + 1, nxt);
        const char* nA = cA; const char* nB = cB;
        if (has_next) PG8_PTRS(nxt, nA, nB);
        for (int t = 0; t < nt; t += 2) {
            const bool last = (t == nt - 2);
            const char* a1 = cA + (size_t)(t + 1) * kstep;
            const char* a2 = last ? nA : cA + (size_t)(t + 2) * kstep; const char* b2 = last ? nB : cB + (size_t)(t + 2) * kstep;
            const char* a3 = a2 + kstep; const char* b3 = b2 + kstep;
            PG8_LDB(B0, 0, 0); PG8_SCHED; PG8_LDA(At, 0, 0); PG8_STAGE(PG8_SA(1, 1), a1 + hstep, voffA);
            PG8_WAIT_L(8); PG8_BAR; PG8_WAIT_L(0); PG8_MMA(0, 0, At, B0); PG8_BAR; PG8_SCHED;
            PG8_LDB(B1, 0, 1); PG8_STAGE(PG8_SB(0, 0), b2, voffB);
            PG8_BAR; PG8_WAIT_L(0); PG8_MMA(0, 1, At, B1); PG8_BAR;
            PG8_LDA(At, 0, 1); PG8_STAGE(PG8_SA(0, 0), a2, voffA);
            PG8_BAR; PG8_WAIT_L(0); PG8_MMA(1, 0, At, B0); PG8_BAR; PG8_SCHED;
            PG8_STAGE(PG8_SB(0, 1), b2 + hstep, voffB);
            PG8_WAIT_V(6); PG8_BAR; PG8_MMA(1, 1, At, B1); PG8_BAR;
            PG8_LDB(B0, 1, 0); PG8_SCHED; PG8_LDA(At, 1, 0); PG8_STAGE(PG8_SA(0, 1), a2 + hstep, voffA);
            PG8_WAIT_L(8); PG8_BAR; PG8_WAIT_L(0); PG8_MMA(0, 0, At, B0); PG8_BAR; PG8_SCHED;
            PG8_LDB(B1, 1, 1); PG8_STAGE(PG8_SB(1, 0), b3, voffB);
            PG8_BAR; PG8_WAIT_L(0); PG8_MMA(0, 1, At, B1); PG8_BAR;
            PG8_LDA(At, 1, 1); PG8_STAGE(PG8_SA(1, 0), a3, voffA);
            PG8_BAR; PG8_WAIT_L(0); PG8_MMA(1, 0, At, B0); PG8_BAR; PG8_SCHED;
            PG8_STAGE(PG8_SB(1, 1), b3 + hstep, voffB);
            PG8_WAIT_V(6); PG8_BAR; PG8_MMA(1, 1, At, B1); PG8_BAR;
        }
        E(acc, cur, wr, wc, fr, fq);
        if (!has_next) break;
#pragma unroll
        for (int a = 0; a < 2; ++a)
#pragma unroll
            for (int b = 0; b < 2; ++b)
#pragma unroll
                for (int m = 0; m < 4; ++m)
#pragma unroll
                    for (int n = 0; n < 2; ++n) acc[a][b][m][n] = (f32x4){0.f, 0.f, 0.f, 0.f};
        cur = nxt; cA = nA; cB = nB; ++ui;
    }
    PG8_WAIT_V(0);
    if (wr == 0) PG8_BAR;
    PG8_BAR;
#undef PG8_SA
#undef PG8_SB
#undef PG8_STAGE
#undef PG8_LDA
#undef PG8_LDB
#undef PG8_MMA
#undef PG8_WAIT_V
#undef PG8_WAIT_L
#undef PG8_BAR
#undef PG8_SCHED
#undef PG8_PTRS
}
}
using pg8::Unit;

struct EpiF32 {
    float* C; int ldc;
    __device__ __forceinline__ static bool swap(const Unit&) { return false; }
    __device__ __forceinline__ void operator()(const f32x4 (&acc)[2][2][4][2], const Unit& u, int wr, int wc, int fr, int fq) const {
        const int row0 = u.pm * 256 + wr * 64 + fr, col0 = u.pn * 256 + wc * 32 + 4 * fq;
#pragma unroll
        for (int ai = 0; ai < 2; ++ai)
#pragma unroll
            for (int m = 0; m < 4; ++m) { float* rowp = C + (size_t)(row0 + ai * 128 + m * 16) * ldc + col0;
#pragma unroll
                for (int bj = 0; bj < 2; ++bj)
#pragma unroll
                    for (int n = 0; n < 2; ++n) *(f32x4*)(rowp + bj * 128 + n * 16) = acc[ai][bj][m][n]; }
    }
};
struct EpiB16 {
    bf16_t* C; int ldc;
    __device__ __forceinline__ static bool swap(const Unit&) { return false; }
    __device__ __forceinline__ void operator()(const f32x4 (&acc)[2][2][4][2], const Unit& u, int wr, int wc, int fr, int fq) const {
        const int row0 = u.pm * 256 + wr * 64 + fr, col0 = u.pn * 256 + wc * 32 + 4 * fq;
#pragma unroll
        for (int ai = 0; ai < 2; ++ai)
#pragma unroll
            for (int m = 0; m < 4; ++m) { bf16_t* rowp = C + (size_t)(row0 + ai * 128 + m * 16) * ldc + col0;
#pragma unroll
                for (int bj = 0; bj < 2; ++bj)
#pragma unroll
                    for (int n = 0; n < 2; ++n) *(u32x2*)(rowp + bj * 128 + n * 16) = pk4(acc[ai][bj][m][n]); }
    }
};
template <bool OB16> struct EpiGate {
    const bf16_t* X1; const bf16_t* PLE; float* O; bf16_t* Ob;
    __device__ __forceinline__ static bool swap(const Unit&) { return false; }
    __device__ __forceinline__ void operator()(const f32x4 (&acc)[2][2][4][2], const Unit& u, int wr, int wc, int fr, int fq) const {
        const int row0 = u.pm * 256 + wr * 64 + fr, col0 = u.pn * 256 + wc * 32 + 4 * fq;
#pragma unroll
        for (int ai = 0; ai < 2; ++ai)
#pragma unroll
            for (int m = 0; m < 4; ++m) { const size_t ro = (size_t)(row0 + ai * 128 + m * 16) * 1024 + col0;
#pragma unroll
                for (int bj = 0; bj < 2; ++bj)
#pragma unroll
                    for (int n = 0; n < 2; ++n) { const size_t o = ro + bj * 128 + n * 16; const f32x4 a = acc[ai][bj][m][n]; const u32x2 xw = *(const u32x2*)(X1 + o), pw = *(const u32x2*)(PLE + o);
                        const f32x4 x1 = {bflo(xw.x), bfhi(xw.x), bflo(xw.y), bfhi(xw.y)}, pl = {bflo(pw.x), bfhi(pw.x), bflo(pw.y), bfhi(pw.y)}; f32x4 r;
#pragma unroll
                        for (int j = 0; j < 4; ++j) r[j] = x1[j] + sigmoid_f(a[j]) * pl[j];
                        if (OB16) *(u32x2*)(Ob + o) = pk4(r); else *(f32x4*)(O + o) = r; } }
    }
};
struct EpiInAttn {
    bf16_t *Zq, *Zk, *Zg, *vTp, *vTs; const float* tab; float* out;
    __device__ __forceinline__ static bool swap(const Unit& u) { return u.pn == 5; }
    __device__ __forceinline__ void operator()(const f32x4 (&acc)[2][2][4][2], const Unit& u, int wr, int wc, int fr, int fq) const {
        const int pn = u.pn;
        if (pn < 5) {
            const bool isq = pn < 4;
            const int fi = 16 * (wc & 1) + 4 * fq;
#pragma unroll
            for (int ai = 0; ai < 2; ++ai)
#pragma unroll
                for (int m = 0; m < 4; ++m) {
                    const int r = u.pm * 256 + ai * 128 + wr * 64 + m * 16 + fr;
                    const int pi = r < MP ? (r & 4095) : 4096 + ((r - MP) & 7);
                    const f32x4 t0 = *(const f32x4*)(tab + ((size_t)pi * 32 + fi) * 2), t1 = *(const f32x4*)(tab + ((size_t)pi * 32 + fi) * 2 + 4);
                    const float cs[4] = {t0[0], t0[2], t1[0], t1[2]}, sn[4] = {t0[1], t0[3], t1[1], t1[3]};
#pragma unroll
                    for (int bj = 0; bj < 2; ++bj) {
                        const f32x4 x1 = acc[ai][bj][m][0], x2 = acc[ai][bj][m][1]; f32x4 o1, o2;
#pragma unroll
                        for (int j = 0; j < 4; ++j) { o1[j] = x1[j] * cs[j] - x2[j] * sn[j]; o2[j] = x2[j] * cs[j] + x1[j] * sn[j]; }
                        const int hh = 2 * bj + (wc >> 1), d1 = 16 * (wc & 1) + 4 * fq;
                        if (isq) {
                            bf16_t* p = Zq + (size_t)r * 1024 + pn * 256 + hh * 64 + d1;
                            *(u32x2*)p = pk4(o1 * 0.125f); *(u32x2*)(p + 32) = pk4(o2 * 0.125f);
                        } else {
                            bf16_t* p = Zk + (size_t)r * 256 + hh * 64 + d1;
                            *(u32x2*)p = pk4(o1); *(u32x2*)(p + 32) = pk4(o2);
                            if (r < MP) { const int t = r & 4095; if (t >= 3968) { float* dst = out + OFF_KWP + ((size_t)((r >> 12) * 128 + t - 3968) * 4 + hh) * 64 + d1; *(f32x4*)dst = o1; *(f32x4*)(dst + 32) = o2; } }
                            else { const int rs = r - MP; float* dst = out + OFF_KWS + ((size_t)((rs >> 3) * 128 + 120 + (rs & 7)) * 4 + hh) * 64 + d1; *(f32x4*)dst = o1; *(f32x4*)(dst + 32) = o2; }
                        }
                    }
                    asm volatile("" ::: "memory");
                }
        } else if (pn == 5) {
#pragma unroll
            for (int ai = 0; ai < 2; ++ai)
#pragma unroll
                for (int m = 0; m < 4; ++m) {
                    const int e = ai * 128 + wr * 64 + m * 16 + fr, kvh = e >> 6, d = e & 63;
#pragma unroll
                    for (int bj = 0; bj < 2; ++bj)
#pragma unroll
                        for (int n = 0; n < 2; ++n) {
                            const int tok = u.pm * 256 + bj * 128 + wc * 32 + n * 16 + 4 * fq; const f32x4 v = acc[ai][bj][m][n];
                            if (tok < MP) { const int b = tok >> 12, t = tok & 4095;
                                *(u32x2*)(vTp + ((size_t)((b * 4 + kvh) * 64 + d)) * 4096 + t) = pk4(v);
                                if (t >= 3968) {
#pragma unroll
                                    for (int jj = 0; jj < 4; ++jj) out[OFF_VWP + ((size_t)(b * 128 + t - 3968 + jj) * 4 + kvh) * 64 + d] = v[jj]; }
                            } else { const int ts = tok - MP, bs = ts >> 3, l0 = ts & 7;
                                *(u32x2*)(vTs + ((size_t)((bs * 4 + kvh) * 64 + d)) * 8 + l0) = pk4(v);
#pragma unroll
                                for (int jj = 0; jj < 4; ++jj) out[OFF_VWS + ((size_t)(bs * 128 + 120 + l0 + jj) * 4 + kvh) * 64 + d] = v[jj]; }
                        }
                }
        } else {
#pragma unroll
            for (int ai = 0; ai < 2; ++ai)
#pragma unroll
                for (int m = 0; m < 4; ++m) { const int r = u.pm * 256 + ai * 128 + wr * 64 + m * 16 + fr;
#pragma unroll
                    for (int bj = 0; bj < 2; ++bj)
#pragma unroll
                        for (int n = 0; n < 2; ++n) { const f32x4 a = acc[ai][bj][m][n]; f32x4 s;
#pragma unroll
                            for (int j = 0; j < 4; ++j) s[j] = silu_f(a[j]);
                            *(u32x2*)(Zg + (size_t)r * 1024 + (pn - 6) * 256 + bj * 128 + wc * 32 + n * 16 + 4 * fq) = pk4(s); } }
        }
    }
};
struct EpiInRet {
    bf16_t *Zq, *Zk, *Zg, *vTp, *vTs; const float* tab;
    __device__ __forceinline__ static bool swap(const Unit& u) { return u.pn >= 8 && u.pn < 16; }
    __device__ __forceinline__ void operator()(const f32x4 (&acc)[2][2][4][2], const Unit& u, int wr, int wc, int fr, int fq) const {
        const int pn = u.pn;
        if (pn < 8) {
            const bool isq = pn < 4; const float sc = isq ? 1.f : 0.0625f;
            bf16_t* Z = isq ? Zq : Zk; const int hc = (pn & 3) * 256;
#pragma unroll
            for (int ai = 0; ai < 2; ++ai)
#pragma unroll
                for (int m = 0; m < 4; ++m) {
                    const int r = u.pm * 256 + ai * 128 + wr * 64 + m * 16 + fr;
                    const int pi = r < MP ? (r & 4095) : 4096 + ((r - MP) & 7);
#pragma unroll
                    for (int n = 0; n < 2; ++n) {
                        const int d = wc * 32 + n * 16 + 4 * fq;
                        const f32x4 t0 = *(const f32x4*)(tab + ((size_t)pi * 128 + d) * 2), t1 = *(const f32x4*)(tab + ((size_t)pi * 128 + d) * 2 + 4);
                        const float cs[4] = {t0[0], t0[2], t1[0], t1[2]}, sn[4] = {t0[1], t0[3], t1[1], t1[3]};
                        const f32x4 x1 = acc[ai][0][m][n], x2 = acc[ai][1][m][n]; f32x4 o1, o2;
#pragma unroll
                        for (int j = 0; j < 4; ++j) { o1[j] = (x1[j] * cs[j] - x2[j] * sn[j]) * sc; o2[j] = (x2[j] * cs[j] + x1[j] * sn[j]) * sc; }
                        bf16_t* p = Z + (size_t)r * 1024 + hc + d;
                        *(u32x2*)p = pk4(o1); *(u32x2*)(p + 128) = pk4(o2);
                    }
                }
        } else if (pn < 16) {
#pragma unroll
            for (int ai = 0; ai < 2; ++ai)
#pragma unroll
                for (int m = 0; m < 4; ++m) {
                    const int eg = (pn - 8) * 256 + ai * 128 + wr * 64 + m * 16 + fr, h = eg >> 9, e = eg & 511;
#pragma unroll
                    for (int bj = 0; bj < 2; ++bj)
#pragma unroll
                        for (int n = 0; n < 2; ++n) {
                            const int tok = u.pm * 256 + bj * 128 + wc * 32 + n * 16 + 4 * fq; const u32x2 w = pk4(acc[ai][bj][m][n]);
                            if (tok < MP) { const int b = tok >> 12, t = tok & 4095; *(u32x2*)(vTp + ((size_t)((b * 4 + h) * 512 + e)) * 4096 + t) = w; }
                            else { const int ts = tok - MP, bs = ts >> 3, l0 = ts & 7; *(u32x2*)(vTs + ((size_t)((bs * 4 + h) * 512 + e)) * 8 + l0) = w; }
                        }
                }
        } else {
#pragma unroll
            for (int ai = 0; ai < 2; ++ai)
#pragma unroll
                for (int m = 0; m < 4; ++m) { const int r = u.pm * 256 + ai * 128 + wr * 64 + m * 16 + fr;
#pragma unroll
                    for (int bj = 0; bj < 2; ++bj)
#pragma unroll
                        for (int n = 0; n < 2; ++n) { const f32x4 a = acc[ai][bj][m][n]; f32x4 s;
#pragma unroll
                            for (int j = 0; j < 4; ++j) s[j] = silu_f(a[j]);
                            *(u32x2*)(Zg + (size_t)r * 2048 + (pn - 16) * 256 + bj * 128 + wc * 32 + n * 16 + 4 * fq) = pk4(s); } }
        }
    }
};

__device__ __forceinline__ void transpose_tile(const float* __restrict__ W, bf16_t* __restrict__ Wt, int K, int N, bool perm, int tile, LAS float* T) {
    const int tid = otid(), ntn = N >> 6;
    const int n0 = (tile % ntn) * 64, k0 = (tile / ntn) * 64, nn = tid & 63;
    const int nd = n0 + nn; int ns = nd;
    if (perm && nd < 1280) { const int p = nd & 63; ns = (nd - p) + (p >> 5) * 16 + (p & 15) + ((p >> 4) & 1) * 32; }
#pragma unroll
    for (int i = 0; i < 8; ++i) { const int kk = (tid >> 6) + 8 * i; T[kk * 65 + nn] = W[(size_t)(k0 + kk) * N + ns]; }
    __syncthreads();
    const int kk2 = (tid & 31) * 2;
#pragma unroll
    for (int i = 0; i < 4; ++i) { const int n2 = (tid >> 5) + 16 * i; *(unsigned*)(Wt + (size_t)(n0 + n2) * K + k0 + kk2) = cvt_pk_bf16(T[kk2 * 65 + n2], T[(kk2 + 1) * 65 + n2]); }
    __syncthreads();
}

__device__ __forceinline__ void rms_rows(const float* __restrict__ Xa, const float* __restrict__ Xb, const float* __restrict__ g, bf16_t* __restrict__ H, int G) {
    const int tid_o = otid(), wave = tid_o >> 6, lane = tid_o & 63;
    for (int row = blockIdx.x * 8 + wave; row < MT; row += G * 8) {
        const float* x = row < MP ? Xa + (size_t)row * 1024 : Xb + (size_t)(row - MP) * 1024;
        f32x4 v[4]; float ss = 0.f;
#pragma unroll
        for (int i = 0; i < 4; ++i) { v[i] = *(const f32x4*)(x + lane * 4 + 256 * i); ss += v[i][0] * v[i][0] + v[i][1] * v[i][1] + v[i][2] * v[i][2] + v[i][3] * v[i][3]; }
        ss = wave_sum(ss);
        const float rr = rsqrtf(ss * (1.f / 1024.f) + EPS);
#pragma unroll
        for (int i = 0; i < 4; ++i) { const f32x4 gg = *(const f32x4*)(g + lane * 4 + 256 * i); *(u32x2*)(H + (size_t)row * 1024 + lane * 4 + 256 * i) = pk4(v[i] * rr * gg); }
    }
}
__device__ __forceinline__ void rms_rows_b16(const bf16_t* __restrict__ X, const float* __restrict__ g, bf16_t* __restrict__ H, int G) {
    const int tid_o = otid(), wave = tid_o >> 6, lane = tid_o & 63;
    for (int row = blockIdx.x * 8 + wave; row < MT; row += G * 8) {
        const u32x4 a = *(const u32x4*)(X + (size_t)row * 1024 + lane * 8), b = *(const u32x4*)(X + (size_t)row * 1024 + 512 + lane * 8);
        const float v[16] = {bflo(a.x), bfhi(a.x), bflo(a.y), bfhi(a.y), bflo(a.z), bfhi(a.z), bflo(a.w), bfhi(a.w), bflo(b.x), bfhi(b.x), bflo(b.y), bfhi(b.y), bflo(b.z), bfhi(b.z), bflo(b.w), bfhi(b.w)};
        float ss = 0.f;
#pragma unroll
        for (int i = 0; i < 16; ++i) ss += v[i] * v[i];
        ss = wave_sum(ss);
        const float rr = rsqrtf(ss * (1.f / 1024.f) + EPS);
#pragma unroll
        for (int hh = 0; hh < 2; ++hh) { const int c = hh * 512 + lane * 8; const f32x4 g0 = *(const f32x4*)(g + c), g1 = *(const f32x4*)(g + c + 4); u32x4 o;
            o.x = cvt_pk_bf16(v[hh * 8 + 0] * rr * g0[0], v[hh * 8 + 1] * rr * g0[1]); o.y = cvt_pk_bf16(v[hh * 8 + 2] * rr * g0[2], v[hh * 8 + 3] * rr * g0[3]);
            o.z = cvt_pk_bf16(v[hh * 8 + 4] * rr * g1[0], v[hh * 8 + 5] * rr * g1[1]); o.w = cvt_pk_bf16(v[hh * 8 + 6] * rr * g1[2], v[hh * 8 + 7] * rr * g1[3]);
            *(u32x4*)(H + (size_t)row * 1024 + c) = o; }
    }
}
template <bool XB16>
__device__ __forceinline__ void resid_rows(const float* __restrict__ Xa, const float* __restrict__ Xb, const bf16_t* __restrict__ Xh, const bf16_t* __restrict__ Y, const float* __restrict__ g, bf16_t* __restrict__ H, int G) {
    const int tid_o = otid(), wave = tid_o >> 6, lane = tid_o & 63;
    for (int row = blockIdx.x * 8 + wave; row < MT; row += G * 8) {
        const bf16_t* y = Y + (size_t)row * 1024;
        f32x4 v[4]; float ss = 0.f;
#pragma unroll
        for (int i = 0; i < 4; ++i) { const u32x2 yw = *(const u32x2*)(y + lane * 4 + 256 * i); v[i] = (f32x4){bflo(yw.x), bfhi(yw.x), bflo(yw.y), bfhi(yw.y)}; ss += v[i][0] * v[i][0] + v[i][1] * v[i][1] + v[i][2] * v[i][2] + v[i][3] * v[i][3]; }
        ss = wave_sum(ss);
        const float rr = rsqrtf(ss * (1.f / 1024.f) + EPS);
#pragma unroll
        for (int i = 0; i < 4; ++i) { const int c = lane * 4 + 256 * i; const f32x4 gg = *(const f32x4*)(g + c); f32x4 xx;
            if (XB16) { const u32x2 xw = *(const u32x2*)(Xh + (size_t)row * 1024 + c); xx = (f32x4){bflo(xw.x), bfhi(xw.x), bflo(xw.y), bfhi(xw.y)}; }
            else xx = *(const f32x4*)((row < MP ? Xa + (size_t)row * 1024 : Xb + (size_t)(row - MP) * 1024) + c);
            *(u32x2*)(H + (size_t)row * 1024 + c) = pk4(xx + v[i] * rr * gg); }
    }
}

struct SkF32 { float* C; __device__ __forceinline__ void operator()(int row, int col, f32x4 v) const { *(f32x4*)(C + (size_t)row * 1024 + col) = v; } };
struct SkB16 { bf16_t* C; __device__ __forceinline__ void operator()(int row, int col, f32x4 v) const { *(u32x2*)(C + (size_t)row * 1024 + col) = pk4(v); } };
template <bool OB16> struct SkGate { const bf16_t* X1; const bf16_t* PLE; float* O; bf16_t* Ob;
    __device__ __forceinline__ void operator()(int row, int col, f32x4 a) const { const size_t o = (size_t)row * 1024 + col; const u32x2 xw = *(const u32x2*)(X1 + o), pw = *(const u32x2*)(PLE + o);
        const f32x4 x1 = {bflo(xw.x), bfhi(xw.x), bflo(xw.y), bfhi(xw.y)}, pl = {bflo(pw.x), bfhi(pw.x), bflo(pw.y), bfhi(pw.y)}; f32x4 r;
#pragma unroll
        for (int j = 0; j < 4; ++j) r[j] = x1[j] + sigmoid_f(a[j]) * pl[j];
        if (OB16) *(u32x2*)(Ob + o) = pk4(r); else *(f32x4*)(O + o) = r; } };
template <class Epi>
__device__ __forceinline__ void skinny_gemm(LAS unsigned char* lds, const bf16_t* __restrict__ A, const bf16_t* __restrict__ Bt, int K, const Epi& E, int G) {
    LAS float* red = (LAS float*)lds;
    const int tid = otid(), w = tid >> 6, lane = tid & 63, l16 = lane & 15, g = lane >> 4;
    const int KS = K >> 3, nks = KS >> 5;
    for (int u = blockIdx.x; u < 256; u += G) {
        const int row0 = (u >> 4) * 64, col0 = (u & 15) * 64;
        const bf16_t* ap = A + (size_t)(row0 + l16) * K + w * KS + 8 * g;
        const bf16_t* bp = Bt + (size_t)(col0 + l16) * K + w * KS + 8 * g;
        f32x4 acc[4][4];
#pragma unroll
        for (int mt = 0; mt < 4; ++mt)
#pragma unroll
            for (int nt = 0; nt < 4; ++nt) acc[mt][nt] = (f32x4){0.f, 0.f, 0.f, 0.f};
#pragma unroll 4
        for (int ks = 0; ks < nks; ++ks) {
            bf16x8 af[4], bf[4];
#pragma unroll
            for (int t = 0; t < 4; ++t) { af[t] = *(const bf16x8*)(ap + (size_t)(16 * t) * K + 32 * ks); bf[t] = *(const bf16x8*)(bp + (size_t)(16 * t) * K + 32 * ks); }
#pragma unroll
            for (int mt = 0; mt < 4; ++mt)
#pragma unroll
                for (int nt = 0; nt < 4; ++nt) acc[mt][nt] = __builtin_amdgcn_mfma_f32_16x16x32_bf16(bf[nt], af[mt], acc[mt][nt], 0, 0, 0);
        }
        __syncthreads();
#pragma unroll
        for (int mt = 0; mt < 4; ++mt)
#pragma unroll
            for (int nt = 0; nt < 4; ++nt) *(LAS f32x4*)(red + (w * 64 + 16 * mt + l16) * 68 + 16 * nt + 4 * g) = acc[mt][nt];
        __syncthreads();
#pragma unroll
        for (int j = 0; j < 2; ++j) { const int q = tid + 512 * j, row = q >> 4, c4 = (q & 15) * 4; f32x4 sum = *(const LAS f32x4*)(red + row * 68 + c4);
#pragma unroll
            for (int ww = 1; ww < 8; ++ww) sum += *(const LAS f32x4*)(red + (ww * 64 + row) * 68 + c4);
            E(row0 + row, col0 + c4, sum); }
    }
}

__device__ __forceinline__ void attn_prompt(LAS unsigned char* lds, const bf16_t* __restrict__ Zq, const bf16_t* __restrict__ Zk, const bf16_t* __restrict__ Zg, const bf16_t* __restrict__ vTp,
                                            const float* __restrict__ sinks, bf16_t* __restrict__ OG, int G) {
    LAS bf16_t* Ks = (LAS bf16_t*)lds;
    LAS bf16_t* Vt = (LAS bf16_t*)(lds + 256 * 72 * 2);
    const int tid = otid(), w = tid >> 6, lane = tid & 63, l16 = lane & 15, g = lane >> 4;
    for (int it = blockIdx.x; it < 512; it += G) {
        const int kvh = it & 3, nb = (it >> 2) & 31, b = it >> 7;
        __syncthreads();
#pragma unroll
        for (int i = 0; i < 4; ++i) { const int ch = tid + 512 * i, s = ch >> 3, c8 = ch & 7, t = (nb - 1) * 128 + s;
            u32x4 val = {0u, 0u, 0u, 0u}; if (t >= 0) val = *(const u32x4*)(Zk + (size_t)(b * 4096 + t) * 256 + kvh * 64 + c8 * 8);
            *(LAS u32x4*)(Ks + s * 72 + c8 * 8) = val; }
#pragma unroll
        for (int i = 0; i < 4; ++i) { const int ch = tid + 512 * i, d = ch >> 5, s0 = (ch & 31) * 8, t0 = (nb - 1) * 128 + s0;
            u32x4 val = {0u, 0u, 0u, 0u}; if (t0 >= 0) val = *(const u32x4*)(vTp + ((size_t)((b * 4 + kvh) * 64 + d)) * 4096 + t0);
            *(LAS u32x4*)(Vt + d * 264 + s0) = val; }
        __syncthreads();
        const int head = kvh * 4 + (w >> 1);
        const float sk = sinks[head];
        for (int qi = 0; qi < 4; ++qi) {
            const int qt = (w & 1) * 4 + qi;
            const size_t tq = (size_t)b * 4096 + nb * 128 + qt * 16 + l16;
            bf16x8 qf[2];
#pragma unroll
            for (int ks = 0; ks < 2; ++ks) qf[ks] = *(const bf16x8*)(Zq + tq * 1024 + head * 64 + ks * 32 + g * 8);
            f32x4 sa[9];
#pragma unroll
            for (int j = 0; j < 9; ++j) { sa[j] = (f32x4){0.f, 0.f, 0.f, 0.f};
#pragma unroll
                for (int ks = 0; ks < 2; ++ks) { const bf16x8 kf = *(const LAS bf16x8*)(Ks + (16 * (qt + j) + l16) * 72 + ks * 32 + g * 8);
                    sa[j] = __builtin_amdgcn_mfma_f32_16x16x32_bf16(kf, qf[ks], sa[j], 0, 0, 0); } }
            float mx = sk;
#pragma unroll
            for (int j = 0; j < 9; ++j)
#pragma unroll
                for (int r = 0; r < 4; ++r) {
                    bool vis = true;
                    if (j == 0) vis = (4 * g + r) > l16;
                    if (j == 8) vis = (4 * g + r) <= l16;
                    if (nb == 0 && (qt + j) < 8) vis = false;
                    sa[j][r] = vis ? sa[j][r] : -1e30f;
                    mx = fmaxf(mx, sa[j][r]);
                }
            mx = fmaxf(mx, __shfl_xor(mx, 16, 64)); mx = fmaxf(mx, __shfl_xor(mx, 32, 64));
            float sum = 0.f;
#pragma unroll
            for (int j = 0; j < 9; ++j)
#pragma unroll
                for (int r = 0; r < 4; ++r) { const float p = __expf(sa[j][r] - mx); sa[j][r] = p; sum += p; }
            sum += __shfl_xor(sum, 16, 64); sum += __shfl_xor(sum, 32, 64);
            const float inv = 1.f / (sum + __expf(sk - mx));
            f32x4 oa[4];
#pragma unroll
            for (int dt = 0; dt < 4; ++dt) oa[dt] = (f32x4){0.f, 0.f, 0.f, 0.f};
#pragma unroll
            for (int u = 0; u < 5; ++u) {
                u32x4 pw; pw.x = cvt_pk_bf16(sa[2 * u][0], sa[2 * u][1]); pw.y = cvt_pk_bf16(sa[2 * u][2], sa[2 * u][3]);
                if (u < 4) { pw.z = cvt_pk_bf16(sa[2 * u + 1][0], sa[2 * u + 1][1]); pw.w = cvt_pk_bf16(sa[2 * u + 1][2], sa[2 * u + 1][3]); } else { pw.z = 0u; pw.w = 0u; }
                const bf16x8 pf = __builtin_bit_cast(bf16x8, pw);
                const int k0 = 16 * (qt + 2 * u) + 4 * g, k1 = (u < 4) ? k0 + 16 : k0;
#pragma unroll
                for (int dt = 0; dt < 4; ++dt) {
                    const u32x2 v0 = *(const LAS u32x2*)(Vt + (16 * dt + l16) * 264 + k0), v1 = *(const LAS u32x2*)(Vt + (16 * dt + l16) * 264 + k1);
                    u32x4 vw; vw.x = v0.x; vw.y = v0.y; vw.z = v1.x; vw.w = v1.y;
                    oa[dt] = __builtin_amdgcn_mfma_f32_16x16x32_bf16(__builtin_bit_cast(bf16x8, vw), pf, oa[dt], 0, 0, 0);
                }
            }
#pragma unroll
            for (int dt = 0; dt < 4; ++dt) {
                const size_t o = tq * 1024 + head * 64 + 16 * dt + 4 * g;
                const u32x2 gw = *(const u32x2*)(Zg + o);
                f32x4 r; r[0] = oa[dt][0] * inv * bflo(gw.x); r[1] = oa[dt][1] * inv * bfhi(gw.x); r[2] = oa[dt][2] * inv * bflo(gw.y); r[3] = oa[dt][3] * inv * bfhi(gw.y);
                *(u32x2*)(OG + o) = pk4(r);
            }
        }
    }
}

__device__ __forceinline__ void attn_sample(LAS unsigned char* lds, const Params& P, const bf16_t* __restrict__ Zq, const bf16_t* __restrict__ Zk, const bf16_t* __restrict__ Zg, const bf16_t* __restrict__ vTs,
                                            bf16_t* __restrict__ OG, int G) {
    constexpr int KS_B = 144 * 72 * 2, VT_B = 64 * 152 * 2, SLOT_B = KS_B + VT_B;
    for (int pr = blockIdx.x; pr < 256; pr += G) {
        const int tid = otid(), w = tid >> 6, lane = tid & 63, l16 = lane & 15, g = lane >> 4;
        __syncthreads();
#pragma unroll
        for (int sl = 0; sl < 2; ++sl) {
            const int it = 2 * pr + sl, bs = it >> 2, kvh = it & 3;
            LAS bf16_t* Ks = (LAS bf16_t*)(lds + sl * SLOT_B); LAS bf16_t* Vt = (LAS bf16_t*)(lds + sl * SLOT_B + KS_B);
#pragma unroll
            for (int i = 0; i < 4; ++i) { const int ch = tid + 512 * i, j = ch >> 4, d4 = (ch & 15) * 4;
                const size_t src = ((size_t)(bs * 128 + j) * 4 + kvh) * 64 + d4;
                const f32x4 kv = *(const f32x4*)(P.cache_k + src), vv = *(const f32x4*)(P.cache_v + src);
                if (j >= 8) { const size_t dst = ((size_t)(bs * 128 + j - 8) * 4 + kvh) * 64 + d4; *(f32x4*)(P.out + OFF_KWS + dst) = kv; *(f32x4*)(P.out + OFF_VWS + dst) = vv; }
                *(LAS u32x2*)(Ks + j * 72 + d4) = pk4(kv);
                const u32x2 vw = pk4(vv);
                Vt[(d4 + 0) * 152 + j] = (bf16_t)(vw.x & 0xffffu); Vt[(d4 + 1) * 152 + j] = (bf16_t)(vw.x >> 16); Vt[(d4 + 2) * 152 + j] = (bf16_t)(vw.y & 0xffffu); Vt[(d4 + 3) * 152 + j] = (bf16_t)(vw.y >> 16); }
            { const int l = tid >> 6, d = tid & 63;
              Ks[(128 + l) * 72 + d] = Zk[(size_t)(MP + bs * 8 + l) * 256 + kvh * 64 + d]; Ks[(136 + l) * 72 + d] = 0; }
            if (tid < 64) { const u32x4 nv = *(const u32x4*)(vTs + ((size_t)((bs * 4 + kvh) * 64 + tid)) * 8);
                *(LAS u32x4*)(Vt + tid * 152 + 128) = nv; *(LAS u32x4*)(Vt + tid * 152 + 136) = (u32x4){0u, 0u, 0u, 0u}; *(LAS u32x4*)(Vt + tid * 152 + 144) = (u32x4){0u, 0u, 0u, 0u}; }
        }
        __syncthreads();
        if (w < 4) {
            const int sl = w >> 1, t = w & 1, it = 2 * pr + sl, bs = it >> 2, kvh = it & 3;
            const LAS bf16_t* Ks = (const LAS bf16_t*)(lds + sl * SLOT_B); const LAS bf16_t* Vt = (const LAS bf16_t*)(lds + sl * SLOT_B + KS_B);
            const int hq = 2 * t + (l16 >> 3), l = l16 & 7, head = kvh * 4 + hq;
            const size_t tq = (size_t)(MP + bs * 8 + l);
            const float sk = P.sinks[head];
            bf16x8 qf[2];
#pragma unroll
            for (int ks = 0; ks < 2; ++ks) qf[ks] = *(const bf16x8*)(Zq + tq * 1024 + head * 64 + ks * 32 + g * 8);
            f32x4 sa[9];
#pragma unroll
            for (int j = 0; j < 9; ++j) { sa[j] = (f32x4){0.f, 0.f, 0.f, 0.f};
#pragma unroll
                for (int ks = 0; ks < 2; ++ks) { const bf16x8 kf = *(const LAS bf16x8*)(Ks + (16 * j + l16) * 72 + ks * 32 + g * 8);
                    sa[j] = __builtin_amdgcn_mfma_f32_16x16x32_bf16(kf, qf[ks], sa[j], 0, 0, 0); } }
            float mx = sk;
#pragma unroll
            for (int j = 0; j < 9; ++j)
#pragma unroll
                for (int r = 0; r < 4; ++r) { const int key = 16 * j + 4 * g + r;
                    const bool vis = (j < 8) ? (key > l) : (key - 128 <= l);
                    sa[j][r] = vis ? sa[j][r] : -1e30f; mx = fmaxf(mx, sa[j][r]); }
            mx = fmaxf(mx, __shfl_xor(mx, 16, 64)); mx = fmaxf(mx, __shfl_xor(mx, 32, 64));
            float sum = 0.f;
#pragma unroll
            for (int j = 0; j < 9; ++j)
#pragma unroll
                for (int r = 0; r < 4; ++r) { const float p = __expf(sa[j][r] - mx); sa[j][r] = p; sum += p; }
            sum += __shfl_xor(sum, 16, 64); sum += __shfl_xor(sum, 32, 64);
            const float inv = 1.f / (sum + __expf(sk - mx));
            f32x4 oa[4];
#pragma unroll
            for (int dt = 0; dt < 4; ++dt) oa[dt] = (f32x4){0.f, 0.f, 0.f, 0.f};
#pragma unroll
            for (int u = 0; u < 5; ++u) {
                u32x4 pw; pw.x = cvt_pk_bf16(sa[2 * u][0], sa[2 * u][1]); pw.y = cvt_pk_bf16(sa[2 * u][2], sa[2 * u][3]);
                if (u < 4) { pw.z = cvt_pk_bf16(sa[2 * u + 1][0], sa[2 * u + 1][1]); pw.w = cvt_pk_bf16(sa[2 * u + 1][2], sa[2 * u + 1][3]); } else { pw.z = 0u; pw.w = 0u; }
                const bf16x8 pf = __builtin_bit_cast(bf16x8, pw);
                const int k0 = 32 * u + 4 * g, k1 = (u < 4) ? k0 + 16 : k0;
#pragma unroll
                for (int dt = 0; dt < 4; ++dt) {
                    const u32x2 v0 = *(const LAS u32x2*)(Vt + (16 * dt + l16) * 152 + k0), v1 = *(const LAS u32x2*)(Vt + (16 * dt + l16) * 152 + k1);
                    u32x4 vw; vw.x = v0.x; vw.y = v0.y; vw.z = v1.x; vw.w = v1.y;
                    oa[dt] = __builtin_amdgcn_mfma_f32_16x16x32_bf16(__builtin_bit_cast(bf16x8, vw), pf, oa[dt], 0, 0, 0);
                }
            }
#pragma unroll
            for (int dt = 0; dt < 4; ++dt) {
                const size_t o = tq * 1024 + head * 64 + 16 * dt + 4 * g;
                const u32x2 gw = *(const u32x2*)(Zg + o);
                f32x4 r; r[0] = oa[dt][0] * inv * bflo(gw.x); r[1] = oa[dt][1] * inv * bfhi(gw.x); r[2] = oa[dt][2] * inv * bflo(gw.y); r[3] = oa[dt][3] * inv * bfhi(gw.y);
                *(u32x2*)(OG + o) = pk4(r);
            }
        }
    }
}

__device__ __forceinline__ void ret_A(LAS unsigned char* lds, const bf16_t* __restrict__ Zq, const bf16_t* __restrict__ Zk, bf16_t* __restrict__ ABUF, bf16_t* __restrict__ KDT, int G) {
    LAS bf16_t* Qs = (LAS bf16_t*)lds;
    LAS bf16_t* Ks = (LAS bf16_t*)(lds + 128 * 264 * 2);
    const int tid = otid(), w = tid >> 6, lane = tid & 63, l16 = lane & 15, g = lane >> 4;
    for (int it = blockIdx.x; it < 512; it += G) {
        const int c = it & 31, h = (it >> 5) & 3, b = it >> 7;
        const float lg = ret_lg(h);
        const size_t tok0 = (size_t)b * 4096 + c * 128;
        __syncthreads();
#pragma unroll
        for (int i = 0; i < 8; ++i) { const int ch = tid + 512 * i, s = ch >> 5, c8 = (ch & 31) * 8; const size_t src = (tok0 + s) * 1024 + h * 256 + c8;
            *(LAS u32x4*)(Qs + s * 264 + c8) = *(const u32x4*)(Zq + src); *(LAS u32x4*)(Ks + s * 264 + c8) = *(const u32x4*)(Zk + src); }
        __syncthreads();
        const int i_row = 16 * w + l16;
#pragma unroll
        for (int nt = 0; nt < 8; ++nt) {
            f32x4 a = {0.f, 0.f, 0.f, 0.f};
            if (nt <= w) {
#pragma unroll
                for (int ks = 0; ks < 8; ++ks) { const bf16x8 kf = *(const LAS bf16x8*)(Ks + (16 * nt + l16) * 264 + ks * 32 + g * 8), qf = *(const LAS bf16x8*)(Qs + i_row * 264 + ks * 32 + g * 8);
                    a = __builtin_amdgcn_mfma_f32_16x16x32_bf16(kf, qf, a, 0, 0, 0); }
#pragma unroll
                for (int r = 0; r < 4; ++r) { const int s = 16 * nt + 4 * g + r; a[r] = (s <= i_row) ? a[r] * __expf((float)(i_row - s) * lg) : 0.f; }
            }
            *(u32x2*)(ABUF + ((size_t)it * 128 + i_row) * 128 + 16 * nt + 4 * g) = pk4(a);
        }
        { const int d = tid & 255, sg0 = tid >> 8;
#pragma unroll
          for (int k = 0; k < 8; ++k) { const int s0 = 8 * (sg0 + 2 * k); float v[8];
#pragma unroll
              for (int jj = 0; jj < 8; ++jj) v[jj] = bf2f(Ks[(s0 + jj) * 264 + d]) * __expf((float)(127 - s0 - jj) * lg);
              u32x4 wv; wv.x = cvt_pk_bf16(v[0], v[1]); wv.y = cvt_pk_bf16(v[2], v[3]); wv.z = cvt_pk_bf16(v[4], v[5]); wv.w = cvt_pk_bf16(v[6], v[7]);
              *(u32x4*)(KDT + ((size_t)it * 256 + d) * 128 + s0) = wv; } }
    }
}

__device__ __forceinline__ void ret_seq_unit(LAS unsigned char* lds, int u, const bf16_t* __restrict__ Zq, const bf16_t* __restrict__ vTp, const bf16_t* __restrict__ ABUF, const bf16_t* __restrict__ KDT,
                                             bf16_t* __restrict__ ORET, float* __restrict__ out) {
    LAS bf16_t* ST = (LAS bf16_t*)lds;
    LAS bf16_t* VT = (LAS bf16_t*)(lds + 2 * 64 * 264 * 2);
    const int tid = otid(), w = tid >> 6, lane = tid & 63, l16 = lane & 15, g = lane >> 4;
    const int xcd = u & 7, jj = u >> 3, bh = xcd * 2 + (jj >> 3), es = jj & 7, b = bh >> 2, h = bh & 3;
    const float lg = ret_lg(h), g128 = __expf(128.f * lg), gi = __expf((float)(16 * w + l16 + 1) * lg);
    __syncthreads();
    for (int e = tid; e < 64 * 264 / 2; e += NT) ((LAS unsigned*)ST)[e] = 0u;
    const bf16_t* vrow = vTp + ((size_t)bh * 512 + es * 64 + (tid >> 3)) * 4096 + (tid & 7) * 16;
    LAS bf16_t* vdst = VT + (tid >> 3) * 136 + (tid & 7) * 16;
    { const u32x4 a = *(const u32x4*)vrow, bq = *(const u32x4*)(vrow + 8); *(LAS u32x4*)vdst = a; *(LAS u32x4*)(vdst + 8) = bq; }
    f32x4 sacc[2][4];
#pragma unroll
    for (int dt = 0; dt < 2; ++dt)
#pragma unroll
        for (int et = 0; et < 4; ++et) sacc[dt][et] = (f32x4){0.f, 0.f, 0.f, 0.f};
    const bf16_t* aptr = ABUF + ((size_t)bh * 32 * 128 + 16 * w + l16) * 128 + 8 * g;
    const bf16_t* qptr = Zq + ((size_t)b * 4096 + 16 * w + l16) * 1024 + h * 256 + 8 * g;
    const bf16_t* kptr = KDT + ((size_t)bh * 32 * 256 + 32 * w + l16) * 128 + 8 * g;
    bf16_t* optr = ORET + ((size_t)b * 4096 + 16 * w + l16) * 2048 + h * 512 + es * 64 + 4 * g;
    bf16x8 af[4], qf[8], kf[2][4];
#pragma unroll
    for (int ks = 0; ks < 4; ++ks) af[ks] = *(const bf16x8*)(aptr + 32 * ks);
#pragma unroll
    for (int kd = 0; kd < 8; ++kd) qf[kd] = *(const bf16x8*)(qptr + 32 * kd);
    __syncthreads();
    u32x2 opk[4];
    for (int c = 0; c < 32; ++c) {
        const int buf = c & 1;
        if (c > 0) {
#pragma unroll
            for (int et = 0; et < 4; ++et) *(u32x2*)(optr + (size_t)(c - 1) * 128 * 2048 + 16 * et) = opk[et]; }
#pragma unroll
        for (int dt = 0; dt < 2; ++dt)
#pragma unroll
            for (int ks = 0; ks < 4; ++ks) kf[dt][ks] = *(const bf16x8*)(kptr + (size_t)c * 256 * 128 + dt * 2048 + 32 * ks);
        u32x4 nv0 = {0u, 0u, 0u, 0u}, nv1 = {0u, 0u, 0u, 0u};
        if (c < 31) { nv0 = *(const u32x4*)(vrow + (c + 1) * 128); nv1 = *(const u32x4*)(vrow + (c + 1) * 128 + 8); }
        const LAS bf16_t* VTb = VT + buf * 64 * 136; const LAS bf16_t* STb = ST + buf * 64 * 264;
#pragma unroll
        for (int et = 0; et < 4; ++et) {
            f32x4 oin = {0.f, 0.f, 0.f, 0.f}, ocr = {0.f, 0.f, 0.f, 0.f};
#pragma unroll
            for (int ks = 0; ks < 4; ++ks) { const bf16x8 vf = *(const LAS bf16x8*)(VTb + (16 * et + l16) * 136 + 32 * ks + 8 * g); oin = __builtin_amdgcn_mfma_f32_16x16x32_bf16(vf, af[ks], oin, 0, 0, 0); }
#pragma unroll
            for (int kd = 0; kd < 8; ++kd) { const bf16x8 sf = *(const LAS bf16x8*)(STb + (16 * et + l16) * 264 + 32 * kd + 8 * g); ocr = __builtin_amdgcn_mfma_f32_16x16x32_bf16(sf, qf[kd], ocr, 0, 0, 0); }
            opk[et] = pk4(oin + ocr * gi);
        }
        if (c < 31) {
#pragma unroll
            for (int ks = 0; ks < 4; ++ks) af[ks] = *(const bf16x8*)(aptr + (size_t)(c + 1) * 128 * 128 + 32 * ks);
#pragma unroll
            for (int kd = 0; kd < 8; ++kd) qf[kd] = *(const bf16x8*)(qptr + (size_t)(c + 1) * 128 * 1024 + 32 * kd);
        }
#pragma unroll
        for (int dt = 0; dt < 2; ++dt)
#pragma unroll
            for (int et = 0; et < 4; ++et) sacc[dt][et] *= g128;
#pragma unroll
        for (int et = 0; et < 4; ++et)
#pragma unroll
            for (int ks = 0; ks < 4; ++ks) { const bf16x8 vf = *(const LAS bf16x8*)(VTb + (16 * et + l16) * 136 + 32 * ks + 8 * g);
#pragma unroll
                for (int dt = 0; dt < 2; ++dt) sacc[dt][et] = __builtin_amdgcn_mfma_f32_16x16x32_bf16(kf[dt][ks], vf, sacc[dt][et], 0, 0, 0); }
#pragma unroll
        for (int dt = 0; dt < 2; ++dt)
#pragma unroll
            for (int et = 0; et < 4; ++et) *(LAS u32x2*)(ST + ((buf ^ 1) * 64 + 16 * et + l16) * 264 + 32 * w + 16 * dt + 4 * g) = pk4(sacc[dt][et]);
        if (c < 31) { LAS bf16_t* d2 = vdst + (buf ^ 1) * 64 * 136; *(LAS u32x4*)d2 = nv0; *(LAS u32x4*)(d2 + 8) = nv1; }
        __syncthreads();
    }
#pragma unroll
    for (int et = 0; et < 4; ++et) *(u32x2*)(optr + (size_t)31 * 128 * 2048 + 16 * et) = opk[et];
#pragma unroll
    for (int dt = 0; dt < 2; ++dt)
#pragma unroll
        for (int et = 0; et < 4; ++et)
#pragma unroll
            for (int r = 0; r < 4; ++r) out[OFF_RSP + ((size_t)bh * 256 + 32 * w + 16 * dt + 4 * g + r) * 512 + es * 64 + 16 * et + l16] = sacc[dt][et][r];
}

__device__ __forceinline__ void ret_sample(LAS unsigned char* lds, const Params& P, const bf16_t* __restrict__ Zq, const bf16_t* __restrict__ Zk, const bf16_t* __restrict__ vTs, bf16_t* __restrict__ ORET, unsigned* ctr, unsigned* done, unsigned target) {
    LAS float* qs = (LAS float*)lds;
    LAS float* kds = qs + 2048;
    LAS float* A8 = kds + 2048;
    LAS float* red = A8 + 64;
    volatile LAS int* slot = (volatile LAS int*)(lds + LDS_BYTES - 32);
    for (;;) {
        const int tid = otid();
        __syncthreads();
        if (tid == 0) *slot = (done && xb_ld(done) >= target) ? 512 : (int)atomicAdd(ctr, 1u);
        __syncthreads();
        const int it = *slot;
        if (it >= 512) break;
        const int bs = it >> 2, h = it & 3;
        const float lg = ret_lg(h), g8 = __expf(8.f * lg), ig8 = __expf(-8.f * lg);
#pragma unroll
        for (int k = 0; k < 4; ++k) { const int e = tid + 512 * k, i = e >> 8, d = e & 255; const size_t src = (size_t)(MP + bs * 8 + i) * 1024 + h * 256 + d;
            qs[d * 8 + i] = bf2f(Zq[src]) * __expf((float)(i + 1) * lg); kds[d * 8 + i] = bf2f(Zk[src]) * __expf((float)(7 - i) * lg); }
        __syncthreads();
        if (tid < 64) { const int i = tid >> 3, s = tid & 7; float a = 0.f;
            if (s <= i) { for (int d = 0; d < 256; ++d) a += qs[d * 8 + i] * kds[d * 8 + s]; a *= ig8; }
            A8[tid] = a; }
        const int eg = tid & 127, dp = tid >> 7, e0 = 4 * eg;
        f32x4 vq[8];
#pragma unroll
        for (int jj = 0; jj < 4; ++jj) { const u32x4 wv = *(const u32x4*)(vTs + ((size_t)((bs * 4 + h) * 512 + e0 + jj)) * 8);
            vq[0][jj] = bflo(wv.x); vq[1][jj] = bfhi(wv.x); vq[2][jj] = bflo(wv.y); vq[3][jj] = bfhi(wv.y); vq[4][jj] = bflo(wv.z); vq[5][jj] = bfhi(wv.z); vq[6][jj] = bflo(wv.w); vq[7][jj] = bfhi(wv.w); }
        f32x4 cr[8];
#pragma unroll
        for (int i = 0; i < 8; ++i) cr[i] = (f32x4){0.f, 0.f, 0.f, 0.f};
        const size_t sbase = ((size_t)(bs * 4 + h) * 256 + dp * 64) * 512 + e0;
        const float* __restrict__ sp = P.state_ret + sbase; float* __restrict__ op = P.out + OFF_RSS + sbase;
        f32x4 sta[8];
#pragma unroll
        for (int j = 0; j < 8; ++j) sta[j] = __builtin_nontemporal_load((const f32x4*)(sp + (size_t)j * 512));
#pragma unroll 1
        for (int d0 = 0; d0 < 64; d0 += 8) {
            const bool more = d0 + 8 < 64;
#pragma unroll
            for (int j = 0; j < 8; ++j) {
                const int d = dp * 64 + d0 + j; const f32x4 st = sta[j];
                if (more) sta[j] = __builtin_nontemporal_load((const f32x4*)(sp + (size_t)(d0 + 8 + j) * 512));
                const f32x4 qa = *(const LAS f32x4*)(qs + d * 8), qb = *(const LAS f32x4*)(qs + d * 8 + 4), ka = *(const LAS f32x4*)(kds + d * 8), kb = *(const LAS f32x4*)(kds + d * 8 + 4);
                const float q8[8] = {qa[0], qa[1], qa[2], qa[3], qb[0], qb[1], qb[2], qb[3]}, k8[8] = {ka[0], ka[1], ka[2], ka[3], kb[0], kb[1], kb[2], kb[3]};
                f32x4 ns = st * g8;
#pragma unroll
                for (int s2 = 0; s2 < 8; ++s2) ns += vq[s2] * k8[s2];
                __builtin_nontemporal_store(ns, (f32x4*)(op + (size_t)(d0 + j) * 512));
#pragma unroll
                for (int i = 0; i < 8; ++i) cr[i] += st * q8[i];
                asm volatile("" ::: "memory");
            }
        }
#pragma unroll
        for (int i = 0; i < 8; ++i) *(LAS f32x4*)(red + (dp * 8 + i) * 512 + e0) = cr[i];
        __syncthreads();
        { const int i = tid >> 6, e8 = (tid & 63) * 8;
          float o[8];
#pragma unroll
          for (int jj = 0; jj < 8; ++jj) o[jj] = red[(0 * 8 + i) * 512 + e8 + jj] + red[(1 * 8 + i) * 512 + e8 + jj] + red[(2 * 8 + i) * 512 + e8 + jj] + red[(3 * 8 + i) * 512 + e8 + jj];
#pragma unroll
          for (int jj = 0; jj < 8; ++jj) { const u32x4 wv = *(const u32x4*)(vTs + ((size_t)((bs * 4 + h) * 512 + e8 + jj)) * 8);
              const float v8[8] = {bflo(wv.x), bfhi(wv.x), bflo(wv.y), bfhi(wv.y), bflo(wv.z), bfhi(wv.z), bflo(wv.w), bfhi(wv.w)};
#pragma unroll
              for (int s = 0; s < 8; ++s) o[jj] += A8[i * 8 + s] * v8[s]; }
          bf16_t* dst = ORET + (size_t)(MP + bs * 8 + i) * 2048 + h * 512 + e8;
          u32x4 ow; ow.x = cvt_pk_bf16(o[0], o[1]); ow.y = cvt_pk_bf16(o[2], o[3]); ow.z = cvt_pk_bf16(o[4], o[5]); ow.w = cvt_pk_bf16(o[6], o[7]); *(u32x4*)dst = ow; }
    }
}

__device__ __forceinline__ void ret_gnorm(const bf16_t* __restrict__ ORET, const bf16_t* __restrict__ Zg, bf16_t* __restrict__ OG, int G) {
    const int tid_o = otid(), wave = tid_o >> 6, lane = tid_o & 63;
    for (int task = blockIdx.x * 8 + wave; task < MT * 4; task += G * 8) {
        const size_t o = (size_t)(task >> 2) * 2048 + (task & 3) * 512 + lane * 8;
        const u32x4 ow = *(const u32x4*)(ORET + o); const f32x4 a = {bflo(ow.x), bfhi(ow.x), bflo(ow.y), bfhi(ow.y)}, b = {bflo(ow.z), bfhi(ow.z), bflo(ow.w), bfhi(ow.w)};
        const float mu = wave_sum(a[0] + a[1] + a[2] + a[3] + b[0] + b[1] + b[2] + b[3]) * (1.f / 512.f);
        const f32x4 da = a - mu, db = b - mu;
        const float var = wave_sum(da[0] * da[0] + da[1] * da[1] + da[2] * da[2] + da[3] * da[3] + db[0] * db[0] + db[1] * db[1] + db[2] * db[2] + db[3] * db[3]) * (1.f / 512.f);
        const float rs = rsqrtf(var + EPS);
        const u32x4 gw = *(const u32x4*)(Zg + o);
        u32x4 r;
        r.x = cvt_pk_bf16(da[0] * rs * bflo(gw.x), da[1] * rs * bfhi(gw.x)); r.y = cvt_pk_bf16(da[2] * rs * bflo(gw.y), da[3] * rs * bfhi(gw.y));
        r.z = cvt_pk_bf16(db[0] * rs * bflo(gw.z), db[1] * rs * bfhi(gw.z)); r.w = cvt_pk_bf16(db[2] * rs * bflo(gw.w), db[3] * rs * bfhi(gw.w));
        *(u32x4*)(OG + o) = r;
    }
}

__global__ void __launch_bounds__(NT) hybrid_fwd(Params P) {
    extern __shared__ __attribute__((aligned(16))) unsigned char lds_raw[];
    LAS unsigned char* lds = (LAS unsigned char*)lds_raw;
    cg::grid_group grid = cg::this_grid();
    const int G = gridDim.x, tid = threadIdx.x;
    unsigned char* ws = P.ws;
    bf16_t* WT_IN_ATTN = (bf16_t*)(ws + WS_WT_IN_ATTN); bf16_t* WT_OUT_ATTN = (bf16_t*)(ws + WS_WT_OUT_ATTN); bf16_t* WT_IN_RET = (bf16_t*)(ws + WS_WT_IN_RET); bf16_t* WT_OUT_RET = (bf16_t*)(ws + WS_WT_OUT_RET);
    bf16_t* WT_GATE = (bf16_t*)(ws + WS_WT_GATE); bf16_t* WT_PLE = (bf16_t*)(ws + WS_WT_PLE);
    float* TABA = (float*)(ws + WS_TABA); float* TABR = (float*)(ws + WS_TABR);
    bf16_t* H = (bf16_t*)(ws + WS_H); bf16_t* PB = (bf16_t*)(ws + WS_PB);
    bf16_t* PLE = (bf16_t*)(ws + WS_PLE); bf16_t* Y = (bf16_t*)(ws + WS_Y); bf16_t* X2 = (bf16_t*)(ws + WS_X2);
    bf16_t* OG = (bf16_t*)(ws + WS_OG); bf16_t* ZQ = (bf16_t*)(ws + WS_ZQ); bf16_t* ZK = (bf16_t*)(ws + WS_ZK); bf16_t* ZG = (bf16_t*)(ws + WS_ZG);
    bf16_t* VTP = (bf16_t*)(ws + WS_VTP); bf16_t* VTS = (bf16_t*)(ws + WS_VTS); bf16_t* ABUF = (bf16_t*)(ws + WS_ABUF); bf16_t* KDT = (bf16_t*)(ws + WS_KDT); bf16_t* ORET = (bf16_t*)(ws + WS_ORET);
    bf16_t* SC = (bf16_t*)(ws + WS_Y);
    pg8::StaticOrder SO;
    volatile LAS unsigned* bst = (volatile LAS unsigned*)(lds + LDS_BYTES - 16);
    if (tid < 4) bst[tid] = 0u;
    __syncthreads();
    const XcdBarrier xbar = xcd_barrier_post((unsigned*)(ws + WS_BAR), bst);
#define GSYNC() xcd_barrier(xbar)

for (int rep_ = 0; rep_ < REP_P0; ++rep_) {
    {
        LAS float* T = (LAS float*)lds;
        const int ttid = otid(), nn = ttid & 63, kq = ttid >> 6, kk2 = (ttid & 31) * 2, nq = ttid >> 5;
#define TILE_DESC(t_, W_, Wt_, K_, N_, perm_, tl_) do { \
        if ((t_) < 640) { W_ = P.w_in_attn; Wt_ = WT_IN_ATTN; K_ = 1024; N_ = 2560; perm_ = true; tl_ = (t_); } \
        else if ((t_) < 896) { W_ = P.w_out_attn; Wt_ = WT_OUT_ATTN; K_ = 1024; N_ = 1024; perm_ = false; tl_ = (t_) - 640; } \
        else if ((t_) < 2432) { W_ = P.w_in_ret; Wt_ = WT_IN_RET; K_ = 1024; N_ = 6144; perm_ = false; tl_ = (t_) - 896; } \
        else if ((t_) < 2944) { W_ = P.w_out_ret; Wt_ = WT_OUT_RET; K_ = 2048; N_ = 1024; perm_ = false; tl_ = (t_) - 2432; } \
        else if ((t_) < 3200) { W_ = P.w_gate; Wt_ = WT_GATE; K_ = 1024; N_ = 1024; perm_ = false; tl_ = (t_) - 2944; } \
        else if ((t_) < 3456) { W_ = P.w_gate + 1024 * 1024; Wt_ = WT_GATE + 1024 * 1024; K_ = 1024; N_ = 1024; perm_ = false; tl_ = (t_) - 3200; } \
        else if ((t_) < 3520) { W_ = P.w_ple; Wt_ = WT_PLE; K_ = 256; N_ = 1024; perm_ = false; tl_ = (t_) - 3456; } \
        else { W_ = P.w_ple + 256 * 1024; Wt_ = WT_PLE + 1024 * 256; K_ = 256; N_ = 1024; perm_ = false; tl_ = (t_) - 3520; } } while (0)
#define TILE_LOAD(W_, N_, perm_, tl_, r_) do { const int ntn_ = (N_) >> 6, n0_ = ((tl_) % ntn_) * 64, k0_ = ((tl_) / ntn_) * 64, nd_ = n0_ + nn; int ns_ = nd_; \
        if ((perm_) && nd_ < 1280) { const int p_ = nd_ & 63; ns_ = (nd_ - p_) + (p_ >> 5) * 16 + (p_ & 15) + ((p_ >> 4) & 1) * 32; } \
        _Pragma("unroll") for (int i_ = 0; i_ < 8; ++i_) r_[i_] = (W_)[(size_t)(k0_ + kq + 8 * i_) * (N_) + ns_]; } while (0)
        float r[8];
        const float* Wc; bf16_t* Wtc; int Kc, Nc, tlc; bool pc;
        int t = blockIdx.x;
        if (t < 3584) { TILE_DESC(t, Wc, Wtc, Kc, Nc, pc, tlc); TILE_LOAD(Wc, Nc, pc, tlc, r); }
        for (; t < 3584; t += G) {
            __syncthreads();
#pragma unroll
            for (int i = 0; i < 8; ++i) T[(kq + 8 * i) * 65 + nn] = r[i];
            __syncthreads();
            const int ntn = Nc >> 6, n0 = (tlc % ntn) * 64, k0 = (tlc / ntn) * 64; bf16_t* Wto = Wtc; const int Ko = Kc;
            if (t + G < 3584) { TILE_DESC(t + G, Wc, Wtc, Kc, Nc, pc, tlc); TILE_LOAD(Wc, Nc, pc, tlc, r); }
#pragma unroll
            for (int i = 0; i < 4; ++i) { const int n2 = nq + 16 * i; *(unsigned*)(Wto + (size_t)(n0 + n2) * Ko + k0 + kk2) = cvt_pk_bf16(T[kk2 * 65 + n2], T[(kk2 + 1) * 65 + n2]); }
        }
        __syncthreads();
#undef TILE_DESC
#undef TILE_LOAD
    }
    for (int e = blockIdx.x * NT + tid; e < 4104 * 160; e += G * NT) {
        const int pi = e / 160, f = e % 160; const int pos = pi < 4096 ? pi : 16384 + (pi - 4096);
        if (f < 32) { const float inv = powf(10000.f, -(float)f / 32.f), ang = (float)pos * inv; TABA[((size_t)pi * 32 + f) * 2] = cosf(ang); TABA[((size_t)pi * 32 + f) * 2 + 1] = sinf(ang); }
        else { const int f2 = f - 32; const float inv = powf(10000.f, -(float)f2 / 128.f), ang = (float)pos * inv; TABR[((size_t)pi * 128 + f2) * 2] = cosf(ang); TABR[((size_t)pi * 128 + f2) * 2 + 1] = sinf(ang); }
    }
    for (int e = blockIdx.x * NT + tid; e < 2 * MT * 64; e += G * NT) {
        const int i = e / (MT * 64), rem = e % (MT * 64), row = rem >> 6, c4 = (rem & 63) * 4;
        const float* src = row < MP ? P.p_prompt + ((size_t)i * MP + row) * 256 + c4 : P.p_sample + ((size_t)i * MS + row - MP) * 256 + c4;
        *(u32x2*)(PB + ((size_t)i * MT + row) * 256 + c4) = pk4(*(const f32x4*)src);
    }
    rms_rows(P.x_prompt, P.x_sample, P.pre_norm, H, G);
}
    if (P.ws == nullptr) grid.sync();
    GSYNC();

for (int rep_ = 0; rep_ < REP_GIN; ++rep_) {
    { pg8::Gemm g{H, WT_IN_ATTN, MT, 2560, 1024}; SO.init(MT, 2560, G, blockIdx.x);
      EpiInAttn E{ZQ, ZK, ZG, VTP, VTS, TABA, P.out}; pg8::gemm_phase(lds, g, SO, E); }
    { pg8::Gemm g{PB, WT_PLE, MP, 1024, 256}; EpiB16 E{PLE, 1024};
      if (G == 256) { pg8::TailOrder TO; TO.init(MP, 680 - 512, G, blockIdx.x); pg8::gemm_phase(lds, g, TO, E); }
      else { SO.init(MP, 1024, G, blockIdx.x); pg8::gemm_phase(lds, g, SO, E); }
      skinny_gemm(lds, PB + (size_t)MP * 256, WT_PLE, 256, SkB16{PLE + (size_t)MP * 1024}, G); }
}
    GSYNC();

for (int rep_ = 0; rep_ < REP_ATT; ++rep_) {
    attn_prompt(lds, ZQ, ZK, ZG, VTP, P.sinks, OG, G);
    attn_sample(lds, P, ZQ, ZK, ZG, VTS, OG, G);
}
    GSYNC();

for (int rep_ = 0; rep_ < REP_GN1; ++rep_) {
    { pg8::Gemm g{OG, WT_OUT_ATTN, MP, 1024, 1024}; SO.init(MP, 1024, G, blockIdx.x); EpiB16 E{Y, 1024}; pg8::gemm_phase(lds, g, SO, E);
      skinny_gemm(lds, OG + (size_t)MP * 1024, WT_OUT_ATTN, 1024, SkB16{Y + (size_t)MP * 1024}, G); }
}
    GSYNC();
for (int rep_ = 0; rep_ < REP_ROW; ++rep_) {
    resid_rows<false>(P.x_prompt, P.x_sample, nullptr, Y, P.post_norm, H, G);
}
    GSYNC();
for (int rep_ = 0; rep_ < REP_GN1; ++rep_) {
    { pg8::Gemm g{H, WT_GATE, MP, 1024, 1024}; SO.init(MP, 1024, G, blockIdx.x); EpiGate<true> E{H, PLE, nullptr, X2}; pg8::gemm_phase(lds, g, SO, E);
      skinny_gemm(lds, H + (size_t)MP * 1024, WT_GATE, 1024, SkGate<true>{H + (size_t)MP * 1024, PLE + (size_t)MP * 1024, nullptr, X2 + (size_t)MP * 1024}, G); }
}
    GSYNC();
for (int rep_ = 0; rep_ < REP_ROW; ++rep_) {
    rms_rows_b16(X2, P.pre_norm + 1024, H, G);
}
    GSYNC();
for (int rep_ = 0; rep_ < REP_GIN; ++rep_) {
    { pg8::Gemm g{H, WT_IN_RET, MT, 6144, 1024}; SO.init(MT, 6144, G, blockIdx.x);
      EpiInRet E{ZQ, ZK, ZG, VTP, VTS, TABR}; pg8::gemm_phase(lds, g, SO, E); }
    { pg8::Gemm g{PB + (size_t)MT * 256, WT_PLE + 1024 * 256, MP, 1024, 256}; EpiB16 E{PLE, 1024};
      if (G == 256) { pg8::TailOrder TO; TO.init(MP, 1632 - 6 * 256, G, blockIdx.x); pg8::gemm_phase(lds, g, TO, E); }
      else { SO.init(MP, 1024, G, blockIdx.x); pg8::gemm_phase(lds, g, SO, E); }
      skinny_gemm(lds, PB + (size_t)MT * 256 + (size_t)MP * 256, WT_PLE + 1024 * 256, 256, SkB16{PLE + (size_t)MP * 1024}, G); }
}
    GSYNC();
for (int rep_ = 0; rep_ < REP_RA; ++rep_) {
    ret_A(lds, ZQ, ZK, ABUF, KDT, G);
}
    GSYNC();
    { unsigned* ctr = (unsigned*)(ws + WS_BAR + 14336);
      if (blockIdx.x < 128) for (int u = blockIdx.x; u < 128; u += G) ret_seq_unit(lds, u, ZQ, VTP, ABUF, KDT, ORET, P.out);
      ret_sample(lds, P, ZQ, ZK, VTS, ORET, ctr, nullptr, 0u); }
for (int rep_ = 0; rep_ < REP_SYNC; ++rep_) GSYNC();
    GSYNC();
for (int rep_ = 0; rep_ < REP_ROW; ++rep_) {
    ret_gnorm(ORET, ZG, OG, G);
}
    GSYNC();
for (int rep_ = 0; rep_ < REP_GN1; ++rep_) {
    { pg8::Gemm g{OG, WT_OUT_RET, MP, 1024, 2048}; SO.init(MP, 1024, G, blockIdx.x); EpiB16 E{Y, 1024}; pg8::gemm_phase(lds, g, SO, E);
      skinny_gemm(lds, OG + (size_t)MP * 2048, WT_OUT_RET, 2048, SkB16{Y + (size_t)MP * 1024}, G); }
}
    GSYNC();
for (int rep_ = 0; rep_ < REP_ROW; ++rep_) {
    resid_rows<true>(nullptr, nullptr, X2, Y, P.post_norm + 1024, H, G);
}
    GSYNC();
for (int rep_ = 0; rep_ < REP_GN1; ++rep_) {
    { pg8::Gemm g{H, WT_GATE + 1024 * 1024, MP, 1024, 1024}; SO.init(MP, 1024, G, blockIdx.x); EpiGate<false> E{H, PLE, P.out, nullptr}; pg8::gemm_phase(lds, g, SO, E);
      skinny_gemm(lds, H + (size_t)MP * 1024, WT_GATE + 1024 * 1024, 1024, SkGate<false>{H + (size_t)MP * 1024, PLE + (size_t)MP * 1024, P.out + (size_t)MP * 1024, nullptr}, G); }
}
}

extern "C" void kernel_launch(void* const* d_in, const int* in_sizes, int n_in, void* d_out, int out_size, void* d_ws, size_t ws_size, hipStream_t stream) {
    static int grid_blocks = 0;
    if (!grid_blocks) {
        int dev = 0, cus = 0, per_cu = 0;
        hipGetDevice(&dev);
        hipDeviceGetAttribute(&cus, hipDeviceAttributeMultiprocessorCount, dev);
        hipFuncSetAttribute((const void*)hybrid_fwd, hipFuncAttributeMaxDynamicSharedMemorySize, LDS_BYTES);
        hipOccupancyMaxActiveBlocksPerMultiprocessor(&per_cu, (const void*)hybrid_fwd, NT, LDS_BYTES);
        if (per_cu < 1) per_cu = 1;
        if (per_cu > 1) per_cu = 1;
        grid_blocks = cus * per_cu;
        if (ws_size < WS_END) fprintf(stderr, "kernel_launch: workspace too small: %zu < %zu\n", ws_size, (size_t)WS_END);
    }
    Params p{};
    p.x_prompt = (const float*)d_in[0]; p.x_sample = (const float*)d_in[1]; p.cache_k = (const float*)d_in[2]; p.cache_v = (const float*)d_in[3]; p.state_ret = (const float*)d_in[4];
    p.p_prompt = (const float*)d_in[5]; p.p_sample = (const float*)d_in[6]; p.pre_norm = (const float*)d_in[7]; p.post_norm = (const float*)d_in[8]; p.w_in_attn = (const float*)d_in[9];
    p.sinks = (const float*)d_in[10]; p.w_out_attn = (const float*)d_in[11]; p.w_in_ret = (const float*)d_in[12]; p.w_out_ret = (const float*)d_in[13]; p.w_ple = (const float*)d_in[14]; p.w_gate = (const float*)d_in[15];
    p.out = (float*)d_out; p.ws = (unsigned char*)d_ws;
    (void)hipMemsetAsync((unsigned char*)d_ws + WS_BAR, 0, 16384, stream);
    void* args[] = {&p};
    hipError_t e = hipLaunchCooperativeKernel((const void*)hybrid_fwd, dim3(grid_blocks), dim3(NT), args, LDS_BYTES, stream);
    if (e != hipSuccess) fprintf(stderr, "cooperative launch failed: %s (grid %d)\n", hipGetErrorString(e), grid_blocks);
}
```

```cpp
#include <hip/hip_runtime.h>
#include <hip/hip_cooperative_groups.h>
#include <cstdio>
#include <cstdint>
namespace cg = cooperative_groups;

#define LAS __attribute__((address_space(3)))
typedef unsigned short bf16_t;
typedef short bf16x8 __attribute__((ext_vector_type(8)));
typedef float f32x4 __attribute__((ext_vector_type(4)));
typedef float f32x2 __attribute__((ext_vector_type(2)));
typedef unsigned u32x2 __attribute__((ext_vector_type(2)));
typedef unsigned u32x4 __attribute__((ext_vector_type(4)));

constexpr int MP = 16384, MS = 1024, MT = MP + MS;
constexpr int NT = 512;
#define REP_P0 1
#define REP_GIN 1
#define REP_ATT 1
#define REP_RA 1
#define REP_SYNC 0
#define REP_R3 1
#define REP_SCAN 1
#define REP_ROW 1
#define REP_GN1 1
constexpr int LDS_BYTES = 140 * 1024;
constexpr float EPS = 1e-6f;

constexpr size_t OFF_YP = 0, OFF_YS = 16777216, OFF_KWP = 17825792, OFF_VWP = 17956864, OFF_KWS = 18087936, OFF_VWS = 22282240, OFF_RSP = 26476544, OFF_RSS = 28573696;

constexpr size_t al256(size_t x) { return (x + 255) & ~(size_t)255; }
constexpr size_t WS_WT_IN_ATTN = 0;
constexpr size_t WS_WT_OUT_ATTN = WS_WT_IN_ATTN + (size_t)2560 * 1024 * 2;
constexpr size_t WS_WT_IN_RET = WS_WT_OUT_ATTN + (size_t)1024 * 1024 * 2;
constexpr size_t WS_WT_OUT_RET = WS_WT_IN_RET + (size_t)6144 * 1024 * 2;
constexpr size_t WS_WT_GATE = WS_WT_OUT_RET + (size_t)1024 * 2048 * 2;
constexpr size_t WS_WT_PLE = WS_WT_GATE + (size_t)2 * 1024 * 1024 * 2;
constexpr size_t WS_TABA = WS_WT_PLE + (size_t)2 * 1024 * 256 * 2;
constexpr size_t WS_TABR = WS_TABA + (size_t)4104 * 32 * 8;
constexpr size_t WS_H = al256(WS_TABR + (size_t)4104 * 128 * 8);
constexpr size_t WS_PB = WS_H + (size_t)MT * 1024 * 2;
constexpr size_t WS_PLE = WS_PB + (size_t)2 * MT * 256 * 2;
constexpr size_t WS_Y = WS_PLE + (size_t)MT * 1024 * 4;
constexpr size_t WS_X1 = WS_Y + (size_t)MT * 1024 * 4;
constexpr size_t WS_X2 = WS_X1 + (size_t)MT * 1024 * 4;
constexpr size_t WS_OG = WS_X2 + (size_t)MT * 1024 * 4;
constexpr size_t WS_ZQ = WS_OG + (size_t)MT * 2048 * 2;
constexpr size_t WS_ZK = WS_ZQ + (size_t)MT * 1024 * 2;
constexpr size_t WS_ZG = WS_ZK + (size_t)MT * 1024 * 2;
constexpr size_t WS_VTP = WS_ZG + (size_t)MT * 2048 * 2;
constexpr size_t WS_VTS = WS_VTP + (size_t)16 * 512 * 4096 * 2;
constexpr size_t WS_ABUF = WS_VTS + (size_t)128 * 4 * 512 * 8 * 2;
constexpr size_t WS_KDT = WS_ABUF + (size_t)512 * 128 * 128 * 2;
constexpr size_t WS_ORET = WS_KDT + (size_t)512 * 256 * 128 * 2;
constexpr size_t WS_BAR = WS_ORET + (size_t)MT * 2048 * 4;
constexpr size_t WS_END = WS_BAR + 16384;

struct Params {
    const float *x_prompt, *x_sample, *cache_k, *cache_v, *state_ret, *p_prompt, *p_sample, *pre_norm, *post_norm, *w_in_attn, *sinks, *w_out_attn, *w_in_ret, *w_out_ret, *w_ple, *w_gate;
    float* out; unsigned char* ws;
};

__device__ __forceinline__ unsigned cvt_pk_bf16(float lo, float hi) { unsigned r; asm volatile("v_cvt_pk_bf16_f32 %0, %1, %2" : "=v"(r) : "v"(lo), "v"(hi)); return r; }
__device__ __forceinline__ u32x2 pk4(f32x4 v) { u32x2 w; w.x = cvt_pk_bf16(v[0], v[1]); w.y = cvt_pk_bf16(v[2], v[3]); return w; }
__device__ __forceinline__ float bf2f(bf16_t b) { return __uint_as_float(((unsigned)b) << 16); }
__device__ __forceinline__ float bflo(unsigned w) { return __uint_as_float(w << 16); }
__device__ __forceinline__ float bfhi(unsigned w) { return __uint_as_float(w & 0xffff0000u); }
__device__ __forceinline__ float silu_f(float x) { return x / (1.f + __expf(-x)); }
__device__ __forceinline__ float sigmoid_f(float x) { return 1.f / (1.f + __expf(-x)); }
__device__ __forceinline__ float wave_sum(float v) {
#pragma unroll
    for (int o = 32; o >= 1; o >>= 1) v += __shfl_xor(v, o, 64);
    return v;
}
__device__ __forceinline__ int otid() { int t = threadIdx.x; asm volatile("" : "+v"(t)); return t; }
__device__ __forceinline__ void lds_barrier() { asm volatile("s_waitcnt lgkmcnt(0)" ::: "memory"); __builtin_amdgcn_s_barrier(); asm volatile("" ::: "memory"); }
__device__ __forceinline__ float ret_lg(int h) { return h == 0 ? -3.1748698315e-02f : h == 1 ? -1.5748356968e-02f : h == 2 ? -7.8431774610e-03f : -3.9138993211e-03f; }

#define XB_TMO      128
#define XB_XCNT(j)  (256  + 64 * (j))
#define XB_XSUB(j)  (1280 + 64 * (j))
#define XB_XGEN(j)  (2304 + 64 * (j))
#define XB_TOP      3328
#define XB_TOPGEN   3392
#define XCD_BAR_WORDS 3456
#define XB_SPIN_CAP (1u << 18)

__device__ __forceinline__ unsigned xb_ld(unsigned* p)              { return __hip_atomic_load(p, __ATOMIC_RELAXED, __HIP_MEMORY_SCOPE_AGENT); }
__device__ __forceinline__ unsigned xb_add(unsigned* p, unsigned v) { return __hip_atomic_fetch_add(p, v, __ATOMIC_RELAXED, __HIP_MEMORY_SCOPE_AGENT); }
__device__ __forceinline__ unsigned xb_xcc_id() { return (unsigned)__builtin_amdgcn_s_getreg((3 << 11) | 20) & 0xFu; }
#define XB_SPIN(cond, bar) do { unsigned _sp = 0; while (cond) { __builtin_amdgcn_s_sleep(1); \
    if ((++_sp & 255u) == 0u) { if (xb_ld(&(bar)[XB_TMO])) break; if (_sp > XB_SPIN_CAP) { atomicAdd(&(bar)[XB_TMO], 1u); break; } } } } while (0)

struct XcdBarrier {
    unsigned* bar; unsigned x;
    volatile LAS unsigned* st;
};

__device__ __forceinline__ XcdBarrier xcd_barrier_post(unsigned* bar, volatile LAS unsigned* st) {
    XcdBarrier b; b.bar = bar; b.x = xb_xcc_id(); b.st = st;
    if (threadIdx.x == 0) (void)xb_add(&bar[XB_XCNT(b.x)], 1u);
    return b;
}
__device__ __forceinline__ void xcd_barrier_complete(unsigned* bar, unsigned x, unsigned& nloc, unsigned& nx) {
    const unsigned G = gridDim.x * gridDim.y * gridDim.z;
    unsigned sum, cnt, mine, sp = 0u;
    for (;;) {
        sum = 0u; cnt = 0u; mine = 0u;
#pragma unroll
        for (unsigned j = 0; j < 16; ++j) { const unsigned c = xb_ld(&bar[XB_XCNT(j)]); sum += c; cnt += (c > 0u) ? 1u : 0u; mine = (j == x) ? c : mine; }
        if (sum == G) break;
        __builtin_amdgcn_s_sleep(1);
        if ((++sp & 255u) == 0u) { if (xb_ld(&bar[XB_TMO])) break; if (sp > XB_SPIN_CAP) { atomicAdd(&bar[XB_TMO], 1u); break; } }
    }
    nloc = mine > 0u ? mine : 1u; nx = cnt > 0u ? cnt : 1u;
}

__device__ __forceinline__ void xcd_barrier(const XcdBarrier& b) {
    asm volatile("s_waitcnt vmcnt(0)" ::: "memory");
    __syncthreads();
    if (threadIdx.x == 0) {
        unsigned* bar = b.bar;
        __builtin_amdgcn_s_waitcnt(0);
        unsigned nloc = b.st[0], nx = b.st[1];
        if (nloc == 0u) { xcd_barrier_complete(bar, b.x, nloc, nx); b.st[0] = nloc; b.st[1] = nx; }
        const unsigned old = xb_add(&bar[XB_XSUB(b.x)], 1u);
        const unsigned gen = old / nloc;
        if (old + 1u == (gen + 1u) * nloc) {
            __builtin_amdgcn_fence(__ATOMIC_RELEASE, "agent");
            asm volatile("s_waitcnt vmcnt(0)" ::: "memory");
            const unsigned og = xb_add(&bar[XB_TOP], 1u);
            const unsigned tg = og / nx;
            if (og + 1u == (tg + 1u) * nx) xb_add(&bar[XB_TOPGEN], 1u);
            else XB_SPIN(xb_ld(&bar[XB_TOPGEN]) == tg, bar);
            __builtin_amdgcn_fence(__ATOMIC_ACQUIRE, "agent");
            xb_add(&bar[XB_XGEN(b.x)], 1u);
            asm volatile("s_waitcnt vmcnt(0)" ::: "memory");
        } else {
            XB_SPIN(xb_ld(&bar[XB_XGEN(b.x)]) == gen, bar);
            __builtin_amdgcn_fence(__ATOMIC_ACQUIRE, "agent");
            asm volatile("s_waitcnt vmcnt(0)" ::: "memory");
        }
    }
    __syncthreads();
}

namespace pg8 {
constexpr int BM = 256, BK = 64, HALF = 128, HTB = HALF * BK * 2, STAGE_BYTES = 8 * HTB, NXCD = 8, WGM = 8;
__host__ __device__ __forceinline__ int lds_byte(int r, int c) { const int st = (r >> 4) * 2 + (c >> 5), rr = r & 15, cc = c & 31, ob = rr * 64 + cc * 2; return st * 1024 + (ob ^ (((ob >> 9) & 1) << 5)); }
__host__ __device__ __forceinline__ void stage_rc(int b, int& R, int& C) { const int st = b / 1024, sb = b % 1024, swz = sb ^ (((sb >> 9) & 1) << 5); R = (st >> 1) * 16 + swz / 64; C = (st & 1) * 32 + (swz % 64) / 2; }
struct Unit { int pm, pn; };
struct Gemm { const bf16_t* A; const bf16_t* Bt; int M, N, K; };
struct StaticOrder {
    int nM, nN, nwg, G, c;
    __host__ __device__ void init(int M, int N, int G_, int c_) { nM = M / BM; nN = N / BM; nwg = nM * nN; G = G_; c = c_; }
    __host__ __device__ bool next(int i, Unit& u) const {
        const long L = (long)i * G + c; if (L >= nwg) return false;
        int wgid = (int)L; { const int q = nwg / NXCD, r = nwg % NXCD, xcd = wgid % NXCD, off = wgid / NXCD; wgid = (xcd < r ? xcd * (q + 1) : r * (q + 1) + (xcd - r) * q) + off; }
        const int nig = WGM * nN, gid = wgid / nig, fm = gid * WGM, gsz = (nM - fm) < WGM ? (nM - fm) : WGM;
        u.pm = fm + ((wgid % nig) % gsz); u.pn = (wgid % nig) / gsz; return true;
    }
};

struct TailOrder {
    int first, nblk, nwg, c;
    __host__ __device__ void init(int M, int first_, int G_, int c_) { nwg = (M / BM) * 4; first = first_; nblk = G_ - first_; c = c_; }
    __host__ __device__ bool next(int i, Unit& u) const { if (c < first) return false; const int L = (c - first) + i * nblk; if (L >= nwg) return false; u.pm = L >> 2; u.pn = L & 3; return true; }
};

template <class Epi, class Sched>
__device__ __forceinline__ void gemm_phase(LAS unsigned char* lds, const Gemm g, const Sched& S, const Epi& E) {
    const int tid = otid(), wid = __builtin_amdgcn_readfirstlane(tid >> 6), lane = tid & 63, wr = wid >> 2, wc = wid & 3, fr = lane & 15, fq = lane >> 4;
    const int K = g.K, nt = K / BK;
    unsigned voffA[2], voffB[2];
#pragma unroll
    for (int i = 0; i < 2; ++i) { int R, C; stage_rc(tid * 16 + i * 8192, R, C); voffA[i] = (unsigned)(R * K + C) * 2u; voffB[i] = voffA[i]; }
    const size_t kstep = (size_t)(BK * 2);
    const size_t hstep = (size_t)HALF * K * 2;
    const size_t tstep = 2 * hstep;
    const unsigned ldsw = (unsigned)wid * 1024u;
    const int aoff = lds_byte(wr * 64 + fr, fq * 8), boff = lds_byte(wc * 32 + fr, fq * 8);
#define PG8_SA(b, h) (((b) * 2 + (h)) * HTB)
#define PG8_SB(b, h) ((4 + (b) * 2 + (h)) * HTB)
#define PG8_STAGE(bufoff, gbase, voff) do { _Pragma("unroll") for (int _i = 0; _i < 2; ++_i) \
        __builtin_amdgcn_global_load_lds((const unsigned*)((const char*)(gbase) + (voff)[_i]), (LAS unsigned*)(lds + (bufoff) + ldsw + _i * 8192), 16, 0, 0); } while (0)
#define PG8_LDA(dst, b, h) do { _Pragma("unroll") for (int m = 0; m < 4; ++m) _Pragma("unroll") for (int k = 0; k < 2; ++k) dst[m][k] = *(const LAS bf16x8*)(lds + PG8_SA(b, h) + aoff + m * 2048 + k * 1024); } while (0)
#define PG8_LDB(dst, b, h) do { _Pragma("unroll") for (int n = 0; n < 2; ++n) _Pragma("unroll") for (int k = 0; k < 2; ++k) dst[n][k] = *(const LAS bf16x8*)(lds + PG8_SB(b, h) + boff + n * 2048 + k * 1024); } while (0)
#define PG8_MMA(ai, bj, At, Bt) do { __builtin_amdgcn_s_setprio(1); _Pragma("unroll") for (int m = 0; m < 4; ++m) _Pragma("unroll") for (int n = 0; n < 2; ++n) _Pragma("unroll") for (int k = 0; k < 2; ++k) \
        acc[ai][bj][m][n] = __builtin_amdgcn_mfma_f32_16x16x32_bf16(Bt[n][k], At[m][k], acc[ai][bj][m][n], 0, 0, 0); __builtin_amdgcn_s_setprio(0); } while (0)
#define PG8_WAIT_V(n) asm volatile("s_waitcnt vmcnt(" #n ")" ::: "memory")
#define PG8_WAIT_L(n) asm volatile("s_waitcnt lgkmcnt(" #n ")" ::: "memory")
#define PG8_BAR __builtin_amdgcn_s_barrier()
#define PG8_SCHED __builtin_amdgcn_sched_barrier(0)
#define PG8_PTRS(u, pa, pb) do { const char* _a = (const char*)g.A + (size_t)(u).pm * tstep; const char* _b = (const char*)g.Bt + (size_t)(u).pn * tstep; if (Epi::swap(u)) { pa = _b; pb = _a; } else { pa = _a; pb = _b; } } while (0)
    Unit cur, nxt; int ui = 0;
    if (!S.next(0, cur)) return;
    f32x4 acc[2][2][4][2];
#pragma unroll
    for (int a = 0; a < 2; ++a)
#pragma unroll
        for (int b = 0; b < 2; ++b)
#pragma unroll
            for (int m = 0; m < 4; ++m)
#pragma unroll
                for (int n = 0; n < 2; ++n) acc[a][b][m][n] = (f32x4){0.f, 0.f, 0.f, 0.f};
    bf16x8 At[4][2], B0[2][2], B1[2][2];
    const char* cA; const char* cB;
    PG8_PTRS(cur, cA, cB);
    PG8_STAGE(PG8_SB(0, 0), cB, voffB); PG8_STAGE(PG8_SA(0, 0), cA, voffA); PG8_STAGE(PG8_SB(0, 1), cB + hstep, voffB); PG8_STAGE(PG8_SA(0, 1), cA + hstep, voffA);
    if (wr == 1) PG8_BAR;
    PG8_WAIT_V(4); PG8_BAR;
    PG8_STAGE(PG8_SB(1, 0), cB + kstep, voffB); PG8_STAGE(PG8_SA(1, 0), cA + kstep, voffA); PG8_STAGE(PG8_SB(1, 1), cB + hstep + kstep, voffB);
    PG8_WAIT_V(6); PG8_BAR;
    for (;;) {
        const bool has_next = S.next(ui + 1, nxt);
        const char* nA = cA; const char* nB = cB;
        if (has_next) PG8_PTRS(nxt, nA, nB);
        for (int t = 0; t < nt; t += 2) {
            const bool last = (t == nt - 2);
            const char* a1 = cA + (size_t)(t + 1) * kstep;
            const char* a2 = last ? nA : cA + (size_t)(t + 2) * kstep; const char* b2 = last ? nB : cB + (size_t)(t + 2) * kstep;
            const char* a3 = a2 + kstep; const char* b3 = b2 + kstep;
            PG8_LDB(B0, 0, 0); PG8_SCHED; PG8_LDA(At, 0, 0); PG8_STAGE(PG8_SA(1, 1), a1 + hstep, voffA);
            PG8_WAIT_L(8); PG8_BAR; PG8_WAIT_L(0); PG8_MMA(0, 0, At, B0); PG8_BAR; PG8_SCHED;
            PG8_LDB(B1, 0, 1); PG8_STAGE(PG8_SB(0, 0), b2, voffB);
            PG8_BAR; PG8_WAIT_L(0); PG8_MMA(0, 1, At, B1); PG8_BAR;
            PG8_LDA(At, 0, 1); PG8_STAGE(PG8_SA(0, 0), a2, voffA);
            PG8_BAR; PG8_WAIT_L(0); PG8_MMA(1, 0, At, B0); PG8_BAR; PG8_SCHED;
            PG8_STAGE(PG8_SB(0, 1), b2 + hstep, voffB);
            PG8_WAIT_V(6); PG8_BAR; PG8_MMA(1, 1, At, B1); PG8_BAR;
            PG8_LDB(B0, 1, 0); PG8_SCHED; PG8_LDA(At, 1, 0); PG8_STAGE(PG8_SA(0, 1), a2 + hstep, voffA);
            PG8_WAIT_L(8); PG8_BAR; PG8_WAIT_L(0); PG8_MMA(0, 0, At, B0); PG8_BAR; PG8_SCHED;
            PG8_LDB(B1, 1, 1); PG8_STAGE(PG8_SB(1, 0), b3, voffB);
            PG8_BAR; PG8_WAIT_L(0); PG8_MMA(0, 1, At, B1); PG8_BAR;
            PG8_LDA(At, 1, 1); PG8_STAGE(PG8_SA(1, 0), a3, voffA);
            PG8_BAR; PG8_WAIT_L(0); PG8_MMA(1, 0, At, B0); PG8_BAR; PG8_SCHED;
            PG8_STAGE(PG8_SB(1, 1), b3 + hstep, voffB);
            PG8_WAIT_V(6); PG8_BAR; PG8_MMA(1, 1, At, B1); PG8_BAR;
        }
        E(acc, cur, wr, wc, fr, fq);
        if (!has_next) break;
#pragma unroll
        for (int a = 0; a < 2; ++a)
#pragma unroll
            for (int b = 0; b < 2; ++b)
#pragma unroll
                for (int m = 0; m < 4; ++m)
#pragma unroll
                    for (int n = 0; n < 2; ++n) acc[a][b][m][n] = (f32x4){0.f, 0.f, 0.f, 0.f};
        cur = nxt; cA = nA; cB = nB; ++ui;
    }
    PG8_WAIT_V(0);
    if (wr == 0) PG8_BAR;
    PG8_BAR;
#undef PG8_SA
#undef PG8_SB
#undef PG8_STAGE
#undef PG8_LDA
#undef PG8_LDB
#undef PG8_MMA
#undef PG8_WAIT_V
#undef PG8_WAIT_L
#undef PG8_BAR
#undef PG8_SCHED
#undef PG8_PTRS
}
}
using pg8::Unit;

struct EpiF32 {
    float* C; int ldc;
    __device__ __forceinline__ static bool swap(const Unit&) { return false; }
    __device__ __forceinline__ void operator()(const f32x4 (&acc)[2][2][4][2], const Unit& u, int wr, int wc, int fr, int fq) const {
        const int row0 = u.pm * 256 + wr * 64 + fr, col0 = u.pn * 256 + wc * 32 + 4 * fq;
#pragma unroll
        for (int ai = 0; ai < 2; ++ai)
#pragma unroll
            for (int m = 0; m < 4; ++m) { float* rowp = C + (size_t)(row0 + ai * 128 + m * 16) * ldc + col0;
#pragma unroll
                for (int bj = 0; bj < 2; ++bj)
#pragma unroll
                    for (int n = 0; n < 2; ++n) *(f32x4*)(rowp + bj * 128 + n * 16) = acc[ai][bj][m][n]; }
    }
};
struct EpiB16 {
    bf16_t* C; int ldc;
    __device__ __forceinline__ static bool swap(const Unit&) { return false; }
    __device__ __forceinline__ void operator()(const f32x4 (&acc)[2][2][4][2], const Unit& u, int wr, int wc, int fr, int fq) const {
        const int row0 = u.pm * 256 + wr * 64 + fr, col0 = u.pn * 256 + wc * 32 + 4 * fq;
#pragma unroll
        for (int ai = 0; ai < 2; ++ai)
#pragma unroll
            for (int m = 0; m < 4; ++m) { bf16_t* rowp = C + (size_t)(row0 + ai * 128 + m * 16) * ldc + col0;
#pragma unroll
                for (int bj = 0; bj < 2; ++bj)
#pragma unroll
                    for (int n = 0; n < 2; ++n) *(u32x2*)(rowp + bj * 128 + n * 16) = pk4(acc[ai][bj][m][n]); }
    }
};
template <bool OB16> struct EpiGate {
    const bf16_t* X1; const bf16_t* PLE; float* O; bf16_t* Ob;
    __device__ __forceinline__ static bool swap(const Unit&) { return false; }
    __device__ __forceinline__ void operator()(const f32x4 (&acc)[2][2][4][2], const Unit& u, int wr, int wc, int fr, int fq) const {
        const int row0 = u.pm * 256 + wr * 64 + fr, col0 = u.pn * 256 + wc * 32 + 4 * fq;
#pragma unroll
        for (int ai = 0; ai < 2; ++ai)
#pragma unroll
            for (int m = 0; m < 4; ++m) { const size_t ro = (size_t)(row0 + ai * 128 + m * 16) * 1024 + col0;
#pragma unroll
                for (int bj = 0; bj < 2; ++bj)
#pragma unroll
                    for (int n = 0; n < 2; ++n) { const size_t o = ro + bj * 128 + n * 16; const f32x4 a = acc[ai][bj][m][n]; const u32x2 xw = *(const u32x2*)(X1 + o), pw = *(const u32x2*)(PLE + o);
                        const f32x4 x1 = {bflo(xw.x), bfhi(xw.x), bflo(xw.y), bfhi(xw.y)}, pl = {bflo(pw.x), bfhi(pw.x), bflo(pw.y), bfhi(pw.y)}; f32x4 r;
#pragma unroll
                        for (int j = 0; j < 4; ++j) r[j] = x1[j] + sigmoid_f(a[j]) * pl[j];
                        if (OB16) *(u32x2*)(Ob + o) = pk4(r); else *(f32x4*)(O + o) = r; } }
    }
};
struct EpiInAttn {
    bf16_t *Zq, *Zk, *Zg, *vTp, *vTs; const float* tab; float* out;
    __device__ __forceinline__ static bool swap(const Unit& u) { return u.pn == 5; }
    __device__ __forceinline__ void operator()(const f32x4 (&acc)[2][2][4][2], const Unit& u, int wr, int wc, int fr, int fq) const {
        const int pn = u.pn;
        if (pn < 5) {
            const bool isq = pn < 4;
            const int fi = 16 * (wc & 1) + 4 * fq;
#pragma unroll
            for (int ai = 0; ai < 2; ++ai)
#pragma unroll
                for (int m = 0; m < 4; ++m) {
                    const int r = u.pm * 256 + ai * 128 + wr * 64 + m * 16 + fr;
                    const int pi = r < MP ? (r & 4095) : 4096 + ((r - MP) & 7);
                    const f32x4 t0 = *(const f32x4*)(tab + ((size_t)pi * 32 + fi) * 2), t1 = *(const f32x4*)(tab + ((size_t)pi * 32 + fi) * 2 + 4);
                    const float cs[4] = {t0[0], t0[2], t1[0], t1[2]}, sn[4] = {t0[1], t0[3], t1[1], t1[3]};
#pragma unroll
                    for (int bj = 0; bj < 2; ++bj) {
                        const f32x4 x1 = acc[ai][bj][m][0], x2 = acc[ai][bj][m][1]; f32x4 o1, o2;
#pragma unroll
                        for (int j = 0; j < 4; ++j) { o1[j] = x1[j] * cs[j] - x2[j] * sn[j]; o2[j] = x2[j] * cs[j] + x1[j] * sn[j]; }
                        const int hh = 2 * bj + (wc >> 1), d1 = 16 * (wc & 1) + 4 * fq;
                        if (isq) {
                            bf16_t* p = Zq + (size_t)r * 1024 + pn * 256 + hh * 64 + d1;
                            *(u32x2*)p = pk4(o1 * 0.125f); *(u32x2*)(p + 32) = pk4(o2 * 0.125f);
                        } else {
                            bf16_t* p = Zk + (size_t)r * 256 + hh * 64 + d1;
                            *(u32x2*)p = pk4(o1); *(u32x2*)(p + 32) = pk4(o2);
                            if (r < MP) { const int t = r & 4095; if (t >= 3968) { float* dst = out + OFF_KWP + ((size_t)((r >> 12) * 128 + t - 3968) * 4 + hh) * 64 + d1; *(f32x4*)dst = o1; *(f32x4*)(dst + 32) = o2; } }
                            else { const int rs = r - MP; float* dst = out + OFF_KWS + ((size_t)((rs >> 3) * 128 + 120 + (rs & 7)) * 4 + hh) * 64 + d1; *(f32x4*)dst = o1; *(f32x4*)(dst + 32) = o2; }
                        }
                    }
                    asm volatile("" ::: "memory");
                }
        } else if (pn == 5) {
#pragma unroll
            for (int ai = 0; ai < 2; ++ai)
#pragma unroll
                for (int m = 0; m < 4; ++m) {
                    const int e = ai * 128 + wr * 64 + m * 16 + fr, kvh = e >> 6, d = e & 63;
#pragma unroll
                    for (int bj = 0; bj < 2; ++bj)
#pragma unroll
                        for (int n = 0; n < 2; ++n) {
                            const int tok = u.pm * 256 + bj * 128 + wc * 32 + n * 16 + 4 * fq; const f32x4 v = acc[ai][bj][m][n];
                            if (tok < MP) { const int b = tok >> 12, t = tok & 4095;
                                *(u32x2*)(vTp + ((size_t)((b * 4 + kvh) * 64 + d)) * 4096 + t) = pk4(v);
                                if (t >= 3968) {
#pragma unroll
                                    for (int jj = 0; jj < 4; ++jj) out[OFF_VWP + ((size_t)(b * 128 + t - 3968 + jj) * 4 + kvh) * 64 + d] = v[jj]; }
                            } else { const int ts = tok - MP, bs = ts >> 3, l0 = ts & 7;
                                *(u32x2*)(vTs + ((size_t)((bs * 4 + kvh) * 64 + d)) * 8 + l0) = pk4(v);
#pragma unroll
                                for (int jj = 0; jj < 4; ++jj) out[OFF_VWS + ((size_t)(bs * 128 + 120 + l0 + jj) * 4 + kvh) * 64 + d] = v[jj]; }
                        }
                }
        } else {
#pragma unroll
            for (int ai = 0; ai < 2; ++ai)
#pragma unroll
                for (int m = 0; m < 4; ++m) { const int r = u.pm * 256 + ai * 128 + wr * 64 + m * 16 + fr;
#pragma unroll
                    for (int bj = 0; bj < 2; ++bj)
#pragma unroll
                        for (int n = 0; n < 2; ++n) { const f32x4 a = acc[ai][bj][m][n]; f32x4 s;
#pragma unroll
                            for (int j = 0; j < 4; ++j) s[j] = silu_f(a[j]);
                            *(u32x2*)(Zg + (size_t)r * 1024 + (pn - 6) * 256 + bj * 128 + wc * 32 + n * 16 + 4 * fq) = pk4(s); } }
        }
    }
};
struct EpiInRet {
    bf16_t *Zq, *Zk, *Zg, *vTp, *vTs; const float* tab;
    __device__ __forceinline__ static bool swap(const Unit& u) { return u.pn >= 8 && u.pn < 16; }
    __device__ __forceinline__ void operator()(const f32x4 (&acc)[2][2][4][2], const Unit& u, int wr, int wc, int fr, int fq) const {
        const int pn = u.pn;
        if (pn < 8) {
            const bool isq = pn < 4; const float sc = isq ? 1.f : 0.0625f;
            bf16_t* Z = isq ? Zq : Zk; const int hc = (pn & 3) * 256;
#pragma unroll
            for (int ai = 0; ai < 2; ++ai)
#pragma unroll
                for (int m = 0; m < 4; ++m) {
                    const int r = u.pm * 256 + ai * 128 + wr * 64 + m * 16 + fr;
                    const int pi = r < MP ? (r & 4095) : 4096 + ((r - MP) & 7);
#pragma unroll
                    for (int n = 0; n < 2; ++n) {
                        const int d = wc * 32 + n * 16 + 4 * fq;
                        const f32x4 t0 = *(const f32x4*)(tab + ((size_t)pi * 128 + d) * 2), t1 = *(const f32x4*)(tab + ((size_t)pi * 128 + d) * 2 + 4);
                        const float cs[4] = {t0[0], t0[2], t1[0], t1[2]}, sn[4] = {t0[1], t0[3], t1[1], t1[3]};
                        const f32x4 x1 = acc[ai][0][m][n], x2 = acc[ai][1][m][n]; f32x4 o1, o2;
#pragma unroll
                        for (int j = 0; j < 4; ++j) { o1[j] = (x1[j] * cs[j] - x2[j] * sn[j]) * sc; o2[j] = (x2[j] * cs[j] + x1[j] * sn[j]) * sc; }
                        bf16_t* p = Z + (size_t)r * 1024 + hc + d;
                        *(u32x2*)p = pk4(o1); *(u32x2*)(p + 128) = pk4(o2);
                    }
                }
        } else if (pn < 16) {
#pragma unroll
            for (int ai = 0; ai < 2; ++ai)
#pragma unroll
                for (int m = 0; m < 4; ++m) {
                    const int eg = (pn - 8) * 256 + ai * 128 + wr * 64 + m * 16 + fr, h = eg >> 9, e = eg & 511;
#pragma unroll
                    for (int bj = 0; bj < 2; ++bj)
#pragma unroll
                        for (int n = 0; n < 2; ++n) {
                            const int tok = u.pm * 256 + bj * 128 + wc * 32 + n * 16 + 4 * fq; const u32x2 w = pk4(acc[ai][bj][m][n]);
                            if (tok < MP) { const int b = tok >> 12, t = tok & 4095; *(u32x2*)(vTp + ((size_t)((b * 4 + h) * 512 + e)) * 4096 + t) = w; }
                            else { const int ts = tok - MP, bs = ts >> 3, l0 = ts & 7; *(u32x2*)(vTs + ((size_t)((bs * 4 + h) * 512 + e)) * 8 + l0) = w; }
                        }
                }
        } else {
#pragma unroll
            for (int ai = 0; ai < 2; ++ai)
#pragma unroll
                for (int m = 0; m < 4; ++m) { const int r = u.pm * 256 + ai * 128 + wr * 64 + m * 16 + fr;
#pragma unroll
                    for (int bj = 0; bj < 2; ++bj)
#pragma unroll
                        for (int n = 0; n < 2; ++n) { const f32x4 a = acc[ai][bj][m][n]; f32x4 s;
#pragma unroll
                            for (int j = 0; j < 4; ++j) s[j] = silu_f(a[j]);
                            *(u32x2*)(Zg + (size_t)r * 2048 + (pn - 16) * 256 + bj * 128 + wc * 32 + n * 16 + 4 * fq) = pk4(s); } }
        }
    }
};

__device__ __forceinline__ void transpose_tile(const float* __restrict__ W, bf16_t* __restrict__ Wt, int K, int N, bool perm, int tile, LAS float* T) {
    const int tid = otid(), ntn = N >> 6;
    const int n0 = (tile % ntn) * 64, k0 = (tile / ntn) * 64, nn = tid & 63;
    const int nd = n0 + nn; int ns = nd;
    if (perm && nd < 1280) { const int p = nd & 63; ns = (nd - p) + (p >> 5) * 16 + (p & 15) + ((p >> 4) & 1) * 32; }
#pragma unroll
    for (int i = 0; i < 8; ++i) { const int kk = (tid >> 6) + 8 * i; T[kk * 65 + nn] = W[(size_t)(k0 + kk) * N + ns]; }
    __syncthreads();
    const int kk2 = (tid & 31) * 2;
#pragma unroll
    for (int i = 0; i < 4; ++i) { const int n2 = (tid >> 5) + 16 * i; *(unsigned*)(Wt + (size_t)(n0 + n2) * K + k0 + kk2) = cvt_pk_bf16(T[kk2 * 65 + n2], T[(kk2 + 1) * 65 + n2]); }
    __syncthreads();
}

__device__ __forceinline__ void rms_rows(const float* __restrict__ Xa, const float* __restrict__ Xb, const float* __restrict__ g, bf16_t* __restrict__ H, int G) {
    const int tid_o = otid(), wave = tid_o >> 6, lane = tid_o & 63;
    for (int row = blockIdx.x * 8 + wave; row < MT; row += G * 8) {
        const float* x = row < MP ? Xa + (size_t)row * 1024 : Xb + (size_t)(row - MP) * 1024;
        f32x4 v[4]; float ss = 0.f;
#pragma unroll
        for (int i = 0; i < 4; ++i) { v[i] = *(const f32x4*)(x + lane * 4 + 256 * i); ss += v[i][0] * v[i][0] + v[i][1] * v[i][1] + v[i][2] * v[i][2] + v[i][3] * v[i][3]; }
        ss = wave_sum(ss);
        const float rr = rsqrtf(ss * (1.f / 1024.f) + EPS);
#pragma unroll
        for (int i = 0; i < 4; ++i) { const f32x4 gg = *(const f32x4*)(g + lane * 4 + 256 * i); *(u32x2*)(H + (size_t)row * 1024 + lane * 4 + 256 * i) = pk4(v[i] * rr * gg); }
    }
}
__device__ __forceinline__ void rms_rows_b16(const bf16_t* __restrict__ X, const float* __restrict__ g, bf16_t* __restrict__ H, int G) {
    const int tid_o = otid(), wave = tid_o >> 6, lane = tid_o & 63;
    for (int row = blockIdx.x * 8 + wave; row < MT; row += G * 8) {
        const u32x4 a = *(const u32x4*)(X + (size_t)row * 1024 + lane * 8), b = *(const u32x4*)(X + (size_t)row * 1024 + 512 + lane * 8);
        const float v[16] = {bflo(a.x), bfhi(a.x), bflo(a.y), bfhi(a.y), bflo(a.z), bfhi(a.z), bflo(a.w), bfhi(a.w), bflo(b.x), bfhi(b.x), bflo(b.y), bfhi(b.y), bflo(b.z), bfhi(b.z), bflo(b.w), bfhi(b.w)};
        float ss = 0.f;
#pragma unroll
        for (int i = 0; i < 16; ++i) ss += v[i] * v[i];
        ss = wave_sum(ss);
        const float rr = rsqrtf(ss * (1.f / 1024.f) + EPS);
#pragma unroll
        for (int hh = 0; hh < 2; ++hh) { const int c = hh * 512 + lane * 8; const f32x4 g0 = *(const f32x4*)(g + c), g1 = *(const f32x4*)(g + c + 4); u32x4 o;
            o.x = cvt_pk_bf16(v[hh * 8 + 0] * rr * g0[0], v[hh * 8 + 1] * rr * g0[1]); o.y = cvt_pk_bf16(v[hh * 8 + 2] * rr * g0[2], v[hh * 8 + 3] * rr * g0[3]);
            o.z = cvt_pk_bf16(v[hh * 8 + 4] * rr * g1[0], v[hh * 8 + 5] * rr * g1[1]); o.w = cvt_pk_bf16(v[hh * 8 + 6] * rr * g1[2], v[hh * 8 + 7] * rr * g1[3]);
            *(u32x4*)(H + (size_t)row * 1024 + c) = o; }
    }
}
template <bool XB16>
__device__ __forceinline__ void resid_rows(const float* __restrict__ Xa, const float* __restrict__ Xb, const bf16_t* __restrict__ Xh, const bf16_t* __restrict__ Y, const float* __restrict__ g, bf16_t* __restrict__ H, int G) {
    const int tid_o = otid(), wave = tid_o >> 6, lane = tid_o & 63;
    for (int row = blockIdx.x * 8 + wave; row < MT; row += G * 8) {
        const bf16_t* y = Y + (size_t)row * 1024;
        f32x4 v[4]; float ss = 0.f;
#pragma unroll
        for (int i = 0; i < 4; ++i) { const u32x2 yw = *(const u32x2*)(y + lane * 4 + 256 * i); v[i] = (f32x4){bflo(yw.x), bfhi(yw.x), bflo(yw.y), bfhi(yw.y)}; ss += v[i][0] * v[i][0] + v[i][1] * v[i][1] + v[i][2] * v[i][2] + v[i][3] * v[i][3]; }
        ss = wave_sum(ss);
        const float rr = rsqrtf(ss * (1.f / 1024.f) + EPS);
#pragma unroll
        for (int i = 0; i < 4; ++i) { const int c = lane * 4 + 256 * i; const f32x4 gg = *(const f32x4*)(g + c); f32x4 xx;
            if (XB16) { const u32x2 xw = *(const u32x2*)(Xh + (size_t)row * 1024 + c); xx = (f32x4){bflo(xw.x), bfhi(xw.x), bflo(xw.y), bfhi(xw.y)}; }
            else xx = *(const f32x4*)((row < MP ? Xa + (size_t)row * 1024 : Xb + (size_t)(row - MP) * 1024) + c);
            *(u32x2*)(H + (size_t)row * 1024 + c) = pk4(xx + v[i] * rr * gg); }
    }
}

struct SkF32 { float* C; __device__ __forceinline__ void operator()(int row, int col, f32x4 v) const { *(f32x4*)(C + (size_t)row * 1024 + col) = v; } };
struct SkB16 { bf16_t* C; __device__ __forceinline__ void operator()(int row, int col, f32x4 v) const { *(u32x2*)(C + (size_t)row * 1024 + col) = pk4(v); } };
template <bool OB16> struct SkGate { const bf16_t* X1; const bf16_t* PLE; float* O; bf16_t* Ob;
    __device__ __forceinline__ void operator()(int row, int col, f32x4 a) const { const size_t o = (size_t)row * 1024 + col; const u32x2 xw = *(const u32x2*)(X1 + o), pw = *(const u32x2*)(PLE + o);
        const f32x4 x1 = {bflo(xw.x), bfhi(xw.x), bflo(xw.y), bfhi(xw.y)}, pl = {bflo(pw.x), bfhi(pw.x), bflo(pw.y), bfhi(pw.y)}; f32x4 r;
#pragma unroll
        for (int j = 0; j < 4; ++j) r[j] = x1[j] + sigmoid_f(a[j]) * pl[j];
        if (OB16) *(u32x2*)(Ob + o) = pk4(r); else *(f32x4*)(O + o) = r; } };
template <class Epi>
__device__ __forceinline__ void skinny_gemm(LAS unsigned char* lds, const bf16_t* __restrict__ A, const bf16_t* __restrict__ Bt, int K, const Epi& E, int G) {
    LAS float* red = (LAS float*)lds;
    const int tid = otid(), w = tid >> 6, lane = tid & 63, l16 = lane & 15, g = lane >> 4;
    const int KS = K >> 3, nks = KS >> 5;
    for (int u = blockIdx.x; u < 256; u += G) {
        const int row0 = (u >> 4) * 64, col0 = (u & 15) * 64;
        const bf16_t* ap = A + (size_t)(row0 + l16) * K + w * KS + 8 * g;
        const bf16_t* bp = Bt + (size_t)(col0 + l16) * K + w * KS + 8 * g;
        f32x4 acc[4][4];
#pragma unroll
        for (int mt = 0; mt < 4; ++mt)
#pragma unroll
            for (int nt = 0; nt < 4; ++nt) acc[mt][nt] = (f32x4){0.f, 0.f, 0.f, 0.f};
#pragma unroll 4
        for (int ks = 0; ks < nks; ++ks) {
            bf16x8 af[4], bf[4];
#pragma unroll
            for (int t = 0; t < 4; ++t) { af[t] = *(const bf16x8*)(ap + (size_t)(16 * t) * K + 32 * ks); bf[t] = *(const bf16x8*)(bp + (size_t)(16 * t) * K + 32 * ks); }
#pragma unroll
            for (int mt = 0; mt < 4; ++mt)
#pragma unroll
                for (int nt = 0; nt < 4; ++nt) acc[mt][nt] = __builtin_amdgcn_mfma_f32_16x16x32_bf16(bf[nt], af[mt], acc[mt][nt], 0, 0, 0);
        }
        __syncthreads();
#pragma unroll
        for (int mt = 0; mt < 4; ++mt)
#pragma unroll
            for (int nt = 0; nt < 4; ++nt) *(LAS f32x4*)(red + (w * 64 + 16 * mt + l16) * 68 + 16 * nt + 4 * g) = acc[mt][nt];
        __syncthreads();
#pragma unroll
        for (int j = 0; j < 2; ++j) { const int q = tid + 512 * j, row = q >> 4, c4 = (q & 15) * 4; f32x4 sum = *(const LAS f32x4*)(red + row * 68 + c4);
#pragma unroll
            for (int ww = 1; ww < 8; ++ww) sum += *(const LAS f32x4*)(red + (ww * 64 + row) * 68 + c4);
            E(row0 + row, col0 + c4, sum); }
    }
}

__device__ __forceinline__ void attn_prompt(LAS unsigned char* lds, const bf16_t* __restrict__ Zq, const bf16_t* __restrict__ Zk, const bf16_t* __restrict__ Zg, const bf16_t* __restrict__ vTp,
                                            const float* __restrict__ sinks, bf16_t* __restrict__ OG, int G) {
    LAS bf16_t* Ks = (LAS bf16_t*)lds;
    LAS bf16_t* Vt = (LAS bf16_t*)(lds + 256 * 72 * 2);
    const int tid = otid(), w = tid >> 6, lane = tid & 63, l16 = lane & 15, g = lane >> 4;
    u32x4 pk_[4], pv_[4];
#define AP_LOAD(it_) do { const int kvh_ = (it_) & 3, nb_ = ((it_) >> 2) & 31, b_ = (it_) >> 7; \
        _Pragma("unroll") for (int i = 0; i < 4; ++i) { const int ch = tid + 512 * i, s = ch >> 3, c8 = ch & 7, t = (nb_ - 1) * 128 + s; \
            pk_[i] = (u32x4){0u, 0u, 0u, 0u}; if (t >= 0) pk_[i] = *(const u32x4*)(Zk + (size_t)(b_ * 4096 + t) * 256 + kvh_ * 64 + c8 * 8); } \
        _Pragma("unroll") for (int i = 0; i < 4; ++i) { const int ch = tid + 512 * i, d = ch >> 5, s0 = (ch & 31) * 8, t0 = (nb_ - 1) * 128 + s0; \
            pv_[i] = (u32x4){0u, 0u, 0u, 0u}; if (t0 >= 0) pv_[i] = *(const u32x4*)(vTp + ((size_t)((b_ * 4 + kvh_) * 64 + d)) * 4096 + t0); } } while (0)
    if ((int)blockIdx.x < 512) AP_LOAD((int)blockIdx.x);
    for (int it = blockIdx.x; it < 512; it += G) {
        const int kvh = it & 3, nb = (it >> 2) & 31, b = it >> 7;
        __syncthreads();
#pragma unroll
        for (int i = 0; i < 4; ++i) { const int ch = tid + 512 * i, s = ch >> 3, c8 = ch & 7; *(LAS u32x4*)(Ks + s * 72 + c8 * 8) = pk_[i]; }
#pragma unroll
        for (int i = 0; i < 4; ++i) { const int ch = tid + 512 * i, d = ch >> 5, s0 = (ch & 31) * 8; *(LAS u32x4*)(Vt + d * 264 + s0) = pv_[i]; }
        __syncthreads();
        if (it + G < 512) AP_LOAD(it + G);
        asm volatile("" ::: "memory");
        const int head = kvh * 4 + (w >> 1);
        const float sk = sinks[head];
        for (int qi = 0; qi < 4; ++qi) {
            const int qt = (w & 1) * 4 + qi;
            const size_t tq = (size_t)b * 4096 + nb * 128 + qt * 16 + l16;
            bf16x8 qf[2];
#pragma unroll
            for (int ks = 0; ks < 2; ++ks) qf[ks] = *(const bf16x8*)(Zq + tq * 1024 + head * 64 + ks * 32 + g * 8);
            f32x4 sa[9];
#pragma unroll
            for (int j = 0; j < 9; ++j) { sa[j] = (f32x4){0.f, 0.f, 0.f, 0.f};
#pragma unroll
                for (int ks = 0; ks < 2; ++ks) { const bf16x8 kf = *(const LAS bf16x8*)(Ks + (16 * (qt + j) + l16) * 72 + ks * 32 + g * 8);
                    sa[j] = __builtin_amdgcn_mfma_f32_16x16x32_bf16(kf, qf[ks], sa[j], 0, 0, 0); } }
            float mx = sk;
#pragma unroll
            for (int j = 0; j < 9; ++j)
#pragma unroll
                for (int r = 0; r < 4; ++r) {
                    bool vis = true;
                    if (j == 0) vis = (4 * g + r) > l16;
                    if (j == 8) vis = (4 * g + r) <= l16;
                    if (nb == 0 && (qt + j) < 8) vis = false;
                    sa[j][r] = vis ? sa[j][r] : -1e30f;
                    mx = fmaxf(mx, sa[j][r]);
                }
            mx = fmaxf(mx, __shfl_xor(mx, 16, 64)); mx = fmaxf(mx, __shfl_xor(mx, 32, 64));
            float sum = 0.f;
#pragma unroll
            for (int j = 0; j < 9; ++j)
#pragma unroll
                for (int r = 0; r < 4; ++r) { const float p = __expf(sa[j][r] - mx); sa[j][r] = p; sum += p; }
            sum += __shfl_xor(sum, 16, 64); sum += __shfl_xor(sum, 32, 64);
            const float inv = 1.f / (sum + __expf(sk - mx));
            f32x4 oa[4];
#pragma unroll
            for (int dt = 0; dt < 4; ++dt) oa[dt] = (f32x4){0.f, 0.f, 0.f, 0.f};
#pragma unroll
            for (int u = 0; u < 5; ++u) {
                u32x4 pw; pw.x = cvt_pk_bf16(sa[2 * u][0], sa[2 * u][1]); pw.y = cvt_pk_bf16(sa[2 * u][2], sa[2 * u][3]);
                if (u < 4) { pw.z = cvt_pk_bf16(sa[2 * u + 1][0], sa[2 * u + 1][1]); pw.w = cvt_pk_bf16(sa[2 * u + 1][2], sa[2 * u + 1][3]); } else { pw.z = 0u; pw.w = 0u; }
                const bf16x8 pf = __builtin_bit_cast(bf16x8, pw);
                const int k0 = 16 * (qt + 2 * u) + 4 * g, k1 = (u < 4) ? k0 + 16 : k0;
#pragma unroll
                for (int dt = 0; dt < 4; ++dt) {
                    const u32x2 v0 = *(const LAS u32x2*)(Vt + (16 * dt + l16) * 264 + k0), v1 = *(const LAS u32x2*)(Vt + (16 * dt + l16) * 264 + k1);
                    u32x4 vw; vw.x = v0.x; vw.y = v0.y; vw.z = v1.x; vw.w = v1.y;
                    oa[dt] = __builtin_amdgcn_mfma_f32_16x16x32_bf16(__builtin_bit_cast(bf16x8, vw), pf, oa[dt], 0, 0, 0);
                }
            }
#pragma unroll
            for (int dt = 0; dt < 4; ++dt) {
                const size_t o = tq * 1024 + head * 64 + 16 * dt + 4 * g;
                const u32x2 gw = *(const u32x2*)(Zg + o);
                f32x4 r; r[0] = oa[dt][0] * inv * bflo(gw.x); r[1] = oa[dt][1] * inv * bfhi(gw.x); r[2] = oa[dt][2] * inv * bflo(gw.y); r[3] = oa[dt][3] * inv * bfhi(gw.y);
                *(u32x2*)(OG + o) = pk4(r);
            }
        }
    }
}
#undef AP_LOAD

__device__ __forceinline__ void attn_sample(LAS unsigned char* lds, const Params& P, const bf16_t* __restrict__ Zq, const bf16_t* __restrict__ Zk, const bf16_t* __restrict__ Zg, const bf16_t* __restrict__ vTs,
                                            bf16_t* __restrict__ OG, int G) {
    constexpr int KS_B = 144 * 72 * 2, VT_B = 64 * 152 * 2, SLOT_B = KS_B + VT_B;
    for (int pr = blockIdx.x; pr < 256; pr += G) {
        const int tid = otid(), w = tid >> 6, lane = tid & 63, l16 = lane & 15, g = lane >> 4;
        __syncthreads();
#pragma unroll
        for (int sl = 0; sl < 2; ++sl) {
            const int it = 2 * pr + sl, bs = it >> 2, kvh = it & 3;
            LAS bf16_t* Ks = (LAS bf16_t*)(lds + sl * SLOT_B); LAS bf16_t* Vt = (LAS bf16_t*)(lds + sl * SLOT_B + KS_B);
#pragma unroll
            for (int i = 0; i < 4; ++i) { const int ch = tid + 512 * i, j = ch >> 4, d4 = (ch & 15) * 4;
                const size_t src = ((size_t)(bs * 128 + j) * 4 + kvh) * 64 + d4;
                const f32x4 kv = *(const f32x4*)(P.cache_k + src), vv = *(const f32x4*)(P.cache_v + src);
                if (j >= 8) { const size_t dst = ((size_t)(bs * 128 + j - 8) * 4 + kvh) * 64 + d4; *(f32x4*)(P.out + OFF_KWS + dst) = kv; *(f32x4*)(P.out + OFF_VWS + dst) = vv; }
                *(LAS u32x2*)(Ks + j * 72 + d4) = pk4(kv);
                const u32x2 vw = pk4(vv);
                Vt[(d4 + 0) * 152 + j] = (bf16_t)(vw.x & 0xffffu); Vt[(d4 + 1) * 152 + j] = (bf16_t)(vw.x >> 16); Vt[(d4 + 2) * 152 + j] = (bf16_t)(vw.y & 0xffffu); Vt[(d4 + 3) * 152 + j] = (bf16_t)(vw.y >> 16); }
            { const int l = tid >> 6, d = tid & 63;
              Ks[(128 + l) * 72 + d] = Zk[(size_t)(MP + bs * 8 + l) * 256 + kvh * 64 + d]; Ks[(136 + l) * 72 + d] = 0; }
            if (tid < 64) { const u32x4 nv = *(const u32x4*)(vTs + ((size_t)((bs * 4 + kvh) * 64 + tid)) * 8);
                *(LAS u32x4*)(Vt + tid * 152 + 128) = nv; *(LAS u32x4*)(Vt + tid * 152 + 136) = (u32x4){0u, 0u, 0u, 0u}; *(LAS u32x4*)(Vt + tid * 152 + 144) = (u32x4){0u, 0u, 0u, 0u}; }
        }
        __syncthreads();
        if (w < 4) {
            const int sl = w >> 1, t = w & 1, it = 2 * pr + sl, bs = it >> 2, kvh = it & 3;
            const LAS bf16_t* Ks = (const LAS bf16_t*)(lds + sl * SLOT_B); const LAS bf16_t* Vt = (const LAS bf16_t*)(lds + sl * SLOT_B + KS_B);
            const int hq = 2 * t + (l16 >> 3), l = l16 & 7, head = kvh * 4 + hq;
            const size_t tq = (size_t)(MP + bs * 8 + l);
            const float sk = P.sinks[head];
            bf16x8 qf[2];
#pragma unroll
            for (int ks = 0; ks < 2; ++ks) qf[ks] = *(const bf16x8*)(Zq + tq * 1024 + head * 64 + ks * 32 + g * 8);
            f32x4 sa[9];
#pragma unroll
            for (int j = 0; j < 9; ++j) { sa[j] = (f32x4){0.f, 0.f, 0.f, 0.f};
#pragma unroll
                for (int ks = 0; ks < 2; ++ks) { const bf16x8 kf = *(const LAS bf16x8*)(Ks + (16 * j + l16) * 72 + ks * 32 + g * 8);
                    sa[j] = __builtin_amdgcn_mfma_f32_16x16x32_bf16(kf, qf[ks], sa[j], 0, 0, 0); } }
            float mx = sk;
#pragma unroll
            for (int j = 0; j < 9; ++j)
#pragma unroll
                for (int r = 0; r < 4; ++r) { const int key = 16 * j + 4 * g + r;
                    const bool vis = (j < 8) ? (key > l) : (key - 128 <= l);
                    sa[j][r] = vis ? sa[j][r] : -1e30f; mx = fmaxf(mx, sa[j][r]); }
            mx = fmaxf(mx, __shfl_xor(mx, 16, 64)); mx = fmaxf(mx, __shfl_xor(mx, 32, 64));
            float sum = 0.f;
#pragma unroll
            for (int j = 0; j < 9; ++j)
#pragma unroll
                for (int r = 0; r < 4; ++r) { const float p = __expf(sa[j][r] - mx); sa[j][r] = p; sum += p; }
            sum += __shfl_xor(sum, 16, 64); sum += __shfl_xor(sum, 32, 64);
            const float inv = 1.f / (sum + __expf(sk - mx));
            f32x4 oa[4];
#pragma unroll
            for (int dt = 0; dt < 4; ++dt) oa[dt] = (f32x4){0.f, 0.f, 0.f, 0.f};
#pragma unroll
            for (int u = 0; u < 5; ++u) {
                u32x4 pw; pw.x = cvt_pk_bf16(sa[2 * u][0], sa[2 * u][1]); pw.y = cvt_pk_bf16(sa[2 * u][2], sa[2 * u][3]);
                if (u < 4) { pw.z = cvt_pk_bf16(sa[2 * u + 1][0], sa[2 * u + 1][1]); pw.w = cvt_pk_bf16(sa[2 * u + 1][2], sa[2 * u + 1][3]); } else { pw.z = 0u; pw.w = 0u; }
                const bf16x8 pf = __builtin_bit_cast(bf16x8, pw);
                const int k0 = 32 * u + 4 * g, k1 = (u < 4) ? k0 + 16 : k0;
#pragma unroll
                for (int dt = 0; dt < 4; ++dt) {
                    const u32x2 v0 = *(const LAS u32x2*)(Vt + (16 * dt + l16) * 152 + k0), v1 = *(const LAS u32x2*)(Vt + (16 * dt + l16) * 152 + k1);
                    u32x4 vw; vw.x = v0.x; vw.y = v0.y; vw.z = v1.x; vw.w = v1.y;
                    oa[dt] = __builtin_amdgcn_mfma_f32_16x16x32_bf16(__builtin_bit_cast(bf16x8, vw), pf, oa[dt], 0, 0, 0);
                }
            }
#pragma unroll
            for (int dt = 0; dt < 4; ++dt) {
                const size_t o = tq * 1024 + head * 64 + 16 * dt + 4 * g;
                const u32x2 gw = *(const u32x2*)(Zg + o);
                f32x4 r; r[0] = oa[dt][0] * inv * bflo(gw.x); r[1] = oa[dt][1] * inv * bfhi(gw.x); r[2] = oa[dt][2] * inv * bflo(gw.y); r[3] = oa[dt][3] * inv * bfhi(gw.y);
                *(u32x2*)(OG + o) = pk4(r);
            }
        }
    }
}

__device__ __forceinline__ void ret_A(LAS unsigned char* lds, const bf16_t* __restrict__ Zq, const bf16_t* __restrict__ Zk, bf16_t* __restrict__ ABUF, bf16_t* __restrict__ KDT, int G) {
    LAS bf16_t* Qs = (LAS bf16_t*)lds;
    LAS bf16_t* Ks = (LAS bf16_t*)(lds + 128 * 264 * 2);
    const int tid = otid(), w = tid >> 6, lane = tid & 63, l16 = lane & 15, g = lane >> 4;
    u32x4 rq[8], rk[8];
#define RA_LOAD(it_) do { const int c_ = (it_) & 31, h_ = ((it_) >> 5) & 3, b_ = (it_) >> 7; const size_t t0_ = (size_t)b_ * 4096 + c_ * 128; \
        _Pragma("unroll") for (int i = 0; i < 8; ++i) { const int ch = tid + 512 * i, s = ch >> 5, c8 = (ch & 31) * 8; const size_t src = (t0_ + s) * 1024 + h_ * 256 + c8; rq[i] = *(const u32x4*)(Zq + src); rk[i] = *(const u32x4*)(Zk + src); } } while (0)
    if ((int)blockIdx.x < 512) RA_LOAD((int)blockIdx.x);
    for (int it = blockIdx.x; it < 512; it += G) {
        const int c = it & 31, h = (it >> 5) & 3, b = it >> 7;
        const float lg = ret_lg(h);
        __syncthreads();
#pragma unroll
        for (int i = 0; i < 8; ++i) { const int ch = tid + 512 * i, s = ch >> 5, c8 = (ch & 31) * 8; *(LAS u32x4*)(Qs + s * 264 + c8) = rq[i]; *(LAS u32x4*)(Ks + s * 264 + c8) = rk[i]; }
        __syncthreads();
        if (it + G < 512) RA_LOAD(it + G);
        asm volatile("" ::: "memory");
        const int i_row = 16 * w + l16;
#pragma unroll
        for (int nt = 0; nt < 8; ++nt) {
            f32x4 a = {0.f, 0.f, 0.f, 0.f};
            if (nt <= w) {
#pragma unroll
                for (int ks = 0; ks < 8; ++ks) { const bf16x8 kf = *(const LAS bf16x8*)(Ks + (16 * nt + l16) * 264 + ks * 32 + g * 8), qf = *(const LAS bf16x8*)(Qs + i_row * 264 + ks * 32 + g * 8);
                    a = __builtin_amdgcn_mfma_f32_16x16x32_bf16(kf, qf, a, 0, 0, 0); }
#pragma unroll
                for (int r = 0; r < 4; ++r) { const int s = 16 * nt + 4 * g + r; a[r] = (s <= i_row) ? a[r] * __expf((float)(i_row - s) * lg) : 0.f; }
            }
            *(u32x2*)(ABUF + ((size_t)it * 128 + i_row) * 128 + 16 * nt + 4 * g) = pk4(a);
        }
        { const int d = tid & 255, sg0 = tid >> 8;
#pragma unroll
          for (int k = 0; k < 8; ++k) { const int s0 = 8 * (sg0 + 2 * k); float v[8];
#pragma unroll
              for (int jj = 0; jj < 8; ++jj) v[jj] = bf2f(Ks[(s0 + jj) * 264 + d]) * __expf((float)(127 - s0 - jj) * lg);
              u32x4 wv; wv.x = cvt_pk_bf16(v[0], v[1]); wv.y = cvt_pk_bf16(v[2], v[3]); wv.z = cvt_pk_bf16(v[4], v[5]); wv.w = cvt_pk_bf16(v[6], v[7]);
              *(u32x4*)(KDT + ((size_t)it * 256 + d) * 128 + s0) = wv; } }
    }
}
#undef RA_LOAD

__device__ __forceinline__ void ret_seq_unit(LAS unsigned char* lds, int u, const bf16_t* __restrict__ Zq, const bf16_t* __restrict__ vTp, const bf16_t* __restrict__ ABUF, const bf16_t* __restrict__ KDT,
                                             bf16_t* __restrict__ ORET, float* __restrict__ out) {
    LAS bf16_t* ST = (LAS bf16_t*)lds;
    LAS bf16_t* VT = (LAS bf16_t*)(lds + 2 * 64 * 264 * 2);
    const int tid = otid(), w = tid >> 6, lane = tid & 63, l16 = lane & 15, g = lane >> 4;
    const int xcd = u & 7, jj = u >> 3, bh = xcd * 2 + (jj >> 3), es = jj & 7, b = bh >> 2, h = bh & 3;
    const float lg = ret_lg(h), g128 = __expf(128.f * lg), gi = __expf((float)(16 * w + l16 + 1) * lg);
    __syncthreads();
    for (int e = tid; e < 64 * 264 / 2; e += NT) ((LAS unsigned*)ST)[e] = 0u;
    const bf16_t* vrow = vTp + ((size_t)bh * 512 + es * 64 + (tid >> 3)) * 4096 + (tid & 7) * 16;
    LAS bf16_t* vdst = VT + (tid >> 3) * 136 + (tid & 7) * 16;
    { const u32x4 a = *(const u32x4*)vrow, bq = *(const u32x4*)(vrow + 8); *(LAS u32x4*)vdst = a; *(LAS u32x4*)(vdst + 8) = bq; }
    f32x4 sacc[2][4];
#pragma unroll
    for (int dt = 0; dt < 2; ++dt)
#pragma unroll
        for (int et = 0; et < 4; ++et) sacc[dt][et] = (f32x4){0.f, 0.f, 0.f, 0.f};
    const bf16_t* aptr = ABUF + ((size_t)bh * 32 * 128 + 16 * w + l16) * 128 + 8 * g;
    const bf16_t* qptr = Zq + ((size_t)b * 4096 + 16 * w + l16) * 1024 + h * 256 + 8 * g;
    const bf16_t* kptr = KDT + ((size_t)bh * 32 * 256 + 32 * w + l16) * 128 + 8 * g;
    bf16_t* optr = ORET + ((size_t)b * 4096 + 16 * w + l16) * 2048 + h * 512 + es * 64 + 4 * g;
    bf16x8 af[4], qf[8], kf[2][4];
#pragma unroll
    for (int ks = 0; ks < 4; ++ks) af[ks] = *(const bf16x8*)(aptr + 32 * ks);
#pragma unroll
    for (int kd = 0; kd < 8; ++kd) qf[kd] = *(const bf16x8*)(qptr + 32 * kd);
    __syncthreads();
    u32x2 opk[4];
    for (int c = 0; c < 32; ++c) {
        const int buf = c & 1;
        if (c > 0) {
#pragma unroll
            for (int et = 0; et < 4; ++et) *(u32x2*)(optr + (size_t)(c - 1) * 128 * 2048 + 16 * et) = opk[et]; }
#pragma unroll
        for (int dt = 0; dt < 2; ++dt)
#pragma unroll
            for (int ks = 0; ks < 4; ++ks) kf[dt][ks] = *(const bf16x8*)(kptr + (size_t)c * 256 * 128 + dt * 2048 + 32 * ks);
        u32x4 nv0 = {0u, 0u, 0u, 0u}, nv1 = {0u, 0u, 0u, 0u};
        if (c < 31) { nv0 = *(const u32x4*)(vrow + (c + 1) * 128); nv1 = *(const u32x4*)(vrow + (c + 1) * 128 + 8); }
        const LAS bf16_t* VTb = VT + buf * 64 * 136; const LAS bf16_t* STb = ST + buf * 64 * 264;
#pragma unroll
        for (int et = 0; et < 4; ++et) {
            f32x4 oin = {0.f, 0.f, 0.f, 0.f}, ocr = {0.f, 0.f, 0.f, 0.f};
#pragma unroll
            for (int ks = 0; ks < 4; ++ks) { const bf16x8 vf = *(const LAS bf16x8*)(VTb + (16 * et + l16) * 136 + 32 * ks + 8 * g); oin = __builtin_amdgcn_mfma_f32_16x16x32_bf16(vf, af[ks], oin, 0, 0, 0); }
#pragma unroll
            for (int kd = 0; kd < 8; ++kd) { const bf16x8 sf = *(const LAS bf16x8*)(STb + (16 * et + l16) * 264 + 32 * kd + 8 * g); ocr = __builtin_amdgcn_mfma_f32_16x16x32_bf16(sf, qf[kd], ocr, 0, 0, 0); }
            opk[et] = pk4(oin + ocr * gi);
        }
        if (c < 31) {
#pragma unroll
            for (int ks = 0; ks < 4; ++ks) af[ks] = *(const bf16x8*)(aptr + (size_t)(c + 1) * 128 * 128 + 32 * ks);
#pragma unroll
            for (int kd = 0; kd < 8; ++kd) qf[kd] = *(const bf16x8*)(qptr + (size_t)(c + 1) * 128 * 1024 + 32 * kd);
        }
#pragma unroll
        for (int dt = 0; dt < 2; ++dt)
#pragma unroll
            for (int et = 0; et < 4; ++et) sacc[dt][et] *= g128;
#pragma unroll
        for (int et = 0; et < 4; ++et)
#pragma unroll
            for (int ks = 0; ks < 4; ++ks) { const bf16x8 vf = *(const LAS bf16x8*)(VTb + (16 * et + l16) * 136 + 32 * ks + 8 * g);
#pragma unroll
                for (int dt = 0; dt < 2; ++dt) sacc[dt][et] = __builtin_amdgcn_mfma_f32_16x16x32_bf16(kf[dt][ks], vf, sacc[dt][et], 0, 0, 0); }
#pragma unroll
        for (int dt = 0; dt < 2; ++dt)
#pragma unroll
            for (int et = 0; et < 4; ++et) *(LAS u32x2*)(ST + ((buf ^ 1) * 64 + 16 * et + l16) * 264 + 32 * w + 16 * dt + 4 * g) = pk4(sacc[dt][et]);
        if (c < 31) { LAS bf16_t* d2 = vdst + (buf ^ 1) * 64 * 136; *(LAS u32x4*)d2 = nv0; *(LAS u32x4*)(d2 + 8) = nv1; }
        __syncthreads();
    }
#pragma unroll
    for (int et = 0; et < 4; ++et) *(u32x2*)(optr + (size_t)31 * 128 * 2048 + 16 * et) = opk[et];
#pragma unroll
    for (int dt = 0; dt < 2; ++dt)
#pragma unroll
        for (int et = 0; et < 4; ++et)
#pragma unroll
            for (int r = 0; r < 4; ++r) out[OFF_RSP + ((size_t)bh * 256 + 32 * w + 16 * dt + 4 * g + r) * 512 + es * 64 + 16 * et + l16] = sacc[dt][et][r];
}

__device__ __forceinline__ void ret_sample(LAS unsigned char* lds, const Params& P, const bf16_t* __restrict__ Zq, const bf16_t* __restrict__ Zk, const bf16_t* __restrict__ vTs, bf16_t* __restrict__ ORET, unsigned* ctr, unsigned* done, unsigned target) {
    LAS float* qs = (LAS float*)lds;
    LAS float* kds = qs + 2048;
    LAS float* A8 = kds + 2048;
    LAS float* red = A8 + 64;
    volatile LAS int* slot = (volatile LAS int*)(lds + LDS_BYTES - 32);
    for (;;) {
        const int tid = otid();
        __syncthreads();
        if (tid == 0) *slot = (done && xb_ld(done) >= target) ? 512 : (int)atomicAdd(ctr, 1u);
        __syncthreads();
        const int it = *slot;
        if (it >= 512) break;
        const int bs = it >> 2, h = it & 3;
        const float lg = ret_lg(h), g8 = __expf(8.f * lg), ig8 = __expf(-8.f * lg);
#pragma unroll
        for (int k = 0; k < 4; ++k) { const int e = tid + 512 * k, i = e >> 8, d = e & 255; const size_t src = (size_t)(MP + bs * 8 + i) * 1024 + h * 256 + d;
            qs[d * 8 + i] = bf2f(Zq[src]) * __expf((float)(i + 1) * lg); kds[d * 8 + i] = bf2f(Zk[src]) * __expf((float)(7 - i) * lg); }
        __syncthreads();
        if (tid < 64) { const int i = tid >> 3, s = tid & 7; float a = 0.f;
            if (s <= i) { for (int d = 0; d < 256; ++d) a += qs[d * 8 + i] * kds[d * 8 + s]; a *= ig8; }
            A8[tid] = a; }
        const int eg = tid & 127, dp = tid >> 7, e0 = 4 * eg;
        f32x4 vq[8];
#pragma unroll
        for (int jj = 0; jj < 4; ++jj) { const u32x4 wv = *(const u32x4*)(vTs + ((size_t)((bs * 4 + h) * 512 + e0 + jj)) * 8);
            vq[0][jj] = bflo(wv.x); vq[1][jj] = bfhi(wv.x); vq[2][jj] = bflo(wv.y); vq[3][jj] = bfhi(wv.y); vq[4][jj] = bflo(wv.z); vq[5][jj] = bfhi(wv.z); vq[6][jj] = bflo(wv.w); vq[7][jj] = bfhi(wv.w); }
        f32x4 cr[8];
#pragma unroll
        for (int i = 0; i < 8; ++i) cr[i] = (f32x4){0.f, 0.f, 0.f, 0.f};
        const size_t sbase = ((size_t)(bs * 4 + h) * 256 + dp * 64) * 512 + e0;
        const float* __restrict__ sp = P.state_ret + sbase; float* __restrict__ op = P.out + OFF_RSS + sbase;
        f32x4 sta[8];
#pragma unroll
        for (int j = 0; j < 8; ++j) sta[j] = __builtin_nontemporal_load((const f32x4*)(sp + (size_t)j * 512));
#pragma unroll 1
        for (int d0 = 0; d0 < 64; d0 += 8) {
            const bool more = d0 + 8 < 64;
#pragma unroll
            for (int j = 0; j < 8; ++j) {
                const int d = dp * 64 + d0 + j; const f32x4 st = sta[j];
                if (more) sta[j] = __builtin_nontemporal_load((const f32x4*)(sp + (size_t)(d0 + 8 + j) * 512));
                const f32x4 qa = *(const LAS f32x4*)(qs + d * 8), qb = *(const LAS f32x4*)(qs + d * 8 + 4), ka = *(const LAS f32x4*)(kds + d * 8), kb = *(const LAS f32x4*)(kds + d * 8 + 4);
                const float q8[8] = {qa[0], qa[1], qa[2], qa[3], qb[0], qb[1], qb[2], qb[3]}, k8[8] = {ka[0], ka[1], ka[2], ka[3], kb[0], kb[1], kb[2], kb[3]};
                f32x4 ns = st * g8;
#pragma unroll
                for (int s2 = 0; s2 < 8; ++s2) ns += vq[s2] * k8[s2];
                __builtin_nontemporal_store(ns, (f32x4*)(op + (size_t)(d0 + j) * 512));
#pragma unroll
                for (int i = 0; i < 8; ++i) cr[i] += st * q8[i];
                asm volatile("" ::: "memory");
            }
        }
#pragma unroll
        for (int i = 0; i < 8; ++i) *(LAS f32x4*)(red + (dp * 8 + i) * 512 + e0) = cr[i];
        __syncthreads();
        { const int i = tid >> 6, e8 = (tid & 63) * 8;
          float o[8];
#pragma unroll
          for (int jj = 0; jj < 8; ++jj) o[jj] = red[(0 * 8 + i) * 512 + e8 + jj] + red[(1 * 8 + i) * 512 + e8 + jj] + red[(2 * 8 + i) * 512 + e8 + jj] + red[(3 * 8 + i) * 512 + e8 + jj];
#pragma unroll
          for (int jj = 0; jj < 8; ++jj) { const u32x4 wv = *(const u32x4*)(vTs + ((size_t)((bs * 4 + h) * 512 + e8 + jj)) * 8);
              const float v8[8] = {bflo(wv.x), bfhi(wv.x), bflo(wv.y), bfhi(wv.y), bflo(wv.z), bfhi(wv.z), bflo(wv.w), bfhi(wv.w)};
#pragma unroll
              for (int s = 0; s < 8; ++s) o[jj] += A8[i * 8 + s] * v8[s]; }
          bf16_t* dst = ORET + (size_t)(MP + bs * 8 + i) * 2048 + h * 512 + e8;
          u32x4 ow; ow.x = cvt_pk_bf16(o[0], o[1]); ow.y = cvt_pk_bf16(o[2], o[3]); ow.z = cvt_pk_bf16(o[4], o[5]); ow.w = cvt_pk_bf16(o[6], o[7]); *(u32x4*)dst = ow; }
    }
}

__device__ __forceinline__ void ret_gnorm(const bf16_t* __restrict__ ORET, const bf16_t* __restrict__ Zg, bf16_t* __restrict__ OG, int G) {
    const int tid_o = otid(), wave = tid_o >> 6, lane = tid_o & 63;
    for (int task = blockIdx.x * 8 + wave; task < MT * 4; task += G * 8) {
        const size_t o = (size_t)(task >> 2) * 2048 + (task & 3) * 512 + lane * 8;
        const u32x4 ow = *(const u32x4*)(ORET + o); const f32x4 a = {bflo(ow.x), bfhi(ow.x), bflo(ow.y), bfhi(ow.y)}, b = {bflo(ow.z), bfhi(ow.z), bflo(ow.w), bfhi(ow.w)};
        const float mu = wave_sum(a[0] + a[1] + a[2] + a[3] + b[0] + b[1] + b[2] + b[3]) * (1.f / 512.f);
        const f32x4 da = a - mu, db = b - mu;
        const float var = wave_sum(da[0] * da[0] + da[1] * da[1] + da[2] * da[2] + da[3] * da[3] + db[0] * db[0] + db[1] * db[1] + db[2] * db[2] + db[3] * db[3]) * (1.f / 512.f);
        const float rs = rsqrtf(var + EPS);
        const u32x4 gw = *(const u32x4*)(Zg + o);
        u32x4 r;
        r.x = cvt_pk_bf16(da[0] * rs * bflo(gw.x), da[1] * rs * bfhi(gw.x)); r.y = cvt_pk_bf16(da[2] * rs * bflo(gw.y), da[3] * rs * bfhi(gw.y));
        r.z = cvt_pk_bf16(db[0] * rs * bflo(gw.z), db[1] * rs * bfhi(gw.z)); r.w = cvt_pk_bf16(db[2] * rs * bflo(gw.w), db[3] * rs * bfhi(gw.w));
        *(u32x4*)(OG + o) = r;
    }
}

__global__ void __launch_bounds__(NT) hybrid_fwd(Params P) {
    extern __shared__ __attribute__((aligned(16))) unsigned char lds_raw[];
    LAS unsigned char* lds = (LAS unsigned char*)lds_raw;
    cg::grid_group grid = cg::this_grid();
    const int G = gridDim.x, tid = threadIdx.x;
    unsigned char* ws = P.ws;
    bf16_t* WT_IN_ATTN = (bf16_t*)(ws + WS_WT_IN_ATTN); bf16_t* WT_OUT_ATTN = (bf16_t*)(ws + WS_WT_OUT_ATTN); bf16_t* WT_IN_RET = (bf16_t*)(ws + WS_WT_IN_RET); bf16_t* WT_OUT_RET = (bf16_t*)(ws + WS_WT_OUT_RET);
    bf16_t* WT_GATE = (bf16_t*)(ws + WS_WT_GATE); bf16_t* WT_PLE = (bf16_t*)(ws + WS_WT_PLE);
    float* TABA = (float*)(ws + WS_TABA); float* TABR = (float*)(ws + WS_TABR);
    bf16_t* H = (bf16_t*)(ws + WS_H); bf16_t* PB = (bf16_t*)(ws + WS_PB);
    bf16_t* PLE = (bf16_t*)(ws + WS_PLE); bf16_t* Y = (bf16_t*)(ws + WS_Y); bf16_t* X2 = (bf16_t*)(ws + WS_X2);
    bf16_t* OG = (bf16_t*)(ws + WS_OG); bf16_t* ZQ = (bf16_t*)(ws + WS_ZQ); bf16_t* ZK = (bf16_t*)(ws + WS_ZK); bf16_t* ZG = (bf16_t*)(ws + WS_ZG);
    bf16_t* VTP = (bf16_t*)(ws + WS_VTP); bf16_t* VTS = (bf16_t*)(ws + WS_VTS); bf16_t* ABUF = (bf16_t*)(ws + WS_ABUF); bf16_t* KDT = (bf16_t*)(ws + WS_KDT); bf16_t* ORET = (bf16_t*)(ws + WS_ORET);
    bf16_t* SC = (bf16_t*)(ws + WS_Y);
    pg8::StaticOrder SO;
    volatile LAS unsigned* bst = (volatile LAS unsigned*)(lds + LDS_BYTES - 16);
    if (tid < 4) bst[tid] = 0u;
    __syncthreads();
    const XcdBarrier xbar = xcd_barrier_post((unsigned*)(ws + WS_BAR), bst);
#define GSYNC() xcd_barrier(xbar)

for (int rep_ = 0; rep_ < REP_P0; ++rep_) {
    {
        LAS float* T = (LAS float*)lds;
        const int ttid = otid(), nn = ttid & 63, kq = ttid >> 6, kk2 = (ttid & 31) * 2, nq = ttid >> 5;
#define TILE_DESC(t_, W_, Wt_, K_, N_, perm_, tl_) do { \
        if ((t_) < 640) { W_ = P.w_in_attn; Wt_ = WT_IN_ATTN; K_ = 1024; N_ = 2560; perm_ = true; tl_ = (t_); } \
        else if ((t_) < 896) { W_ = P.w_out_attn; Wt_ = WT_OUT_ATTN; K_ = 1024; N_ = 1024; perm_ = false; tl_ = (t_) - 640; } \
        else if ((t_) < 2432) { W_ = P.w_in_ret; Wt_ = WT_IN_RET; K_ = 1024; N_ = 6144; perm_ = false; tl_ = (t_) - 896; } \
        else if ((t_) < 2944) { W_ = P.w_out_ret; Wt_ = WT_OUT_RET; K_ = 2048; N_ = 1024; perm_ = false; tl_ = (t_) - 2432; } \
        else if ((t_) < 3200) { W_ = P.w_gate; Wt_ = WT_GATE; K_ = 1024; N_ = 1024; perm_ = false; tl_ = (t_) - 2944; } \
        else if ((t_) < 3456) { W_ = P.w_gate + 1024 * 1024; Wt_ = WT_GATE + 1024 * 1024; K_ = 1024; N_ = 1024; perm_ = false; tl_ = (t_) - 3200; } \
        else if ((t_) < 3520) { W_ = P.w_ple; Wt_ = WT_PLE; K_ = 256; N_ = 1024; perm_ = false; tl_ = (t_) - 3456; } \
        else { W_ = P.w_ple + 256 * 1024; Wt_ = WT_PLE + 1024 * 256; K_ = 256; N_ = 1024; perm_ = false; tl_ = (t_) - 3520; } } while (0)
#define TILE_LOAD(W_, N_, perm_, tl_, r_) do { const int ntn_ = (N_) >> 6, n0_ = ((tl_) % ntn_) * 64, k0_ = ((tl_) / ntn_) * 64, nd_ = n0_ + nn; int ns_ = nd_; \
        if ((perm_) && nd_ < 1280) { const int p_ = nd_ & 63; ns_ = (nd_ - p_) + (p_ >> 5) * 16 + (p_ & 15) + ((p_ >> 4) & 1) * 32; } \
        _Pragma("unroll") for (int i_ = 0; i_ < 8; ++i_) r_[i_] = (W_)[(size_t)(k0_ + kq + 8 * i_) * (N_) + ns_]; } while (0)
        float r[8];
        const float* Wc; bf16_t* Wtc; int Kc, Nc, tlc; bool pc;
        int t = blockIdx.x;
        if (t < 3584) { TILE_DESC(t, Wc, Wtc, Kc, Nc, pc, tlc); TILE_LOAD(Wc, Nc, pc, tlc, r); }
        for (; t < 3584; t += G) {
            __syncthreads();
#pragma unroll
            for (int i = 0; i < 8; ++i) T[(kq + 8 * i) * 65 + nn] = r[i];
            __syncthreads();
            const int ntn = Nc >> 6, n0 = (tlc % ntn) * 64, k0 = (tlc / ntn) * 64; bf16_t* Wto = Wtc; const int Ko = Kc;
            if (t + G < 3584) { TILE_DESC(t + G, Wc, Wtc, Kc, Nc, pc, tlc); TILE_LOAD(Wc, Nc, pc, tlc, r); }
#pragma unroll
            for (int i = 0; i < 4; ++i) { const int n2 = nq + 16 * i; *(unsigned*)(Wto + (size_t)(n0 + n2) * Ko + k0 + kk2) = cvt_pk_bf16(T[kk2 * 65 + n2], T[(kk2 + 1) * 65 + n2]); }
        }
        __syncthreads();
#undef TILE_DESC
#undef TILE_LOAD
    }
    for (int e = blockIdx.x * NT + tid; e < 4104 * 160; e += G * NT) {
        const int pi = e / 160, f = e % 160; const int pos = pi < 4096 ? pi : 16384 + (pi - 4096);
        if (f < 32) { const float inv = powf(10000.f, -(float)f / 32.f), ang = (float)pos * inv; TABA[((size_t)pi * 32 + f) * 2] = cosf(ang); TABA[((size_t)pi * 32 + f) * 2 + 1] = sinf(ang); }
        else { const int f2 = f - 32; const float inv = powf(10000.f, -(float)f2 / 128.f), ang = (float)pos * inv; TABR[((size_t)pi * 128 + f2) * 2] = cosf(ang); TABR[((size_t)pi * 128 + f2) * 2 + 1] = sinf(ang); }
    }
    for (int e = blockIdx.x * NT + tid; e < 2 * MT * 64; e += G * NT) {
        const int i = e / (MT * 64), rem = e % (MT * 64), row = rem >> 6, c4 = (rem & 63) * 4;
        const float* src = row < MP ? P.p_prompt + ((size_t)i * MP + row) * 256 + c4 : P.p_sample + ((size_t)i * MS + row - MP) * 256 + c4;
        *(u32x2*)(PB + ((size_t)i * MT + row) * 256 + c4) = pk4(*(const f32x4*)src);
    }
    rms_rows(P.x_prompt, P.x_sample, P.pre_norm, H, G);
}
    if (P.ws == nullptr) grid.sync();
    GSYNC();

for (int rep_ = 0; rep_ < REP_GIN; ++rep_) {
    { pg8::Gemm g{H, WT_IN_ATTN, MT, 2560, 1024}; SO.init(MT, 2560, G, blockIdx.x);
      EpiInAttn E{ZQ, ZK, ZG, VTP, VTS, TABA, P.out}; pg8::gemm_phase(lds, g, SO, E); }
    { pg8::Gemm g{PB, WT_PLE, MP, 1024, 256}; EpiB16 E{PLE, 1024};
      if (G == 256) { pg8::TailOrder TO; TO.init(MP, 680 - 512, G, blockIdx.x); pg8::gemm_phase(lds, g, TO, E); }
      else { SO.init(MP, 1024, G, blockIdx.x); pg8::gemm_phase(lds, g, SO, E); }
      skinny_gemm(lds, PB + (size_t)MP * 256, WT_PLE, 256, SkB16{PLE + (size_t)MP * 1024}, G); }
}
    GSYNC();

for (int rep_ = 0; rep_ < REP_ATT; ++rep_) {
    attn_prompt(lds, ZQ, ZK, ZG, VTP, P.sinks, OG, G);
    attn_sample(lds, P, ZQ, ZK, ZG, VTS, OG, G);
}
    GSYNC();

for (int rep_ = 0; rep_ < REP_GN1; ++rep_) {
    { pg8::Gemm g{OG, WT_OUT_ATTN, MP, 1024, 1024}; SO.init(MP, 1024, G, blockIdx.x); EpiB16 E{Y, 1024}; pg8::gemm_phase(lds, g, SO, E);
      skinny_gemm(lds, OG + (size_t)MP * 1024, WT_OUT_ATTN, 1024, SkB16{Y + (size_t)MP * 1024}, G); }
}
    GSYNC();
for (int rep_ = 0; rep_ < REP_ROW; ++rep_) {
    resid_rows<false>(P.x_prompt, P.x_sample, nullptr, Y, P.post_norm, H, G);
}
    GSYNC();
for (int rep_ = 0; rep_ < REP_GN1; ++rep_) {
    { pg8::Gemm g{H, WT_GATE, MP, 1024, 1024}; SO.init(MP, 1024, G, blockIdx.x); EpiGate<true> E{H, PLE, nullptr, X2}; pg8::gemm_phase(lds, g, SO, E);
      skinny_gemm(lds, H + (size_t)MP * 1024, WT_GATE, 1024, SkGate<true>{H + (size_t)MP * 1024, PLE + (size_t)MP * 1024, nullptr, X2 + (size_t)MP * 1024}, G); }
}
    GSYNC();
for (int rep_ = 0; rep_ < REP_ROW; ++rep_) {
    rms_rows_b16(X2, P.pre_norm + 1024, H, G);
}
    GSYNC();
for (int rep_ = 0; rep_ < REP_GIN; ++rep_) {
    { pg8::Gemm g{H, WT_IN_RET, MT, 6144, 1024}; SO.init(MT, 6144, G, blockIdx.x);
      EpiInRet E{ZQ, ZK, ZG, VTP, VTS, TABR}; pg8::gemm_phase(lds, g, SO, E); }
    { pg8::Gemm g{PB + (size_t)MT * 256, WT_PLE + 1024 * 256, MP, 1024, 256}; EpiB16 E{PLE, 1024};
      if (G == 256) { pg8::TailOrder TO; TO.init(MP, 1632 - 6 * 256, G, blockIdx.x); pg8::gemm_phase(lds, g, TO, E); }
      else { SO.init(MP, 1024, G, blockIdx.x); pg8::gemm_phase(lds, g, SO, E); }
      skinny_gemm(lds, PB + (size_t)MT * 256 + (size_t)MP * 256, WT_PLE + 1024 * 256, 256, SkB16{PLE + (size_t)MP * 1024}, G); }
}
    GSYNC();
for (int rep_ = 0; rep_ < REP_RA; ++rep_) {
    ret_A(lds, ZQ, ZK, ABUF, KDT, G);
}
    GSYNC();
    { unsigned* ctr = (unsigned*)(ws + WS_BAR + 14336);
      if (blockIdx.x < 128) for (int u = blockIdx.x; u < 128; u += G) ret_seq_unit(lds, u, ZQ, VTP, ABUF, KDT, ORET, P.out);
      ret_sample(lds, P, ZQ, ZK, VTS, ORET, ctr, nullptr, 0u); }
for (int rep_ = 0; rep_ < REP_SYNC; ++rep_) GSYNC();
    GSYNC();
for (int rep_ = 0; rep_ < REP_ROW; ++rep_) {
    ret_gnorm(ORET, ZG, OG, G);
}
    GSYNC();
for (int rep_ = 0; rep_ < REP_GN1; ++rep_) {
    { pg8::Gemm g{OG, WT_OUT_RET, MP, 1024, 2048}; SO.init(MP, 1024, G, blockIdx.x); EpiB16 E{Y, 1024}; pg8::gemm_phase(lds, g, SO, E);
      skinny_gemm(lds, OG + (size_t)MP * 2048, WT_OUT_RET, 2048, SkB16{Y + (size_t)MP * 1024}, G); }
}
    GSYNC();
for (int rep_ = 0; rep_ < REP_ROW; ++rep_) {
    resid_rows<true>(nullptr, nullptr, X2, Y, P.post_norm + 1024, H, G);
}
    GSYNC();
for (int rep_ = 0; rep_ < REP_GN1; ++rep_) {
    { pg8::Gemm g{H, WT_GATE + 1024 * 1024, MP, 1024, 1024}; SO.init(MP, 1024, G, blockIdx.x); EpiGate<false> E{H, PLE, P.out, nullptr}; pg8::gemm_phase(lds, g, SO, E);
      skinny_gemm(lds, H + (size_t)MP * 1024, WT_GATE + 1024 * 1024, 1024, SkGate<false>{H + (size_t)MP * 1024, PLE + (size_t)MP * 1024, P.out + (size_t)MP * 1024, nullptr}, G); }
}
}

extern "C" void kernel_launch(void* const* d_in, const int* in_sizes, int n_in, void* d_out, int out_size, void* d_ws, size_t ws_size, hipStream_t stream) {
    static int grid_blocks = 0;
    if (!grid_blocks) {
        int dev = 0, cus = 0, per_cu = 0;
        hipGetDevice(&dev);
        hipDeviceGetAttribute(&cus, hipDeviceAttributeMultiprocessorCount, dev);
        hipFuncSetAttribute((const void*)hybrid_fwd, hipFuncAttributeMaxDynamicSharedMemorySize, LDS_BYTES);
        hipOccupancyMaxActiveBlocksPerMultiprocessor(&per_cu, (const void*)hybrid_fwd, NT, LDS_BYTES);
        if (per_cu < 1) per_cu = 1;
        if (per_cu > 1) per_cu = 1;
        grid_blocks = cus * per_cu;
        if (ws_size < WS_END) fprintf(stderr, "kernel_launch: workspace too small: %zu < %zu\n", ws_size, (size_t)WS_END);
    }
    Params p{};
    p.x_prompt = (const float*)d_in[0]; p.x_sample = (const float*)d_in[1]; p.cache_k = (const float*)d_in[2]; p.cache_v = (const float*)d_in[3]; p.state_ret = (const float*)d_in[4];
    p.p_prompt = (const float*)d_in[5]; p.p_sample = (const float*)d_in[6]; p.pre_norm = (const float*)d_in[7]; p.post_norm = (const float*)d_in[8]; p.w_in_attn = (const float*)d_in[9];
    p.sinks = (const float*)d_in[10]; p.w_out_attn = (const float*)d_in[11]; p.w_in_ret = (const float*)d_in[12]; p.w_out_ret = (const float*)d_in[13]; p.w_ple = (const float*)d_in[14]; p.w_gate = (const float*)d_in[15];
    p.out = (float*)d_out; p.ws = (unsigned char*)d_ws;
    (void)hipMemsetAsync((unsigned char*)d_ws + WS_BAR, 0, 16384, stream);
    void* args[] = {&p};
    hipError_t e = hipLaunchCooperativeKernel((const void*)hybrid_fwd, dim3(grid_blocks), dim3(NT), args, LDS_BYTES, stream);
    if (e != hipSuccess) fprintf(stderr, "cooperative launch failed: %s (grid %d)\n", hipGetErrorString(e), grid_blocks);
}
```

```cpp
#include <hip/hip_runtime.h>
#include <hip/hip_cooperative_groups.h>
#include <cstdio>
#include <cstdint>
namespace cg = cooperative_groups;

#define LAS __attribute__((address_space(3)))
typedef unsigned short bf16_t;
typedef short bf16x8 __attribute__((ext_vector_type(8)));
typedef float f32x4 __attribute__((ext_vector_type(4)));
typedef float f32x2 __attribute__((ext_vector_type(2)));
typedef unsigned u32x2 __attribute__((ext_vector_type(2)));
typedef unsigned u32x4 __attribute__((ext_vector_type(4)));

constexpr int MP = 16384, MS = 1024, MT = MP + MS;
constexpr int NT = 512;
#define REP_P0 1
#define REP_GIN 1
#define REP_ATT 1
#define REP_RA 1
#define REP_SYNC 0
#define REP_R3 1
#define REP_SCAN 1
#define REP_ROW 1
#define REP_GN1 1
constexpr int LDS_BYTES = 140 * 1024;
constexpr float EPS = 1e-6f;

constexpr size_t OFF_YP = 0, OFF_YS = 16777216, OFF_KWP = 17825792, OFF_VWP = 17956864, OFF_KWS = 18087936, OFF_VWS = 22282240, OFF_RSP = 26476544, OFF_RSS = 28573696;

constexpr size_t al256(size_t x) { return (x + 255) & ~(size_t)255; }
constexpr size_t WS_WT_IN_ATTN = 0;
constexpr size_t WS_WT_OUT_ATTN = WS_WT_IN_ATTN + (size_t)2560 * 1024 * 2;
constexpr size_t WS_WT_IN_RET = WS_WT_OUT_ATTN + (size_t)1024 * 1024 * 2;
constexpr size_t WS_WT_OUT_RET = WS_WT_IN_RET + (size_t)6144 * 1024 * 2;
constexpr size_t WS_WT_GATE = WS_WT_OUT_RET + (size_t)1024 * 2048 * 2;
constexpr size_t WS_WT_PLE = WS_WT_GATE + (size_t)2 * 1024 * 1024 * 2;
constexpr size_t WS_TABA = WS_WT_PLE + (size_t)2 * 1024 * 256 * 2;
constexpr size_t WS_TABR = WS_TABA + (size_t)4104 * 32 * 8;
constexpr size_t WS_H = al256(WS_TABR + (size_t)4104 * 128 * 8);
constexpr size_t WS_PB = WS_H + (size_t)MT * 1024 * 2;
constexpr size_t WS_PLE = WS_PB + (size_t)2 * MT * 256 * 2;
constexpr size_t WS_Y = WS_PLE + (size_t)MT * 1024 * 4;
constexpr size_t WS_X1 = WS_Y + (size_t)MT * 1024 * 4;
constexpr size_t WS_X2 = WS_X1 + (size_t)MT * 1024 * 4;
constexpr size_t WS_OG = WS_X2 + (size_t)MT * 1024 * 4;
constexpr size_t WS_ZQ = WS_OG + (size_t)MT * 2048 * 2;
constexpr size_t WS_ZK = WS_ZQ + (size_t)MT * 1024 * 2;
constexpr size_t WS_ZG = WS_ZK + (size_t)MT * 1024 * 2;
constexpr size_t WS_VTP = WS_ZG + (size_t)MT * 2048 * 2;
constexpr size_t WS_VTS = WS_VTP + (size_t)16 * 512 * 4096 * 2;
constexpr size_t WS_ABUF = WS_VTS + (size_t)128 * 4 * 512 * 8 * 2;
constexpr size_t WS_KDT = WS_ABUF + (size_t)512 * 128 * 128 * 2;
constexpr size_t WS_ORET = WS_KDT + (size_t)512 * 256 * 128 * 2;
constexpr size_t WS_BAR = WS_ORET + (size_t)MT * 2048 * 4;
constexpr size_t WS_END = WS_BAR + 16384;

struct Params {
    const float *x_prompt, *x_sample, *cache_k, *cache_v, *state_ret, *p_prompt, *p_sample, *pre_norm, *post_norm, *w_in_attn, *sinks, *w_out_attn, *w_in_ret, *w_out_ret, *w_ple, *w_gate;
    float* out; unsigned char* ws;
};

__device__ __forceinline__ unsigned cvt_pk_bf16(float lo, float hi) { unsigned r; asm volatile("v_cvt_pk_bf16_f32 %0, %1, %2" : "=v"(r) : "v"(lo), "v"(hi)); return r; }
__device__ __forceinline__ u32x2 pk4(f32x4 v) { u32x2 w; w.x = cvt_pk_bf16(v[0], v[1]); w.y = cvt_pk_bf16(v[2], v[3]); return w; }
__device__ __forceinline__ float bf2f(bf16_t b) { return __uint_as_float(((unsigned)b) << 16); }
__device__ __forceinline__ float bflo(unsigned w) { return __uint_as_float(w << 16); }
__device__ __forceinline__ float bfhi(unsigned w) { return __uint_as_float(w & 0xffff0000u); }
__device__ __forceinline__ float silu_f(float x) { return x * __builtin_amdgcn_rcpf(1.f + __expf(-x)); }
__device__ __forceinline__ float sigmoid_f(float x) { return __builtin_amdgcn_rcpf(1.f + __expf(-x)); }
__device__ __forceinline__ float wave_sum(float v) {
#pragma unroll
    for (int o = 32; o >= 1; o >>= 1) v += __shfl_xor(v, o, 64);
    return v;
}
__device__ __forceinline__ int otid() { int t = threadIdx.x; asm volatile("" : "+v"(t)); return t; }
__device__ __forceinline__ void lds_barrier() { asm volatile("s_waitcnt lgkmcnt(0)" ::: "memory"); __builtin_amdgcn_s_barrier(); asm volatile("" ::: "memory"); }
__device__ __forceinline__ float ret_lg(int h) { return h == 0 ? -3.1748698315e-02f : h == 1 ? -1.5748356968e-02f : h == 2 ? -7.8431774610e-03f : -3.9138993211e-03f; }

#define XB_TMO      128
#define XB_XCNT(j)  (256  + 64 * (j))
#define XB_XSUB(j)  (1280 + 64 * (j))
#define XB_XGEN(j)  (2304 + 64 * (j))
#define XB_TOP      3328
#define XB_TOPGEN   3392
#define XCD_BAR_WORDS 3456
#define XB_SPIN_CAP (1u << 18)

__device__ __forceinline__ unsigned xb_ld(unsigned* p)              { return __hip_atomic_load(p, __ATOMIC_RELAXED, __HIP_MEMORY_SCOPE_AGENT); }
__device__ __forceinline__ unsigned xb_add(unsigned* p, unsigned v) { return __hip_atomic_fetch_add(p, v, __ATOMIC_RELAXED, __HIP_MEMORY_SCOPE_AGENT); }
__device__ __forceinline__ unsigned xb_xcc_id() { return (unsigned)__builtin_amdgcn_s_getreg((3 << 11) | 20) & 0xFu; }
#define XB_SPIN(cond, bar) do { unsigned _sp = 0; while (cond) { __builtin_amdgcn_s_sleep(1); \
    if ((++_sp & 255u) == 0u) { if (xb_ld(&(bar)[XB_TMO])) break; if (_sp > XB_SPIN_CAP) { atomicAdd(&(bar)[XB_TMO], 1u); break; } } } } while (0)

struct XcdBarrier {
    unsigned* bar; unsigned x;
    volatile LAS unsigned* st;
};

__device__ __forceinline__ XcdBarrier xcd_barrier_post(unsigned* bar, volatile LAS unsigned* st) {
    XcdBarrier b; b.bar = bar; b.x = xb_xcc_id(); b.st = st;
    if (threadIdx.x == 0) (void)xb_add(&bar[XB_XCNT(b.x)], 1u);
    return b;
}
__device__ __forceinline__ void xcd_barrier_complete(unsigned* bar, unsigned x, unsigned& nloc, unsigned& nx) {
    const unsigned G = gridDim.x * gridDim.y * gridDim.z;
    unsigned sum, cnt, mine, sp = 0u;
    for (;;) {
        sum = 0u; cnt = 0u; mine = 0u;
#pragma unroll
        for (unsigned j = 0; j < 16; ++j) { const unsigned c = xb_ld(&bar[XB_XCNT(j)]); sum += c; cnt += (c > 0u) ? 1u : 0u; mine = (j == x) ? c : mine; }
        if (sum == G) break;
        __builtin_amdgcn_s_sleep(1);
        if ((++sp & 255u) == 0u) { if (xb_ld(&bar[XB_TMO])) break; if (sp > XB_SPIN_CAP) { atomicAdd(&bar[XB_TMO], 1u); break; } }
    }
    nloc = mine > 0u ? mine : 1u; nx = cnt > 0u ? cnt : 1u;
}

__device__ __forceinline__ void xcd_barrier(const XcdBarrier& b) {
    asm volatile("s_waitcnt vmcnt(0)" ::: "memory");
    __syncthreads();
    if (threadIdx.x == 0) {
        unsigned* bar = b.bar;
        __builtin_amdgcn_s_waitcnt(0);
        unsigned nloc = b.st[0], nx = b.st[1];
        if (nloc == 0u) { xcd_barrier_complete(bar, b.x, nloc, nx); b.st[0] = nloc; b.st[1] = nx; }
        const unsigned old = xb_add(&bar[XB_XSUB(b.x)], 1u);
        const unsigned gen = old / nloc;
        if (old + 1u == (gen + 1u) * nloc) {
            __builtin_amdgcn_fence(__ATOMIC_RELEASE, "agent");
            asm volatile("s_waitcnt vmcnt(0)" ::: "memory");
            const unsigned og = xb_add(&bar[XB_TOP], 1u);
            const unsigned tg = og / nx;
            if (og + 1u == (tg + 1u) * nx) xb_add(&bar[XB_TOPGEN], 1u);
            else XB_SPIN(xb_ld(&bar[XB_TOPGEN]) == tg, bar);
            __builtin_amdgcn_fence(__ATOMIC_ACQUIRE, "agent");
            xb_add(&bar[XB_XGEN(b.x)], 1u);
            asm volatile("s_waitcnt vmcnt(0)" ::: "memory");
        } else {
            XB_SPIN(xb_ld(&bar[XB_XGEN(b.x)]) == gen, bar);
            __builtin_amdgcn_fence(__ATOMIC_ACQUIRE, "agent");
            asm volatile("s_waitcnt vmcnt(0)" ::: "memory");
        }
    }
    __syncthreads();
}

namespace pg8 {
constexpr int BM = 256, BK = 64, HALF = 128, HTB = HALF * BK * 2, STAGE_BYTES = 8 * HTB, NXCD = 8, WGM = 8;
__host__ __device__ __forceinline__ int lds_byte(int r, int c) { const int st = (r >> 4) * 2 + (c >> 5), rr = r & 15, cc = c & 31, ob = rr * 64 + cc * 2; return st * 1024 + (ob ^ (((ob >> 9) & 1) << 5)); }
__host__ __device__ __forceinline__ void stage_rc(int b, int& R, int& C) { const int st = b / 1024, sb = b % 1024, swz = sb ^ (((sb >> 9) & 1) << 5); R = (st >> 1) * 16 + swz / 64; C = (st & 1) * 32 + (swz % 64) / 2; }
struct Unit { int pm, pn; };
struct Gemm { const bf16_t* A; const bf16_t* Bt; int M, N, K; };
struct StaticOrder {
    int nM, nN, nwg, G, c;
    __host__ __device__ void init(int M, int N, int G_, int c_) { nM = M / BM; nN = N / BM; nwg = nM * nN; G = G_; c = c_; }
    __host__ __device__ bool next(int i, Unit& u) const {
        const long L = (long)i * G + c; if (L >= nwg) return false;
        int wgid = (int)L; { const int q = nwg / NXCD, r = nwg % NXCD, xcd = wgid % NXCD, off = wgid / NXCD; wgid = (xcd < r ? xcd * (q + 1) : r * (q + 1) + (xcd - r) * q) + off; }
        const int nig = WGM * nN, gid = wgid / nig, fm = gid * WGM, gsz = (nM - fm) < WGM ? (nM - fm) : WGM;
        u.pm = fm + ((wgid % nig) % gsz); u.pn = (wgid % nig) / gsz; return true;
    }
};

struct TailOrder {
    int first, nblk, nwg, c;
    __host__ __device__ void init(int M, int first_, int G_, int c_) { nwg = (M / BM) * 4; first = first_; nblk = G_ - first_; c = c_; }
    __host__ __device__ bool next(int i, Unit& u) const { if (c < first) return false; const int L = (c - first) + i * nblk; if (L >= nwg) return false; u.pm = L >> 2; u.pn = L & 3; return true; }
};

template <class Epi, class Sched>
__device__ __forceinline__ void gemm_phase(LAS unsigned char* lds, const Gemm g, const Sched& S, const Epi& E) {
    const int tid = otid(), wid = __builtin_amdgcn_readfirstlane(tid >> 6), lane = tid & 63, wr = wid >> 2, wc = wid & 3, fr = lane & 15, fq = lane >> 4;
    const int K = g.K, nt = K / BK;
    unsigned voffA[2], voffB[2];
#pragma unroll
    for (int i = 0; i < 2; ++i) { int R, C; stage_rc(tid * 16 + i * 8192, R, C); voffA[i] = (unsigned)(R * K + C) * 2u; voffB[i] = voffA[i]; }
    const size_t kstep = (size_t)(BK * 2);
    const size_t hstep = (size_t)HALF * K * 2;
    const size_t tstep = 2 * hstep;
    const unsigned ldsw = (unsigned)wid * 1024u;
    const int aoff = lds_byte(wr * 64 + fr, fq * 8), boff = lds_byte(wc * 32 + fr, fq * 8);
#define PG8_SA(b, h) (((b) * 2 + (h)) * HTB)
#define PG8_SB(b, h) ((4 + (b) * 2 + (h)) * HTB)
#define PG8_STAGE(bufoff, gbase, voff) do { _Pragma("unroll") for (int _i = 0; _i < 2; ++_i) \
        __builtin_amdgcn_global_load_lds((const unsigned*)((const char*)(gbase) + (voff)[_i]), (LAS unsigned*)(lds + (bufoff) + ldsw + _i * 8192), 16, 0, 0); } while (0)
#define PG8_LDA(dst, b, h) do { _Pragma("unroll") for (int m = 0; m < 4; ++m) _Pragma("unroll") for (int k = 0; k < 2; ++k) dst[m][k] = *(const LAS bf16x8*)(lds + PG8_SA(b, h) + aoff + m * 2048 + k * 1024); } while (0)
#define PG8_LDB(dst, b, h) do { _Pragma("unroll") for (int n = 0; n < 2; ++n) _Pragma("unroll") for (int k = 0; k < 2; ++k) dst[n][k] = *(const LAS bf16x8*)(lds + PG8_SB(b, h) + boff + n * 2048 + k * 1024); } while (0)
#define PG8_MMA(ai, bj, At, Bt) do { __builtin_amdgcn_s_setprio(1); _Pragma("unroll") for (int m = 0; m < 4; ++m) _Pragma("unroll") for (int n = 0; n < 2; ++n) _Pragma("unroll") for (int k = 0; k < 2; ++k) \
        acc[ai][bj][m][n] = __builtin_amdgcn_mfma_f32_16x16x32_bf16(Bt[n][k], At[m][k], acc[ai][bj][m][n], 0, 0, 0); __builtin_amdgcn_s_setprio(0); } while (0)
#define PG8_WAIT_V(n) asm volatile("s_waitcnt vmcnt(" #n ")" ::: "memory")
#define PG8_WAIT_L(n) asm volatile("s_waitcnt lgkmcnt(" #n ")" ::: "memory")
#define PG8_BAR __builtin_amdgcn_s_barrier()
#define PG8_SCHED __builtin_amdgcn_sched_barrier(0)
#define PG8_PTRS(u, pa, pb) do { const char* _a = (const char*)g.A + (size_t)(u).pm * tstep; const char* _b = (const char*)g.Bt + (size_t)(u).pn * tstep; if (Epi::swap(u)) { pa = _b; pb = _a; } else { pa = _a; pb = _b; } } while (0)
    Unit cur, nxt; int ui = 0;
    if (!S.next(0, cur)) return;
    f32x4 acc[2][2][4][2];
#pragma unroll
    for (int a = 0; a < 2; ++a)
#pragma unroll
        for (int b = 0; b < 2; ++b)
#pragma unroll
            for (int m = 0; m < 4; ++m)
#pragma unroll
                for (int n = 0; n < 2; ++n) acc[a][b][m][n] = (f32x4){0.f, 0.f, 0.f, 0.f};
    bf16x8 At[4][2], B0[2][2], B1[2][2];
    const char* cA; const char* cB;
    PG8_PTRS(cur, cA, cB);
    PG8_STAGE(PG8_SB(0, 0), cB, voffB); PG8_STAGE(PG8_SA(0, 0), cA, voffA); PG8_STAGE(PG8_SB(0, 1), cB + hstep, voffB); PG8_STAGE(PG8_SA(0, 1), cA + hstep, voffA);
    if (wr == 1) PG8_BAR;
    PG8_WAIT_V(4); PG8_BAR;
    PG8_STAGE(PG8_SB(1, 0), cB + kstep, voffB); PG8_STAGE(PG8_SA(1, 0), cA + kstep, voffA); PG8_STAGE(PG8_SB(1, 1), cB + hstep + kstep, voffB);
    PG8_WAIT_V(6); PG8_BAR;
    for (;;) {
        const bool has_next = S.next(ui + 1, nxt);
        const char* nA = cA; const char* nB = cB;
        if (has_next) PG8_PTRS(nxt, nA, nB);
        for (int t = 0; t < nt; t += 2) {
            const bool last = (t == nt - 2);
            const char* a1 = cA + (size_t)(t + 1) * kstep;
            const char* a2 = last ? nA : cA + (size_t)(t + 2) * kstep; const char* b2 = last ? nB : cB + (size_t)(t + 2) * kstep;
            const char* a3 = a2 + kstep; const char* b3 = b2 + kstep;
            PG8_LDB(B0, 0, 0); PG8_SCHED; PG8_LDA(At, 0, 0); PG8_STAGE(PG8_SA(1, 1), a1 + hstep, voffA);
            PG8_WAIT_L(8); PG8_BAR; PG8_WAIT_L(0); PG8_MMA(0, 0, At, B0); PG8_BAR; PG8_SCHED;
            PG8_LDB(B1, 0, 1); PG8_STAGE(PG8_SB(0, 0), b2, voffB);
            PG8_BAR; PG8_WAIT_L(0); PG8_MMA(0, 1, At, B1); PG8_BAR;
            PG8_LDA(At, 0, 1); PG8_STAGE(PG8_SA(0, 0), a2, voffA);
            PG8_BAR; PG8_WAIT_L(0); PG8_MMA(1, 0, At, B0); PG8_BAR; PG8_SCHED;
            PG8_STAGE(PG8_SB(0, 1), b2 + hstep, voffB);
            PG8_WAIT_V(6); PG8_BAR; PG8_MMA(1, 1, At, B1); PG8_BAR;
            PG8_LDB(B0, 1, 0); PG8_SCHED; PG8_LDA(At, 1, 0); PG8_STAGE(PG8_SA(0, 1), a2 + hstep, voffA);
            PG8_WAIT_L(8); PG8_BAR; PG8_WAIT_L(0); PG8_MMA(0, 0, At, B0); PG8_BAR; PG8_SCHED;
            PG8_LDB(B1, 1, 1); PG8_STAGE(PG8_SB(1, 0), b3, voffB);
            PG8_BAR; PG8_WAIT_L(0); PG8_MMA(0, 1, At, B1); PG8_BAR;
            PG8_LDA(At, 1, 1); PG8_STAGE(PG8_SA(1, 0), a3, voffA);
            PG8_BAR; PG8_WAIT_L(0); PG8_MMA(1, 0, At, B0); PG8_BAR; PG8_SCHED;
            PG8_STAGE(PG8_SB(1, 1), b3 + hstep, voffB);
            PG8_WAIT_V(6); PG8_BAR; PG8_MMA(1, 1, At, B1); PG8_BAR;
        }
        E(acc, cur, wr, wc, fr, fq);
        if (!has_next) break;
#pragma unroll
        for (int a = 0; a < 2; ++a)
#pragma unroll
            for (int b = 0; b < 2; ++b)
#pragma unroll
                for (int m = 0; m < 4; ++m)
#pragma unroll
                    for (int n = 0; n < 2; ++n) acc[a][b][m][n] = (f32x4){0.f, 0.f, 0.f, 0.f};
        cur = nxt; cA = nA; cB = nB; ++ui;
    }
    PG8_WAIT_V(0);
    if (wr == 0) PG8_BAR;
    PG8_BAR;
#undef PG8_SA
#undef PG8_SB
#undef PG8_STAGE
#undef PG8_LDA
#undef PG8_LDB
#undef PG8_MMA
#undef PG8_WAIT_V
#undef PG8_WAIT_L
#undef PG8_BAR
#undef PG8_SCHED
#undef PG8_PTRS
}
}
using pg8::Unit;

struct EpiF32 {
    float* C; int ldc;
    __device__ __forceinline__ static bool swap(const Unit&) { return false; }
    __device__ __forceinline__ void operator()(const f32x4 (&acc)[2][2][4][2], const Unit& u, int wr, int wc, int fr, int fq) const {
        const int row0 = u.pm * 256 + wr * 64 + fr, col0 = u.pn * 256 + wc * 32 + 4 * fq;
#pragma unroll
        for (int ai = 0; ai < 2; ++ai)
#pragma unroll
            for (int m = 0; m < 4; ++m) { float* rowp = C + (size_t)(row0 + ai * 128 + m * 16) * ldc + col0;
#pragma unroll
                for (int bj = 0; bj < 2; ++bj)
#pragma unroll
                    for (int n = 0; n < 2; ++n) *(f32x4*)(rowp + bj * 128 + n * 16) = acc[ai][bj][m][n]; }
    }
};
struct EpiB16 {
    bf16_t* C; int ldc;
    __device__ __forceinline__ static bool swap(const Unit&) { return false; }
    __device__ __forceinline__ void operator()(const f32x4 (&acc)[2][2][4][2], const Unit& u, int wr, int wc, int fr, int fq) const {
        const int row0 = u.pm * 256 + wr * 64 + fr, col0 = u.pn * 256 + wc * 32 + 4 * fq;
#pragma unroll
        for (int ai = 0; ai < 2; ++ai)
#pragma unroll
            for (int m = 0; m < 4; ++m) { bf16_t* rowp = C + (size_t)(row0 + ai * 128 + m * 16) * ldc + col0;
#pragma unroll
                for (int bj = 0; bj < 2; ++bj)
#pragma unroll
                    for (int n = 0; n < 2; ++n) *(u32x2*)(rowp + bj * 128 + n * 16) = pk4(acc[ai][bj][m][n]); }
    }
};
template <bool OB16> struct EpiGate {
    const bf16_t* X1; const bf16_t* PLE; float* O; bf16_t* Ob;
    __device__ __forceinline__ static bool swap(const Unit&) { return false; }
    __device__ __forceinline__ void operator()(const f32x4 (&acc)[2][2][4][2], const Unit& u, int wr, int wc, int fr, int fq) const {
        const int row0 = u.pm * 256 + wr * 64 + fr, col0 = u.pn * 256 + wc * 32 + 4 * fq;
#pragma unroll
        for (int ai = 0; ai < 2; ++ai)
#pragma unroll
            for (int m = 0; m < 4; ++m) { const size_t ro = (size_t)(row0 + ai * 128 + m * 16) * 1024 + col0;
#pragma unroll
                for (int bj = 0; bj < 2; ++bj)
#pragma unroll
                    for (int n = 0; n < 2; ++n) { const size_t o = ro + bj * 128 + n * 16; const f32x4 a = acc[ai][bj][m][n]; const u32x2 xw = *(const u32x2*)(X1 + o), pw = *(const u32x2*)(PLE + o);
                        const f32x4 x1 = {bflo(xw.x), bfhi(xw.x), bflo(xw.y), bfhi(xw.y)}, pl = {bflo(pw.x), bfhi(pw.x), bflo(pw.y), bfhi(pw.y)}; f32x4 r;
#pragma unroll
                        for (int j = 0; j < 4; ++j) r[j] = x1[j] + sigmoid_f(a[j]) * pl[j];
                        if (OB16) *(u32x2*)(Ob + o) = pk4(r); else *(f32x4*)(O + o) = r; } }
    }
};
struct EpiInAttn {
    bf16_t *Zq, *Zk, *Zg, *vTp, *vTs; const float* tab; float* out;
    __device__ __forceinline__ static bool swap(const Unit& u) { return u.pn == 5; }
    __device__ __forceinline__ void operator()(const f32x4 (&acc)[2][2][4][2], const Unit& u, int wr, int wc, int fr, int fq) const {
        const int pn = u.pn;
        if (pn < 5) {
            const bool isq = pn < 4;
            const int fi = 16 * (wc & 1) + 4 * fq;
#pragma unroll
            for (int ai = 0; ai < 2; ++ai)
#pragma unroll
                for (int m = 0; m < 4; ++m) {
                    const int r = u.pm * 256 + ai * 128 + wr * 64 + m * 16 + fr;
                    const int pi = r < MP ? (r & 4095) : 4096 + ((r - MP) & 7);
                    const f32x4 t0 = *(const f32x4*)(tab + ((size_t)pi * 32 + fi) * 2), t1 = *(const f32x4*)(tab + ((size_t)pi * 32 + fi) * 2 + 4);
                    const float cs[4] = {t0[0], t0[2], t1[0], t1[2]}, sn[4] = {t0[1], t0[3], t1[1], t1[3]};
#pragma unroll
                    for (int bj = 0; bj < 2; ++bj) {
                        const f32x4 x1 = acc[ai][bj][m][0], x2 = acc[ai][bj][m][1]; f32x4 o1, o2;
#pragma unroll
                        for (int j = 0; j < 4; ++j) { o1[j] = x1[j] * cs[j] - x2[j] * sn[j]; o2[j] = x2[j] * cs[j] + x1[j] * sn[j]; }
                        const int hh = 2 * bj + (wc >> 1), d1 = 16 * (wc & 1) + 4 * fq;
                        if (isq) {
                            bf16_t* p = Zq + (size_t)r * 1024 + pn * 256 + hh * 64 + d1;
                            *(u32x2*)p = pk4(o1 * 0.125f); *(u32x2*)(p + 32) = pk4(o2 * 0.125f);
                        } else {
                            bf16_t* p = Zk + (size_t)r * 256 + hh * 64 + d1;
                            *(u32x2*)p = pk4(o1); *(u32x2*)(p + 32) = pk4(o2);
                            if (r < MP) { const int t = r & 4095; if (t >= 3968) { float* dst = out + OFF_KWP + ((size_t)((r >> 12) * 128 + t - 3968) * 4 + hh) * 64 + d1; *(f32x4*)dst = o1; *(f32x4*)(dst + 32) = o2; } }
                            else { const int rs = r - MP; float* dst = out + OFF_KWS + ((size_t)((rs >> 3) * 128 + 120 + (rs & 7)) * 4 + hh) * 64 + d1; *(f32x4*)dst = o1; *(f32x4*)(dst + 32) = o2; }
                        }
                    }
                    asm volatile("" ::: "memory");
                }
        } else if (pn == 5) {
#pragma unroll
            for (int ai = 0; ai < 2; ++ai)
#pragma unroll
                for (int m = 0; m < 4; ++m) {
                    const int e = ai * 128 + wr * 64 + m * 16 + fr, kvh = e >> 6, d = e & 63;
#pragma unroll
                    for (int bj = 0; bj < 2; ++bj)
#pragma unroll
                        for (int n = 0; n < 2; ++n) {
                            const int tok = u.pm * 256 + bj * 128 + wc * 32 + n * 16 + 4 * fq; const f32x4 v = acc[ai][bj][m][n];
                            if (tok < MP) { const int b = tok >> 12, t = tok & 4095;
                                *(u32x2*)(vTp + ((size_t)((b * 4 + kvh) * 64 + d)) * 4096 + t) = pk4(v);
                                if (t >= 3968) {
#pragma unroll
                                    for (int jj = 0; jj < 4; ++jj) out[OFF_VWP + ((size_t)(b * 128 + t - 3968 + jj) * 4 + kvh) * 64 + d] = v[jj]; }
                            } else { const int ts = tok - MP, bs = ts >> 3, l0 = ts & 7;
                                *(u32x2*)(vTs + ((size_t)((bs * 4 + kvh) * 64 + d)) * 8 + l0) = pk4(v);
#pragma unroll
                                for (int jj = 0; jj < 4; ++jj) out[OFF_VWS + ((size_t)(bs * 128 + 120 + l0 + jj) * 4 + kvh) * 64 + d] = v[jj]; }
                        }
                }
        } else {
#pragma unroll
            for (int ai = 0; ai < 2; ++ai)
#pragma unroll
                for (int m = 0; m < 4; ++m) { const int r = u.pm * 256 + ai * 128 + wr * 64 + m * 16 + fr;
#pragma unroll
                    for (int bj = 0; bj < 2; ++bj)
#pragma unroll
                        for (int n = 0; n < 2; ++n) { const f32x4 a = acc[ai][bj][m][n]; f32x4 s;
#pragma unroll
                            for (int j = 0; j < 4; ++j) s[j] = silu_f(a[j]);
                            *(u32x2*)(Zg + (size_t)r * 1024 + (pn - 6) * 256 + bj * 128 + wc * 32 + n * 16 + 4 * fq) = pk4(s); } }
        }
    }
};
struct EpiInRet {
    bf16_t *Zq, *Zk, *Zg, *vTp, *vTs; const float* tab;
    __device__ __forceinline__ static bool swap(const Unit& u) { return u.pn >= 8 && u.pn < 16; }
    __device__ __forceinline__ void operator()(const f32x4 (&acc)[2][2][4][2], const Unit& u, int wr, int wc, int fr, int fq) const {
        const int pn = u.pn;
        if (pn < 8) {
            const bool isq = pn < 4; const float sc = isq ? 1.f : 0.0625f;
            bf16_t* Z = isq ? Zq : Zk; const int hc = (pn & 3) * 256;
#pragma unroll
            for (int ai = 0; ai < 2; ++ai)
#pragma unroll
                for (int m = 0; m < 4; ++m) {
                    const int r = u.pm * 256 + ai * 128 + wr * 64 + m * 16 + fr;
                    const int pi = r < MP ? (r & 4095) : 4096 + ((r - MP) & 7);
#pragma unroll
                    for (int n = 0; n < 2; ++n) {
                        const int d = wc * 32 + n * 16 + 4 * fq;
                        const f32x4 t0 = *(const f32x4*)(tab + ((size_t)pi * 128 + d) * 2), t1 = *(const f32x4*)(tab + ((size_t)pi * 128 + d) * 2 + 4);
                        const float cs[4] = {t0[0], t0[2], t1[0], t1[2]}, sn[4] = {t0[1], t0[3], t1[1], t1[3]};
                        const f32x4 x1 = acc[ai][0][m][n], x2 = acc[ai][1][m][n]; f32x4 o1, o2;
#pragma unroll
                        for (int j = 0; j < 4; ++j) { o1[j] = (x1[j] * cs[j] - x2[j] * sn[j]) * sc; o2[j] = (x2[j] * cs[j] + x1[j] * sn[j]) * sc; }
                        bf16_t* p = Z + (size_t)r * 1024 + hc + d;
                        *(u32x2*)p = pk4(o1); *(u32x2*)(p + 128) = pk4(o2);
                    }
                }
        } else if (pn < 16) {
#pragma unroll
            for (int ai = 0; ai < 2; ++ai)
#pragma unroll
                for (int m = 0; m < 4; ++m) {
                    const int eg = (pn - 8) * 256 + ai * 128 + wr * 64 + m * 16 + fr, h = eg >> 9, e = eg & 511;
#pragma unroll
                    for (int bj = 0; bj < 2; ++bj)
#pragma unroll
                        for (int n = 0; n < 2; ++n) {
                            const int tok = u.pm * 256 + bj * 128 + wc * 32 + n * 16 + 4 * fq; const u32x2 w = pk4(acc[ai][bj][m][n]);
                            if (tok < MP) { const int b = tok >> 12, t = tok & 4095; *(u32x2*)(vTp + ((size_t)((b * 4 + h) * 512 + e)) * 4096 + t) = w; }
                            else { const int ts = tok - MP, bs = ts >> 3, l0 = ts & 7; *(u32x2*)(vTs + ((size_t)((bs * 4 + h) * 512 + e)) * 8 + l0) = w; }
                        }
                }
        } else {
#pragma unroll
            for (int ai = 0; ai < 2; ++ai)
#pragma unroll
                for (int m = 0; m < 4; ++m) { const int r = u.pm * 256 + ai * 128 + wr * 64 + m * 16 + fr;
#pragma unroll
                    for (int bj = 0; bj < 2; ++bj)
#pragma unroll
                        for (int n = 0; n < 2; ++n) { const f32x4 a = acc[ai][bj][m][n]; f32x4 s;
#pragma unroll
                            for (int j = 0; j < 4; ++j) s[j] = silu_f(a[j]);
                            *(u32x2*)(Zg + (size_t)r * 2048 + (pn - 16) * 256 + bj * 128 + wc * 32 + n * 16 + 4 * fq) = pk4(s); } }
        }
    }
};

__device__ __forceinline__ void transpose_tile(const float* __restrict__ W, bf16_t* __restrict__ Wt, int K, int N, bool perm, int tile, LAS float* T) {
    const int tid = otid(), ntn = N >> 6;
    const int n0 = (tile % ntn) * 64, k0 = (tile / ntn) * 64, nn = tid & 63;
    const int nd = n0 + nn; int ns = nd;
    if (perm && nd < 1280) { const int p = nd & 63; ns = (nd - p) + (p >> 5) * 16 + (p & 15) + ((p >> 4) & 1) * 32; }
#pragma unroll
    for (int i = 0; i < 8; ++i) { const int kk = (tid >> 6) + 8 * i; T[kk * 65 + nn] = W[(size_t)(k0 + kk) * N + ns]; }
    __syncthreads();
    const int kk2 = (tid & 31) * 2;
#pragma unroll
    for (int i = 0; i < 4; ++i) { const int n2 = (tid >> 5) + 16 * i; *(unsigned*)(Wt + (size_t)(n0 + n2) * K + k0 + kk2) = cvt_pk_bf16(T[kk2 * 65 + n2], T[(kk2 + 1) * 65 + n2]); }
    __syncthreads();
}

__device__ __forceinline__ void rms_rows(const float* __restrict__ Xa, const float* __restrict__ Xb, const float* __restrict__ g, bf16_t* __restrict__ H, int G) {
    const int tid_o = otid(), wave = tid_o >> 6, lane = tid_o & 63;
    for (int row = blockIdx.x * 8 + wave; row < MT; row += G * 8) {
        const float* x = row < MP ? Xa + (size_t)row * 1024 : Xb + (size_t)(row - MP) * 1024;
        f32x4 v[4]; float ss = 0.f;
#pragma unroll
        for (int i = 0; i < 4; ++i) { v[i] = *(const f32x4*)(x + lane * 4 + 256 * i); ss += v[i][0] * v[i][0] + v[i][1] * v[i][1] + v[i][2] * v[i][2] + v[i][3] * v[i][3]; }
        ss = wave_sum(ss);
        const float rr = rsqrtf(ss * (1.f / 1024.f) + EPS);
#pragma unroll
        for (int i = 0; i < 4; ++i) { const f32x4 gg = *(const f32x4*)(g + lane * 4 + 256 * i); *(u32x2*)(H + (size_t)row * 1024 + lane * 4 + 256 * i) = pk4(v[i] * rr * gg); }
    }
}
__device__ __forceinline__ void rms_rows_b16(const bf16_t* __restrict__ X, const float* __restrict__ g, bf16_t* __restrict__ H, int G) {
    const int tid_o = otid(), wave = tid_o >> 6, lane = tid_o & 63;
    for (int row = blockIdx.x * 8 + wave; row < MT; row += G * 8) {
        const u32x4 a = *(const u32x4*)(X + (size_t)row * 1024 + lane * 8), b = *(const u32x4*)(X + (size_t)row * 1024 + 512 + lane * 8);
        const float v[16] = {bflo(a.x), bfhi(a.x), bflo(a.y), bfhi(a.y), bflo(a.z), bfhi(a.z), bflo(a.w), bfhi(a.w), bflo(b.x), bfhi(b.x), bflo(b.y), bfhi(b.y), bflo(b.z), bfhi(b.z), bflo(b.w), bfhi(b.w)};
        float ss = 0.f;
#pragma unroll
        for (int i = 0; i < 16; ++i) ss += v[i] * v[i];
        ss = wave_sum(ss);
        const float rr = rsqrtf(ss * (1.f / 1024.f) + EPS);
#pragma unroll
        for (int hh = 0; hh < 2; ++hh) { const int c = hh * 512 + lane * 8; const f32x4 g0 = *(const f32x4*)(g + c), g1 = *(const f32x4*)(g + c + 4); u32x4 o;
            o.x = cvt_pk_bf16(v[hh * 8 + 0] * rr * g0[0], v[hh * 8 + 1] * rr * g0[1]); o.y = cvt_pk_bf16(v[hh * 8 + 2] * rr * g0[2], v[hh * 8 + 3] * rr * g0[3]);
            o.z = cvt_pk_bf16(v[hh * 8 + 4] * rr * g1[0], v[hh * 8 + 5] * rr * g1[1]); o.w = cvt_pk_bf16(v[hh * 8 + 6] * rr * g1[2], v[hh * 8 + 7] * rr * g1[3]);
            *(u32x4*)(H + (size_t)row * 1024 + c) = o; }
    }
}
template <bool XB16>
__device__ __forceinline__ void resid_rows(const float* __restrict__ Xa, const float* __restrict__ Xb, const bf16_t* __restrict__ Xh, const bf16_t* __restrict__ Y, const float* __restrict__ g, bf16_t* __restrict__ H, int G) {
    const int tid_o = otid(), wave = tid_o >> 6, lane = tid_o & 63;
    for (int row = blockIdx.x * 8 + wave; row < MT; row += G * 8) {
        const bf16_t* y = Y + (size_t)row * 1024;
        f32x4 v[4]; float ss = 0.f;
#pragma unroll
        for (int i = 0; i < 4; ++i) { const u32x2 yw = *(const u32x2*)(y + lane * 4 + 256 * i); v[i] = (f32x4){bflo(yw.x), bfhi(yw.x), bflo(yw.y), bfhi(yw.y)}; ss += v[i][0] * v[i][0] + v[i][1] * v[i][1] + v[i][2] * v[i][2] + v[i][3] * v[i][3]; }
        ss = wave_sum(ss);
        const float rr = rsqrtf(ss * (1.f / 1024.f) + EPS);
#pragma unroll
        for (int i = 0; i < 4; ++i) { const int c = lane * 4 + 256 * i; const f32x4 gg = *(const f32x4*)(g + c); f32x4 xx;
            if (XB16) { const u32x2 xw = *(const u32x2*)(Xh + (size_t)row * 1024 + c); xx = (f32x4){bflo(xw.x), bfhi(xw.x), bflo(xw.y), bfhi(xw.y)}; }
            else xx = *(const f32x4*)((row < MP ? Xa + (size_t)row * 1024 : Xb + (size_t)(row - MP) * 1024) + c);
            *(u32x2*)(H + (size_t)row * 1024 + c) = pk4(xx + v[i] * rr * gg); }
    }
}

struct SkF32 { float* C; __device__ __forceinline__ void operator()(int row, int col, f32x4 v) const { *(f32x4*)(C + (size_t)row * 1024 + col) = v; } };
struct SkB16 { bf16_t* C; __device__ __forceinline__ void operator()(int row, int col, f32x4 v) const { *(u32x2*)(C + (size_t)row * 1024 + col) = pk4(v); } };
template <bool OB16> struct SkGate { const bf16_t* X1; const bf16_t* PLE; float* O; bf16_t* Ob;
    __device__ __forceinline__ void operator()(int row, int col, f32x4 a) const { const size_t o = (size_t)row * 1024 + col; const u32x2 xw = *(const u32x2*)(X1 + o), pw = *(const u32x2*)(PLE + o);
        const f32x4 x1 = {bflo(xw.x), bfhi(xw.x), bflo(xw.y), bfhi(xw.y)}, pl = {bflo(pw.x), bfhi(pw.x), bflo(pw.y), bfhi(pw.y)}; f32x4 r;
#pragma unroll
        for (int j = 0; j < 4; ++j) r[j] = x1[j] + sigmoid_f(a[j]) * pl[j];
        if (OB16) *(u32x2*)(Ob + o) = pk4(r); else *(f32x4*)(O + o) = r; } };
template <class Epi>
__device__ __forceinline__ void skinny_gemm(LAS unsigned char* lds, const bf16_t* __restrict__ A, const bf16_t* __restrict__ Bt, int K, const Epi& E, int G) {
    LAS float* red = (LAS float*)lds;
    const int tid = otid(), w = tid >> 6, lane = tid & 63, l16 = lane & 15, g = lane >> 4;
    const int KS = K >> 3, nks = KS >> 5;
    for (int u = blockIdx.x; u < 256; u += G) {
        const int row0 = (u >> 4) * 64, col0 = (u & 15) * 64;
        const bf16_t* ap = A + (size_t)(row0 + l16) * K + w * KS + 8 * g;
        const bf16_t* bp = Bt + (size_t)(col0 + l16) * K + w * KS + 8 * g;
        f32x4 acc[4][4];
#pragma unroll
        for (int mt = 0; mt < 4; ++mt)
#pragma unroll
            for (int nt = 0; nt < 4; ++nt) acc[mt][nt] = (f32x4){0.f, 0.f, 0.f, 0.f};
#pragma unroll 4
        for (int ks = 0; ks < nks; ++ks) {
            bf16x8 af[4], bf[4];
#pragma unroll
            for (int t = 0; t < 4; ++t) { af[t] = *(const bf16x8*)(ap + (size_t)(16 * t) * K + 32 * ks); bf[t] = *(const bf16x8*)(bp + (size_t)(16 * t) * K + 32 * ks); }
#pragma unroll
            for (int mt = 0; mt < 4; ++mt)
#pragma unroll
                for (int nt = 0; nt < 4; ++nt) acc[mt][nt] = __builtin_amdgcn_mfma_f32_16x16x32_bf16(bf[nt], af[mt], acc[mt][nt], 0, 0, 0);
        }
        __syncthreads();
#pragma unroll
        for (int mt = 0; mt < 4; ++mt)
#pragma unroll
            for (int nt = 0; nt < 4; ++nt) *(LAS f32x4*)(red + (w * 64 + 16 * mt + l16) * 68 + 16 * nt + 4 * g) = acc[mt][nt];
        __syncthreads();
#pragma unroll
        for (int j = 0; j < 2; ++j) { const int q = tid + 512 * j, row = q >> 4, c4 = (q & 15) * 4; f32x4 sum = *(const LAS f32x4*)(red + row * 68 + c4);
#pragma unroll
            for (int ww = 1; ww < 8; ++ww) sum += *(const LAS f32x4*)(red + (ww * 64 + row) * 68 + c4);
            E(row0 + row, col0 + c4, sum); }
    }
}

__device__ __forceinline__ void attn_prompt(LAS unsigned char* lds, const bf16_t* __restrict__ Zq, const bf16_t* __restrict__ Zk, const bf16_t* __restrict__ Zg, const bf16_t* __restrict__ vTp,
                                            const float* __restrict__ sinks, bf16_t* __restrict__ OG, int G) {
    LAS bf16_t* Ks = (LAS bf16_t*)lds;
    LAS bf16_t* Vt = (LAS bf16_t*)(lds + 256 * 72 * 2);
    const int tid = otid(), w = tid >> 6, lane = tid & 63, l16 = lane & 15, g = lane >> 4;
    u32x4 pk_[4], pv_[4];
#define AP_LOAD(it_) do { const int kvh_ = (it_) & 3, nb_ = ((it_) >> 2) & 31, b_ = (it_) >> 7; \
        _Pragma("unroll") for (int i = 0; i < 4; ++i) { const int ch = tid + 512 * i, s = ch >> 3, c8 = ch & 7, t = (nb_ - 1) * 128 + s; \
            pk_[i] = (u32x4){0u, 0u, 0u, 0u}; if (t >= 0) pk_[i] = *(const u32x4*)(Zk + (size_t)(b_ * 4096 + t) * 256 + kvh_ * 64 + c8 * 8); } \
        _Pragma("unroll") for (int i = 0; i < 4; ++i) { const int ch = tid + 512 * i, d = ch >> 5, s0 = (ch & 31) * 8, t0 = (nb_ - 1) * 128 + s0; \
            pv_[i] = (u32x4){0u, 0u, 0u, 0u}; if (t0 >= 0) pv_[i] = *(const u32x4*)(vTp + ((size_t)((b_ * 4 + kvh_) * 64 + d)) * 4096 + t0); } } while (0)
    if ((int)blockIdx.x < 512) AP_LOAD((int)blockIdx.x);
    for (int it = blockIdx.x; it < 512; it += G) {
        const int kvh = it & 3, nb = (it >> 2) & 31, b = it >> 7;
        __syncthreads();
#pragma unroll
        for (int i = 0; i < 4; ++i) { const int ch = tid + 512 * i, s = ch >> 3, c8 = ch & 7; *(LAS u32x4*)(Ks + s * 72 + c8 * 8) = pk_[i]; }
#pragma unroll
        for (int i = 0; i < 4; ++i) { const int ch = tid + 512 * i, d = ch >> 5, s0 = (ch & 31) * 8; *(LAS u32x4*)(Vt + d * 264 + s0) = pv_[i]; }
        __syncthreads();
        if (it + G < 512) AP_LOAD(it + G);
        asm volatile("" ::: "memory");
        const int head = kvh * 4 + (w >> 1);
        const float sk = sinks[head];
        for (int qi = 0; qi < 4; ++qi) {
            const int qt = (w & 1) * 4 + qi;
            const size_t tq = (size_t)b * 4096 + nb * 128 + qt * 16 + l16;
            bf16x8 qf[2];
#pragma unroll
            for (int ks = 0; ks < 2; ++ks) qf[ks] = *(const bf16x8*)(Zq + tq * 1024 + head * 64 + ks * 32 + g * 8);
            f32x4 sa[9];
#pragma unroll
            for (int j = 0; j < 9; ++j) { sa[j] = (f32x4){0.f, 0.f, 0.f, 0.f};
#pragma unroll
                for (int ks = 0; ks < 2; ++ks) { const bf16x8 kf = *(const LAS bf16x8*)(Ks + (16 * (qt + j) + l16) * 72 + ks * 32 + g * 8);
                    sa[j] = __builtin_amdgcn_mfma_f32_16x16x32_bf16(kf, qf[ks], sa[j], 0, 0, 0); } }
            float mx = sk;
#pragma unroll
            for (int j = 0; j < 9; ++j)
#pragma unroll
                for (int r = 0; r < 4; ++r) {
                    bool vis = true;
                    if (j == 0) vis = (4 * g + r) > l16;
                    if (j == 8) vis = (4 * g + r) <= l16;
                    if (nb == 0 && (qt + j) < 8) vis = false;
                    sa[j][r] = vis ? sa[j][r] : -1e30f;
                    mx = fmaxf(mx, sa[j][r]);
                }
            mx = fmaxf(mx, __shfl_xor(mx, 16, 64)); mx = fmaxf(mx, __shfl_xor(mx, 32, 64));
            float sum = 0.f;
#pragma unroll
            for (int j = 0; j < 9; ++j)
#pragma unroll
                for (int r = 0; r < 4; ++r) { const float p = __expf(sa[j][r] - mx); sa[j][r] = p; sum += p; }
            sum += __shfl_xor(sum, 16, 64); sum += __shfl_xor(sum, 32, 64);
            const float inv = 1.f / (sum + __expf(sk - mx));
            f32x4 oa[4];
#pragma unroll
            for (int dt = 0; dt < 4; ++dt) oa[dt] = (f32x4){0.f, 0.f, 0.f, 0.f};
#pragma unroll
            for (int u = 0; u < 5; ++u) {
                u32x4 pw; pw.x = cvt_pk_bf16(sa[2 * u][0], sa[2 * u][1]); pw.y = cvt_pk_bf16(sa[2 * u][2], sa[2 * u][3]);
                if (u < 4) { pw.z = cvt_pk_bf16(sa[2 * u + 1][0], sa[2 * u + 1][1]); pw.w = cvt_pk_bf16(sa[2 * u + 1][2], sa[2 * u + 1][3]); } else { pw.z = 0u; pw.w = 0u; }
                const bf16x8 pf = __builtin_bit_cast(bf16x8, pw);
                const int k0 = 16 * (qt + 2 * u) + 4 * g, k1 = (u < 4) ? k0 + 16 : k0;
#pragma unroll
                for (int dt = 0; dt < 4; ++dt) {
                    const u32x2 v0 = *(const LAS u32x2*)(Vt + (16 * dt + l16) * 264 + k0), v1 = *(const LAS u32x2*)(Vt + (16 * dt + l16) * 264 + k1);
                    u32x4 vw; vw.x = v0.x; vw.y = v0.y; vw.z = v1.x; vw.w = v1.y;
                    oa[dt] = __builtin_amdgcn_mfma_f32_16x16x32_bf16(__builtin_bit_cast(bf16x8, vw), pf, oa[dt], 0, 0, 0);
                }
            }
#pragma unroll
            for (int dt = 0; dt < 4; ++dt) {
                const size_t o = tq * 1024 + head * 64 + 16 * dt + 4 * g;
                const u32x2 gw = *(const u32x2*)(Zg + o);
                f32x4 r; r[0] = oa[dt][0] * inv * bflo(gw.x); r[1] = oa[dt][1] * inv * bfhi(gw.x); r[2] = oa[dt][2] * inv * bflo(gw.y); r[3] = oa[dt][3] * inv * bfhi(gw.y);
                *(u32x2*)(OG + o) = pk4(r);
            }
        }
    }
}
#undef AP_LOAD

__device__ __forceinline__ void attn_sample(LAS unsigned char* lds, const Params& P, const bf16_t* __restrict__ Zq, const bf16_t* __restrict__ Zk, const bf16_t* __restrict__ Zg, const bf16_t* __restrict__ vTs,
                                            bf16_t* __restrict__ OG, int G) {
    constexpr int KS_B = 144 * 72 * 2, VT_B = 64 * 152 * 2, SLOT_B = KS_B + VT_B;
    for (int pr = blockIdx.x; pr < 256; pr += G) {
        const int tid = otid(), w = tid >> 6, lane = tid & 63, l16 = lane & 15, g = lane >> 4;
        __syncthreads();
#pragma unroll
        for (int sl = 0; sl < 2; ++sl) {
            const int it = 2 * pr + sl, bs = it >> 2, kvh = it & 3;
            LAS bf16_t* Ks = (LAS bf16_t*)(lds + sl * SLOT_B); LAS bf16_t* Vt = (LAS bf16_t*)(lds + sl * SLOT_B + KS_B);
#pragma unroll
            for (int i = 0; i < 4; ++i) { const int ch = tid + 512 * i, j = ch >> 4, d4 = (ch & 15) * 4;
                const size_t src = ((size_t)(bs * 128 + j) * 4 + kvh) * 64 + d4;
                const f32x4 kv = *(const f32x4*)(P.cache_k + src), vv = *(const f32x4*)(P.cache_v + src);
                if (j >= 8) { const size_t dst = ((size_t)(bs * 128 + j - 8) * 4 + kvh) * 64 + d4; *(f32x4*)(P.out + OFF_KWS + dst) = kv; *(f32x4*)(P.out + OFF_VWS + dst) = vv; }
                *(LAS u32x2*)(Ks + j * 72 + d4) = pk4(kv);
                const u32x2 vw = pk4(vv);
                Vt[(d4 + 0) * 152 + j] = (bf16_t)(vw.x & 0xffffu); Vt[(d4 + 1) * 152 + j] = (bf16_t)(vw.x >> 16); Vt[(d4 + 2) * 152 + j] = (bf16_t)(vw.y & 0xffffu); Vt[(d4 + 3) * 152 + j] = (bf16_t)(vw.y >> 16); }
            { const int l = tid >> 6, d = tid & 63;
              Ks[(128 + l) * 72 + d] = Zk[(size_t)(MP + bs * 8 + l) * 256 + kvh * 64 + d]; Ks[(136 + l) * 72 + d] = 0; }
            if (tid < 64) { const u32x4 nv = *(const u32x4*)(vTs + ((size_t)((bs * 4 + kvh) * 64 + tid)) * 8);
                *(LAS u32x4*)(Vt + tid * 152 + 128) = nv; *(LAS u32x4*)(Vt + tid * 152 + 136) = (u32x4){0u, 0u, 0u, 0u}; *(LAS u32x4*)(Vt + tid * 152 + 144) = (u32x4){0u, 0u, 0u, 0u}; }
        }
        __syncthreads();
        if (w < 4) {
            const int sl = w >> 1, t = w & 1, it = 2 * pr + sl, bs = it >> 2, kvh = it & 3;
            const LAS bf16_t* Ks = (const LAS bf16_t*)(lds + sl * SLOT_B); const LAS bf16_t* Vt = (const LAS bf16_t*)(lds + sl * SLOT_B + KS_B);
            const int hq = 2 * t + (l16 >> 3), l = l16 & 7, head = kvh * 4 + hq;
            const size_t tq = (size_t)(MP + bs * 8 + l);
            const float sk = P.sinks[head];
            bf16x8 qf[2];
#pragma unroll
            for (int ks = 0; ks < 2; ++ks) qf[ks] = *(const bf16x8*)(Zq + tq * 1024 + head * 64 + ks * 32 + g * 8);
            f32x4 sa[9];
#pragma unroll
            for (int j = 0; j < 9; ++j) { sa[j] = (f32x4){0.f, 0.f, 0.f, 0.f};
#pragma unroll
                for (int ks = 0; ks < 2; ++ks) { const bf16x8 kf = *(const LAS bf16x8*)(Ks + (16 * j + l16) * 72 + ks * 32 + g * 8);
                    sa[j] = __builtin_amdgcn_mfma_f32_16x16x32_bf16(kf, qf[ks], sa[j], 0, 0, 0); } }
            float mx = sk;
#pragma unroll
            for (int j = 0; j < 9; ++j)
#pragma unroll
                for (int r = 0; r < 4; ++r) { const int key = 16 * j + 4 * g + r;
                    const bool vis = (j < 8) ? (key > l) : (key - 128 <= l);
                    sa[j][r] = vis ? sa[j][r] : -1e30f; mx = fmaxf(mx, sa[j][r]); }
            mx = fmaxf(mx, __shfl_xor(mx, 16, 64)); mx = fmaxf(mx, __shfl_xor(mx, 32, 64));
            float sum = 0.f;
#pragma unroll
            for (int j = 0; j < 9; ++j)
#pragma unroll
                for (int r = 0; r < 4; ++r) { const float p = __expf(sa[j][r] - mx); sa[j][r] = p; sum += p; }
            sum += __shfl_xor(sum, 16, 64); sum += __shfl_xor(sum, 32, 64);
            const float inv = 1.f / (sum + __expf(sk - mx));
            f32x4 oa[4];
#pragma unroll
            for (int dt = 0; dt < 4; ++dt) oa[dt] = (f32x4){0.f, 0.f, 0.f, 0.f};
#pragma unroll
            for (int u = 0; u < 5; ++u) {
                u32x4 pw; pw.x = cvt_pk_bf16(sa[2 * u][0], sa[2 * u][1]); pw.y = cvt_pk_bf16(sa[2 * u][2], sa[2 * u][3]);
                if (u < 4) { pw.z = cvt_pk_bf16(sa[2 * u + 1][0], sa[2 * u + 1][1]); pw.w = cvt_pk_bf16(sa[2 * u + 1][2], sa[2 * u + 1][3]); } else { pw.z = 0u; pw.w = 0u; }
                const bf16x8 pf = __builtin_bit_cast(bf16x8, pw);
                const int k0 = 32 * u + 4 * g, k1 = (u < 4) ? k0 + 16 : k0;
#pragma unroll
                for (int dt = 0; dt < 4; ++dt) {
                    const u32x2 v0 = *(const LAS u32x2*)(Vt + (16 * dt + l16) * 152 + k0), v1 = *(const LAS u32x2*)(Vt + (16 * dt + l16) * 152 + k1);
                    u32x4 vw; vw.x = v0.x; vw.y = v0.y; vw.z = v1.x; vw.w = v1.y;
                    oa[dt] = __builtin_amdgcn_mfma_f32_16x16x32_bf16(__builtin_bit_cast(bf16x8, vw), pf, oa[dt], 0, 0, 0);
                }
            }
#pragma unroll
            for (int dt = 0; dt < 4; ++dt) {
                const size_t o = tq * 1024 + head * 64 + 16 * dt + 4 * g;
                const u32x2 gw = *(const u32x2*)(Zg + o);
                f32x4 r; r[0] = oa[dt][0] * inv * bflo(gw.x); r[1] = oa[dt][1] * inv * bfhi(gw.x); r[2] = oa[dt][2] * inv * bflo(gw.y); r[3] = oa[dt][3] * inv * bfhi(gw.y);
                *(u32x2*)(OG + o) = pk4(r);
            }
        }
    }
}

__device__ __forceinline__ void ret_A(LAS unsigned char* lds, const bf16_t* __restrict__ Zq, const bf16_t* __restrict__ Zk, bf16_t* __restrict__ ABUF, bf16_t* __restrict__ KDT, int G) {
    LAS bf16_t* Qs = (LAS bf16_t*)lds;
    LAS bf16_t* Ks = (LAS bf16_t*)(lds + 128 * 264 * 2);
    const int tid = otid(), w = tid >> 6, lane = tid & 63, l16 = lane & 15, g = lane >> 4;
    u32x4 rq[8], rk[8];
#define RA_LOAD(it_) do { const int c_ = (it_) & 31, h_ = ((it_) >> 5) & 3, b_ = (it_) >> 7; const size_t t0_ = (size_t)b_ * 4096 + c_ * 128; \
        _Pragma("unroll") for (int i = 0; i < 8; ++i) { const int ch = tid + 512 * i, s = ch >> 5, c8 = (ch & 31) * 8; const size_t src = (t0_ + s) * 1024 + h_ * 256 + c8; rq[i] = *(const u32x4*)(Zq + src); rk[i] = *(const u32x4*)(Zk + src); } } while (0)
    if ((int)blockIdx.x < 512) RA_LOAD((int)blockIdx.x);
    for (int it = blockIdx.x; it < 512; it += G) {
        const int c = it & 31, h = (it >> 5) & 3, b = it >> 7;
        const float lg = ret_lg(h);
        __syncthreads();
#pragma unroll
        for (int i = 0; i < 8; ++i) { const int ch = tid + 512 * i, s = ch >> 5, c8 = (ch & 31) * 8; *(LAS u32x4*)(Qs + s * 264 + c8) = rq[i]; *(LAS u32x4*)(Ks + s * 264 + c8) = rk[i]; }
        __syncthreads();
        if (it + G < 512) RA_LOAD(it + G);
        asm volatile("" ::: "memory");
        const int i_row = 16 * w + l16;
#pragma unroll
        for (int nt = 0; nt < 8; ++nt) {
            f32x4 a = {0.f, 0.f, 0.f, 0.f};
            if (nt <= w) {
#pragma unroll
                for (int ks = 0; ks < 8; ++ks) { const bf16x8 kf = *(const LAS bf16x8*)(Ks + (16 * nt + l16) * 264 + ks * 32 + g * 8), qf = *(const LAS bf16x8*)(Qs + i_row * 264 + ks * 32 + g * 8);
                    a = __builtin_amdgcn_mfma_f32_16x16x32_bf16(kf, qf, a, 0, 0, 0); }
#pragma unroll
                for (int r = 0; r < 4; ++r) { const int s = 16 * nt + 4 * g + r; a[r] = (s <= i_row) ? a[r] * __expf((float)(i_row - s) * lg) : 0.f; }
            }
            *(u32x2*)(ABUF + ((size_t)it * 128 + i_row) * 128 + 16 * nt + 4 * g) = pk4(a);
        }
        { const int d = tid & 255, sg0 = tid >> 8;
#pragma unroll
          for (int k = 0; k < 8; ++k) { const int s0 = 8 * (sg0 + 2 * k); float v[8];
#pragma unroll
              for (int jj = 0; jj < 8; ++jj) v[jj] = bf2f(Ks[(s0 + jj) * 264 + d]) * __expf((float)(127 - s0 - jj) * lg);
              u32x4 wv; wv.x = cvt_pk_bf16(v[0], v[1]); wv.y = cvt_pk_bf16(v[2], v[3]); wv.z = cvt_pk_bf16(v[4], v[5]); wv.w = cvt_pk_bf16(v[6], v[7]);
              *(u32x4*)(KDT + ((size_t)it * 256 + d) * 128 + s0) = wv; } }
    }
}
#undef RA_LOAD

__device__ __forceinline__ void ret_seq_unit(LAS unsigned char* lds, int u, const bf16_t* __restrict__ Zq, const bf16_t* __restrict__ vTp, const bf16_t* __restrict__ ABUF, const bf16_t* __restrict__ KDT,
                                             bf16_t* __restrict__ ORET, float* __restrict__ out) {
    LAS bf16_t* ST = (LAS bf16_t*)lds;
    LAS bf16_t* VT = (LAS bf16_t*)(lds + 2 * 64 * 264 * 2);
    const int tid = otid(), w = tid >> 6, lane = tid & 63, l16 = lane & 15, g = lane >> 4;
    const int xcd = u & 7, jj = u >> 3, bh = xcd * 2 + (jj >> 3), es = jj & 7, b = bh >> 2, h = bh & 3;
    const float lg = ret_lg(h), g128 = __expf(128.f * lg), gi = __expf((float)(16 * w + l16 + 1) * lg);
    __syncthreads();
    for (int e = tid; e < 64 * 264 / 2; e += NT) ((LAS unsigned*)ST)[e] = 0u;
    const bf16_t* vrow = vTp + ((size_t)bh * 512 + es * 64 + (tid >> 3)) * 4096 + (tid & 7) * 16;
    LAS bf16_t* vdst = VT + (tid >> 3) * 136 + (tid & 7) * 16;
    { const u32x4 a = *(const u32x4*)vrow, bq = *(const u32x4*)(vrow + 8); *(LAS u32x4*)vdst = a; *(LAS u32x4*)(vdst + 8) = bq; }
    f32x4 sacc[2][4];
#pragma unroll
    for (int dt = 0; dt < 2; ++dt)
#pragma unroll
        for (int et = 0; et < 4; ++et) sacc[dt][et] = (f32x4){0.f, 0.f, 0.f, 0.f};
    const bf16_t* aptr = ABUF + ((size_t)bh * 32 * 128 + 16 * w + l16) * 128 + 8 * g;
    const bf16_t* qptr = Zq + ((size_t)b * 4096 + 16 * w + l16) * 1024 + h * 256 + 8 * g;
    const bf16_t* kptr = KDT + ((size_t)bh * 32 * 256 + 32 * w + l16) * 128 + 8 * g;
    bf16_t* optr = ORET + ((size_t)b * 4096 + 16 * w + l16) * 2048 + h * 512 + es * 64 + 4 * g;
    bf16x8 af[4], qf[8], kf[2][4];
#pragma unroll
    for (int ks = 0; ks < 4; ++ks) af[ks] = *(const bf16x8*)(aptr + 32 * ks);
#pragma unroll
    for (int kd = 0; kd < 8; ++kd) qf[kd] = *(const bf16x8*)(qptr + 32 * kd);
    __syncthreads();
    u32x2 opk[4];
    for (int c = 0; c < 32; ++c) {
        const int buf = c & 1;
        if (c > 0) {
#pragma unroll
            for (int et = 0; et < 4; ++et) *(u32x2*)(optr + (size_t)(c - 1) * 128 * 2048 + 16 * et) = opk[et]; }
#pragma unroll
        for (int dt = 0; dt < 2; ++dt)
#pragma unroll
            for (int ks = 0; ks < 4; ++ks) kf[dt][ks] = *(const bf16x8*)(kptr + (size_t)c * 256 * 128 + dt * 2048 + 32 * ks);
        u32x4 nv0 = {0u, 0u, 0u, 0u}, nv1 = {0u, 0u, 0u, 0u};
        if (c < 31) { nv0 = *(const u32x4*)(vrow + (c + 1) * 128); nv1 = *(const u32x4*)(vrow + (c + 1) * 128 + 8); }
        const LAS bf16_t* VTb = VT + buf * 64 * 136; const LAS bf16_t* STb = ST + buf * 64 * 264;
#pragma unroll
        for (int et = 0; et < 4; ++et) {
            f32x4 oin = {0.f, 0.f, 0.f, 0.f}, ocr = {0.f, 0.f, 0.f, 0.f};
#pragma unroll
            for (int ks = 0; ks < 4; ++ks) { const bf16x8 vf = *(const LAS bf16x8*)(VTb + (16 * et + l16) * 136 + 32 * ks + 8 * g); oin = __builtin_amdgcn_mfma_f32_16x16x32_bf16(vf, af[ks], oin, 0, 0, 0); }
#pragma unroll
            for (int kd = 0; kd < 8; ++kd) { const bf16x8 sf = *(const LAS bf16x8*)(STb + (16 * et + l16) * 264 + 32 * kd + 8 * g); ocr = __builtin_amdgcn_mfma_f32_16x16x32_bf16(sf, qf[kd], ocr, 0, 0, 0); }
            opk[et] = pk4(oin + ocr * gi);
        }
        if (c < 31) {
#pragma unroll
            for (int ks = 0; ks < 4; ++ks) af[ks] = *(const bf16x8*)(aptr + (size_t)(c + 1) * 128 * 128 + 32 * ks);
#pragma unroll
            for (int kd = 0; kd < 8; ++kd) qf[kd] = *(const bf16x8*)(qptr + (size_t)(c + 1) * 128 * 1024 + 32 * kd);
        }
#pragma unroll
        for (int dt = 0; dt < 2; ++dt)
#pragma unroll
            for (int et = 0; et < 4; ++et) sacc[dt][et] *= g128;
#pragma unroll
        for (int et = 0; et < 4; ++et)
#pragma unroll
            for (int ks = 0; ks < 4; ++ks) { const bf16x8 vf = *(const LAS bf16x8*)(VTb + (16 * et + l16) * 136 + 32 * ks + 8 * g);
#pragma unroll
                for (int dt = 0; dt < 2; ++dt) sacc[dt][et] = __builtin_amdgcn_mfma_f32_16x16x32_bf16(kf[dt][ks], vf, sacc[dt][et], 0, 0, 0); }
#pragma unroll
        for (int dt = 0; dt < 2; ++dt)
#pragma unroll
            for (int et = 0; et < 4; ++et) *(LAS u32x2*)(ST + ((buf ^ 1) * 64 + 16 * et + l16) * 264 + 32 * w + 16 * dt + 4 * g) = pk4(sacc[dt][et]);
        if (c < 31) { LAS bf16_t* d2 = vdst + (buf ^ 1) * 64 * 136; *(LAS u32x4*)d2 = nv0; *(LAS u32x4*)(d2 + 8) = nv1; }
        __syncthreads();
    }
#pragma unroll
    for (int et = 0; et < 4; ++et) *(u32x2*)(optr + (size_t)31 * 128 * 2048 + 16 * et) = opk[et];
#pragma unroll
    for (int dt = 0; dt < 2; ++dt)
#pragma unroll
        for (int et = 0; et < 4; ++et)
#pragma unroll
            for (int r = 0; r < 4; ++r) out[OFF_RSP + ((size_t)bh * 256 + 32 * w + 16 * dt + 4 * g + r) * 512 + es * 64 + 16 * et + l16] = sacc[dt][et][r];
}

__device__ __forceinline__ void ret_sample(LAS unsigned char* lds, const Params& P, const bf16_t* __restrict__ Zq, const bf16_t* __restrict__ Zk, const bf16_t* __restrict__ vTs, bf16_t* __restrict__ ORET, unsigned* ctr, unsigned* done, unsigned target) {
    LAS float* qs = (LAS float*)lds;
    LAS float* kds = qs + 2048;
    LAS float* A8 = kds + 2048;
    LAS float* red = A8 + 64;
    volatile LAS int* slot = (volatile LAS int*)(lds + LDS_BYTES - 32);
    for (;;) {
        const int tid = otid();
        __syncthreads();
        if (tid == 0) *slot = (done && xb_ld(done) >= target) ? 512 : (int)atomicAdd(ctr, 1u);
        __syncthreads();
        const int it = *slot;
        if (it >= 512) break;
        const int bs = it >> 2, h = it & 3;
        const float lg = ret_lg(h), g8 = __expf(8.f * lg), ig8 = __expf(-8.f * lg);
#pragma unroll
        for (int k = 0; k < 4; ++k) { const int e = tid + 512 * k, i = e >> 8, d = e & 255; const size_t src = (size_t)(MP + bs * 8 + i) * 1024 + h * 256 + d;
            qs[d * 8 + i] = bf2f(Zq[src]) * __expf((float)(i + 1) * lg); kds[d * 8 + i] = bf2f(Zk[src]) * __expf((float)(7 - i) * lg); }
        __syncthreads();
        if (tid < 64) { const int i = tid >> 3, s = tid & 7; float a = 0.f;
            if (s <= i) { for (int d = 0; d < 256; ++d) a += qs[d * 8 + i] * kds[d * 8 + s]; a *= ig8; }
            A8[tid] = a; }
        const int eg = tid & 127, dp = tid >> 7, e0 = 4 * eg;
        f32x4 vq[8];
#pragma unroll
        for (int jj = 0; jj < 4; ++jj) { const u32x4 wv = *(const u32x4*)(vTs + ((size_t)((bs * 4 + h) * 512 + e0 + jj)) * 8);
            vq[0][jj] = bflo(wv.x); vq[1][jj] = bfhi(wv.x); vq[2][jj] = bflo(wv.y); vq[3][jj] = bfhi(wv.y); vq[4][jj] = bflo(wv.z); vq[5][jj] = bfhi(wv.z); vq[6][jj] = bflo(wv.w); vq[7][jj] = bfhi(wv.w); }
        f32x4 cr[8];
#pragma unroll
        for (int i = 0; i < 8; ++i) cr[i] = (f32x4){0.f, 0.f, 0.f, 0.f};
        const size_t sbase = ((size_t)(bs * 4 + h) * 256 + dp * 64) * 512 + e0;
        const float* __restrict__ sp = P.state_ret + sbase; float* __restrict__ op = P.out + OFF_RSS + sbase;
        f32x4 sta[8];
#pragma unroll
        for (int j = 0; j < 8; ++j) sta[j] = __builtin_nontemporal_load((const f32x4*)(sp + (size_t)j * 512));
#pragma unroll 1
        for (int d0 = 0; d0 < 64; d0 += 8) {
            const bool more = d0 + 8 < 64;
#pragma unroll
            for (int j = 0; j < 8; ++j) {
                const int d = dp * 64 + d0 + j; const f32x4 st = sta[j];
                if (more) sta[j] = __builtin_nontemporal_load((const f32x4*)(sp + (size_t)(d0 + 8 + j) * 512));
                const f32x4 qa = *(const LAS f32x4*)(qs + d * 8), qb = *(const LAS f32x4*)(qs + d * 8 + 4), ka = *(const LAS f32x4*)(kds + d * 8), kb = *(const LAS f32x4*)(kds + d * 8 + 4);
                const float q8[8] = {qa[0], qa[1], qa[2], qa[3], qb[0], qb[1], qb[2], qb[3]}, k8[8] = {ka[0], ka[1], ka[2], ka[3], kb[0], kb[1], kb[2], kb[3]};
                f32x4 ns = st * g8;
#pragma unroll
                for (int s2 = 0; s2 < 8; ++s2) ns += vq[s2] * k8[s2];
                __builtin_nontemporal_store(ns, (f32x4*)(op + (size_t)(d0 + j) * 512));
#pragma unroll
                for (int i = 0; i < 8; ++i) cr[i] += st * q8[i];
                asm volatile("" ::: "memory");
            }
        }
#pragma unroll
        for (int i = 0; i < 8; ++i) *(LAS f32x4*)(red + (dp * 8 + i) * 512 + e0) = cr[i];
        __syncthreads();
        { const int i = tid >> 6, e8 = (tid & 63) * 8;
          float o[8];
#pragma unroll
          for (int jj = 0; jj < 8; ++jj) o[jj] = red[(0 * 8 + i) * 512 + e8 + jj] + red[(1 * 8 + i) * 512 + e8 + jj] + red[(2 * 8 + i) * 512 + e8 + jj] + red[(3 * 8 + i) * 512 + e8 + jj];
#pragma unroll
          for (int jj = 0; jj < 8; ++jj) { const u32x4 wv = *(const u32x4*)(vTs + ((size_t)((bs * 4 + h) * 512 + e8 + jj)) * 8);
              const float v8[8] = {bflo(wv.x), bfhi(wv.x), bflo(wv.y), bfhi(wv.y), bflo(wv.z), bfhi(wv.z), bflo(wv.w), bfhi(wv.w)};
#pragma unroll
              for (int s = 0; s < 8; ++s) o[jj] += A8[i * 8 + s] * v8[s]; }
          bf16_t* dst = ORET + (size_t)(MP + bs * 8 + i) * 2048 + h * 512 + e8;
          u32x4 ow; ow.x = cvt_pk_bf16(o[0], o[1]); ow.y = cvt_pk_bf16(o[2], o[3]); ow.z = cvt_pk_bf16(o[4], o[5]); ow.w = cvt_pk_bf16(o[6], o[7]); *(u32x4*)dst = ow; }
    }
}

__device__ __forceinline__ void ret_gnorm(const bf16_t* __restrict__ ORET, const bf16_t* __restrict__ Zg, bf16_t* __restrict__ OG, int G) {
    const int tid_o = otid(), wave = tid_o >> 6, lane = tid_o & 63;
    for (int task = blockIdx.x * 8 + wave; task < MT * 4; task += G * 8) {
        const size_t o = (size_t)(task >> 2) * 2048 + (task & 3) * 512 + lane * 8;
        const u32x4 ow = *(const u32x4*)(ORET + o); const f32x4 a = {bflo(ow.x), bfhi(ow.x), bflo(ow.y), bfhi(ow.y)}, b = {bflo(ow.z), bfhi(ow.z), bflo(ow.w), bfhi(ow.w)};
        const float mu = wave_sum(a[0] + a[1] + a[2] + a[3] + b[0] + b[1] + b[2] + b[3]) * (1.f / 512.f);
        const f32x4 da = a - mu, db = b - mu;
        const float var = wave_sum(da[0] * da[0] + da[1] * da[1] + da[2] * da[2] + da[3] * da[3] + db[0] * db[0] + db[1] * db[1] + db[2] * db[2] + db[3] * db[3]) * (1.f / 512.f);
        const float rs = rsqrtf(var + EPS);
        const u32x4 gw = *(const u32x4*)(Zg + o);
        u32x4 r;
        r.x = cvt_pk_bf16(da[0] * rs * bflo(gw.x), da[1] * rs * bfhi(gw.x)); r.y = cvt_pk_bf16(da[2] * rs * bflo(gw.y), da[3] * rs * bfhi(gw.y));
        r.z = cvt_pk_bf16(db[0] * rs * bflo(gw.z), db[1] * rs * bfhi(gw.z)); r.w = cvt_pk_bf16(db[2] * rs * bflo(gw.w), db[3] * rs * bfhi(gw.w));
        *(u32x4*)(OG + o) = r;
    }
}

__global__ void __launch_bounds__(NT) hybrid_fwd(Params P) {
    extern __shared__ __attribute__((aligned(16))) unsigned char lds_raw[];
    LAS unsigned char* lds = (LAS unsigned char*)lds_raw;
    cg::grid_group grid = cg::this_grid();
    const int G = gridDim.x, tid = threadIdx.x;
    unsigned char* ws = P.ws;
    bf16_t* WT_IN_ATTN = (bf16_t*)(ws + WS_WT_IN_ATTN); bf16_t* WT_OUT_ATTN = (bf16_t*)(ws + WS_WT_OUT_ATTN); bf16_t* WT_IN_RET = (bf16_t*)(ws + WS_WT_IN_RET); bf16_t* WT_OUT_RET = (bf16_t*)(ws + WS_WT_OUT_RET);
    bf16_t* WT_GATE = (bf16_t*)(ws + WS_WT_GATE); bf16_t* WT_PLE = (bf16_t*)(ws + WS_WT_PLE);
    float* TABA = (float*)(ws + WS_TABA); float* TABR = (float*)(ws + WS_TABR);
    bf16_t* H = (bf16_t*)(ws + WS_H); bf16_t* PB = (bf16_t*)(ws + WS_PB);
    bf16_t* PLE = (bf16_t*)(ws + WS_PLE); bf16_t* Y = (bf16_t*)(ws + WS_Y); bf16_t* X2 = (bf16_t*)(ws + WS_X2);
    bf16_t* OG = (bf16_t*)(ws + WS_OG); bf16_t* ZQ = (bf16_t*)(ws + WS_ZQ); bf16_t* ZK = (bf16_t*)(ws + WS_ZK); bf16_t* ZG = (bf16_t*)(ws + WS_ZG);
    bf16_t* VTP = (bf16_t*)(ws + WS_VTP); bf16_t* VTS = (bf16_t*)(ws + WS_VTS); bf16_t* ABUF = (bf16_t*)(ws + WS_ABUF); bf16_t* KDT = (bf16_t*)(ws + WS_KDT); bf16_t* ORET = (bf16_t*)(ws + WS_ORET);
    bf16_t* SC = (bf16_t*)(ws + WS_Y);
    pg8::StaticOrder SO;
    volatile LAS unsigned* bst = (volatile LAS unsigned*)(lds + LDS_BYTES - 16);
    if (tid < 4) bst[tid] = 0u;
    __syncthreads();
    const XcdBarrier xbar = xcd_barrier_post((unsigned*)(ws + WS_BAR), bst);
#define GSYNC() xcd_barrier(xbar)

for (int rep_ = 0; rep_ < REP_P0; ++rep_) {
    {
        LAS float* T = (LAS float*)lds;
        const int ttid = otid(), nn = ttid & 63, kq = ttid >> 6, kk2 = (ttid & 31) * 2, nq = ttid >> 5;
#define TILE_DESC(t_, W_, Wt_, K_, N_, perm_, tl_) do { \
        if ((t_) < 640) { W_ = P.w_in_attn; Wt_ = WT_IN_ATTN; K_ = 1024; N_ = 2560; perm_ = true; tl_ = (t_); } \
        else if ((t_) < 896) { W_ = P.w_out_attn; Wt_ = WT_OUT_ATTN; K_ = 1024; N_ = 1024; perm_ = false; tl_ = (t_) - 640; } \
        else if ((t_) < 2432) { W_ = P.w_in_ret; Wt_ = WT_IN_RET; K_ = 1024; N_ = 6144; perm_ = false; tl_ = (t_) - 896; } \
        else if ((t_) < 2944) { W_ = P.w_out_ret; Wt_ = WT_OUT_RET; K_ = 2048; N_ = 1024; perm_ = false; tl_ = (t_) - 2432; } \
        else if ((t_) < 3200) { W_ = P.w_gate; Wt_ = WT_GATE; K_ = 1024; N_ = 1024; perm_ = false; tl_ = (t_) - 2944; } \
        else if ((t_) < 3456) { W_ = P.w_gate + 1024 * 1024; Wt_ = WT_GATE + 1024 * 1024; K_ = 1024; N_ = 1024; perm_ = false; tl_ = (t_) - 3200; } \
        else if ((t_) < 3520) { W_ = P.w_ple; Wt_ = WT_PLE; K_ = 256; N_ = 1024; perm_ = false; tl_ = (t_) - 3456; } \
        else { W_ = P.w_ple + 256 * 1024; Wt_ = WT_PLE + 1024 * 256; K_ = 256; N_ = 1024; perm_ = false; tl_ = (t_) - 3520; } } while (0)
#define TILE_LOAD(W_, N_, perm_, tl_, r_) do { const int ntn_ = (N_) >> 6, n0_ = ((tl_) % ntn_) * 64, k0_ = ((tl_) / ntn_) * 64, nd_ = n0_ + nn; int ns_ = nd_; \
        if ((perm_) && nd_ < 1280) { const int p_ = nd_ & 63; ns_ = (nd_ - p_) + (p_ >> 5) * 16 + (p_ & 15) + ((p_ >> 4) & 1) * 32; } \
        _Pragma("unroll") for (int i_ = 0; i_ < 8; ++i_) r_[i_] = (W_)[(size_t)(k0_ + kq + 8 * i_) * (N_) + ns_]; } while (0)
        float r[8];
        const float* Wc; bf16_t* Wtc; int Kc, Nc, tlc; bool pc;
        int t = blockIdx.x;
        if (t < 3584) { TILE_DESC(t, Wc, Wtc, Kc, Nc, pc, tlc); TILE_LOAD(Wc, Nc, pc, tlc, r); }
        for (; t < 3584; t += G) {
            __syncthreads();
#pragma unroll
            for (int i = 0; i < 8; ++i) T[(kq + 8 * i) * 65 + nn] = r[i];
            __syncthreads();
            const int ntn = Nc >> 6, n0 = (tlc % ntn) * 64, k0 = (tlc / ntn) * 64; bf16_t* Wto = Wtc; const int Ko = Kc;
            if (t + G < 3584) { TILE_DESC(t + G, Wc, Wtc, Kc, Nc, pc, tlc); TILE_LOAD(Wc, Nc, pc, tlc, r); }
#pragma unroll
            for (int i = 0; i < 4; ++i) { const int n2 = nq + 16 * i; *(unsigned*)(Wto + (size_t)(n0 + n2) * Ko + k0 + kk2) = cvt_pk_bf16(T[kk2 * 65 + n2], T[(kk2 + 1) * 65 + n2]); }
        }
        __syncthreads();
#undef TILE_DESC
#undef TILE_LOAD
    }
    for (int e = blockIdx.x * NT + tid; e < 4104 * 160; e += G * NT) {
        const int pi = e / 160, f = e % 160; const int pos = pi < 4096 ? pi : 16384 + (pi - 4096);
        if (f < 32) { const float inv = powf(10000.f, -(float)f / 32.f), ang = (float)pos * inv; TABA[((size_t)pi * 32 + f) * 2] = cosf(ang); TABA[((size_t)pi * 32 + f) * 2 + 1] = sinf(ang); }
        else { const int f2 = f - 32; const float inv = powf(10000.f, -(float)f2 / 128.f), ang = (float)pos * inv; TABR[((size_t)pi * 128 + f2) * 2] = cosf(ang); TABR[((size_t)pi * 128 + f2) * 2 + 1] = sinf(ang); }
    }
    for (int e = blockIdx.x * NT + tid; e < 2 * MT * 64; e += G * NT) {
        const int i = e / (MT * 64), rem = e % (MT * 64), row = rem >> 6, c4 = (rem & 63) * 4;
        const float* src = row < MP ? P.p_prompt + ((size_t)i * MP + row) * 256 + c4 : P.p_sample + ((size_t)i * MS + row - MP) * 256 + c4;
        *(u32x2*)(PB + ((size_t)i * MT + row) * 256 + c4) = pk4(*(const f32x4*)src);
    }
    rms_rows(P.x_prompt, P.x_sample, P.pre_norm, H, G);
}
    if (P.ws == nullptr) grid.sync();
    GSYNC();

for (int rep_ = 0; rep_ < REP_GIN; ++rep_) {
    { pg8::Gemm g{H, WT_IN_ATTN, MT, 2560, 1024}; SO.init(MT, 2560, G, blockIdx.x);
      EpiInAttn E{ZQ, ZK, ZG, VTP, VTS, TABA, P.out}; pg8::gemm_phase(lds, g, SO, E); }
    { pg8::Gemm g{PB, WT_PLE, MP, 1024, 256}; EpiB16 E{PLE, 1024};
      if (G == 256) { pg8::TailOrder TO; TO.init(MP, 680 - 512, G, blockIdx.x); pg8::gemm_phase(lds, g, TO, E); }
      else { SO.init(MP, 1024, G, blockIdx.x); pg8::gemm_phase(lds, g, SO, E); }
      skinny_gemm(lds, PB + (size_t)MP * 256, WT_PLE, 256, SkB16{PLE + (size_t)MP * 1024}, G); }
}
    GSYNC();

for (int rep_ = 0; rep_ < REP_ATT; ++rep_) {
    attn_prompt(lds, ZQ, ZK, ZG, VTP, P.sinks, OG, G);
    attn_sample(lds, P, ZQ, ZK, ZG, VTS, OG, G);
}
    GSYNC();

for (int rep_ = 0; rep_ < REP_GN1; ++rep_) {
    { pg8::Gemm g{OG, WT_OUT_ATTN, MP, 1024, 1024}; SO.init(MP, 1024, G, blockIdx.x); EpiB16 E{Y, 1024}; pg8::gemm_phase(lds, g, SO, E);
      skinny_gemm(lds, OG + (size_t)MP * 1024, WT_OUT_ATTN, 1024, SkB16{Y + (size_t)MP * 1024}, G); }
}
    GSYNC();
for (int rep_ = 0; rep_ < REP_ROW; ++rep_) {
    resid_rows<false>(P.x_prompt, P.x_sample, nullptr, Y, P.post_norm, H, G);
}
    GSYNC();
for (int rep_ = 0; rep_ < REP_GN1; ++rep_) {
    { pg8::Gemm g{H, WT_GATE, MP, 1024, 1024}; SO.init(MP, 1024, G, blockIdx.x); EpiGate<true> E{H, PLE, nullptr, X2}; pg8::gemm_phase(lds, g, SO, E);
      skinny_gemm(lds, H + (size_t)MP * 1024, WT_GATE, 1024, SkGate<true>{H + (size_t)MP * 1024, PLE + (size_t)MP * 1024, nullptr, X2 + (size_t)MP * 1024}, G); }
}
    GSYNC();
for (int rep_ = 0; rep_ < REP_ROW; ++rep_) {
    rms_rows_b16(X2, P.pre_norm + 1024, H, G);
}
    GSYNC();
for (int rep_ = 0; rep_ < REP_GIN; ++rep_) {
    { pg8::Gemm g{H, WT_IN_RET, MT, 6144, 1024}; SO.init(MT, 6144, G, blockIdx.x);
      EpiInRet E{ZQ, ZK, ZG, VTP, VTS, TABR}; pg8::gemm_phase(lds, g, SO, E); }
    { pg8::Gemm g{PB + (size_t)MT * 256, WT_PLE + 1024 * 256, MP, 1024, 256}; EpiB16 E{PLE, 1024};
      if (G == 256) { pg8::TailOrder TO; TO.init(MP, 1632 - 6 * 256, G, blockIdx.x); pg8::gemm_phase(lds, g, TO, E); }
      else { SO.init(MP, 1024, G, blockIdx.x); pg8::gemm_phase(lds, g, SO, E); }
      skinny_gemm(lds, PB + (size_t)MT * 256 + (size_t)MP * 256, WT_PLE + 1024 * 256, 256, SkB16{PLE + (size_t)MP * 1024}, G); }
}
    GSYNC();
for (int rep_ = 0; rep_ < REP_RA; ++rep_) {
    ret_A(lds, ZQ, ZK, ABUF, KDT, G);
}
    GSYNC();
    { unsigned* ctr = (unsigned*)(ws + WS_BAR + 14336);
      if (blockIdx.x < 128) for (int u = blockIdx.x; u < 128; u += G) ret_seq_unit(lds, u, ZQ, VTP, ABUF, KDT, ORET, P.out);
      ret_sample(lds, P, ZQ, ZK, VTS, ORET, ctr, nullptr, 0u); }
for (int rep_ = 0; rep_ < REP_SYNC; ++rep_) GSYNC();
    GSYNC();
for (int rep_ = 0; rep_ < REP_ROW; ++rep_) {
    ret_gnorm(ORET, ZG, OG, G);
}
    GSYNC();
for (int rep_ = 0; rep_ < REP_GN1; ++rep_) {
    { pg8::Gemm g{OG, WT_OUT_RET, MP, 1024, 2048}; SO.init(MP, 1024, G, blockIdx.x); EpiB16 E{Y, 1024}; pg8::gemm_phase(lds, g, SO, E);
      skinny_gemm(lds, OG + (size_t)MP * 2048, WT_OUT_RET, 2048, SkB16{Y + (size_t)MP * 1024}, G); }
}
    GSYNC();
for (int rep_ = 0; rep_ < REP_ROW; ++rep_) {
    resid_rows<true>(nullptr, nullptr, X2, Y, P.post_norm + 1024, H, G);
}
    GSYNC();
for (int rep_ = 0; rep_ < REP_GN1; ++rep_) {
    { pg8::Gemm g{H, WT_GATE + 1024 * 1024, MP, 1024, 1024}; SO.init(MP, 1024, G, blockIdx.x); EpiGate<false> E{H, PLE, P.out, nullptr}; pg8::gemm_phase(lds, g, SO, E);
      skinny_gemm(lds, H + (size_t)MP * 1024, WT_GATE + 1024 * 1024, 1024, SkGate<false>{H + (size_t)MP * 1024, PLE + (size_t)MP * 1024, P.out + (size_t)MP * 1024, nullptr}, G); }
}
}

extern "C" void kernel_launch(void* const* d_in, const int* in_sizes, int n_in, void* d_out, int out_size, void* d_ws, size_t ws_size, hipStream_t stream) {
    static int grid_blocks = 0;
    if (!grid_blocks) {
        int dev = 0, cus = 0, per_cu = 0;
        hipGetDevice(&dev);
        hipDeviceGetAttribute(&cus, hipDeviceAttributeMultiprocessorCount, dev);
        hipFuncSetAttribute((const void*)hybrid_fwd, hipFuncAttributeMaxDynamicSharedMemorySize, LDS_BYTES);
        hipOccupancyMaxActiveBlocksPerMultiprocessor(&per_cu, (const void*)hybrid_fwd, NT, LDS_BYTES);
        if (per_cu < 1) per_cu = 1;
        if (per_cu > 1) per_cu = 1;
        grid_blocks = cus * per_cu;
        if (ws_size < WS_END) fprintf(stderr, "kernel_launch: workspace too small: %zu < %zu\n", ws_size, (size_t)WS_END);
    }
    Params p{};
    p.x_prompt = (const float*)d_in[0]; p.x_sample = (const float*)d_in[1]; p.cache_k = (const float*)d_in[2]; p.cache_v = (const float*)d_in[3]; p.state_ret = (const float*)d_in[4];
    p.p_prompt = (const float*)d_in[5]; p.p_sample = (const float*)d_in[6]; p.pre_norm = (const float*)d_in[7]; p.post_norm = (const float*)d_in[8]; p.w_in_attn = (const float*)d_in[9];
    p.sinks = (const float*)d_in[10]; p.w_out_attn = (const float*)d_in[11]; p.w_in_ret = (const float*)d_in[12]; p.w_out_ret = (const float*)d_in[13]; p.w_ple = (const float*)d_in[14]; p.w_gate = (const float*)d_in[15];
    p.out = (float*)d_out; p.ws = (unsigned char*)d_ws;
    (void)hipMemsetAsync((unsigned char*)d_ws + WS_BAR, 0, 16384, stream);
    void* args[] = {&p};
    hipError_t e = hipLaunchCooperativeKernel((const void*)hybrid_fwd, dim3(grid_blocks), dim3(NT), args, LDS_BYTES, stream);
    if (e != hipSuccess) fprintf(stderr, "cooperative launch failed: %s (grid %d)\n", hipGetErrorString(e), grid_blocks);
}
```

```cpp
#include <hip/hip_runtime.h>
#include <hip/hip_cooperative_groups.h>
#include <cstdio>
#include <cstdint>
namespace cg = cooperative_groups;

#define LAS __attribute__((address_space(3)))
typedef unsigned short bf16_t;
typedef short bf16x8 __attribute__((ext_vector_type(8)));
typedef float f32x4 __attribute__((ext_vector_type(4)));
typedef float f32x2 __attribute__((ext_vector_type(2)));
typedef unsigned u32x2 __attribute__((ext_vector_type(2)));
typedef unsigned u32x4 __attribute__((ext_vector_type(4)));

constexpr int MP = 16384, MS = 1024, MT = MP + MS;
constexpr int NT = 512;
#define REP_P0 1
#define REP_GIN 1
#define REP_ATT 1
#define REP_RA 1
#define REP_SYNC 0
#define REP_R3 1
#define REP_SCAN 1
#define REP_ROW 1
#define REP_GN1 1
constexpr int LDS_BYTES = 140 * 1024;
constexpr float EPS = 1e-6f;

constexpr size_t OFF_YP = 0, OFF_YS = 16777216, OFF_KWP = 17825792, OFF_VWP = 17956864, OFF_KWS = 18087936, OFF_VWS = 22282240, OFF_RSP = 26476544, OFF_RSS = 28573696;

constexpr size_t al256(size_t x) { return (x + 255) & ~(size_t)255; }
constexpr size_t WS_WT_IN_ATTN = 0;
constexpr size_t WS_WT_OUT_ATTN = WS_WT_IN_ATTN + (size_t)2560 * 1024 * 2;
constexpr size_t WS_WT_IN_RET = WS_WT_OUT_ATTN + (size_t)1024 * 1024 * 2;
constexpr size_t WS_WT_OUT_RET = WS_WT_IN_RET + (size_t)6144 * 1024 * 2;
constexpr size_t WS_WT_GATE = WS_WT_OUT_RET + (size_t)1024 * 2048 * 2;
constexpr size_t WS_WT_PLE = WS_WT_GATE + (size_t)2 * 1024 * 1024 * 2;
constexpr size_t WS_TABA = WS_WT_PLE + (size_t)2 * 1024 * 256 * 2;
constexpr size_t WS_TABR = WS_TABA + (size_t)4104 * 32 * 8;
constexpr size_t WS_H = al256(WS_TABR + (size_t)4104 * 128 * 8);
constexpr size_t WS_PB = WS_H + (size_t)MT * 1024 * 2;
constexpr size_t WS_PLE = WS_PB + (size_t)2 * MT * 256 * 2;
constexpr size_t WS_Y = WS_PLE + (size_t)MT * 1024 * 4;
constexpr size_t WS_X1 = WS_Y + (size_t)MT * 1024 * 4;
constexpr size_t WS_X2 = WS_X1 + (size_t)MT * 1024 * 4;
constexpr size_t WS_OG = WS_X2 + (size_t)MT * 1024 * 4;
constexpr size_t WS_ZQ = WS_OG + (size_t)MT * 2048 * 2;
constexpr size_t WS_ZK = WS_ZQ + (size_t)MT * 1024 * 2;
constexpr size_t WS_ZG = WS_ZK + (size_t)MT * 1024 * 2;
constexpr size_t WS_VTP = WS_ZG + (size_t)MT * 2048 * 2;
constexpr size_t WS_VTS = WS_VTP + (size_t)16 * 512 * 4096 * 2;
constexpr size_t WS_ABUF = WS_VTS + (size_t)128 * 4 * 512 * 8 * 2;
constexpr size_t WS_KDT = WS_ABUF + (size_t)512 * 128 * 128 * 2;
constexpr size_t WS_ORET = WS_KDT + (size_t)512 * 256 * 128 * 2;
constexpr size_t WS_BAR = WS_ORET + (size_t)MT * 2048 * 4;
constexpr size_t WS_END = WS_BAR + 16384;

struct Params {
    const float *x_prompt, *x_sample, *cache_k, *cache_v, *state_ret, *p_prompt, *p_sample, *pre_norm, *post_norm, *w_in_attn, *sinks, *w_out_attn, *w_in_ret, *w_out_ret, *w_ple, *w_gate;
    float* out; unsigned char* ws;
};

__device__ __forceinline__ unsigned cvt_pk_bf16(float lo, float hi) { unsigned r; asm volatile("v_cvt_pk_bf16_f32 %0, %1, %2" : "=v"(r) : "v"(lo), "v"(hi)); return r; }
__device__ __forceinline__ u32x2 pk4(f32x4 v) { u32x2 w; w.x = cvt_pk_bf16(v[0], v[1]); w.y = cvt_pk_bf16(v[2], v[3]); return w; }
__device__ __forceinline__ float bf2f(bf16_t b) { return __uint_as_float(((unsigned)b) << 16); }
__device__ __forceinline__ float bflo(unsigned w) { return __uint_as_float(w << 16); }
__device__ __forceinline__ float bfhi(unsigned w) { return __uint_as_float(w & 0xffff0000u); }
__device__ __forceinline__ float silu_f(float x) { return x * __builtin_amdgcn_rcpf(1.f + __expf(-x)); }
__device__ __forceinline__ float sigmoid_f(float x) { return __builtin_amdgcn_rcpf(1.f + __expf(-x)); }
__device__ __forceinline__ void cos_sin(float ang, float& c, float& s) {
    const float k = rintf(ang * 0.15915494309189535f);
    float r = fmaf(-k, 6.28125f, ang); r = fmaf(-k, 1.9353071795864769e-3f, r);
    const float t = r * 0.15915494309189535f;
    c = __builtin_amdgcn_cosf(t); s = __builtin_amdgcn_sinf(t);
}
__device__ __forceinline__ float wave_sum(float v) {
#pragma unroll
    for (int o = 32; o >= 1; o >>= 1) v += __shfl_xor(v, o, 64);
    return v;
}
__device__ __forceinline__ int otid() { int t = threadIdx.x; asm volatile("" : "+v"(t)); return t; }
__device__ __forceinline__ void lds_barrier() { asm volatile("s_waitcnt lgkmcnt(0)" ::: "memory"); __builtin_amdgcn_s_barrier(); asm volatile("" ::: "memory"); }
__device__ __forceinline__ float ret_lg(int h) { return h == 0 ? -3.1748698315e-02f : h == 1 ? -1.5748356968e-02f : h == 2 ? -7.8431774610e-03f : -3.9138993211e-03f; }

#define XB_TMO      128
#define XB_XCNT(j)  (256  + 64 * (j))
#define XB_XSUB(j)  (1280 + 64 * (j))
#define XB_XGEN(j)  (2304 + 64 * (j))
#define XB_TOP      3328
#define XB_TOPGEN   3392
#define XCD_BAR_WORDS 3456
#define XB_SPIN_CAP (1u << 18)

__device__ __forceinline__ unsigned xb_ld(unsigned* p)              { return __hip_atomic_load(p, __ATOMIC_RELAXED, __HIP_MEMORY_SCOPE_AGENT); }
__device__ __forceinline__ unsigned xb_add(unsigned* p, unsigned v) { return __hip_atomic_fetch_add(p, v, __ATOMIC_RELAXED, __HIP_MEMORY_SCOPE_AGENT); }
__device__ __forceinline__ unsigned xb_xcc_id() { return (unsigned)__builtin_amdgcn_s_getreg((3 << 11) | 20) & 0xFu; }
#define XB_SPIN(cond, bar) do { unsigned _sp = 0; while (cond) { __builtin_amdgcn_s_sleep(1); \
    if ((++_sp & 255u) == 0u) { if (xb_ld(&(bar)[XB_TMO])) break; if (_sp > XB_SPIN_CAP) { atomicAdd(&(bar)[XB_TMO], 1u); break; } } } } while (0)

struct XcdBarrier {
    unsigned* bar; unsigned x;
    volatile LAS unsigned* st;
};

__device__ __forceinline__ XcdBarrier xcd_barrier_post(unsigned* bar, volatile LAS unsigned* st) {
    XcdBarrier b; b.bar = bar; b.x = xb_xcc_id(); b.st = st;
    if (threadIdx.x == 0) (void)xb_add(&bar[XB_XCNT(b.x)], 1u);
    return b;
}
__device__ __forceinline__ void xcd_barrier_complete(unsigned* bar, unsigned x, unsigned& nloc, unsigned& nx) {
    const unsigned G = gridDim.x * gridDim.y * gridDim.z;
    unsigned sum, cnt, mine, sp = 0u;
    for (;;) {
        sum = 0u; cnt = 0u; mine = 0u;
#pragma unroll
        for (unsigned j = 0; j < 16; ++j) { const unsigned c = xb_ld(&bar[XB_XCNT(j)]); sum += c; cnt += (c > 0u) ? 1u : 0u; mine = (j == x) ? c : mine; }
        if (sum == G) break;
        __builtin_amdgcn_s_sleep(1);
        if ((++sp & 255u) == 0u) { if (xb_ld(&bar[XB_TMO])) break; if (sp > XB_SPIN_CAP) { atomicAdd(&bar[XB_TMO], 1u); break; } }
    }
    nloc = mine > 0u ? mine : 1u; nx = cnt > 0u ? cnt : 1u;
}

__device__ __forceinline__ void xcd_barrier(const XcdBarrier& b) {
    asm volatile("s_waitcnt vmcnt(0)" ::: "memory");
    __syncthreads();
    if (threadIdx.x == 0) {
        unsigned* bar = b.bar;
        __builtin_amdgcn_s_waitcnt(0);
        unsigned nloc = b.st[0], nx = b.st[1];
        if (nloc == 0u) { xcd_barrier_complete(bar, b.x, nloc, nx); b.st[0] = nloc; b.st[1] = nx; }
        const unsigned old = xb_add(&bar[XB_XSUB(b.x)], 1u);
        const unsigned gen = old / nloc;
        if (old + 1u == (gen + 1u) * nloc) {
            __builtin_amdgcn_fence(__ATOMIC_RELEASE, "agent");
            asm volatile("s_waitcnt vmcnt(0)" ::: "memory");
            const unsigned og = xb_add(&bar[XB_TOP], 1u);
            const unsigned tg = og / nx;
            if (og + 1u == (tg + 1u) * nx) xb_add(&bar[XB_TOPGEN], 1u);
            else XB_SPIN(xb_ld(&bar[XB_TOPGEN]) == tg, bar);
            __builtin_amdgcn_fence(__ATOMIC_ACQUIRE, "agent");
            xb_add(&bar[XB_XGEN(b.x)], 1u);
            asm volatile("s_waitcnt vmcnt(0)" ::: "memory");
        } else {
            XB_SPIN(xb_ld(&bar[XB_XGEN(b.x)]) == gen, bar);
            __builtin_amdgcn_fence(__ATOMIC_ACQUIRE, "agent");
            asm volatile("s_waitcnt vmcnt(0)" ::: "memory");
        }
    }
    __syncthreads();
}

namespace pg8 {
constexpr int BM = 256, BK = 64, HALF = 128, HTB = HALF * BK * 2, STAGE_BYTES = 8 * HTB, NXCD = 8, WGM = 8;
__host__ __device__ __forceinline__ int lds_byte(int r, int c) { const int st = (r >> 4) * 2 + (c >> 5), rr = r & 15, cc = c & 31, ob = rr * 64 + cc * 2; return st * 1024 + (ob ^ (((ob >> 9) & 1) << 5)); }
__host__ __device__ __forceinline__ void stage_rc(int b, int& R, int& C) { const int st = b / 1024, sb = b % 1024, swz = sb ^ (((sb >> 9) & 1) << 5); R = (st >> 1) * 16 + swz / 64; C = (st & 1) * 32 + (swz % 64) / 2; }
struct Unit { int pm, pn; };
struct Gemm { const bf16_t* A; const bf16_t* Bt; int M, N, K; };
struct StaticOrder {
    int nM, nN, nwg, G, c;
    __host__ __device__ void init(int M, int N, int G_, int c_) { nM = M / BM; nN = N / BM; nwg = nM * nN; G = G_; c = c_; }
    __host__ __device__ bool next(int i, Unit& u) const {
        const long L = (long)i * G + c; if (L >= nwg) return false;
        int wgid = (int)L; { const int q = nwg / NXCD, r = nwg % NXCD, xcd = wgid % NXCD, off = wgid / NXCD; wgid = (xcd < r ? xcd * (q + 1) : r * (q + 1) + (xcd - r) * q) + off; }
        const int nig = WGM * nN, gid = wgid / nig, fm = gid * WGM, gsz = (nM - fm) < WGM ? (nM - fm) : WGM;
        u.pm = fm + ((wgid % nig) % gsz); u.pn = (wgid % nig) / gsz; return true;
    }
};

struct TailOrder {
    int first, nblk, nwg, c;
    __host__ __device__ void init(int M, int first_, int G_, int c_) { nwg = (M / BM) * 4; first = first_; nblk = G_ - first_; c = c_; }
    __host__ __device__ bool next(int i, Unit& u) const { if (c < first) return false; const int L = (c - first) + i * nblk; if (L >= nwg) return false; u.pm = L >> 2; u.pn = L & 3; return true; }
};

template <class Epi, class Sched>
__device__ __forceinline__ void gemm_phase(LAS unsigned char* lds, const Gemm g, const Sched& S, const Epi& E) {
    const int tid = otid(), wid = __builtin_amdgcn_readfirstlane(tid >> 6), lane = tid & 63, wr = wid >> 2, wc = wid & 3, fr = lane & 15, fq = lane >> 4;
    const int K = g.K, nt = K / BK;
    unsigned voffA[2], voffB[2];
#pragma unroll
    for (int i = 0; i < 2; ++i) { int R, C; stage_rc(tid * 16 + i * 8192, R, C); voffA[i] = (unsigned)(R * K + C) * 2u; voffB[i] = voffA[i]; }
    const size_t kstep = (size_t)(BK * 2);
    const size_t hstep = (size_t)HALF * K * 2;
    const size_t tstep = 2 * hstep;
    const unsigned ldsw = (unsigned)wid * 1024u;
    const int aoff = lds_byte(wr * 64 + fr, fq * 8), boff = lds_byte(wc * 32 + fr, fq * 8);
#define PG8_SA(b, h) (((b) * 2 + (h)) * HTB)
#define PG8_SB(b, h) ((4 + (b) * 2 + (h)) * HTB)
#define PG8_STAGE(bufoff, gbase, voff) do { _Pragma("unroll") for (int _i = 0; _i < 2; ++_i) \
        __builtin_amdgcn_global_load_lds((const unsigned*)((const char*)(gbase) + (voff)[_i]), (LAS unsigned*)(lds + (bufoff) + ldsw + _i * 8192), 16, 0, 0); } while (0)
#define PG8_LDA(dst, b, h) do { _Pragma("unroll") for (int m = 0; m < 4; ++m) _Pragma("unroll") for (int k = 0; k < 2; ++k) dst[m][k] = *(const LAS bf16x8*)(lds + PG8_SA(b, h) + aoff + m * 2048 + k * 1024); } while (0)
#define PG8_LDB(dst, b, h) do { _Pragma("unroll") for (int n = 0; n < 2; ++n) _Pragma("unroll") for (int k = 0; k < 2; ++k) dst[n][k] = *(const LAS bf16x8*)(lds + PG8_SB(b, h) + boff + n * 2048 + k * 1024); } while (0)
#define PG8_MMA(ai, bj, At, Bt) do { __builtin_amdgcn_s_setprio(1); _Pragma("unroll") for (int m = 0; m < 4; ++m) _Pragma("unroll") for (int n = 0; n < 2; ++n) _Pragma("unroll") for (int k = 0; k < 2; ++k) \
        acc[ai][bj][m][n] = __builtin_amdgcn_mfma_f32_16x16x32_bf16(Bt[n][k], At[m][k], acc[ai][bj][m][n], 0, 0, 0); __builtin_amdgcn_s_setprio(0); } while (0)
#define PG8_WAIT_V(n) asm volatile("s_waitcnt vmcnt(" #n ")" ::: "memory")
#define PG8_WAIT_L(n) asm volatile("s_waitcnt lgkmcnt(" #n ")" ::: "memory")
#define PG8_BAR __builtin_amdgcn_s_barrier()
#define PG8_SCHED __builtin_amdgcn_sched_barrier(0)
#define PG8_PTRS(u, pa, pb) do { const char* _a = (const char*)g.A + (size_t)(u).pm * tstep; const char* _b = (const char*)g.Bt + (size_t)(u).pn * tstep; if (Epi::swap(u)) { pa = _b; pb = _a; } else { pa = _a; pb = _b; } } while (0)
    Unit cur, nxt; int ui = 0;
    if (!S.next(0, cur)) return;
    f32x4 acc[2][2][4][2];
#pragma unroll
    for (int a = 0; a < 2; ++a)
#pragma unroll
        for (int b = 0; b < 2; ++b)
#pragma unroll
            for (int m = 0; m < 4; ++m)
#pragma unroll
                for (int n = 0; n < 2; ++n) acc[a][b][m][n] = (f32x4){0.f, 0.f, 0.f, 0.f};
    bf16x8 At[4][2], B0[2][2], B1[2][2];
    const char* cA; const char* cB;
    PG8_PTRS(cur, cA, cB);
    PG8_STAGE(PG8_SB(0, 0), cB, voffB); PG8_STAGE(PG8_SA(0, 0), cA, voffA); PG8_STAGE(PG8_SB(0, 1), cB + hstep, voffB); PG8_STAGE(PG8_SA(0, 1), cA + hstep, voffA);
    if (wr == 1) PG8_BAR;
    PG8_WAIT_V(4); PG8_BAR;
    PG8_STAGE(PG8_SB(1, 0), cB + kstep, voffB); PG8_STAGE(PG8_SA(1, 0), cA + kstep, voffA); PG8_STAGE(PG8_SB(1, 1), cB + hstep + kstep, voffB);
    PG8_WAIT_V(6); PG8_BAR;
    for (;;) {
        const bool has_next = S.next(ui + 1, nxt);
        const char* nA = cA; const char* nB = cB;
        if (has_next) PG8_PTRS(nxt, nA, nB);
        for (int t = 0; t < nt; t += 2) {
            const bool last = (t == nt - 2);
            const char* a1 = cA + (size_t)(t + 1) * kstep;
            const char* a2 = last ? nA : cA + (size_t)(t + 2) * kstep; const char* b2 = last ? nB : cB + (size_t)(t + 2) * kstep;
            const char* a3 = a2 + kstep; const char* b3 = b2 + kstep;
            PG8_LDB(B0, 0, 0); PG8_SCHED; PG8_LDA(At, 0, 0); PG8_STAGE(PG8_SA(1, 1), a1 + hstep, voffA);
            PG8_WAIT_L(8); PG8_BAR; PG8_WAIT_L(0); PG8_MMA(0, 0, At, B0); PG8_BAR; PG8_SCHED;
            PG8_LDB(B1, 0, 1); PG8_STAGE(PG8_SB(0, 0), b2, voffB);
            PG8_BAR; PG8_WAIT_L(0); PG8_MMA(0, 1, At, B1); PG8_BAR;
            PG8_LDA(At, 0, 1); PG8_STAGE(PG8_SA(0, 0), a2, voffA);
            PG8_BAR; PG8_WAIT_L(0); PG8_MMA(1, 0, At, B0); PG8_BAR; PG8_SCHED;
            PG8_STAGE(PG8_SB(0, 1), b2 + hstep, voffB);
            PG8_WAIT_V(6); PG8_BAR; PG8_MMA(1, 1, At, B1); PG8_BAR;
            PG8_LDB(B0, 1, 0); PG8_SCHED; PG8_LDA(At, 1, 0); PG8_STAGE(PG8_SA(0, 1), a2 + hstep, voffA);
            PG8_WAIT_L(8); PG8_BAR; PG8_WAIT_L(0); PG8_MMA(0, 0, At, B0); PG8_BAR; PG8_SCHED;
            PG8_LDB(B1, 1, 1); PG8_STAGE(PG8_SB(1, 0), b3, voffB);
            PG8_BAR; PG8_WAIT_L(0); PG8_MMA(0, 1, At, B1); PG8_BAR;
            PG8_LDA(At, 1, 1); PG8_STAGE(PG8_SA(1, 0), a3, voffA);
            PG8_BAR; PG8_WAIT_L(0); PG8_MMA(1, 0, At, B0); PG8_BAR; PG8_SCHED;
            PG8_STAGE(PG8_SB(1, 1), b3 + hstep, voffB);
            PG8_WAIT_V(6); PG8_BAR; PG8_MMA(1, 1, At, B1); PG8_BAR;
        }
        E(acc, cur, wr, wc, fr, fq);
        if (!has_next) break;
#pragma unroll
        for (int a = 0; a < 2; ++a)
#pragma unroll
            for (int b = 0; b < 2; ++b)
#pragma unroll
                for (int m = 0; m < 4; ++m)
#pragma unroll
                    for (int n = 0; n < 2; ++n) acc[a][b][m][n] = (f32x4){0.f, 0.f, 0.f, 0.f};
        cur = nxt; cA = nA; cB = nB; ++ui;
    }
    PG8_WAIT_V(0);
    if (wr == 0) PG8_BAR;
    PG8_BAR;
#undef PG8_SA
#undef PG8_SB
#undef PG8_STAGE
#undef PG8_LDA
#undef PG8_LDB
#undef PG8_MMA
#undef PG8_WAIT_V
#undef PG8_WAIT_L
#undef PG8_BAR
#undef PG8_SCHED
#undef PG8_PTRS
}
}
using pg8::Unit;

struct EpiF32 {
    float* C; int ldc;
    __device__ __forceinline__ static bool swap(const Unit&) { return false; }
    __device__ __forceinline__ void operator()(const f32x4 (&acc)[2][2][4][2], const Unit& u, int wr, int wc, int fr, int fq) const {
        const int row0 = u.pm * 256 + wr * 64 + fr, col0 = u.pn * 256 + wc * 32 + 4 * fq;
#pragma unroll
        for (int ai = 0; ai < 2; ++ai)
#pragma unroll
            for (int m = 0; m < 4; ++m) { float* rowp = C + (size_t)(row0 + ai * 128 + m * 16) * ldc + col0;
#pragma unroll
                for (int bj = 0; bj < 2; ++bj)
#pragma unroll
                    for (int n = 0; n < 2; ++n) *(f32x4*)(rowp + bj * 128 + n * 16) = acc[ai][bj][m][n]; }
    }
};
struct EpiB16 {
    bf16_t* C; int ldc;
    __device__ __forceinline__ static bool swap(const Unit&) { return false; }
    __device__ __forceinline__ void operator()(const f32x4 (&acc)[2][2][4][2], const Unit& u, int wr, int wc, int fr, int fq) const {
        const int row0 = u.pm * 256 + wr * 64 + fr, col0 = u.pn * 256 + wc * 32 + 4 * fq;
#pragma unroll
        for (int ai = 0; ai < 2; ++ai)
#pragma unroll
            for (int m = 0; m < 4; ++m) { bf16_t* rowp = C + (size_t)(row0 + ai * 128 + m * 16) * ldc + col0;
#pragma unroll
                for (int bj = 0; bj < 2; ++bj)
#pragma unroll
                    for (int n = 0; n < 2; ++n) *(u32x2*)(rowp + bj * 128 + n * 16) = pk4(acc[ai][bj][m][n]); }
    }
};
template <bool OB16> struct EpiGate {
    const bf16_t* X1; const bf16_t* PLE; float* O; bf16_t* Ob;
    __device__ __forceinline__ static bool swap(const Unit&) { return false; }
    __device__ __forceinline__ void operator()(const f32x4 (&acc)[2][2][4][2], const Unit& u, int wr, int wc, int fr, int fq) const {
        const int row0 = u.pm * 256 + wr * 64 + fr, col0 = u.pn * 256 + wc * 32 + 4 * fq;
#pragma unroll
        for (int ai = 0; ai < 2; ++ai)
#pragma unroll
            for (int m = 0; m < 4; ++m) { const size_t ro = (size_t)(row0 + ai * 128 + m * 16) * 1024 + col0;
#pragma unroll
                for (int bj = 0; bj < 2; ++bj)
#pragma unroll
                    for (int n = 0; n < 2; ++n) { const size_t o = ro + bj * 128 + n * 16; const f32x4 a = acc[ai][bj][m][n]; const u32x2 xw = *(const u32x2*)(X1 + o), pw = *(const u32x2*)(PLE + o);
                        const f32x4 x1 = {bflo(xw.x), bfhi(xw.x), bflo(xw.y), bfhi(xw.y)}, pl = {bflo(pw.x), bfhi(pw.x), bflo(pw.y), bfhi(pw.y)}; f32x4 r;
#pragma unroll
                        for (int j = 0; j < 4; ++j) r[j] = x1[j] + sigmoid_f(a[j]) * pl[j];
                        if (OB16) *(u32x2*)(Ob + o) = pk4(r); else *(f32x4*)(O + o) = r; } }
    }
};
struct EpiInAttn {
    bf16_t *Zq, *Zk, *Zg, *vTp, *vTs; const float* tab; float* out;
    __device__ __forceinline__ static bool swap(const Unit& u) { return u.pn == 5; }
    __device__ __forceinline__ void operator()(const f32x4 (&acc)[2][2][4][2], const Unit& u, int wr, int wc, int fr, int fq) const {
        const int pn = u.pn;
        if (pn < 5) {
            const bool isq = pn < 4;
            const int fi = 16 * (wc & 1) + 4 * fq;
#pragma unroll
            for (int ai = 0; ai < 2; ++ai)
#pragma unroll
                for (int m = 0; m < 4; ++m) {
                    const int r = u.pm * 256 + ai * 128 + wr * 64 + m * 16 + fr;
                    const int pi = r < MP ? (r & 4095) : 4096 + ((r - MP) & 7);
                    const f32x4 t0 = *(const f32x4*)(tab + ((size_t)pi * 32 + fi) * 2), t1 = *(const f32x4*)(tab + ((size_t)pi * 32 + fi) * 2 + 4);
                    const float cs[4] = {t0[0], t0[2], t1[0], t1[2]}, sn[4] = {t0[1], t0[3], t1[1], t1[3]};
#pragma unroll
                    for (int bj = 0; bj < 2; ++bj) {
                        const f32x4 x1 = acc[ai][bj][m][0], x2 = acc[ai][bj][m][1]; f32x4 o1, o2;
#pragma unroll
                        for (int j = 0; j < 4; ++j) { o1[j] = x1[j] * cs[j] - x2[j] * sn[j]; o2[j] = x2[j] * cs[j] + x1[j] * sn[j]; }
                        const int hh = 2 * bj + (wc >> 1), d1 = 16 * (wc & 1) + 4 * fq;
                        if (isq) {
                            bf16_t* p = Zq + (size_t)r * 1024 + pn * 256 + hh * 64 + d1;
                            *(u32x2*)p = pk4(o1 * 0.125f); *(u32x2*)(p + 32) = pk4(o2 * 0.125f);
                        } else {
                            bf16_t* p = Zk + (size_t)r * 256 + hh * 64 + d1;
                            *(u32x2*)p = pk4(o1); *(u32x2*)(p + 32) = pk4(o2);
                            if (r < MP) { const int t = r & 4095; if (t >= 3968) { float* dst = out + OFF_KWP + ((size_t)((r >> 12) * 128 + t - 3968) * 4 + hh) * 64 + d1; *(f32x4*)dst = o1; *(f32x4*)(dst + 32) = o2; } }
                            else { const int rs = r - MP; float* dst = out + OFF_KWS + ((size_t)((rs >> 3) * 128 + 120 + (rs & 7)) * 4 + hh) * 64 + d1; *(f32x4*)dst = o1; *(f32x4*)(dst + 32) = o2; }
                        }
                    }
                    asm volatile("" ::: "memory");
                }
        } else if (pn == 5) {
#pragma unroll
            for (int ai = 0; ai < 2; ++ai)
#pragma unroll
                for (int m = 0; m < 4; ++m) {
                    const int e = ai * 128 + wr * 64 + m * 16 + fr, kvh = e >> 6, d = e & 63;
#pragma unroll
                    for (int bj = 0; bj < 2; ++bj)
#pragma unroll
                        for (int n = 0; n < 2; ++n) {
                            const int tok = u.pm * 256 + bj * 128 + wc * 32 + n * 16 + 4 * fq; const f32x4 v = acc[ai][bj][m][n];
                            if (tok < MP) { const int b = tok >> 12, t = tok & 4095;
                                *(u32x2*)(vTp + ((size_t)((b * 4 + kvh) * 64 + d)) * 4096 + t) = pk4(v);
                                if (t >= 3968) {
#pragma unroll
                                    for (int jj = 0; jj < 4; ++jj) out[OFF_VWP + ((size_t)(b * 128 + t - 3968 + jj) * 4 + kvh) * 64 + d] = v[jj]; }
                            } else { const int ts = tok - MP, bs = ts >> 3, l0 = ts & 7;
                                *(u32x2*)(vTs + ((size_t)((bs * 4 + kvh) * 64 + d)) * 8 + l0) = pk4(v);
#pragma unroll
                                for (int jj = 0; jj < 4; ++jj) out[OFF_VWS + ((size_t)(bs * 128 + 120 + l0 + jj) * 4 + kvh) * 64 + d] = v[jj]; }
                        }
                }
        } else {
#pragma unroll
            for (int ai = 0; ai < 2; ++ai)
#pragma unroll
                for (int m = 0; m < 4; ++m) { const int r = u.pm * 256 + ai * 128 + wr * 64 + m * 16 + fr;
#pragma unroll
                    for (int bj = 0; bj < 2; ++bj)
#pragma unroll
                        for (int n = 0; n < 2; ++n) { const f32x4 a = acc[ai][bj][m][n]; f32x4 s;
#pragma unroll
                            for (int j = 0; j < 4; ++j) s[j] = silu_f(a[j]);
                            *(u32x2*)(Zg + (size_t)r * 1024 + (pn - 6) * 256 + bj * 128 + wc * 32 + n * 16 + 4 * fq) = pk4(s); } }
        }
    }
};
struct EpiInRet {
    bf16_t *Zq, *Zk, *Zg, *vTp, *vTs; const float* tab;
    __device__ __forceinline__ static bool swap(const Unit& u) { return u.pn >= 8 && u.pn < 16; }
    __device__ __forceinline__ void operator()(const f32x4 (&acc)[2][2][4][2], const Unit& u, int wr, int wc, int fr, int fq) const {
        const int pn = u.pn;
        if (pn < 8) {
            const bool isq = pn < 4; const float sc = isq ? 1.f : 0.0625f;
            bf16_t* Z = isq ? Zq : Zk; const int hc = (pn & 3) * 256;
#pragma unroll
            for (int ai = 0; ai < 2; ++ai)
#pragma unroll
                for (int m = 0; m < 4; ++m) {
                    const int r = u.pm * 256 + ai * 128 + wr * 64 + m * 16 + fr;
                    const int pi = r < MP ? (r & 4095) : 4096 + ((r - MP) & 7);
#pragma unroll
                    for (int n = 0; n < 2; ++n) {
                        const int d = wc * 32 + n * 16 + 4 * fq;
                        const f32x4 t0 = *(const f32x4*)(tab + ((size_t)pi * 128 + d) * 2), t1 = *(const f32x4*)(tab + ((size_t)pi * 128 + d) * 2 + 4);
                        const float cs[4] = {t0[0], t0[2], t1[0], t1[2]}, sn[4] = {t0[1], t0[3], t1[1], t1[3]};
                        const f32x4 x1 = acc[ai][0][m][n], x2 = acc[ai][1][m][n]; f32x4 o1, o2;
#pragma unroll
                        for (int j = 0; j < 4; ++j) { o1[j] = (x1[j] * cs[j] - x2[j] * sn[j]) * sc; o2[j] = (x2[j] * cs[j] + x1[j] * sn[j]) * sc; }
                        bf16_t* p = Z + (size_t)r * 1024 + hc + d;
                        *(u32x2*)p = pk4(o1); *(u32x2*)(p + 128) = pk4(o2);
                    }
                }
        } else if (pn < 16) {
#pragma unroll
            for (int ai = 0; ai < 2; ++ai)
#pragma unroll
                for (int m = 0; m < 4; ++m) {
                    const int eg = (pn - 8) * 256 + ai * 128 + wr * 64 + m * 16 + fr, h = eg >> 9, e = eg & 511;
#pragma unroll
                    for (int bj = 0; bj < 2; ++bj)
#pragma unroll
                        for (int n = 0; n < 2; ++n) {
                            const int tok = u.pm * 256 + bj * 128 + wc * 32 + n * 16 + 4 * fq; const u32x2 w = pk4(acc[ai][bj][m][n]);
                            if (tok < MP) { const int b = tok >> 12, t = tok & 4095; *(u32x2*)(vTp + ((size_t)((b * 4 + h) * 512 + e)) * 4096 + t) = w; }
                            else { const int ts = tok - MP, bs = ts >> 3, l0 = ts & 7; *(u32x2*)(vTs + ((size_t)((bs * 4 + h) * 512 + e)) * 8 + l0) = w; }
                        }
                }
        } else {
#pragma unroll
            for (int ai = 0; ai < 2; ++ai)
#pragma unroll
                for (int m = 0; m < 4; ++m) { const int r = u.pm * 256 + ai * 128 + wr * 64 + m * 16 + fr;
#pragma unroll
                    for (int bj = 0; bj < 2; ++bj)
#pragma unroll
                        for (int n = 0; n < 2; ++n) { const f32x4 a = acc[ai][bj][m][n]; f32x4 s;
#pragma unroll
                            for (int j = 0; j < 4; ++j) s[j] = silu_f(a[j]);
                            *(u32x2*)(Zg + (size_t)r * 2048 + (pn - 16) * 256 + bj * 128 + wc * 32 + n * 16 + 4 * fq) = pk4(s); } }
        }
    }
};

__device__ __forceinline__ void transpose_tile(const float* __restrict__ W, bf16_t* __restrict__ Wt, int K, int N, bool perm, int tile, LAS float* T) {
    const int tid = otid(), ntn = N >> 6;
    const int n0 = (tile % ntn) * 64, k0 = (tile / ntn) * 64, nn = tid & 63;
    const int nd = n0 + nn; int ns = nd;
    if (perm && nd < 1280) { const int p = nd & 63; ns = (nd - p) + (p >> 5) * 16 + (p & 15) + ((p >> 4) & 1) * 32; }
#pragma unroll
    for (int i = 0; i < 8; ++i) { const int kk = (tid >> 6) + 8 * i; T[kk * 65 + nn] = W[(size_t)(k0 + kk) * N + ns]; }
    __syncthreads();
    const int kk2 = (tid & 31) * 2;
#pragma unroll
    for (int i = 0; i < 4; ++i) { const int n2 = (tid >> 5) + 16 * i; *(unsigned*)(Wt + (size_t)(n0 + n2) * K + k0 + kk2) = cvt_pk_bf16(T[kk2 * 65 + n2], T[(kk2 + 1) * 65 + n2]); }
    __syncthreads();
}

__device__ __forceinline__ void rms_rows(const float* __restrict__ Xa, const float* __restrict__ Xb, const float* __restrict__ g, bf16_t* __restrict__ H, int G) {
    const int tid_o = otid(), wave = tid_o >> 6, lane = tid_o & 63;
    for (int row = blockIdx.x * 8 + wave; row < MT; row += G * 8) {
        const float* x = row < MP ? Xa + (size_t)row * 1024 : Xb + (size_t)(row - MP) * 1024;
        f32x4 v[4]; float ss = 0.f;
#pragma unroll
        for (int i = 0; i < 4; ++i) { v[i] = *(const f32x4*)(x + lane * 4 + 256 * i); ss += v[i][0] * v[i][0] + v[i][1] * v[i][1] + v[i][2] * v[i][2] + v[i][3] * v[i][3]; }
        ss = wave_sum(ss);
        const float rr = rsqrtf(ss * (1.f / 1024.f) + EPS);
#pragma unroll
        for (int i = 0; i < 4; ++i) { const f32x4 gg = *(const f32x4*)(g + lane * 4 + 256 * i); *(u32x2*)(H + (size_t)row * 1024 + lane * 4 + 256 * i) = pk4(v[i] * rr * gg); }
    }
}
__device__ __forceinline__ void rms_rows_b16(const bf16_t* __restrict__ X, const float* __restrict__ g, bf16_t* __restrict__ H, int G) {
    const int tid_o = otid(), wave = tid_o >> 6, lane = tid_o & 63;
    for (int row = blockIdx.x * 8 + wave; row < MT; row += G * 8) {
        const u32x4 a = *(const u32x4*)(X + (size_t)row * 1024 + lane * 8), b = *(const u32x4*)(X + (size_t)row * 1024 + 512 + lane * 8);
        const float v[16] = {bflo(a.x), bfhi(a.x), bflo(a.y), bfhi(a.y), bflo(a.z), bfhi(a.z), bflo(a.w), bfhi(a.w), bflo(b.x), bfhi(b.x), bflo(b.y), bfhi(b.y), bflo(b.z), bfhi(b.z), bflo(b.w), bfhi(b.w)};
        float ss = 0.f;
#pragma unroll
        for (int i = 0; i < 16; ++i) ss += v[i] * v[i];
        ss = wave_sum(ss);
        const float rr = rsqrtf(ss * (1.f / 1024.f) + EPS);
#pragma unroll
        for (int hh = 0; hh < 2; ++hh) { const int c = hh * 512 + lane * 8; const f32x4 g0 = *(const f32x4*)(g + c), g1 = *(const f32x4*)(g + c + 4); u32x4 o;
            o.x = cvt_pk_bf16(v[hh * 8 + 0] * rr * g0[0], v[hh * 8 + 1] * rr * g0[1]); o.y = cvt_pk_bf16(v[hh * 8 + 2] * rr * g0[2], v[hh * 8 + 3] * rr * g0[3]);
            o.z = cvt_pk_bf16(v[hh * 8 + 4] * rr * g1[0], v[hh * 8 + 5] * rr * g1[1]); o.w = cvt_pk_bf16(v[hh * 8 + 6] * rr * g1[2], v[hh * 8 + 7] * rr * g1[3]);
            *(u32x4*)(H + (size_t)row * 1024 + c) = o; }
    }
}
template <bool XB16>
__device__ __forceinline__ void resid_rows(const float* __restrict__ Xa, const float* __restrict__ Xb, const bf16_t* __restrict__ Xh, const bf16_t* __restrict__ Y, const float* __restrict__ g, bf16_t* __restrict__ H, int G) {
    const int tid_o = otid(), wave = tid_o >> 6, lane = tid_o & 63;
    for (int row = blockIdx.x * 8 + wave; row < MT; row += G * 8) {
        const bf16_t* y = Y + (size_t)row * 1024;
        f32x4 v[4]; float ss = 0.f;
#pragma unroll
        for (int i = 0; i < 4; ++i) { const u32x2 yw = *(const u32x2*)(y + lane * 4 + 256 * i); v[i] = (f32x4){bflo(yw.x), bfhi(yw.x), bflo(yw.y), bfhi(yw.y)}; ss += v[i][0] * v[i][0] + v[i][1] * v[i][1] + v[i][2] * v[i][2] + v[i][3] * v[i][3]; }
        ss = wave_sum(ss);
        const float rr = rsqrtf(ss * (1.f / 1024.f) + EPS);
#pragma unroll
        for (int i = 0; i < 4; ++i) { const int c = lane * 4 + 256 * i; const f32x4 gg = *(const f32x4*)(g + c); f32x4 xx;
            if (XB16) { const u32x2 xw = *(const u32x2*)(Xh + (size_t)row * 1024 + c); xx = (f32x4){bflo(xw.x), bfhi(xw.x), bflo(xw.y), bfhi(xw.y)}; }
            else xx = *(const f32x4*)((row < MP ? Xa + (size_t)row * 1024 : Xb + (size_t)(row - MP) * 1024) + c);
            *(u32x2*)(H + (size_t)row * 1024 + c) = pk4(xx + v[i] * rr * gg); }
    }
}

struct SkF32 { float* C; __device__ __forceinline__ void operator()(int row, int col, f32x4 v) const { *(f32x4*)(C + (size_t)row * 1024 + col) = v; } };
struct SkB16 { bf16_t* C; __device__ __forceinline__ void operator()(int row, int col, f32x4 v) const { *(u32x2*)(C + (size_t)row * 1024 + col) = pk4(v); } };
template <bool OB16> struct SkGate { const bf16_t* X1; const bf16_t* PLE; float* O; bf16_t* Ob;
    __device__ __forceinline__ void operator()(int row, int col, f32x4 a) const { const size_t o = (size_t)row * 1024 + col; const u32x2 xw = *(const u32x2*)(X1 + o), pw = *(const u32x2*)(PLE + o);
        const f32x4 x1 = {bflo(xw.x), bfhi(xw.x), bflo(xw.y), bfhi(xw.y)}, pl = {bflo(pw.x), bfhi(pw.x), bflo(pw.y), bfhi(pw.y)}; f32x4 r;
#pragma unroll
        for (int j = 0; j < 4; ++j) r[j] = x1[j] + sigmoid_f(a[j]) * pl[j];
        if (OB16) *(u32x2*)(Ob + o) = pk4(r); else *(f32x4*)(O + o) = r; } };
template <class Epi>
__device__ __forceinline__ void skinny_gemm(LAS unsigned char* lds, const bf16_t* __restrict__ A, const bf16_t* __restrict__ Bt, int K, const Epi& E, int G) {
    LAS float* red = (LAS float*)lds;
    const int tid = otid(), w = tid >> 6, lane = tid & 63, l16 = lane & 15, g = lane >> 4;
    const int KS = K >> 3, nks = KS >> 5;
    for (int u = blockIdx.x; u < 256; u += G) {
        const int row0 = (u >> 4) * 64, col0 = (u & 15) * 64;
        const bf16_t* ap = A + (size_t)(row0 + l16) * K + w * KS + 8 * g;
        const bf16_t* bp = Bt + (size_t)(col0 + l16) * K + w * KS + 8 * g;
        f32x4 acc[4][4];
#pragma unroll
        for (int mt = 0; mt < 4; ++mt)
#pragma unroll
            for (int nt = 0; nt < 4; ++nt) acc[mt][nt] = (f32x4){0.f, 0.f, 0.f, 0.f};
#pragma unroll 4
        for (int ks = 0; ks < nks; ++ks) {
            bf16x8 af[4], bf[4];
#pragma unroll
            for (int t = 0; t < 4; ++t) { af[t] = *(const bf16x8*)(ap + (size_t)(16 * t) * K + 32 * ks); bf[t] = *(const bf16x8*)(bp + (size_t)(16 * t) * K + 32 * ks); }
#pragma unroll
            for (int mt = 0; mt < 4; ++mt)
#pragma unroll
                for (int nt = 0; nt < 4; ++nt) acc[mt][nt] = __builtin_amdgcn_mfma_f32_16x16x32_bf16(bf[nt], af[mt], acc[mt][nt], 0, 0, 0);
        }
        __syncthreads();
#pragma unroll
        for (int mt = 0; mt < 4; ++mt)
#pragma unroll
            for (int nt = 0; nt < 4; ++nt) *(LAS f32x4*)(red + (w * 64 + 16 * mt + l16) * 68 + 16 * nt + 4 * g) = acc[mt][nt];
        __syncthreads();
#pragma unroll
        for (int j = 0; j < 2; ++j) { const int q = tid + 512 * j, row = q >> 4, c4 = (q & 15) * 4; f32x4 sum = *(const LAS f32x4*)(red + row * 68 + c4);
#pragma unroll
            for (int ww = 1; ww < 8; ++ww) sum += *(const LAS f32x4*)(red + (ww * 64 + row) * 68 + c4);
            E(row0 + row, col0 + c4, sum); }
    }
}

__device__ __forceinline__ void attn_prompt(LAS unsigned char* lds, const bf16_t* __restrict__ Zq, const bf16_t* __restrict__ Zk, const bf16_t* __restrict__ Zg, const bf16_t* __restrict__ vTp,
                                            const float* __restrict__ sinks, bf16_t* __restrict__ OG, int G) {
    LAS bf16_t* Ks = (LAS bf16_t*)lds;
    LAS bf16_t* Vt = (LAS bf16_t*)(lds + 256 * 72 * 2);
    const int tid = otid(), w = tid >> 6, lane = tid & 63, l16 = lane & 15, g = lane >> 4;
    u32x4 pk_[4], pv_[4];
#define AP_LOAD(it_) do { const int kvh_ = (it_) & 3, nb_ = ((it_) >> 2) & 31, b_ = (it_) >> 7; \
        _Pragma("unroll") for (int i = 0; i < 4; ++i) { const int ch = tid + 512 * i, s = ch >> 3, c8 = ch & 7, t = (nb_ - 1) * 128 + s; \
            pk_[i] = (u32x4){0u, 0u, 0u, 0u}; if (t >= 0) pk_[i] = *(const u32x4*)(Zk + (size_t)(b_ * 4096 + t) * 256 + kvh_ * 64 + c8 * 8); } \
        _Pragma("unroll") for (int i = 0; i < 4; ++i) { const int ch = tid + 512 * i, d = ch >> 5, s0 = (ch & 31) * 8, t0 = (nb_ - 1) * 128 + s0; \
            pv_[i] = (u32x4){0u, 0u, 0u, 0u}; if (t0 >= 0) pv_[i] = *(const u32x4*)(vTp + ((size_t)((b_ * 4 + kvh_) * 64 + d)) * 4096 + t0); } } while (0)
    if ((int)blockIdx.x < 512) AP_LOAD((int)blockIdx.x);
    for (int it = blockIdx.x; it < 512; it += G) {
        const int kvh = it & 3, nb = (it >> 2) & 31, b = it >> 7;
        __syncthreads();
#pragma unroll
        for (int i = 0; i < 4; ++i) { const int ch = tid + 512 * i, s = ch >> 3, c8 = ch & 7; *(LAS u32x4*)(Ks + s * 72 + c8 * 8) = pk_[i]; }
#pragma unroll
        for (int i = 0; i < 4; ++i) { const int ch = tid + 512 * i, d = ch >> 5, s0 = (ch & 31) * 8; *(LAS u32x4*)(Vt + d * 264 + s0) = pv_[i]; }
        __syncthreads();
        if (it + G < 512) AP_LOAD(it + G);
        asm volatile("" ::: "memory");
        const int head = kvh * 4 + (w >> 1);
        const float sk = sinks[head];
        for (int qi = 0; qi < 4; ++qi) {
            const int qt = (w & 1) * 4 + qi;
            const size_t tq = (size_t)b * 4096 + nb * 128 + qt * 16 + l16;
            bf16x8 qf[2];
#pragma unroll
            for (int ks = 0; ks < 2; ++ks) qf[ks] = *(const bf16x8*)(Zq + tq * 1024 + head * 64 + ks * 32 + g * 8);
            f32x4 sa[9];
#pragma unroll
            for (int j = 0; j < 9; ++j) { sa[j] = (f32x4){0.f, 0.f, 0.f, 0.f};
#pragma unroll
                for (int ks = 0; ks < 2; ++ks) { const bf16x8 kf = *(const LAS bf16x8*)(Ks + (16 * (qt + j) + l16) * 72 + ks * 32 + g * 8);
                    sa[j] = __builtin_amdgcn_mfma_f32_16x16x32_bf16(kf, qf[ks], sa[j], 0, 0, 0); } }
            float mx = sk;
#pragma unroll
            for (int j = 0; j < 9; ++j) {
                const bool dead = (nb == 0) && (qt + j) < 8;
#pragma unroll
                for (int r = 0; r < 4; ++r) {
                    bool vis = !dead;
                    if (j == 0) vis = vis && ((4 * g + r) > l16);
                    if (j == 8) vis = vis && ((4 * g + r) <= l16);
                    sa[j][r] = vis ? sa[j][r] : -1e30f;
                    mx = fmaxf(mx, sa[j][r]);
                }
            }
            mx = fmaxf(mx, __shfl_xor(mx, 16, 64)); mx = fmaxf(mx, __shfl_xor(mx, 32, 64));
            float sum = 0.f;
#pragma unroll
            for (int j = 0; j < 9; ++j)
#pragma unroll
                for (int r = 0; r < 4; ++r) { const float p = __expf(sa[j][r] - mx); sa[j][r] = p; sum += p; }
            sum += __shfl_xor(sum, 16, 64); sum += __shfl_xor(sum, 32, 64);
            const float inv = 1.f / (sum + __expf(sk - mx));
            f32x4 oa[4];
#pragma unroll
            for (int dt = 0; dt < 4; ++dt) oa[dt] = (f32x4){0.f, 0.f, 0.f, 0.f};
#pragma unroll
            for (int u = 0; u < 5; ++u) {
                u32x4 pw; pw.x = cvt_pk_bf16(sa[2 * u][0], sa[2 * u][1]); pw.y = cvt_pk_bf16(sa[2 * u][2], sa[2 * u][3]);
                if (u < 4) { pw.z = cvt_pk_bf16(sa[2 * u + 1][0], sa[2 * u + 1][1]); pw.w = cvt_pk_bf16(sa[2 * u + 1][2], sa[2 * u + 1][3]); } else { pw.z = 0u; pw.w = 0u; }
                const bf16x8 pf = __builtin_bit_cast(bf16x8, pw);
                const int k0 = 16 * (qt + 2 * u) + 4 * g, k1 = (u < 4) ? k0 + 16 : k0;
#pragma unroll
                for (int dt = 0; dt < 4; ++dt) {
                    const u32x2 v0 = *(const LAS u32x2*)(Vt + (16 * dt + l16) * 264 + k0), v1 = *(const LAS u32x2*)(Vt + (16 * dt + l16) * 264 + k1);
                    u32x4 vw; vw.x = v0.x; vw.y = v0.y; vw.z = v1.x; vw.w = v1.y;
                    oa[dt] = __builtin_amdgcn_mfma_f32_16x16x32_bf16(__builtin_bit_cast(bf16x8, vw), pf, oa[dt], 0, 0, 0);
                }
            }
#pragma unroll
            for (int dt = 0; dt < 4; ++dt) {
                const size_t o = tq * 1024 + head * 64 + 16 * dt + 4 * g;
                const u32x2 gw = *(const u32x2*)(Zg + o);
                f32x4 r; r[0] = oa[dt][0] * inv * bflo(gw.x); r[1] = oa[dt][1] * inv * bfhi(gw.x); r[2] = oa[dt][2] * inv * bflo(gw.y); r[3] = oa[dt][3] * inv * bfhi(gw.y);
                *(u32x2*)(OG + o) = pk4(r);
            }
        }
    }
}
#undef AP_LOAD

__device__ __forceinline__ void attn_sample(LAS unsigned char* lds, const Params& P, const bf16_t* __restrict__ Zq, const bf16_t* __restrict__ Zk, const bf16_t* __restrict__ Zg, const bf16_t* __restrict__ vTs,
                                            bf16_t* __restrict__ OG, int G) {
    constexpr int KS_B = 144 * 72 * 2, VT_B = 64 * 152 * 2, SLOT_B = KS_B + VT_B;
    for (int pr = blockIdx.x; pr < 256; pr += G) {
        const int tid = otid(), w = tid >> 6, lane = tid & 63, l16 = lane & 15, g = lane >> 4;
        __syncthreads();
#pragma unroll
        for (int sl = 0; sl < 2; ++sl) {
            const int it = 2 * pr + sl, bs = it >> 2, kvh = it & 3;
            LAS bf16_t* Ks = (LAS bf16_t*)(lds + sl * SLOT_B); LAS bf16_t* Vt = (LAS bf16_t*)(lds + sl * SLOT_B + KS_B);
#pragma unroll
            for (int i = 0; i < 4; ++i) { const int ch = tid + 512 * i, j = ch >> 4, d4 = (ch & 15) * 4;
                const size_t src = ((size_t)(bs * 128 + j) * 4 + kvh) * 64 + d4;
                const f32x4 kv = *(const f32x4*)(P.cache_k + src), vv = *(const f32x4*)(P.cache_v + src);
                if (j >= 8) { const size_t dst = ((size_t)(bs * 128 + j - 8) * 4 + kvh) * 64 + d4; *(f32x4*)(P.out + OFF_KWS + dst) = kv; *(f32x4*)(P.out + OFF_VWS + dst) = vv; }
                *(LAS u32x2*)(Ks + j * 72 + d4) = pk4(kv);
                const u32x2 vw = pk4(vv);
                Vt[(d4 + 0) * 152 + j] = (bf16_t)(vw.x & 0xffffu); Vt[(d4 + 1) * 152 + j] = (bf16_t)(vw.x >> 16); Vt[(d4 + 2) * 152 + j] = (bf16_t)(vw.y & 0xffffu); Vt[(d4 + 3) * 152 + j] = (bf16_t)(vw.y >> 16); }
            { const int l = tid >> 6, d = tid & 63;
              Ks[(128 + l) * 72 + d] = Zk[(size_t)(MP + bs * 8 + l) * 256 + kvh * 64 + d]; Ks[(136 + l) * 72 + d] = 0; }
            if (tid < 64) { const u32x4 nv = *(const u32x4*)(vTs + ((size_t)((bs * 4 + kvh) * 64 + tid)) * 8);
                *(LAS u32x4*)(Vt + tid * 152 + 128) = nv; *(LAS u32x4*)(Vt + tid * 152 + 136) = (u32x4){0u, 0u, 0u, 0u}; *(LAS u32x4*)(Vt + tid * 152 + 144) = (u32x4){0u, 0u, 0u, 0u}; }
        }
        __syncthreads();
        if (w < 4) {
            const int sl = w >> 1, t = w & 1, it = 2 * pr + sl, bs = it >> 2, kvh = it & 3;
            const LAS bf16_t* Ks = (const LAS bf16_t*)(lds + sl * SLOT_B); const LAS bf16_t* Vt = (const LAS bf16_t*)(lds + sl * SLOT_B + KS_B);
            const int hq = 2 * t + (l16 >> 3), l = l16 & 7, head = kvh * 4 + hq;
            const size_t tq = (size_t)(MP + bs * 8 + l);
            const float sk = P.sinks[head];
            bf16x8 qf[2];
#pragma unroll
            for (int ks = 0; ks < 2; ++ks) qf[ks] = *(const bf16x8*)(Zq + tq * 1024 + head * 64 + ks * 32 + g * 8);
            f32x4 sa[9];
#pragma unroll
            for (int j = 0; j < 9; ++j) { sa[j] = (f32x4){0.f, 0.f, 0.f, 0.f};
#pragma unroll
                for (int ks = 0; ks < 2; ++ks) { const bf16x8 kf = *(const LAS bf16x8*)(Ks + (16 * j + l16) * 72 + ks * 32 + g * 8);
                    sa[j] = __builtin_amdgcn_mfma_f32_16x16x32_bf16(kf, qf[ks], sa[j], 0, 0, 0); } }
            float mx = sk;
#pragma unroll
            for (int j = 0; j < 9; ++j)
#pragma unroll
                for (int r = 0; r < 4; ++r) { const int key = 16 * j + 4 * g + r;
                    const bool vis = (j < 8) ? (key > l) : (key - 128 <= l);
                    sa[j][r] = vis ? sa[j][r] : -1e30f; mx = fmaxf(mx, sa[j][r]); }
            mx = fmaxf(mx, __shfl_xor(mx, 16, 64)); mx = fmaxf(mx, __shfl_xor(mx, 32, 64));
            float sum = 0.f;
#pragma unroll
            for (int j = 0; j < 9; ++j)
#pragma unroll
                for (int r = 0; r < 4; ++r) { const float p = __expf(sa[j][r] - mx); sa[j][r] = p; sum += p; }
            sum += __shfl_xor(sum, 16, 64); sum += __shfl_xor(sum, 32, 64);
            const float inv = 1.f / (sum + __expf(sk - mx));
            f32x4 oa[4];
#pragma unroll
            for (int dt = 0; dt < 4; ++dt) oa[dt] = (f32x4){0.f, 0.f, 0.f, 0.f};
#pragma unroll
            for (int u = 0; u < 5; ++u) {
                u32x4 pw; pw.x = cvt_pk_bf16(sa[2 * u][0], sa[2 * u][1]); pw.y = cvt_pk_bf16(sa[2 * u][2], sa[2 * u][3]);
                if (u < 4) { pw.z = cvt_pk_bf16(sa[2 * u + 1][0], sa[2 * u + 1][1]); pw.w = cvt_pk_bf16(sa[2 * u + 1][2], sa[2 * u + 1][3]); } else { pw.z = 0u; pw.w = 0u; }
                const bf16x8 pf = __builtin_bit_cast(bf16x8, pw);
                const int k0 = 32 * u + 4 * g, k1 = (u < 4) ? k0 + 16 : k0;
#pragma unroll
                for (int dt = 0; dt < 4; ++dt) {
                    const u32x2 v0 = *(const LAS u32x2*)(Vt + (16 * dt + l16) * 152 + k0), v1 = *(const LAS u32x2*)(Vt + (16 * dt + l16) * 152 + k1);
                    u32x4 vw; vw.x = v0.x; vw.y = v0.y; vw.z = v1.x; vw.w = v1.y;
                    oa[dt] = __builtin_amdgcn_mfma_f32_16x16x32_bf16(__builtin_bit_cast(bf16x8, vw), pf, oa[dt], 0, 0, 0);
                }
            }
#pragma unroll
            for (int dt = 0; dt < 4; ++dt) {
                const size_t o = tq * 1024 + head * 64 + 16 * dt + 4 * g;
                const u32x2 gw = *(const u32x2*)(Zg + o);
                f32x4 r; r[0] = oa[dt][0] * inv * bflo(gw.x); r[1] = oa[dt][1] * inv * bfhi(gw.x); r[2] = oa[dt][2] * inv * bflo(gw.y); r[3] = oa[dt][3] * inv * bfhi(gw.y);
                *(u32x2*)(OG + o) = pk4(r);
            }
        }
    }
}

__device__ __forceinline__ void ret_A(LAS unsigned char* lds, const bf16_t* __restrict__ Zq, const bf16_t* __restrict__ Zk, bf16_t* __restrict__ ABUF, bf16_t* __restrict__ KDT, int G) {
    LAS bf16_t* Qs = (LAS bf16_t*)lds;
    LAS bf16_t* Ks = (LAS bf16_t*)(lds + 128 * 264 * 2);
    const int tid = otid(), w = tid >> 6, lane = tid & 63, l16 = lane & 15, g = lane >> 4;
    u32x4 rq[8], rk[8];
#define RA_LOAD(it_) do { const int c_ = (it_) & 31, h_ = ((it_) >> 5) & 3, b_ = (it_) >> 7; const size_t t0_ = (size_t)b_ * 4096 + c_ * 128; \
        _Pragma("unroll") for (int i = 0; i < 8; ++i) { const int ch = tid + 512 * i, s = ch >> 5, c8 = (ch & 31) * 8; const size_t src = (t0_ + s) * 1024 + h_ * 256 + c8; rq[i] = *(const u32x4*)(Zq + src); rk[i] = *(const u32x4*)(Zk + src); } } while (0)
    if ((int)blockIdx.x < 512) RA_LOAD((int)blockIdx.x);
    for (int it = blockIdx.x; it < 512; it += G) {
        const int c = it & 31, h = (it >> 5) & 3, b = it >> 7;
        const float lg = ret_lg(h);
        __syncthreads();
#pragma unroll
        for (int i = 0; i < 8; ++i) { const int ch = tid + 512 * i, s = ch >> 5, c8 = (ch & 31) * 8; *(LAS u32x4*)(Qs + s * 264 + c8) = rq[i]; *(LAS u32x4*)(Ks + s * 264 + c8) = rk[i]; }
        __syncthreads();
        if (it + G < 512) RA_LOAD(it + G);
        asm volatile("" ::: "memory");
        const int i_row = 16 * w + l16;
#pragma unroll
        for (int nt = 0; nt < 8; ++nt) {
            f32x4 a = {0.f, 0.f, 0.f, 0.f};
            if (nt <= w) {
#pragma unroll
                for (int ks = 0; ks < 8; ++ks) { const bf16x8 kf = *(const LAS bf16x8*)(Ks + (16 * nt + l16) * 264 + ks * 32 + g * 8), qf = *(const LAS bf16x8*)(Qs + i_row * 264 + ks * 32 + g * 8);
                    a = __builtin_amdgcn_mfma_f32_16x16x32_bf16(kf, qf, a, 0, 0, 0); }
#pragma unroll
                for (int r = 0; r < 4; ++r) { const int s = 16 * nt + 4 * g + r; a[r] = (s <= i_row) ? a[r] * __expf((float)(i_row - s) * lg) : 0.f; }
            }
            *(u32x2*)(ABUF + ((size_t)it * 128 + i_row) * 128 + 16 * nt + 4 * g) = pk4(a);
        }
        { const int d = tid & 255, sg0 = tid >> 8;
#pragma unroll
          for (int k = 0; k < 8; ++k) { const int s0 = 8 * (sg0 + 2 * k); float v[8];
#pragma unroll
              for (int jj = 0; jj < 8; ++jj) v[jj] = bf2f(Ks[(s0 + jj) * 264 + d]) * __expf((float)(127 - s0 - jj) * lg);
              u32x4 wv; wv.x = cvt_pk_bf16(v[0], v[1]); wv.y = cvt_pk_bf16(v[2], v[3]); wv.z = cvt_pk_bf16(v[4], v[5]); wv.w = cvt_pk_bf16(v[6], v[7]);
              *(u32x4*)(KDT + ((size_t)it * 256 + d) * 128 + s0) = wv; } }
    }
}
#undef RA_LOAD

__device__ __forceinline__ void ret_seq_unit(LAS unsigned char* lds, int u, const bf16_t* __restrict__ Zq, const bf16_t* __restrict__ vTp, const bf16_t* __restrict__ ABUF, const bf16_t* __restrict__ KDT,
                                             bf16_t* __restrict__ ORET, float* __restrict__ out) {
    LAS bf16_t* ST = (LAS bf16_t*)lds;
    LAS bf16_t* VT = (LAS bf16_t*)(lds + 2 * 64 * 264 * 2);
    const int tid = otid(), w = tid >> 6, lane = tid & 63, l16 = lane & 15, g = lane >> 4;
    const int xcd = u & 7, jj = u >> 3, bh = xcd * 2 + (jj >> 3), es = jj & 7, b = bh >> 2, h = bh & 3;
    const float lg = ret_lg(h), g128 = __expf(128.f * lg), gi = __expf((float)(16 * w + l16 + 1) * lg);
    __syncthreads();
    for (int e = tid; e < 64 * 264 / 2; e += NT) ((LAS unsigned*)ST)[e] = 0u;
    const bf16_t* vrow = vTp + ((size_t)bh * 512 + es * 64 + (tid >> 3)) * 4096 + (tid & 7) * 16;
    LAS bf16_t* vdst = VT + (tid >> 3) * 136 + (tid & 7) * 16;
    { const u32x4 a = *(const u32x4*)vrow, bq = *(const u32x4*)(vrow + 8); *(LAS u32x4*)vdst = a; *(LAS u32x4*)(vdst + 8) = bq; }
    f32x4 sacc[2][4];
#pragma unroll
    for (int dt = 0; dt < 2; ++dt)
#pragma unroll
        for (int et = 0; et < 4; ++et) sacc[dt][et] = (f32x4){0.f, 0.f, 0.f, 0.f};
    const bf16_t* aptr = ABUF + ((size_t)bh * 32 * 128 + 16 * w + l16) * 128 + 8 * g;
    const bf16_t* qptr = Zq + ((size_t)b * 4096 + 16 * w + l16) * 1024 + h * 256 + 8 * g;
    const bf16_t* kptr = KDT + ((size_t)bh * 32 * 256 + 32 * w + l16) * 128 + 8 * g;
    bf16_t* optr = ORET + ((size_t)b * 4096 + 16 * w + l16) * 2048 + h * 512 + es * 64 + 4 * g;
    bf16x8 af[4], qf[8], kf[2][4];
#pragma unroll
    for (int ks = 0; ks < 4; ++ks) af[ks] = *(const bf16x8*)(aptr + 32 * ks);
#pragma unroll
    for (int kd = 0; kd < 8; ++kd) qf[kd] = *(const bf16x8*)(qptr + 32 * kd);
    __syncthreads();
    u32x2 opk[4];
    for (int c = 0; c < 32; ++c) {
        const int buf = c & 1;
        if (c > 0) {
#pragma unroll
            for (int et = 0; et < 4; ++et) *(u32x2*)(optr + (size_t)(c - 1) * 128 * 2048 + 16 * et) = opk[et]; }
#pragma unroll
        for (int dt = 0; dt < 2; ++dt)
#pragma unroll
            for (int ks = 0; ks < 4; ++ks) kf[dt][ks] = *(const bf16x8*)(kptr + (size_t)c * 256 * 128 + dt * 2048 + 32 * ks);
        u32x4 nv0 = {0u, 0u, 0u, 0u}, nv1 = {0u, 0u, 0u, 0u};
        if (c < 31) { nv0 = *(const u32x4*)(vrow + (c + 1) * 128); nv1 = *(const u32x4*)(vrow + (c + 1) * 128 + 8); }
        const LAS bf16_t* VTb = VT + buf * 64 * 136; const LAS bf16_t* STb = ST + buf * 64 * 264;
#pragma unroll
        for (int et = 0; et < 4; ++et) {
            f32x4 oin = {0.f, 0.f, 0.f, 0.f}, ocr = {0.f, 0.f, 0.f, 0.f};
#pragma unroll
            for (int ks = 0; ks < 4; ++ks) { const bf16x8 vf = *(const LAS bf16x8*)(VTb + (16 * et + l16) * 136 + 32 * ks + 8 * g); oin = __builtin_amdgcn_mfma_f32_16x16x32_bf16(vf, af[ks], oin, 0, 0, 0); }
#pragma unroll
            for (int kd = 0; kd < 8; ++kd) { const bf16x8 sf = *(const LAS bf16x8*)(STb + (16 * et + l16) * 264 + 32 * kd + 8 * g); ocr = __builtin_amdgcn_mfma_f32_16x16x32_bf16(sf, qf[kd], ocr, 0, 0, 0); }
            opk[et] = pk4(oin + ocr * gi);
        }
        if (c < 31) {
#pragma unroll
            for (int ks = 0; ks < 4; ++ks) af[ks] = *(const bf16x8*)(aptr + (size_t)(c + 1) * 128 * 128 + 32 * ks);
#pragma unroll
            for (int kd = 0; kd < 8; ++kd) qf[kd] = *(const bf16x8*)(qptr + (size_t)(c + 1) * 128 * 1024 + 32 * kd);
        }
#pragma unroll
        for (int dt = 0; dt < 2; ++dt)
#pragma unroll
            for (int et = 0; et < 4; ++et) sacc[dt][et] *= g128;
#pragma unroll
        for (int et = 0; et < 4; ++et)
#pragma unroll
            for (int ks = 0; ks < 4; ++ks) { const bf16x8 vf = *(const LAS bf16x8*)(VTb + (16 * et + l16) * 136 + 32 * ks + 8 * g);
#pragma unroll
                for (int dt = 0; dt < 2; ++dt) sacc[dt][et] = __builtin_amdgcn_mfma_f32_16x16x32_bf16(kf[dt][ks], vf, sacc[dt][et], 0, 0, 0); }
#pragma unroll
        for (int dt = 0; dt < 2; ++dt)
#pragma unroll
            for (int et = 0; et < 4; ++et) *(LAS u32x2*)(ST + ((buf ^ 1) * 64 + 16 * et + l16) * 264 + 32 * w + 16 * dt + 4 * g) = pk4(sacc[dt][et]);
        if (c < 31) { LAS bf16_t* d2 = vdst + (buf ^ 1) * 64 * 136; *(LAS u32x4*)d2 = nv0; *(LAS u32x4*)(d2 + 8) = nv1; }
        __syncthreads();
    }
#pragma unroll
    for (int et = 0; et < 4; ++et) *(u32x2*)(optr + (size_t)31 * 128 * 2048 + 16 * et) = opk[et];
#pragma unroll
    for (int dt = 0; dt < 2; ++dt)
#pragma unroll
        for (int et = 0; et < 4; ++et)
#pragma unroll
            for (int r = 0; r < 4; ++r) out[OFF_RSP + ((size_t)bh * 256 + 32 * w + 16 * dt + 4 * g + r) * 512 + es * 64 + 16 * et + l16] = sacc[dt][et][r];
}

__device__ __forceinline__ void ret_sample(LAS unsigned char* lds, const Params& P, const bf16_t* __restrict__ Zq, const bf16_t* __restrict__ Zk, const bf16_t* __restrict__ vTs, bf16_t* __restrict__ ORET, unsigned* ctr, unsigned* done, unsigned target) {
    LAS float* qs = (LAS float*)lds;
    LAS float* kds = qs + 2048;
    LAS float* A8 = kds + 2048;
    LAS float* red = A8 + 64;
    volatile LAS int* slot = (volatile LAS int*)(lds + LDS_BYTES - 32);
    for (;;) {
        const int tid = otid();
        __syncthreads();
        if (tid == 0) *slot = (done && xb_ld(done) >= target) ? 512 : (int)atomicAdd(ctr, 1u);
        __syncthreads();
        const int it = *slot;
        if (it >= 512) break;
        const int bs = it >> 2, h = it & 3;
        const float lg = ret_lg(h), g8 = __expf(8.f * lg), ig8 = __expf(-8.f * lg);
#pragma unroll
        for (int k = 0; k < 4; ++k) { const int e = tid + 512 * k, i = e >> 8, d = e & 255; const size_t src = (size_t)(MP + bs * 8 + i) * 1024 + h * 256 + d;
            qs[d * 8 + i] = bf2f(Zq[src]) * __expf((float)(i + 1) * lg); kds[d * 8 + i] = bf2f(Zk[src]) * __expf((float)(7 - i) * lg); }
        __syncthreads();
        if (tid < 64) { const int i = tid >> 3, s = tid & 7; float a = 0.f;
            if (s <= i) { for (int d = 0; d < 256; ++d) a += qs[d * 8 + i] * kds[d * 8 + s]; a *= ig8; }
            A8[tid] = a; }
        const int eg = tid & 127, dp = tid >> 7, e0 = 4 * eg;
        f32x4 vq[8];
#pragma unroll
        for (int jj = 0; jj < 4; ++jj) { const u32x4 wv = *(const u32x4*)(vTs + ((size_t)((bs * 4 + h) * 512 + e0 + jj)) * 8);
            vq[0][jj] = bflo(wv.x); vq[1][jj] = bfhi(wv.x); vq[2][jj] = bflo(wv.y); vq[3][jj] = bfhi(wv.y); vq[4][jj] = bflo(wv.z); vq[5][jj] = bfhi(wv.z); vq[6][jj] = bflo(wv.w); vq[7][jj] = bfhi(wv.w); }
        f32x4 cr[8];
#pragma unroll
        for (int i = 0; i < 8; ++i) cr[i] = (f32x4){0.f, 0.f, 0.f, 0.f};
        const size_t sbase = ((size_t)(bs * 4 + h) * 256 + dp * 64) * 512 + e0;
        const float* __restrict__ sp = P.state_ret + sbase; float* __restrict__ op = P.out + OFF_RSS + sbase;
        f32x4 sta[8];
#pragma unroll
        for (int j = 0; j < 8; ++j) sta[j] = __builtin_nontemporal_load((const f32x4*)(sp + (size_t)j * 512));
#pragma unroll 1
        for (int d0 = 0; d0 < 64; d0 += 8) {
            const bool more = d0 + 8 < 64;
#pragma unroll
            for (int j = 0; j < 8; ++j) {
                const int d = dp * 64 + d0 + j; const f32x4 st = sta[j];
                if (more) sta[j] = __builtin_nontemporal_load((const f32x4*)(sp + (size_t)(d0 + 8 + j) * 512));
                const f32x4 qa = *(const LAS f32x4*)(qs + d * 8), qb = *(const LAS f32x4*)(qs + d * 8 + 4), ka = *(const LAS f32x4*)(kds + d * 8), kb = *(const LAS f32x4*)(kds + d * 8 + 4);
                const float q8[8] = {qa[0], qa[1], qa[2], qa[3], qb[0], qb[1], qb[2], qb[3]}, k8[8] = {ka[0], ka[1], ka[2], ka[3], kb[0], kb[1], kb[2], kb[3]};
                f32x4 ns = st * g8;
#pragma unroll
                for (int s2 = 0; s2 < 8; ++s2) ns += vq[s2] * k8[s2];
                __builtin_nontemporal_store(ns, (f32x4*)(op + (size_t)(d0 + j) * 512));
#pragma unroll
                for (int i = 0; i < 8; ++i) cr[i] += st * q8[i];
                asm volatile("" ::: "memory");
            }
        }
#pragma unroll
        for (int i = 0; i < 8; ++i) *(LAS f32x4*)(red + (dp * 8 + i) * 512 + e0) = cr[i];
        __syncthreads();
        { const int i = tid >> 6, e8 = (tid & 63) * 8;
          float o[8];
#pragma unroll
          for (int jj = 0; jj < 8; ++jj) o[jj] = red[(0 * 8 + i) * 512 + e8 + jj] + red[(1 * 8 + i) * 512 + e8 + jj] + red[(2 * 8 + i) * 512 + e8 + jj] + red[(3 * 8 + i) * 512 + e8 + jj];
#pragma unroll
          for (int jj = 0; jj < 8; ++jj) { const u32x4 wv = *(const u32x4*)(vTs + ((size_t)((bs * 4 + h) * 512 + e8 + jj)) * 8);
              const float v8[8] = {bflo(wv.x), bfhi(wv.x), bflo(wv.y), bfhi(wv.y), bflo(wv.z), bfhi(wv.z), bflo(wv.w), bfhi(wv.w)};
#pragma unroll
              for (int s = 0; s < 8; ++s) o[jj] += A8[i * 8 + s] * v8[s]; }
          bf16_t* dst = ORET + (size_t)(MP + bs * 8 + i) * 2048 + h * 512 + e8;
          u32x4 ow; ow.x = cvt_pk_bf16(o[0], o[1]); ow.y = cvt_pk_bf16(o[2], o[3]); ow.z = cvt_pk_bf16(o[4], o[5]); ow.w = cvt_pk_bf16(o[6], o[7]); *(u32x4*)dst = ow; }
    }
}

__device__ __forceinline__ void ret_gnorm(const bf16_t* __restrict__ ORET, const bf16_t* __restrict__ Zg, bf16_t* __restrict__ OG, int G) {
    const int tid_o = otid(), wave = tid_o >> 6, lane = tid_o & 63;
    for (int task = blockIdx.x * 8 + wave; task < MT * 4; task += G * 8) {
        const size_t o = (size_t)(task >> 2) * 2048 + (task & 3) * 512 + lane * 8;
        const u32x4 ow = *(const u32x4*)(ORET + o); const f32x4 a = {bflo(ow.x), bfhi(ow.x), bflo(ow.y), bfhi(ow.y)}, b = {bflo(ow.z), bfhi(ow.z), bflo(ow.w), bfhi(ow.w)};
        const float mu = wave_sum(a[0] + a[1] + a[2] + a[3] + b[0] + b[1] + b[2] + b[3]) * (1.f / 512.f);
        const f32x4 da = a - mu, db = b - mu;
        const float var = wave_sum(da[0] * da[0] + da[1] * da[1] + da[2] * da[2] + da[3] * da[3] + db[0] * db[0] + db[1] * db[1] + db[2] * db[2] + db[3] * db[3]) * (1.f / 512.f);
        const float rs = rsqrtf(var + EPS);
        const u32x4 gw = *(const u32x4*)(Zg + o);
        u32x4 r;
        r.x = cvt_pk_bf16(da[0] * rs * bflo(gw.x), da[1] * rs * bfhi(gw.x)); r.y = cvt_pk_bf16(da[2] * rs * bflo(gw.y), da[3] * rs * bfhi(gw.y));
        r.z = cvt_pk_bf16(db[0] * rs * bflo(gw.z), db[1] * rs * bfhi(gw.z)); r.w = cvt_pk_bf16(db[2] * rs * bflo(gw.w), db[3] * rs * bfhi(gw.w));
        *(u32x4*)(OG + o) = r;
    }
}

__global__ void __launch_bounds__(NT) hybrid_fwd(Params P) {
    extern __shared__ __attribute__((aligned(16))) unsigned char lds_raw[];
    LAS unsigned char* lds = (LAS unsigned char*)lds_raw;
    cg::grid_group grid = cg::this_grid();
    const int G = gridDim.x, tid = threadIdx.x;
    unsigned char* ws = P.ws;
    bf16_t* WT_IN_ATTN = (bf16_t*)(ws + WS_WT_IN_ATTN); bf16_t* WT_OUT_ATTN = (bf16_t*)(ws + WS_WT_OUT_ATTN); bf16_t* WT_IN_RET = (bf16_t*)(ws + WS_WT_IN_RET); bf16_t* WT_OUT_RET = (bf16_t*)(ws + WS_WT_OUT_RET);
    bf16_t* WT_GATE = (bf16_t*)(ws + WS_WT_GATE); bf16_t* WT_PLE = (bf16_t*)(ws + WS_WT_PLE);
    float* TABA = (float*)(ws + WS_TABA); float* TABR = (float*)(ws + WS_TABR);
    bf16_t* H = (bf16_t*)(ws + WS_H); bf16_t* PB = (bf16_t*)(ws + WS_PB);
    bf16_t* PLE = (bf16_t*)(ws + WS_PLE); bf16_t* Y = (bf16_t*)(ws + WS_Y); bf16_t* X2 = (bf16_t*)(ws + WS_X2);
    bf16_t* OG = (bf16_t*)(ws + WS_OG); bf16_t* ZQ = (bf16_t*)(ws + WS_ZQ); bf16_t* ZK = (bf16_t*)(ws + WS_ZK); bf16_t* ZG = (bf16_t*)(ws + WS_ZG);
    bf16_t* VTP = (bf16_t*)(ws + WS_VTP); bf16_t* VTS = (bf16_t*)(ws + WS_VTS); bf16_t* ABUF = (bf16_t*)(ws + WS_ABUF); bf16_t* KDT = (bf16_t*)(ws + WS_KDT); bf16_t* ORET = (bf16_t*)(ws + WS_ORET);
    bf16_t* SC = (bf16_t*)(ws + WS_Y);
    pg8::StaticOrder SO;
    volatile LAS unsigned* bst = (volatile LAS unsigned*)(lds + LDS_BYTES - 16);
    if (tid < 4) bst[tid] = 0u;
    __syncthreads();
    const XcdBarrier xbar = xcd_barrier_post((unsigned*)(ws + WS_BAR), bst);
#define GSYNC() xcd_barrier(xbar)

for (int rep_ = 0; rep_ < REP_P0; ++rep_) {
    {
        LAS float* T = (LAS float*)lds;
        const int ttid = otid(), nn = ttid & 63, kq = ttid >> 6, kk2 = (ttid & 31) * 2, nq = ttid >> 5;
#define TILE_DESC(t_, W_, Wt_, K_, N_, perm_, tl_) do { \
        if ((t_) < 640) { W_ = P.w_in_attn; Wt_ = WT_IN_ATTN; K_ = 1024; N_ = 2560; perm_ = true; tl_ = (t_); } \
        else if ((t_) < 896) { W_ = P.w_out_attn; Wt_ = WT_OUT_ATTN; K_ = 1024; N_ = 1024; perm_ = false; tl_ = (t_) - 640; } \
        else if ((t_) < 2432) { W_ = P.w_in_ret; Wt_ = WT_IN_RET; K_ = 1024; N_ = 6144; perm_ = false; tl_ = (t_) - 896; } \
        else if ((t_) < 2944) { W_ = P.w_out_ret; Wt_ = WT_OUT_RET; K_ = 2048; N_ = 1024; perm_ = false; tl_ = (t_) - 2432; } \
        else if ((t_) < 3200) { W_ = P.w_gate; Wt_ = WT_GATE; K_ = 1024; N_ = 1024; perm_ = false; tl_ = (t_) - 2944; } \
        else if ((t_) < 3456) { W_ = P.w_gate + 1024 * 1024; Wt_ = WT_GATE + 1024 * 1024; K_ = 1024; N_ = 1024; perm_ = false; tl_ = (t_) - 3200; } \
        else if ((t_) < 3520) { W_ = P.w_ple; Wt_ = WT_PLE; K_ = 256; N_ = 1024; perm_ = false; tl_ = (t_) - 3456; } \
        else { W_ = P.w_ple + 256 * 1024; Wt_ = WT_PLE + 1024 * 256; K_ = 256; N_ = 1024; perm_ = false; tl_ = (t_) - 3520; } } while (0)
#define TILE_LOAD(W_, N_, perm_, tl_, r_) do { const int ntn_ = (N_) >> 6, n0_ = ((tl_) % ntn_) * 64, k0_ = ((tl_) / ntn_) * 64, nd_ = n0_ + nn; int ns_ = nd_; \
        if ((perm_) && nd_ < 1280) { const int p_ = nd_ & 63; ns_ = (nd_ - p_) + (p_ >> 5) * 16 + (p_ & 15) + ((p_ >> 4) & 1) * 32; } \
        _Pragma("unroll") for (int i_ = 0; i_ < 8; ++i_) r_[i_] = (W_)[(size_t)(k0_ + kq + 8 * i_) * (N_) + ns_]; } while (0)
        float r[8];
        const float* Wc; bf16_t* Wtc; int Kc, Nc, tlc; bool pc;
        int t = blockIdx.x;
        if (t < 3584) { TILE_DESC(t, Wc, Wtc, Kc, Nc, pc, tlc); TILE_LOAD(Wc, Nc, pc, tlc, r); }
        for (; t < 3584; t += G) {
            __syncthreads();
#pragma unroll
            for (int i = 0; i < 8; ++i) T[(kq + 8 * i) * 65 + nn] = r[i];
            __syncthreads();
            const int ntn = Nc >> 6, n0 = (tlc % ntn) * 64, k0 = (tlc / ntn) * 64; bf16_t* Wto = Wtc; const int Ko = Kc;
            if (t + G < 3584) { TILE_DESC(t + G, Wc, Wtc, Kc, Nc, pc, tlc); TILE_LOAD(Wc, Nc, pc, tlc, r); }
#pragma unroll
            for (int i = 0; i < 4; ++i) { const int n2 = nq + 16 * i; *(unsigned*)(Wto + (size_t)(n0 + n2) * Ko + k0 + kk2) = cvt_pk_bf16(T[kk2 * 65 + n2], T[(kk2 + 1) * 65 + n2]); }
        }
        __syncthreads();
#undef TILE_DESC
#undef TILE_LOAD
    }
    for (int e = blockIdx.x * NT + tid; e < 4104 * 160; e += G * NT) {
        const int pi = e / 160, f = e % 160; const int pos = pi < 4096 ? pi : 16384 + (pi - 4096);
        if (f < 32) { const float inv = powf(10000.f, -(float)f / 32.f), ang = (float)pos * inv; float cv, sv; cos_sin(ang, cv, sv); TABA[((size_t)pi * 32 + f) * 2] = cv; TABA[((size_t)pi * 32 + f) * 2 + 1] = sv; }
        else { const int f2 = f - 32; const float inv = powf(10000.f, -(float)f2 / 128.f), ang = (float)pos * inv; float cv, sv; cos_sin(ang, cv, sv); TABR[((size_t)pi * 128 + f2) * 2] = cv; TABR[((size_t)pi * 128 + f2) * 2 + 1] = sv; }
    }
    for (int e = blockIdx.x * NT + tid; e < 2 * MT * 64; e += G * NT) {
        const int i = e / (MT * 64), rem = e % (MT * 64), row = rem >> 6, c4 = (rem & 63) * 4;
        const float* src = row < MP ? P.p_prompt + ((size_t)i * MP + row) * 256 + c4 : P.p_sample + ((size_t)i * MS + row - MP) * 256 + c4;
        *(u32x2*)(PB + ((size_t)i * MT + row) * 256 + c4) = pk4(*(const f32x4*)src);
    }
    rms_rows(P.x_prompt, P.x_sample, P.pre_norm, H, G);
}
    if (P.ws == nullptr) grid.sync();
    GSYNC();

for (int rep_ = 0; rep_ < REP_GIN; ++rep_) {
    { pg8::Gemm g{H, WT_IN_ATTN, MT, 2560, 1024}; SO.init(MT, 2560, G, blockIdx.x);
      EpiInAttn E{ZQ, ZK, ZG, VTP, VTS, TABA, P.out}; pg8::gemm_phase(lds, g, SO, E); }
    { pg8::Gemm g{PB, WT_PLE, MP, 1024, 256}; EpiB16 E{PLE, 1024};
      if (G == 256) { pg8::TailOrder TO; TO.init(MP, 680 - 512, G, blockIdx.x); pg8::gemm_phase(lds, g, TO, E); }
      else { SO.init(MP, 1024, G, blockIdx.x); pg8::gemm_phase(lds, g, SO, E); }
      skinny_gemm(lds, PB + (size_t)MP * 256, WT_PLE, 256, SkB16{PLE + (size_t)MP * 1024}, G); }
}
    GSYNC();

for (int rep_ = 0; rep_ < REP_ATT; ++rep_) {
    attn_prompt(lds, ZQ, ZK, ZG, VTP, P.sinks, OG, G);
    attn_sample(lds, P, ZQ, ZK, ZG, VTS, OG, G);
}
    GSYNC();

for (int rep_ = 0; rep_ < REP_GN1; ++rep_) {
    { pg8::Gemm g{OG, WT_OUT_ATTN, MP, 1024, 1024}; SO.init(MP, 1024, G, blockIdx.x); EpiB16 E{Y, 1024}; pg8::gemm_phase(lds, g, SO, E);
      skinny_gemm(lds, OG + (size_t)MP * 1024, WT_OUT_ATTN, 1024, SkB16{Y + (size_t)MP * 1024}, G); }
}
    GSYNC();
for (int rep_ = 0; rep_ < REP_ROW; ++rep_) {
    resid_rows<false>(P.x_prompt, P.x_sample, nullptr, Y, P.post_norm, H, G);
}
    GSYNC();
for (int rep_ = 0; rep_ < REP_GN1; ++rep_) {
    { pg8::Gemm g{H, WT_GATE, MP, 1024, 1024}; SO.init(MP, 1024, G, blockIdx.x); EpiGate<true> E{H, PLE, nullptr, X2}; pg8::gemm_phase(lds, g, SO, E);
      skinny_gemm(lds, H + (size_t)MP * 1024, WT_GATE, 1024, SkGate<true>{H + (size_t)MP * 1024, PLE + (size_t)MP * 1024, nullptr, X2 + (size_t)MP * 1024}, G); }
}
    GSYNC();
for (int rep_ = 0; rep_ < REP_ROW; ++rep_) {
    rms_rows_b16(X2, P.pre_norm + 1024, H, G);
}
    GSYNC();
for (int rep_ = 0; rep_ < REP_GIN; ++rep_) {
    { pg8::Gemm g{H, WT_IN_RET, MT, 6144, 1024}; SO.init(MT, 6144, G, blockIdx.x);
      EpiInRet E{ZQ, ZK, ZG, VTP, VTS, TABR}; pg8::gemm_phase(lds, g, SO, E); }
    { pg8::Gemm g{PB + (size_t)MT * 256, WT_PLE + 1024 * 256, MP, 1024, 256}; EpiB16 E{PLE, 1024};
      if (G == 256) { pg8::TailOrder TO; TO.init(MP, 1632 - 6 * 256, G, blockIdx.x); pg8::gemm_phase(lds, g, TO, E); }
      else { SO.init(MP, 1024, G, blockIdx.x); pg8::gemm_phase(lds, g, SO, E); }
      skinny_gemm(lds, PB + (size_t)MT * 256 + (size_t)MP * 256, WT_PLE + 1024 * 256, 256, SkB16{PLE + (size_t)MP * 1024}, G); }
}
    GSYNC();
for (int rep_ = 0; rep_ < REP_RA; ++rep_) {
    ret_A(lds, ZQ, ZK, ABUF, KDT, G);
}
    GSYNC();
    { unsigned* ctr = (unsigned*)(ws + WS_BAR + 14336);
      if (blockIdx.x < 128) for (int u = blockIdx.x; u < 128; u += G) ret_seq_unit(lds, u, ZQ, VTP, ABUF, KDT, ORET, P.out);
      ret_sample(lds, P, ZQ, ZK, VTS, ORET, ctr, nullptr, 0u); }
for (int rep_ = 0; rep_ < REP_SYNC; ++rep_) GSYNC();
    GSYNC();
for (int rep_ = 0; rep_ < REP_ROW; ++rep_) {
    ret_gnorm(ORET, ZG, OG, G);
}
    GSYNC();
for (int rep_ = 0; rep_ < REP_GN1; ++rep_) {
    { pg8::Gemm g{OG, WT_OUT_RET, MP, 1024, 2048}; SO.init(MP, 1024, G, blockIdx.x); EpiB16 E{Y, 1024}; pg8::gemm_phase(lds, g, SO, E);
      skinny_gemm(lds, OG + (size_t)MP * 2048, WT_OUT_RET, 2048, SkB16{Y + (size_t)MP * 1024}, G); }
}
    GSYNC();
for (int rep_ = 0; rep_ < REP_ROW; ++rep_) {
    resid_rows<true>(nullptr, nullptr, X2, Y, P.post_norm + 1024, H, G);
}
    GSYNC();
for (int rep_ = 0; rep_ < REP_GN1; ++rep_) {
    { pg8::Gemm g{H, WT_GATE + 1024 * 1024, MP, 1024, 1024}; SO.init(MP, 1024, G, blockIdx.x); EpiGate<false> E{H, PLE, P.out, nullptr}; pg8::gemm_phase(lds, g, SO, E);
      skinny_gemm(lds, H + (size_t)MP * 1024, WT_GATE + 1024 * 1024, 1024, SkGate<false>{H + (size_t)MP * 1024, PLE + (size_t)MP * 1024, P.out + (size_t)MP * 1024, nullptr}, G); }
}
}

extern "C" void kernel_launch(void* const* d_in, const int* in_sizes, int n_in, void* d_out, int out_size, void* d_ws, size_t ws_size, hipStream_t stream) {
    static int grid_blocks = 0;
    if (!grid_blocks) {
        int dev = 0, cus = 0, per_cu = 0;
        hipGetDevice(&dev);
        hipDeviceGetAttribute(&cus, hipDeviceAttributeMultiprocessorCount, dev);
        hipFuncSetAttribute((const void*)hybrid_fwd, hipFuncAttributeMaxDynamicSharedMemorySize, LDS_BYTES);
        hipOccupancyMaxActiveBlocksPerMultiprocessor(&per_cu, (const void*)hybrid_fwd, NT, LDS_BYTES);
        if (per_cu < 1) per_cu = 1;
        if (per_cu > 1) per_cu = 1;
        grid_blocks = cus * per_cu;
        if (ws_size < WS_END) fprintf(stderr, "kernel_launch: workspace too small: %zu < %zu\n", ws_size, (size_t)WS_END);
    }
    Params p{};
    p.x_prompt = (const float*)d_in[0]; p.x_sample = (const float*)d_in[1]; p.cache_k = (const float*)d_in[2]; p.cache_v = (const float*)d_in[3]; p.state_ret = (const float*)d_in[4];
    p.p_prompt = (const float*)d_in[5]; p.p_sample = (const float*)d_in[6]; p.pre_norm = (const float*)d_in[7]; p.post_norm = (const float*)d_in[8]; p.w_in_attn = (const float*)d_in[9];
    p.sinks = (const float*)d_in[10]; p.w_out_attn = (const float*)d_in[11]; p.w_in_ret = (const float*)d_in[12]; p.w_out_ret = (const float*)d_in[13]; p.w_ple = (const float*)d_in[14]; p.w_gate = (const float*)d_in[15];
    p.out = (float*)d_out; p.ws = (unsigned char*)d_ws;
    (void)hipMemsetAsync((unsigned char*)d_ws + WS_BAR, 0, 16384, stream);
    void* args[] = {&p};
    hipError_t e = hipLaunchCooperativeKernel((const void*)hybrid_fwd, dim3(grid_blocks), dim3(NT), args, LDS_BYTES, stream);
    if (e != hipSuccess) fprintf(stderr, "cooperative launch failed: %s (grid %d)\n", hipGetErrorString(e), grid_blocks);
}
```

```cpp
#include <hip/hip_runtime.h>
#include <hip/hip_cooperative_groups.h>
#include <cstdio>
#include <cstdint>
namespace cg = cooperative_groups;

#define LAS __attribute__((address_space(3)))
typedef unsigned short bf16_t;
typedef short bf16x8 __attribute__((ext_vector_type(8)));
typedef float f32x4 __attribute__((ext_vector_type(4)));
typedef float f32x2 __attribute__((ext_vector_type(2)));
typedef unsigned u32x2 __attribute__((ext_vector_type(2)));
typedef unsigned u32x4 __attribute__((ext_vector_type(4)));

constexpr int MP = 16384, MS = 1024, MT = MP + MS;
constexpr int NT = 512;
#define REP_P0 1
#define REP_GIN 1
#define REP_ATT 1
#define REP_RA 1
#define REP_SYNC 0
#define REP_R3 1
#define REP_SCAN 1
#define REP_ROW 1
#define REP_GN1 1
constexpr int LDS_BYTES = 140 * 1024;
constexpr float EPS = 1e-6f;

constexpr size_t OFF_YP = 0, OFF_YS = 16777216, OFF_KWP = 17825792, OFF_VWP = 17956864, OFF_KWS = 18087936, OFF_VWS = 22282240, OFF_RSP = 26476544, OFF_RSS = 28573696;

constexpr size_t al256(size_t x) { return (x + 255) & ~(size_t)255; }
constexpr size_t WS_WT_IN_ATTN = 0;
constexpr size_t WS_WT_OUT_ATTN = WS_WT_IN_ATTN + (size_t)2560 * 1024 * 2;
constexpr size_t WS_WT_IN_RET = WS_WT_OUT_ATTN + (size_t)1024 * 1024 * 2;
constexpr size_t WS_WT_OUT_RET = WS_WT_IN_RET + (size_t)6144 * 1024 * 2;
constexpr size_t WS_WT_GATE = WS_WT_OUT_RET + (size_t)1024 * 2048 * 2;
constexpr size_t WS_WT_PLE = WS_WT_GATE + (size_t)2 * 1024 * 1024 * 2;
constexpr size_t WS_TABA = WS_WT_PLE + (size_t)2 * 1024 * 256 * 2;
constexpr size_t WS_TABR = WS_TABA + (size_t)4104 * 32 * 8;
constexpr size_t WS_H = al256(WS_TABR + (size_t)4104 * 128 * 8);
constexpr size_t WS_PB = WS_H + (size_t)MT * 1024 * 2;
constexpr size_t WS_PLE = WS_PB + (size_t)2 * MT * 256 * 2;
constexpr size_t WS_Y = WS_PLE + (size_t)MT * 1024 * 4;
constexpr size_t WS_X1 = WS_Y + (size_t)MT * 1024 * 4;
constexpr size_t WS_X2 = WS_X1 + (size_t)MT * 1024 * 4;
constexpr size_t WS_OG = WS_X2 + (size_t)MT * 1024 * 4;
constexpr size_t WS_ZQ = WS_OG + (size_t)MT * 2048 * 2;
constexpr size_t WS_ZK = WS_ZQ + (size_t)MT * 1024 * 2;
constexpr size_t WS_ZG = WS_ZK + (size_t)MT * 1024 * 2;
constexpr size_t WS_VTP = WS_ZG + (size_t)MT * 2048 * 2;
constexpr size_t WS_VTS = WS_VTP + (size_t)16 * 512 * 4096 * 2;
constexpr size_t WS_ABUF = WS_VTS + (size_t)128 * 4 * 512 * 8 * 2;
constexpr size_t WS_KDT = WS_ABUF + (size_t)512 * 128 * 128 * 2;
constexpr size_t WS_ORET = WS_KDT + (size_t)512 * 256 * 128 * 2;
constexpr size_t WS_BAR = WS_ORET + (size_t)MT * 2048 * 4;
constexpr size_t WS_END = WS_BAR + 16384;

struct Params {
    const float *x_prompt, *x_sample, *cache_k, *cache_v, *state_ret, *p_prompt, *p_sample, *pre_norm, *post_norm, *w_in_attn, *sinks, *w_out_attn, *w_in_ret, *w_out_ret, *w_ple, *w_gate;
    float* out; unsigned char* ws;
};

__device__ __forceinline__ unsigned cvt_pk_bf16(float lo, float hi) { unsigned r; asm volatile("v_cvt_pk_bf16_f32 %0, %1, %2" : "=v"(r) : "v"(lo), "v"(hi)); return r; }
__device__ __forceinline__ u32x2 pk4(f32x4 v) { u32x2 w; w.x = cvt_pk_bf16(v[0], v[1]); w.y = cvt_pk_bf16(v[2], v[3]); return w; }
__device__ __forceinline__ float bf2f(bf16_t b) { return __uint_as_float(((unsigned)b) << 16); }
__device__ __forceinline__ float bflo(unsigned w) { return __uint_as_float(w << 16); }
__device__ __forceinline__ float bfhi(unsigned w) { return __uint_as_float(w & 0xffff0000u); }
__device__ __forceinline__ float silu_f(float x) { return x * __builtin_amdgcn_rcpf(1.f + __expf(-x)); }
__device__ __forceinline__ float sigmoid_f(float x) { return __builtin_amdgcn_rcpf(1.f + __expf(-x)); }
__device__ __forceinline__ void cos_sin(float ang, float& c, float& s) {
    const float k = rintf(ang * 0.15915494309189535f);
    float r = fmaf(-k, 6.28125f, ang); r = fmaf(-k, 1.9353071795864769e-3f, r);
    const float t = r * 0.15915494309189535f;
    c = __builtin_amdgcn_cosf(t); s = __builtin_amdgcn_sinf(t);
}
__device__ __forceinline__ float wave_sum(float v) {
#pragma unroll
    for (int o = 32; o >= 1; o >>= 1) v += __shfl_xor(v, o, 64);
    return v;
}
__device__ __forceinline__ int otid() { int t = threadIdx.x; asm volatile("" : "+v"(t)); return t; }
__device__ __forceinline__ void lds_barrier() { asm volatile("s_waitcnt lgkmcnt(0)" ::: "memory"); __builtin_amdgcn_s_barrier(); asm volatile("" ::: "memory"); }
__device__ __forceinline__ float ret_lg(int h) { return h == 0 ? -3.1748698315e-02f : h == 1 ? -1.5748356968e-02f : h == 2 ? -7.8431774610e-03f : -3.9138993211e-03f; }

#define XB_TMO      128
#define XB_XCNT(j)  (256  + 64 * (j))
#define XB_XSUB(j)  (1280 + 64 * (j))
#define XB_XGEN(j)  (2304 + 64 * (j))
#define XB_TOP      3328
#define XB_TOPGEN   3392
#define XCD_BAR_WORDS 3456
#define XB_SPIN_CAP (1u << 18)

__device__ __forceinline__ unsigned xb_ld(unsigned* p)              { return __hip_atomic_load(p, __ATOMIC_RELAXED, __HIP_MEMORY_SCOPE_AGENT); }
__device__ __forceinline__ unsigned xb_add(unsigned* p, unsigned v) { return __hip_atomic_fetch_add(p, v, __ATOMIC_RELAXED, __HIP_MEMORY_SCOPE_AGENT); }
__device__ __forceinline__ unsigned xb_xcc_id() { return (unsigned)__builtin_amdgcn_s_getreg((3 << 11) | 20) & 0xFu; }
#define XB_SPIN(cond, bar) do { unsigned _sp = 0; while (cond) { __builtin_amdgcn_s_sleep(1); \
    if ((++_sp & 255u) == 0u) { if (xb_ld(&(bar)[XB_TMO])) break; if (_sp > XB_SPIN_CAP) { atomicAdd(&(bar)[XB_TMO], 1u); break; } } } } while (0)

struct XcdBarrier {
    unsigned* bar; unsigned x;
    volatile LAS unsigned* st;
};

__device__ __forceinline__ XcdBarrier xcd_barrier_post(unsigned* bar, volatile LAS unsigned* st) {
    XcdBarrier b; b.bar = bar; b.x = xb_xcc_id(); b.st = st;
    if (threadIdx.x == 0) (void)xb_add(&bar[XB_XCNT(b.x)], 1u);
    return b;
}
__device__ __forceinline__ void xcd_barrier_complete(unsigned* bar, unsigned x, unsigned& nloc, unsigned& nx) {
    const unsigned G = gridDim.x * gridDim.y * gridDim.z;
    unsigned sum, cnt, mine, sp = 0u;
    for (;;) {
        sum = 0u; cnt = 0u; mine = 0u;
#pragma unroll
        for (unsigned j = 0; j < 16; ++j) { const unsigned c = xb_ld(&bar[XB_XCNT(j)]); sum += c; cnt += (c > 0u) ? 1u : 0u; mine = (j == x) ? c : mine; }
        if (sum == G) break;
        __builtin_amdgcn_s_sleep(1);
        if ((++sp & 255u) == 0u) { if (xb_ld(&bar[XB_TMO])) break; if (sp > XB_SPIN_CAP) { atomicAdd(&bar[XB_TMO], 1u); break; } }
    }
    nloc = mine > 0u ? mine : 1u; nx = cnt > 0u ? cnt : 1u;
}

__device__ __forceinline__ void xcd_barrier(const XcdBarrier& b) {
    asm volatile("s_waitcnt vmcnt(0)" ::: "memory");
    __syncthreads();
    if (threadIdx.x == 0) {
        unsigned* bar = b.bar;
        __builtin_amdgcn_s_waitcnt(0);
        unsigned nloc = b.st[0], nx = b.st[1];
        if (nloc == 0u) { xcd_barrier_complete(bar, b.x, nloc, nx); b.st[0] = nloc; b.st[1] = nx; }
        const unsigned old = xb_add(&bar[XB_XSUB(b.x)], 1u);
        const unsigned gen = old / nloc;
        if (old + 1u == (gen + 1u) * nloc) {
            __builtin_amdgcn_fence(__ATOMIC_RELEASE, "agent");
            asm volatile("s_waitcnt vmcnt(0)" ::: "memory");
            const unsigned og = xb_add(&bar[XB_TOP], 1u);
            const unsigned tg = og / nx;
            if (og + 1u == (tg + 1u) * nx) xb_add(&bar[XB_TOPGEN], 1u);
            else XB_SPIN(xb_ld(&bar[XB_TOPGEN]) == tg, bar);
            __builtin_amdgcn_fence(__ATOMIC_ACQUIRE, "agent");
            xb_add(&bar[XB_XGEN(b.x)], 1u);
            asm volatile("s_waitcnt vmcnt(0)" ::: "memory");
        } else {
            XB_SPIN(xb_ld(&bar[XB_XGEN(b.x)]) == gen, bar);
            __builtin_amdgcn_fence(__ATOMIC_ACQUIRE, "agent");
            asm volatile("s_waitcnt vmcnt(0)" ::: "memory");
        }
    }
    __syncthreads();
}

namespace pg8 {
constexpr int BM = 256, BK = 64, HALF = 128, HTB = HALF * BK * 2, STAGE_BYTES = 8 * HTB, NXCD = 8, WGM = 8;
__host__ __device__ __forceinline__ int lds_byte(int r, int c) { const int st = (r >> 4) * 2 + (c >> 5), rr = r & 15, cc = c & 31, ob = rr * 64 + cc * 2; return st * 1024 + (ob ^ (((ob >> 9) & 1) << 5)); }
__host__ __device__ __forceinline__ void stage_rc(int b, int& R, int& C) { const int st = b / 1024, sb = b % 1024, swz = sb ^ (((sb >> 9) & 1) << 5); R = (st >> 1) * 16 + swz / 64; C = (st & 1) * 32 + (swz % 64) / 2; }
struct Unit { int pm, pn; };
struct Gemm { const bf16_t* A; const bf16_t* Bt; int M, N, K; };
struct StaticOrder {
    int nM, nN, nwg, G, c;
    __host__ __device__ void init(int M, int N, int G_, int c_) { nM = M / BM; nN = N / BM; nwg = nM * nN; G = G_; c = c_; }
    __host__ __device__ bool next(int i, Unit& u) const {
        const long L = (long)i * G + c; if (L >= nwg) return false;
        int wgid = (int)L; { const int q = nwg / NXCD, r = nwg % NXCD, xcd = wgid % NXCD, off = wgid / NXCD; wgid = (xcd < r ? xcd * (q + 1) : r * (q + 1) + (xcd - r) * q) + off; }
        const int nig = WGM * nN, gid = wgid / nig, fm = gid * WGM, gsz = (nM - fm) < WGM ? (nM - fm) : WGM;
        u.pm = fm + ((wgid % nig) % gsz); u.pn = (wgid % nig) / gsz; return true;
    }
};

struct TailOrder {
    int first, nblk, nwg, c;
    __host__ __device__ void init(int M, int first_, int G_, int c_) { nwg = (M / BM) * 4; first = first_; nblk = G_ - first_; c = c_; }
    __host__ __device__ bool next(int i, Unit& u) const { if (c < first) return false; const int L = (c - first) + i * nblk; if (L >= nwg) return false; u.pm = L >> 2; u.pn = L & 3; return true; }
};

template <class Epi, class Sched>
__device__ __forceinline__ void gemm_phase(LAS unsigned char* lds, const Gemm g, const Sched& S, const Epi& E) {
    const int tid = otid(), wid = __builtin_amdgcn_readfirstlane(tid >> 6), lane = tid & 63, wr = wid >> 2, wc = wid & 3, fr = lane & 15, fq = lane >> 4;
    const int K = g.K, nt = K / BK;
    unsigned voffA[2], voffB[2];
#pragma unroll
    for (int i = 0; i < 2; ++i) { int R, C; stage_rc(tid * 16 + i * 8192, R, C); voffA[i] = (unsigned)(R * K + C) * 2u; voffB[i] = voffA[i]; }
    const size_t kstep = (size_t)(BK * 2);
    const size_t hstep = (size_t)HALF * K * 2;
    const size_t tstep = 2 * hstep;
    const unsigned ldsw = (unsigned)wid * 1024u;
    const int aoff = lds_byte(wr * 64 + fr, fq * 8), boff = lds_byte(wc * 32 + fr, fq * 8);
#define PG8_SA(b, h) (((b) * 2 + (h)) * HTB)
#define PG8_SB(b, h) ((4 + (b) * 2 + (h)) * HTB)
#define PG8_STAGE(bufoff, gbase, voff) do { _Pragma("unroll") for (int _i = 0; _i < 2; ++_i) \
        __builtin_amdgcn_global_load_lds((const unsigned*)((const char*)(gbase) + (voff)[_i]), (LAS unsigned*)(lds + (bufoff) + ldsw + _i * 8192), 16, 0, 0); } while (0)
#define PG8_LDA(dst, b, h) do { _Pragma("unroll") for (int m = 0; m < 4; ++m) _Pragma("unroll") for (int k = 0; k < 2; ++k) dst[m][k] = *(const LAS bf16x8*)(lds + PG8_SA(b, h) + aoff + m * 2048 + k * 1024); } while (0)
#define PG8_LDB(dst, b, h) do { _Pragma("unroll") for (int n = 0; n < 2; ++n) _Pragma("unroll") for (int k = 0; k < 2; ++k) dst[n][k] = *(const LAS bf16x8*)(lds + PG8_SB(b, h) + boff + n * 2048 + k * 1024); } while (0)
#define PG8_MMA(ai, bj, At, Bt) do { __builtin_amdgcn_s_setprio(1); _Pragma("unroll") for (int m = 0; m < 4; ++m) _Pragma("unroll") for (int n = 0; n < 2; ++n) _Pragma("unroll") for (int k = 0; k < 2; ++k) \
        acc[ai][bj][m][n] = __builtin_amdgcn_mfma_f32_16x16x32_bf16(Bt[n][k], At[m][k], acc[ai][bj][m][n], 0, 0, 0); __builtin_amdgcn_s_setprio(0); } while (0)
#define PG8_WAIT_V(n) asm volatile("s_waitcnt vmcnt(" #n ")" ::: "memory")
#define PG8_WAIT_L(n) asm volatile("s_waitcnt lgkmcnt(" #n ")" ::: "memory")
#define PG8_BAR __builtin_amdgcn_s_barrier()
#define PG8_SCHED __builtin_amdgcn_sched_barrier(0)
#define PG8_PTRS(u, pa, pb) do { const char* _a = (const char*)g.A + (size_t)(u).pm * tstep; const char* _b = (const char*)g.Bt + (size_t)(u).pn * tstep; if (Epi::swap(u)) { pa = _b; pb = _a; } else { pa = _a; pb = _b; } } while (0)
    Unit cur, nxt; int ui = 0;
    if (!S.next(0, cur)) return;
    f32x4 acc[2][2][4][2];
#pragma unroll
    for (int a = 0; a < 2; ++a)
#pragma unroll
        for (int b = 0; b < 2; ++b)
#pragma unroll
            for (int m = 0; m < 4; ++m)
#pragma unroll
                for (int n = 0; n < 2; ++n) acc[a][b][m][n] = (f32x4){0.f, 0.f, 0.f, 0.f};
    bf16x8 At[4][2], B0[2][2], B1[2][2];
    const char* cA; const char* cB;
    PG8_PTRS(cur, cA, cB);
    PG8_STAGE(PG8_SB(0, 0), cB, voffB); PG8_STAGE(PG8_SA(0, 0), cA, voffA); PG8_STAGE(PG8_SB(0, 1), cB + hstep, voffB); PG8_STAGE(PG8_SA(0, 1), cA + hstep, voffA);
    if (wr == 1) PG8_BAR;
    PG8_WAIT_V(4); PG8_BAR;
    PG8_STAGE(PG8_SB(1, 0), cB + kstep, voffB); PG8_STAGE(PG8_SA(1, 0), cA + kstep, voffA); PG8_STAGE(PG8_SB(1, 1), cB + hstep + kstep, voffB);
    PG8_WAIT_V(6); PG8_BAR;
    for (;;) {
        const bool has_next = S.next(ui + 1, nxt);
        const char* nA = cA; const char* nB = cB;
        if (has_next) PG8_PTRS(nxt, nA, nB);
        for (int t = 0; t < nt; t += 2) {
            const bool last = (t == nt - 2);
            const char* a1 = cA + (size_t)(t + 1) * kstep;
            const char* a2 = last ? nA : cA + (size_t)(t + 2) * kstep; const char* b2 = last ? nB : cB + (size_t)(t + 2) * kstep;
            const char* a3 = a2 + kstep; const char* b3 = b2 + kstep;
            PG8_LDB(B0, 0, 0); PG8_SCHED; PG8_LDA(At, 0, 0); PG8_STAGE(PG8_SA(1, 1), a1 + hstep, voffA);
            PG8_WAIT_L(8); PG8_BAR; PG8_WAIT_L(0); PG8_MMA(0, 0, At, B0); PG8_BAR; PG8_SCHED;
            PG8_LDB(B1, 0, 1); PG8_STAGE(PG8_SB(0, 0), b2, voffB);
            PG8_BAR; PG8_WAIT_L(0); PG8_MMA(0, 1, At, B1); PG8_BAR;
            PG8_LDA(At, 0, 1); PG8_STAGE(PG8_SA(0, 0), a2, voffA);
            PG8_BAR; PG8_WAIT_L(0); PG8_MMA(1, 0, At, B0); PG8_BAR; PG8_SCHED;
            PG8_STAGE(PG8_SB(0, 1), b2 + hstep, voffB);
            PG8_WAIT_V(6); PG8_BAR; PG8_MMA(1, 1, At, B1); PG8_BAR;
            PG8_LDB(B0, 1, 0); PG8_SCHED; PG8_LDA(At, 1, 0); PG8_STAGE(PG8_SA(0, 1), a2 + hstep, voffA);
            PG8_WAIT_L(8); PG8_BAR; PG8_WAIT_L(0); PG8_MMA(0, 0, At, B0); PG8_BAR; PG8_SCHED;
            PG8_LDB(B1, 1, 1); PG8_STAGE(PG8_SB(1, 0), b3, voffB);
            PG8_BAR; PG8_WAIT_L(0); PG8_MMA(0, 1, At, B1); PG8_BAR;
            PG8_LDA(At, 1, 1); PG8_STAGE(PG8_SA(1, 0), a3, voffA);
            PG8_BAR; PG8_WAIT_L(0); PG8_MMA(1, 0, At, B0); PG8_BAR; PG8_SCHED;
            PG8_STAGE(PG8_SB(1, 1), b3 + hstep, voffB);
            PG8_WAIT_V(6); PG8_BAR; PG8_MMA(1, 1, At, B1); PG8_BAR;
        }
        E(acc, cur, wr, wc, fr, fq);
        if (!has_next) break;
#pragma unroll
        for (int a = 0; a < 2; ++a)
#pragma unroll
            for (int b = 0; b < 2; ++b)
#pragma unroll
                for (int m = 0; m < 4; ++m)
#pragma unroll
                    for (int n = 0; n < 2; ++n) acc[a][b][m][n] = (f32x4){0.f, 0.f, 0.f, 0.f};
        cur = nxt; cA = nA; cB = nB; ++ui;
    }
    PG8_WAIT_V(0);
    if (wr == 0) PG8_BAR;
    PG8_BAR;
#undef PG8_SA
#undef PG8_SB
#undef PG8_STAGE
#undef PG8_LDA
#undef PG8_LDB
#undef PG8_MMA
#undef PG8_WAIT_V
#undef PG8_WAIT_L
#undef PG8_BAR
#undef PG8_SCHED
#undef PG8_PTRS
}
}
using pg8::Unit;

struct EpiF32 {
    float* C; int ldc;
    __device__ __forceinline__ static bool swap(const Unit&) { return false; }
    __device__ __forceinline__ void operator()(const f32x4 (&acc)[2][2][4][2], const Unit& u, int wr, int wc, int fr, int fq) const {
        const int row0 = u.pm * 256 + wr * 64 + fr, col0 = u.pn * 256 + wc * 32 + 4 * fq;
#pragma unroll
        for (int ai = 0; ai < 2; ++ai)
#pragma unroll
            for (int m = 0; m < 4; ++m) { float* rowp = C + (size_t)(row0 + ai * 128 + m * 16) * ldc + col0;
#pragma unroll
                for (int bj = 0; bj < 2; ++bj)
#pragma unroll
                    for (int n = 0; n < 2; ++n) *(f32x4*)(rowp + bj * 128 + n * 16) = acc[ai][bj][m][n]; }
    }
};
struct EpiB16 {
    bf16_t* C; int ldc;
    __device__ __forceinline__ static bool swap(const Unit&) { return false; }
    __device__ __forceinline__ void operator()(const f32x4 (&acc)[2][2][4][2], const Unit& u, int wr, int wc, int fr, int fq) const {
        const int row0 = u.pm * 256 + wr * 64 + fr, col0 = u.pn * 256 + wc * 32 + 4 * fq;
#pragma unroll
        for (int ai = 0; ai < 2; ++ai)
#pragma unroll
            for (int m = 0; m < 4; ++m) { bf16_t* rowp = C + (size_t)(row0 + ai * 128 + m * 16) * ldc + col0;
#pragma unroll
                for (int bj = 0; bj < 2; ++bj)
#pragma unroll
                    for (int n = 0; n < 2; ++n) *(u32x2*)(rowp + bj * 128 + n * 16) = pk4(acc[ai][bj][m][n]); }
    }
};
template <bool OB16> struct EpiGate {
    const bf16_t* X1; const bf16_t* PLE; float* O; bf16_t* Ob;
    __device__ __forceinline__ static bool swap(const Unit&) { return false; }
    __device__ __forceinline__ void operator()(const f32x4 (&acc)[2][2][4][2], const Unit& u, int wr, int wc, int fr, int fq) const {
        const int row0 = u.pm * 256 + wr * 64 + fr, col0 = u.pn * 256 + wc * 32 + 4 * fq;
#pragma unroll
        for (int ai = 0; ai < 2; ++ai)
#pragma unroll
            for (int m = 0; m < 4; ++m) { const size_t ro = (size_t)(row0 + ai * 128 + m * 16) * 1024 + col0;
#pragma unroll
                for (int bj = 0; bj < 2; ++bj)
#pragma unroll
                    for (int n = 0; n < 2; ++n) { const size_t o = ro + bj * 128 + n * 16; const f32x4 a = acc[ai][bj][m][n]; const u32x2 xw = *(const u32x2*)(X1 + o), pw = *(const u32x2*)(PLE + o);
                        const f32x4 x1 = {bflo(xw.x), bfhi(xw.x), bflo(xw.y), bfhi(xw.y)}, pl = {bflo(pw.x), bfhi(pw.x), bflo(pw.y), bfhi(pw.y)}; f32x4 r;
#pragma unroll
                        for (int j = 0; j < 4; ++j) r[j] = x1[j] + sigmoid_f(a[j]) * pl[j];
                        if (OB16) *(u32x2*)(Ob + o) = pk4(r); else *(f32x4*)(O + o) = r; } }
    }
};
struct EpiInAttn {
    bf16_t *Zq, *Zk, *Zg, *vTp, *vTs; const float* tab; float* out;
    __device__ __forceinline__ static bool swap(const Unit& u) { return u.pn == 5; }
    __device__ __forceinline__ void operator()(const f32x4 (&acc)[2][2][4][2], const Unit& u, int wr, int wc, int fr, int fq) const {
        const int pn = u.pn;
        if (pn < 5) {
            const bool isq = pn < 4;
            const int fi = 16 * (wc & 1) + 4 * fq;
#pragma unroll
            for (int ai = 0; ai < 2; ++ai)
#pragma unroll
                for (int m = 0; m < 4; ++m) {
                    const int r = u.pm * 256 + ai * 128 + wr * 64 + m * 16 + fr;
                    const int pi = r < MP ? (r & 4095) : 4096 + ((r - MP) & 7);
                    const f32x4 t0 = *(const f32x4*)(tab + ((size_t)pi * 32 + fi) * 2), t1 = *(const f32x4*)(tab + ((size_t)pi * 32 + fi) * 2 + 4);
                    const float cs[4] = {t0[0], t0[2], t1[0], t1[2]}, sn[4] = {t0[1], t0[3], t1[1], t1[3]};
#pragma unroll
                    for (int bj = 0; bj < 2; ++bj) {
                        const f32x4 x1 = acc[ai][bj][m][0], x2 = acc[ai][bj][m][1]; f32x4 o1, o2;
#pragma unroll
                        for (int j = 0; j < 4; ++j) { o1[j] = x1[j] * cs[j] - x2[j] * sn[j]; o2[j] = x2[j] * cs[j] + x1[j] * sn[j]; }
                        const int hh = 2 * bj + (wc >> 1), d1 = 16 * (wc & 1) + 4 * fq;
                        if (isq) {
                            bf16_t* p = Zq + (size_t)r * 1024 + pn * 256 + hh * 64 + d1;
                            *(u32x2*)p = pk4(o1 * 0.125f); *(u32x2*)(p + 32) = pk4(o2 * 0.125f);
                        } else {
                            bf16_t* p = Zk + (size_t)r * 256 + hh * 64 + d1;
                            *(u32x2*)p = pk4(o1); *(u32x2*)(p + 32) = pk4(o2);
                            if (r < MP) { const int t = r & 4095; if (t >= 3968) { float* dst = out + OFF_KWP + ((size_t)((r >> 12) * 128 + t - 3968) * 4 + hh) * 64 + d1; *(f32x4*)dst = o1; *(f32x4*)(dst + 32) = o2; } }
                            else { const int rs = r - MP; float* dst = out + OFF_KWS + ((size_t)((rs >> 3) * 128 + 120 + (rs & 7)) * 4 + hh) * 64 + d1; *(f32x4*)dst = o1; *(f32x4*)(dst + 32) = o2; }
                        }
                    }
                    asm volatile("" ::: "memory");
                }
        } else if (pn == 5) {
#pragma unroll
            for (int ai = 0; ai < 2; ++ai)
#pragma unroll
                for (int m = 0; m < 4; ++m) {
                    const int e = ai * 128 + wr * 64 + m * 16 + fr, kvh = e >> 6, d = e & 63;
#pragma unroll
                    for (int bj = 0; bj < 2; ++bj)
#pragma unroll
                        for (int n = 0; n < 2; ++n) {
                            const int tok = u.pm * 256 + bj * 128 + wc * 32 + n * 16 + 4 * fq; const f32x4 v = acc[ai][bj][m][n];
                            if (tok < MP) { const int b = tok >> 12, t = tok & 4095;
                                *(u32x2*)(vTp + ((size_t)((b * 4 + kvh) * 64 + d)) * 4096 + t) = pk4(v);
                                if (t >= 3968) {
#pragma unroll
                                    for (int jj = 0; jj < 4; ++jj) out[OFF_VWP + ((size_t)(b * 128 + t - 3968 + jj) * 4 + kvh) * 64 + d] = v[jj]; }
                            } else { const int ts = tok - MP, bs = ts >> 3, l0 = ts & 7;
                                *(u32x2*)(vTs + ((size_t)((bs * 4 + kvh) * 64 + d)) * 8 + l0) = pk4(v);
#pragma unroll
                                for (int jj = 0; jj < 4; ++jj) out[OFF_VWS + ((size_t)(bs * 128 + 120 + l0 + jj) * 4 + kvh) * 64 + d] = v[jj]; }
                        }
                }
        } else {
#pragma unroll
            for (int ai = 0; ai < 2; ++ai)
#pragma unroll
                for (int m = 0; m < 4; ++m) { const int r = u.pm * 256 + ai * 128 + wr * 64 + m * 16 + fr;
#pragma unroll
                    for (int bj = 0; bj < 2; ++bj)
#pragma unroll
                        for (int n = 0; n < 2; ++n) { const f32x4 a = acc[ai][bj][m][n]; f32x4 s;
#pragma unroll
                            for (int j = 0; j < 4; ++j) s[j] = silu_f(a[j]);
                            *(u32x2*)(Zg + (size_t)r * 1024 + (pn - 6) * 256 + bj * 128 + wc * 32 + n * 16 + 4 * fq) = pk4(s); } }
        }
    }
};
struct EpiInRet {
    bf16_t *Zq, *Zk, *Zg, *vTp, *vTs; const float* tab;
    __device__ __forceinline__ static bool swap(const Unit& u) { return u.pn >= 8 && u.pn < 16; }
    __device__ __forceinline__ void operator()(const f32x4 (&acc)[2][2][4][2], const Unit& u, int wr, int wc, int fr, int fq) const {
        const int pn = u.pn;
        if (pn < 8) {
            const bool isq = pn < 4; const float sc = isq ? 1.f : 0.0625f;
            bf16_t* Z = isq ? Zq : Zk; const int hc = (pn & 3) * 256;
#pragma unroll
            for (int ai = 0; ai < 2; ++ai)
#pragma unroll
                for (int m = 0; m < 4; ++m) {
                    const int r = u.pm * 256 + ai * 128 + wr * 64 + m * 16 + fr;
                    const int pi = r < MP ? (r & 4095) : 4096 + ((r - MP) & 7);
#pragma unroll
                    for (int n = 0; n < 2; ++n) {
                        const int d = wc * 32 + n * 16 + 4 * fq;
                        const f32x4 t0 = *(const f32x4*)(tab + ((size_t)pi * 128 + d) * 2), t1 = *(const f32x4*)(tab + ((size_t)pi * 128 + d) * 2 + 4);
                        const float cs[4] = {t0[0], t0[2], t1[0], t1[2]}, sn[4] = {t0[1], t0[3], t1[1], t1[3]};
                        const f32x4 x1 = acc[ai][0][m][n], x2 = acc[ai][1][m][n]; f32x4 o1, o2;
#pragma unroll
                        for (int j = 0; j < 4; ++j) { o1[j] = (x1[j] * cs[j] - x2[j] * sn[j]) * sc; o2[j] = (x2[j] * cs[j] + x1[j] * sn[j]) * sc; }
                        bf16_t* p = Z + (size_t)r * 1024 + hc + d;
                        *(u32x2*)p = pk4(o1); *(u32x2*)(p + 128) = pk4(o2);
                    }
                }
        } else if (pn < 16) {
#pragma unroll
            for (int ai = 0; ai < 2; ++ai)
#pragma unroll
                for (int m = 0; m < 4; ++m) {
                    const int eg = (pn - 8) * 256 + ai * 128 + wr * 64 + m * 16 + fr, h = eg >> 9, e = eg & 511;
#pragma unroll
                    for (int bj = 0; bj < 2; ++bj)
#pragma unroll
                        for (int n = 0; n < 2; ++n) {
                            const int tok = u.pm * 256 + bj * 128 + wc * 32 + n * 16 + 4 * fq; const u32x2 w = pk4(acc[ai][bj][m][n]);
                            if (tok < MP) { const int b = tok >> 12, t = tok & 4095; *(u32x2*)(vTp + ((size_t)((b * 4 + h) * 512 + e)) * 4096 + t) = w; }
                            else { const int ts = tok - MP, bs = ts >> 3, l0 = ts & 7; *(u32x2*)(vTs + ((size_t)((bs * 4 + h) * 512 + e)) * 8 + l0) = w; }
                        }
                }
        } else {
#pragma unroll
            for (int ai = 0; ai < 2; ++ai)
#pragma unroll
                for (int m = 0; m < 4; ++m) { const int r = u.pm * 256 + ai * 128 + wr * 64 + m * 16 + fr;
#pragma unroll
                    for (int bj = 0; bj < 2; ++bj)
#pragma unroll
                        for (int n = 0; n < 2; ++n) { const f32x4 a = acc[ai][bj][m][n]; f32x4 s;
#pragma unroll
                            for (int j = 0; j < 4; ++j) s[j] = silu_f(a[j]);
                            *(u32x2*)(Zg + (size_t)r * 2048 + (pn - 16) * 256 + bj * 128 + wc * 32 + n * 16 + 4 * fq) = pk4(s); } }
        }
    }
};

__device__ __forceinline__ void transpose_tile(const float* __restrict__ W, bf16_t* __restrict__ Wt, int K, int N, bool perm, int tile, LAS float* T) {
    const int tid = otid(), ntn = N >> 6;
    const int n0 = (tile % ntn) * 64, k0 = (tile / ntn) * 64, nn = tid & 63;
    const int nd = n0 + nn; int ns = nd;
    if (perm && nd < 1280) { const int p = nd & 63; ns = (nd - p) + (p >> 5) * 16 + (p & 15) + ((p >> 4) & 1) * 32; }
#pragma unroll
    for (int i = 0; i < 8; ++i) { const int kk = (tid >> 6) + 8 * i; T[kk * 65 + nn] = W[(size_t)(k0 + kk) * N + ns]; }
    __syncthreads();
    const int kk2 = (tid & 31) * 2;
#pragma unroll
    for (int i = 0; i < 4; ++i) { const int n2 = (tid >> 5) + 16 * i; *(unsigned*)(Wt + (size_t)(n0 + n2) * K + k0 + kk2) = cvt_pk_bf16(T[kk2 * 65 + n2], T[(kk2 + 1) * 65 + n2]); }
    __syncthreads();
}

__device__ __forceinline__ void rms_rows(const float* __restrict__ Xa, const float* __restrict__ Xb, const float* __restrict__ g, bf16_t* __restrict__ H, int G) {
    const int tid_o = otid(), wave = tid_o >> 6, lane = tid_o & 63;
    for (int row = blockIdx.x * 8 + wave; row < MT; row += G * 8) {
        const float* x = row < MP ? Xa + (size_t)row * 1024 : Xb + (size_t)(row - MP) * 1024;
        f32x4 v[4]; float ss = 0.f;
#pragma unroll
        for (int i = 0; i < 4; ++i) { v[i] = *(const f32x4*)(x + lane * 4 + 256 * i); ss += v[i][0] * v[i][0] + v[i][1] * v[i][1] + v[i][2] * v[i][2] + v[i][3] * v[i][3]; }
        ss = wave_sum(ss);
        const float rr = rsqrtf(ss * (1.f / 1024.f) + EPS);
#pragma unroll
        for (int i = 0; i < 4; ++i) { const f32x4 gg = *(const f32x4*)(g + lane * 4 + 256 * i); *(u32x2*)(H + (size_t)row * 1024 + lane * 4 + 256 * i) = pk4(v[i] * rr * gg); }
    }
}
__device__ __forceinline__ void rms_rows_b16(const bf16_t* __restrict__ X, const float* __restrict__ g, bf16_t* __restrict__ H, int G) {
    const int tid_o = otid(), wave = tid_o >> 6, lane = tid_o & 63;
    for (int row = blockIdx.x * 8 + wave; row < MT; row += G * 8) {
        const u32x4 a = *(const u32x4*)(X + (size_t)row * 1024 + lane * 8), b = *(const u32x4*)(X + (size_t)row * 1024 + 512 + lane * 8);
        const float v[16] = {bflo(a.x), bfhi(a.x), bflo(a.y), bfhi(a.y), bflo(a.z), bfhi(a.z), bflo(a.w), bfhi(a.w), bflo(b.x), bfhi(b.x), bflo(b.y), bfhi(b.y), bflo(b.z), bfhi(b.z), bflo(b.w), bfhi(b.w)};
        float ss = 0.f;
#pragma unroll
        for (int i = 0; i < 16; ++i) ss += v[i] * v[i];
        ss = wave_sum(ss);
        const float rr = rsqrtf(ss * (1.f / 1024.f) + EPS);
#pragma unroll
        for (int hh = 0; hh < 2; ++hh) { const int c = hh * 512 + lane * 8; const f32x4 g0 = *(const f32x4*)(g + c), g1 = *(const f32x4*)(g + c + 4); u32x4 o;
            o.x = cvt_pk_bf16(v[hh * 8 + 0] * rr * g0[0], v[hh * 8 + 1] * rr * g0[1]); o.y = cvt_pk_bf16(v[hh * 8 + 2] * rr * g0[2], v[hh * 8 + 3] * rr * g0[3]);
            o.z = cvt_pk_bf16(v[hh * 8 + 4] * rr * g1[0], v[hh * 8 + 5] * rr * g1[1]); o.w = cvt_pk_bf16(v[hh * 8 + 6] * rr * g1[2], v[hh * 8 + 7] * rr * g1[3]);
            *(u32x4*)(H + (size_t)row * 1024 + c) = o; }
    }
}
template <bool XB16>
__device__ __forceinline__ void resid_rows(const float* __restrict__ Xa, const float* __restrict__ Xb, const bf16_t* __restrict__ Xh, const bf16_t* __restrict__ Y, const float* __restrict__ g, bf16_t* __restrict__ H, int G) {
    const int tid_o = otid(), wave = tid_o >> 6, lane = tid_o & 63;
    for (int row = blockIdx.x * 8 + wave; row < MT; row += G * 8) {
        const bf16_t* y = Y + (size_t)row * 1024;
        f32x4 v[4]; float ss = 0.f;
#pragma unroll
        for (int i = 0; i < 4; ++i) { const u32x2 yw = *(const u32x2*)(y + lane * 4 + 256 * i); v[i] = (f32x4){bflo(yw.x), bfhi(yw.x), bflo(yw.y), bfhi(yw.y)}; ss += v[i][0] * v[i][0] + v[i][1] * v[i][1] + v[i][2] * v[i][2] + v[i][3] * v[i][3]; }
        ss = wave_sum(ss);
        const float rr = rsqrtf(ss * (1.f / 1024.f) + EPS);
#pragma unroll
        for (int i = 0; i < 4; ++i) { const int c = lane * 4 + 256 * i; const f32x4 gg = *(const f32x4*)(g + c); f32x4 xx;
            if (XB16) { const u32x2 xw = *(const u32x2*)(Xh + (size_t)row * 1024 + c); xx = (f32x4){bflo(xw.x), bfhi(xw.x), bflo(xw.y), bfhi(xw.y)}; }
            else xx = *(const f32x4*)((row < MP ? Xa + (size_t)row * 1024 : Xb + (size_t)(row - MP) * 1024) + c);
            *(u32x2*)(H + (size_t)row * 1024 + c) = pk4(xx + v[i] * rr * gg); }
    }
}

struct SkF32 { float* C; __device__ __forceinline__ void operator()(int row, int col, f32x4 v) const { *(f32x4*)(C + (size_t)row * 1024 + col) = v; } };
struct SkB16 { bf16_t* C; __device__ __forceinline__ void operator()(int row, int col, f32x4 v) const { *(u32x2*)(C + (size_t)row * 1024 + col) = pk4(v); } };
template <bool OB16> struct SkGate { const bf16_t* X1; const bf16_t* PLE; float* O; bf16_t* Ob;
    __device__ __forceinline__ void operator()(int row, int col, f32x4 a) const { const size_t o = (size_t)row * 1024 + col; const u32x2 xw = *(const u32x2*)(X1 + o), pw = *(const u32x2*)(PLE + o);
        const f32x4 x1 = {bflo(xw.x), bfhi(xw.x), bflo(xw.y), bfhi(xw.y)}, pl = {bflo(pw.x), bfhi(pw.x), bflo(pw.y), bfhi(pw.y)}; f32x4 r;
#pragma unroll
        for (int j = 0; j < 4; ++j) r[j] = x1[j] + sigmoid_f(a[j]) * pl[j];
        if (OB16) *(u32x2*)(Ob + o) = pk4(r); else *(f32x4*)(O + o) = r; } };
template <class Epi>
__device__ __forceinline__ void skinny_gemm(LAS unsigned char* lds, const bf16_t* __restrict__ A, const bf16_t* __restrict__ Bt, int K, const Epi& E, int G) {
    LAS float* red = (LAS float*)lds;
    const int tid = otid(), w = tid >> 6, lane = tid & 63, l16 = lane & 15, g = lane >> 4;
    const int KS = K >> 3, nks = KS >> 5;
    for (int u = blockIdx.x; u < 256; u += G) {
        const int row0 = (u >> 4) * 64, col0 = (u & 15) * 64;
        const bf16_t* ap = A + (size_t)(row0 + l16) * K + w * KS + 8 * g;
        const bf16_t* bp = Bt + (size_t)(col0 + l16) * K + w * KS + 8 * g;
        f32x4 acc[4][4];
#pragma unroll
        for (int mt = 0; mt < 4; ++mt)
#pragma unroll
            for (int nt = 0; nt < 4; ++nt) acc[mt][nt] = (f32x4){0.f, 0.f, 0.f, 0.f};
#pragma unroll 4
        for (int ks = 0; ks < nks; ++ks) {
            bf16x8 af[4], bf[4];
#pragma unroll
            for (int t = 0; t < 4; ++t) { af[t] = *(const bf16x8*)(ap + (size_t)(16 * t) * K + 32 * ks); bf[t] = *(const bf16x8*)(bp + (size_t)(16 * t) * K + 32 * ks); }
#pragma unroll
            for (int mt = 0; mt < 4; ++mt)
#pragma unroll
                for (int nt = 0; nt < 4; ++nt) acc[mt][nt] = __builtin_amdgcn_mfma_f32_16x16x32_bf16(bf[nt], af[mt], acc[mt][nt], 0, 0, 0);
        }
        __syncthreads();
#pragma unroll
        for (int mt = 0; mt < 4; ++mt)
#pragma unroll
            for (int nt = 0; nt < 4; ++nt) *(LAS f32x4*)(red + (w * 64 + 16 * mt + l16) * 68 + 16 * nt + 4 * g) = acc[mt][nt];
        __syncthreads();
#pragma unroll
        for (int j = 0; j < 2; ++j) { const int q = tid + 512 * j, row = q >> 4, c4 = (q & 15) * 4; f32x4 sum = *(const LAS f32x4*)(red + row * 68 + c4);
#pragma unroll
            for (int ww = 1; ww < 8; ++ww) sum += *(const LAS f32x4*)(red + (ww * 64 + row) * 68 + c4);
            E(row0 + row, col0 + c4, sum); }
    }
}

__device__ __forceinline__ void attn_prompt(LAS unsigned char* lds, const bf16_t* __restrict__ Zq, const bf16_t* __restrict__ Zk, const bf16_t* __restrict__ Zg, const bf16_t* __restrict__ vTp,
                                            const float* __restrict__ sinks, bf16_t* __restrict__ OG, int G) {
    LAS bf16_t* Ks = (LAS bf16_t*)lds;
    LAS bf16_t* Vt = (LAS bf16_t*)(lds + 256 * 72 * 2);
    const int tid = otid(), w = tid >> 6, lane = tid & 63, l16 = lane & 15, g = lane >> 4;
    u32x4 pk_[4], pv_[4];
#define AP_LOAD(it_) do { const int kvh_ = (it_) & 3, nb_ = ((it_) >> 2) & 31, b_ = (it_) >> 7; \
        _Pragma("unroll") for (int i = 0; i < 4; ++i) { const int ch = tid + 512 * i, s = ch >> 3, c8 = ch & 7, t = (nb_ - 1) * 128 + s; \
            pk_[i] = (u32x4){0u, 0u, 0u, 0u}; if (t >= 0) pk_[i] = *(const u32x4*)(Zk + (size_t)(b_ * 4096 + t) * 256 + kvh_ * 64 + c8 * 8); } \
        _Pragma("unroll") for (int i = 0; i < 4; ++i) { const int ch = tid + 512 * i, d = ch >> 5, s0 = (ch & 31) * 8, t0 = (nb_ - 1) * 128 + s0; \
            pv_[i] = (u32x4){0u, 0u, 0u, 0u}; if (t0 >= 0) pv_[i] = *(const u32x4*)(vTp + ((size_t)((b_ * 4 + kvh_) * 64 + d)) * 4096 + t0); } } while (0)
    if ((int)blockIdx.x < 512) AP_LOAD((int)blockIdx.x);
    for (int it = blockIdx.x; it < 512; it += G) {
        const int kvh = it & 3, nb = (it >> 2) & 31, b = it >> 7;
        __syncthreads();
#pragma unroll
        for (int i = 0; i < 4; ++i) { const int ch = tid + 512 * i, s = ch >> 3, c8 = ch & 7; *(LAS u32x4*)(Ks + s * 72 + c8 * 8) = pk_[i]; }
#pragma unroll
        for (int i = 0; i < 4; ++i) { const int ch = tid + 512 * i, d = ch >> 5, s0 = (ch & 31) * 8; *(LAS u32x4*)(Vt + d * 264 + s0) = pv_[i]; }
        __syncthreads();
        if (it + G < 512) AP_LOAD(it + G);
        asm volatile("" ::: "memory");
        const int head = kvh * 4 + (w >> 1);
        const float sk = sinks[head];
        for (int qi = 0; qi < 4; ++qi) {
            const int qt = (w & 1) * 4 + qi;
            const size_t tq = (size_t)b * 4096 + nb * 128 + qt * 16 + l16;
            bf16x8 qf[2];
#pragma unroll
            for (int ks = 0; ks < 2; ++ks) qf[ks] = *(const bf16x8*)(Zq + tq * 1024 + head * 64 + ks * 32 + g * 8);
            f32x4 sa[9];
#pragma unroll
            for (int j = 0; j < 9; ++j) { sa[j] = (f32x4){0.f, 0.f, 0.f, 0.f};
#pragma unroll
                for (int ks = 0; ks < 2; ++ks) { const bf16x8 kf = *(const LAS bf16x8*)(Ks + (16 * (qt + j) + l16) * 72 + ks * 32 + g * 8);
                    sa[j] = __builtin_amdgcn_mfma_f32_16x16x32_bf16(kf, qf[ks], sa[j], 0, 0, 0); } }
            float mx = sk;
#pragma unroll
            for (int j = 0; j < 9; ++j) {
                const bool dead = (nb == 0) && (qt + j) < 8;
#pragma unroll
                for (int r = 0; r < 4; ++r) {
                    bool vis = !dead;
                    if (j == 0) vis = vis && ((4 * g + r) > l16);
                    if (j == 8) vis = vis && ((4 * g + r) <= l16);
                    sa[j][r] = vis ? sa[j][r] : -1e30f;
                    mx = fmaxf(mx, sa[j][r]);
                }
            }
            mx = fmaxf(mx, __shfl_xor(mx, 16, 64)); mx = fmaxf(mx, __shfl_xor(mx, 32, 64));
            float sum = 0.f;
#pragma unroll
            for (int j = 0; j < 9; ++j)
#pragma unroll
                for (int r = 0; r < 4; ++r) { const float p = __expf(sa[j][r] - mx); sa[j][r] = p; sum += p; }
            sum += __shfl_xor(sum, 16, 64); sum += __shfl_xor(sum, 32, 64);
            const float inv = 1.f / (sum + __expf(sk - mx));
            f32x4 oa[4];
#pragma unroll
            for (int dt = 0; dt < 4; ++dt) oa[dt] = (f32x4){0.f, 0.f, 0.f, 0.f};
#pragma unroll
            for (int u = 0; u < 5; ++u) {
                u32x4 pw; pw.x = cvt_pk_bf16(sa[2 * u][0], sa[2 * u][1]); pw.y = cvt_pk_bf16(sa[2 * u][2], sa[2 * u][3]);
                if (u < 4) { pw.z = cvt_pk_bf16(sa[2 * u + 1][0], sa[2 * u + 1][1]); pw.w = cvt_pk_bf16(sa[2 * u + 1][2], sa[2 * u + 1][3]); } else { pw.z = 0u; pw.w = 0u; }
                const bf16x8 pf = __builtin_bit_cast(bf16x8, pw);
                const int k0 = 16 * (qt + 2 * u) + 4 * g, k1 = (u < 4) ? k0 + 16 : k0;
#pragma unroll
                for (int dt = 0; dt < 4; ++dt) {
                    const u32x2 v0 = *(const LAS u32x2*)(Vt + (16 * dt + l16) * 264 + k0), v1 = *(const LAS u32x2*)(Vt + (16 * dt + l16) * 264 + k1);
                    u32x4 vw; vw.x = v0.x; vw.y = v0.y; vw.z = v1.x; vw.w = v1.y;
                    oa[dt] = __builtin_amdgcn_mfma_f32_16x16x32_bf16(__builtin_bit_cast(bf16x8, vw), pf, oa[dt], 0, 0, 0);
                }
            }
#pragma unroll
            for (int dt = 0; dt < 4; ++dt) {
                const size_t o = tq * 1024 + head * 64 + 16 * dt + 4 * g;
                const u32x2 gw = *(const u32x2*)(Zg + o);
                f32x4 r; r[0] = oa[dt][0] * inv * bflo(gw.x); r[1] = oa[dt][1] * inv * bfhi(gw.x); r[2] = oa[dt][2] * inv * bflo(gw.y); r[3] = oa[dt][3] * inv * bfhi(gw.y);
                *(u32x2*)(OG + o) = pk4(r);
            }
        }
    }
}
#undef AP_LOAD

__device__ __forceinline__ void attn_sample(LAS unsigned char* lds, const Params& P, const bf16_t* __restrict__ Zq, const bf16_t* __restrict__ Zk, const bf16_t* __restrict__ Zg, const bf16_t* __restrict__ vTs,
                                            bf16_t* __restrict__ OG, int G) {
    constexpr int KS_B = 144 * 72 * 2, VT_B = 64 * 152 * 2, SLOT_B = KS_B + VT_B;
    for (int pr = blockIdx.x; pr < 256; pr += G) {
        const int tid = otid(), w = tid >> 6, lane = tid & 63, l16 = lane & 15, g = lane >> 4;
        __syncthreads();
#pragma unroll
        for (int sl = 0; sl < 2; ++sl) {
            const int it = 2 * pr + sl, bs = it >> 2, kvh = it & 3;
            LAS bf16_t* Ks = (LAS bf16_t*)(lds + sl * SLOT_B); LAS bf16_t* Vt = (LAS bf16_t*)(lds + sl * SLOT_B + KS_B);
#pragma unroll
            for (int i = 0; i < 4; ++i) { const int ch = tid + 512 * i, j = ch >> 4, d4 = (ch & 15) * 4;
                const size_t src = ((size_t)(bs * 128 + j) * 4 + kvh) * 64 + d4;
                const f32x4 kv = *(const f32x4*)(P.cache_k + src), vv = *(const f32x4*)(P.cache_v + src);
                if (j >= 8) { const size_t dst = ((size_t)(bs * 128 + j - 8) * 4 + kvh) * 64 + d4; *(f32x4*)(P.out + OFF_KWS + dst) = kv; *(f32x4*)(P.out + OFF_VWS + dst) = vv; }
                *(LAS u32x2*)(Ks + j * 72 + d4) = pk4(kv);
                const u32x2 vw = pk4(vv);
                Vt[(d4 + 0) * 152 + j] = (bf16_t)(vw.x & 0xffffu); Vt[(d4 + 1) * 152 + j] = (bf16_t)(vw.x >> 16); Vt[(d4 + 2) * 152 + j] = (bf16_t)(vw.y & 0xffffu); Vt[(d4 + 3) * 152 + j] = (bf16_t)(vw.y >> 16); }
            { const int l = tid >> 6, d = tid & 63;
              Ks[(128 + l) * 72 + d] = Zk[(size_t)(MP + bs * 8 + l) * 256 + kvh * 64 + d]; Ks[(136 + l) * 72 + d] = 0; }
            if (tid < 64) { const u32x4 nv = *(const u32x4*)(vTs + ((size_t)((bs * 4 + kvh) * 64 + tid)) * 8);
                *(LAS u32x4*)(Vt + tid * 152 + 128) = nv; *(LAS u32x4*)(Vt + tid * 152 + 136) = (u32x4){0u, 0u, 0u, 0u}; *(LAS u32x4*)(Vt + tid * 152 + 144) = (u32x4){0u, 0u, 0u, 0u}; }
        }
        __syncthreads();
        if (w < 4) {
            const int sl = w >> 1, t = w & 1, it = 2 * pr + sl, bs = it >> 2, kvh = it & 3;
            const LAS bf16_t* Ks = (const LAS bf16_t*)(lds + sl * SLOT_B); const LAS bf16_t* Vt = (const LAS bf16_t*)(lds + sl * SLOT_B + KS_B);
            const int hq = 2 * t + (l16 >> 3), l = l16 & 7, head = kvh * 4 + hq;
            const size_t tq = (size_t)(MP + bs * 8 + l);
            const float sk = P.sinks[head];
            bf16x8 qf[2];
#pragma unroll
            for (int ks = 0; ks < 2; ++ks) qf[ks] = *(const bf16x8*)(Zq + tq * 1024 + head * 64 + ks * 32 + g * 8);
            f32x4 sa[9];
#pragma unroll
            for (int j = 0; j < 9; ++j) { sa[j] = (f32x4){0.f, 0.f, 0.f, 0.f};
#pragma unroll
                for (int ks = 0; ks < 2; ++ks) { const bf16x8 kf = *(const LAS bf16x8*)(Ks + (16 * j + l16) * 72 + ks * 32 + g * 8);
                    sa[j] = __builtin_amdgcn_mfma_f32_16x16x32_bf16(kf, qf[ks], sa[j], 0, 0, 0); } }
            float mx = sk;
#pragma unroll
            for (int j = 0; j < 9; ++j)
#pragma unroll
                for (int r = 0; r < 4; ++r) { const int key = 16 * j + 4 * g + r;
                    const bool vis = (j < 8) ? (key > l) : (key - 128 <= l);
                    sa[j][r] = vis ? sa[j][r] : -1e30f; mx = fmaxf(mx, sa[j][r]); }
            mx = fmaxf(mx, __shfl_xor(mx, 16, 64)); mx = fmaxf(mx, __shfl_xor(mx, 32, 64));
            float sum = 0.f;
#pragma unroll
            for (int j = 0; j < 9; ++j)
#pragma unroll
                for (int r = 0; r < 4; ++r) { const float p = __expf(sa[j][r] - mx); sa[j][r] = p; sum += p; }
            sum += __shfl_xor(sum, 16, 64); sum += __shfl_xor(sum, 32, 64);
            const float inv = 1.f / (sum + __expf(sk - mx));
            f32x4 oa[4];
#pragma unroll
            for (int dt = 0; dt < 4; ++dt) oa[dt] = (f32x4){0.f, 0.f, 0.f, 0.f};
#pragma unroll
            for (int u = 0; u < 5; ++u) {
                u32x4 pw; pw.x = cvt_pk_bf16(sa[2 * u][0], sa[2 * u][1]); pw.y = cvt_pk_bf16(sa[2 * u][2], sa[2 * u][3]);
                if (u < 4) { pw.z = cvt_pk_bf16(sa[2 * u + 1][0], sa[2 * u + 1][1]); pw.w = cvt_pk_bf16(sa[2 * u + 1][2], sa[2 * u + 1][3]); } else { pw.z = 0u; pw.w = 0u; }
                const bf16x8 pf = __builtin_bit_cast(bf16x8, pw);
                const int k0 = 32 * u + 4 * g, k1 = (u < 4) ? k0 + 16 : k0;
#pragma unroll
                for (int dt = 0; dt < 4; ++dt) {
                    const u32x2 v0 = *(const LAS u32x2*)(Vt + (16 * dt + l16) * 152 + k0), v1 = *(const LAS u32x2*)(Vt + (16 * dt + l16) * 152 + k1);
                    u32x4 vw; vw.x = v0.x; vw.y = v0.y; vw.z = v1.x; vw.w = v1.y;
                    oa[dt] = __builtin_amdgcn_mfma_f32_16x16x32_bf16(__builtin_bit_cast(bf16x8, vw), pf, oa[dt], 0, 0, 0);
                }
            }
#pragma unroll
            for (int dt = 0; dt < 4; ++dt) {
                const size_t o = tq * 1024 + head * 64 + 16 * dt + 4 * g;
                const u32x2 gw = *(const u32x2*)(Zg + o);
                f32x4 r; r[0] = oa[dt][0] * inv * bflo(gw.x); r[1] = oa[dt][1] * inv * bfhi(gw.x); r[2] = oa[dt][2] * inv * bflo(gw.y); r[3] = oa[dt][3] * inv * bfhi(gw.y);
                *(u32x2*)(OG + o) = pk4(r);
            }
        }
    }
}

__device__ __forceinline__ void ret_A(LAS unsigned char* lds, const bf16_t* __restrict__ Zq, const bf16_t* __restrict__ Zk, bf16_t* __restrict__ ABUF, bf16_t* __restrict__ KDT, int G) {
    LAS bf16_t* Qs = (LAS bf16_t*)lds;
    LAS bf16_t* Ks = (LAS bf16_t*)(lds + 128 * 264 * 2);
    const int tid = otid(), w = tid >> 6, lane = tid & 63, l16 = lane & 15, g = lane >> 4;
    u32x4 rq[8], rk[8];
#define RA_LOAD(it_) do { const int c_ = (it_) & 31, h_ = ((it_) >> 5) & 3, b_ = (it_) >> 7; const size_t t0_ = (size_t)b_ * 4096 + c_ * 128; \
        _Pragma("unroll") for (int i = 0; i < 8; ++i) { const int ch = tid + 512 * i, s = ch >> 5, c8 = (ch & 31) * 8; const size_t src = (t0_ + s) * 1024 + h_ * 256 + c8; rq[i] = *(const u32x4*)(Zq + src); rk[i] = *(const u32x4*)(Zk + src); } } while (0)
    if ((int)blockIdx.x < 512) RA_LOAD((int)blockIdx.x);
    for (int it = blockIdx.x; it < 512; it += G) {
        const int c = it & 31, h = (it >> 5) & 3, b = it >> 7;
        const float lg = ret_lg(h);
        __syncthreads();
#pragma unroll
        for (int i = 0; i < 8; ++i) { const int ch = tid + 512 * i, s = ch >> 5, c8 = (ch & 31) * 8; *(LAS u32x4*)(Qs + s * 264 + c8) = rq[i]; *(LAS u32x4*)(Ks + s * 264 + c8) = rk[i]; }
        __syncthreads();
        if (it + G < 512) RA_LOAD(it + G);
        asm volatile("" ::: "memory");
        const int i_row = 16 * w + l16;
#pragma unroll
        for (int nt = 0; nt < 8; ++nt) {
            f32x4 a = {0.f, 0.f, 0.f, 0.f};
            if (nt <= w) {
#pragma unroll
                for (int ks = 0; ks < 8; ++ks) { const bf16x8 kf = *(const LAS bf16x8*)(Ks + (16 * nt + l16) * 264 + ks * 32 + g * 8), qf = *(const LAS bf16x8*)(Qs + i_row * 264 + ks * 32 + g * 8);
                    a = __builtin_amdgcn_mfma_f32_16x16x32_bf16(kf, qf, a, 0, 0, 0); }
#pragma unroll
                for (int r = 0; r < 4; ++r) { const int s = 16 * nt + 4 * g + r; a[r] = (s <= i_row) ? a[r] * __expf((float)(i_row - s) * lg) : 0.f; }
            }
            *(u32x2*)(ABUF + ((size_t)it * 128 + i_row) * 128 + 16 * nt + 4 * g) = pk4(a);
        }
        { const int d = tid & 255, sg0 = tid >> 8;
#pragma unroll
          for (int k = 0; k < 8; ++k) { const int s0 = 8 * (sg0 + 2 * k); float v[8];
#pragma unroll
              for (int jj = 0; jj < 8; ++jj) v[jj] = bf2f(Ks[(s0 + jj) * 264 + d]) * __expf((float)(127 - s0 - jj) * lg);
              u32x4 wv; wv.x = cvt_pk_bf16(v[0], v[1]); wv.y = cvt_pk_bf16(v[2], v[3]); wv.z = cvt_pk_bf16(v[4], v[5]); wv.w = cvt_pk_bf16(v[6], v[7]);
              *(u32x4*)(KDT + ((size_t)it * 256 + d) * 128 + s0) = wv; } }
    }
}
#undef RA_LOAD

__device__ __forceinline__ void ret_seq_unit(LAS unsigned char* lds, int u, const bf16_t* __restrict__ Zq, const bf16_t* __restrict__ vTp, const bf16_t* __restrict__ ABUF, const bf16_t* __restrict__ KDT,
                                             bf16_t* __restrict__ ORET, float* __restrict__ out) {
    LAS bf16_t* ST = (LAS bf16_t*)lds;
    LAS bf16_t* VT = (LAS bf16_t*)(lds + 2 * 64 * 264 * 2);
    const int tid = otid(), w = tid >> 6, lane = tid & 63, l16 = lane & 15, g = lane >> 4;
    const int xcd = u & 7, jj = u >> 3, bh = xcd * 2 + (jj >> 3), es = jj & 7, b = bh >> 2, h = bh & 3;
    const float lg = ret_lg(h), g128 = __expf(128.f * lg), gi = __expf((float)(16 * w + l16 + 1) * lg);
    __syncthreads();
    for (int e = tid; e < 64 * 264 / 2; e += NT) ((LAS unsigned*)ST)[e] = 0u;
    const bf16_t* vrow = vTp + ((size_t)bh * 512 + es * 64 + (tid >> 3)) * 4096 + (tid & 7) * 16;
    LAS bf16_t* vdst = VT + (tid >> 3) * 136 + (tid & 7) * 16;
    { const u32x4 a = *(const u32x4*)vrow, bq = *(const u32x4*)(vrow + 8); *(LAS u32x4*)vdst = a; *(LAS u32x4*)(vdst + 8) = bq; }
    f32x4 sacc[2][4];
#pragma unroll
    for (int dt = 0; dt < 2; ++dt)
#pragma unroll
        for (int et = 0; et < 4; ++et) sacc[dt][et] = (f32x4){0.f, 0.f, 0.f, 0.f};
    const bf16_t* aptr = ABUF + ((size_t)bh * 32 * 128 + 16 * w + l16) * 128 + 8 * g;
    const bf16_t* qptr = Zq + ((size_t)b * 4096 + 16 * w + l16) * 1024 + h * 256 + 8 * g;
    const bf16_t* kptr = KDT + ((size_t)bh * 32 * 256 + 32 * w + l16) * 128 + 8 * g;
    bf16_t* optr = ORET + ((size_t)b * 4096 + 16 * w + l16) * 2048 + h * 512 + es * 64 + 4 * g;
    bf16x8 af[4], qf[8], kf[2][4];
#pragma unroll
    for (int ks = 0; ks < 4; ++ks) af[ks] = *(const bf16x8*)(aptr + 32 * ks);
#pragma unroll
    for (int kd = 0; kd < 8; ++kd) qf[kd] = *(const bf16x8*)(qptr + 32 * kd);
    __syncthreads();
    u32x2 opk[4];
    for (int c = 0; c < 32; ++c) {
        const int buf = c & 1;
        if (c > 0) {
#pragma unroll
            for (int et = 0; et < 4; ++et) *(u32x2*)(optr + (size_t)(c - 1) * 128 * 2048 + 16 * et) = opk[et]; }
#pragma unroll
        for (int dt = 0; dt < 2; ++dt)
#pragma unroll
            for (int ks = 0; ks < 4; ++ks) kf[dt][ks] = *(const bf16x8*)(kptr + (size_t)c * 256 * 128 + dt * 2048 + 32 * ks);
        u32x4 nv0 = {0u, 0u, 0u, 0u}, nv1 = {0u, 0u, 0u, 0u};
        if (c < 31) { nv0 = *(const u32x4*)(vrow + (c + 1) * 128); nv1 = *(const u32x4*)(vrow + (c + 1) * 128 + 8); }
        const LAS bf16_t* VTb = VT + buf * 64 * 136; const LAS bf16_t* STb = ST + buf * 64 * 264;
#pragma unroll
        for (int et = 0; et < 4; ++et) {
            f32x4 oin = {0.f, 0.f, 0.f, 0.f}, ocr = {0.f, 0.f, 0.f, 0.f};
#pragma unroll
            for (int ks = 0; ks < 4; ++ks) { const bf16x8 vf = *(const LAS bf16x8*)(VTb + (16 * et + l16) * 136 + 32 * ks + 8 * g); oin = __builtin_amdgcn_mfma_f32_16x16x32_bf16(vf, af[ks], oin, 0, 0, 0); }
#pragma unroll
            for (int kd = 0; kd < 8; ++kd) { const bf16x8 sf = *(const LAS bf16x8*)(STb + (16 * et + l16) * 264 + 32 * kd + 8 * g); ocr = __builtin_amdgcn_mfma_f32_16x16x32_bf16(sf, qf[kd], ocr, 0, 0, 0); }
            opk[et] = pk4(oin + ocr * gi);
        }
        if (c < 31) {
#pragma unroll
            for (int ks = 0; ks < 4; ++ks) af[ks] = *(const bf16x8*)(aptr + (size_t)(c + 1) * 128 * 128 + 32 * ks);
#pragma unroll
            for (int kd = 0; kd < 8; ++kd) qf[kd] = *(const bf16x8*)(qptr + (size_t)(c + 1) * 128 * 1024 + 32 * kd);
        }
#pragma unroll
        for (int dt = 0; dt < 2; ++dt)
#pragma unroll
            for (int et = 0; et < 4; ++et) sacc[dt][et] *= g128;
#pragma unroll
        for (int et = 0; et < 4; ++et)
#pragma unroll
            for (int ks = 0; ks < 4; ++ks) { const bf16x8 vf = *(const LAS bf16x8*)(VTb + (16 * et + l16) * 136 + 32 * ks + 8 * g);
#pragma unroll
                for (int dt = 0; dt < 2; ++dt) sacc[dt][et] = __builtin_amdgcn_mfma_f32_16x16x32_bf16(kf[dt][ks], vf, sacc[dt][et], 0, 0, 0); }
#pragma unroll
        for (int dt = 0; dt < 2; ++dt)
#pragma unroll
            for (int et = 0; et < 4; ++et) *(LAS u32x2*)(ST + ((buf ^ 1) * 64 + 16 * et + l16) * 264 + 32 * w + 16 * dt + 4 * g) = pk4(sacc[dt][et]);
        if (c < 31) { LAS bf16_t* d2 = vdst + (buf ^ 1) * 64 * 136; *(LAS u32x4*)d2 = nv0; *(LAS u32x4*)(d2 + 8) = nv1; }
        __syncthreads();
    }
#pragma unroll
    for (int et = 0; et < 4; ++et) *(u32x2*)(optr + (size_t)31 * 128 * 2048 + 16 * et) = opk[et];
#pragma unroll
    for (int dt = 0; dt < 2; ++dt)
#pragma unroll
        for (int et = 0; et < 4; ++et)
#pragma unroll
            for (int r = 0; r < 4; ++r) out[OFF_RSP + ((size_t)bh * 256 + 32 * w + 16 * dt + 4 * g + r) * 512 + es * 64 + 16 * et + l16] = sacc[dt][et][r];
}

__device__ __forceinline__ void ret_sample(LAS unsigned char* lds, const Params& P, const bf16_t* __restrict__ Zq, const bf16_t* __restrict__ Zk, const bf16_t* __restrict__ vTs, bf16_t* __restrict__ ORET, unsigned* ctr, unsigned* done, unsigned target) {
    LAS float* qs = (LAS float*)lds;
    LAS float* kds = qs + 2048;
    LAS float* A8 = kds + 2048;
    LAS float* red = A8 + 64;
    volatile LAS int* slot = (volatile LAS int*)(lds + LDS_BYTES - 32);
    for (;;) {
        const int tid = otid();
        __syncthreads();
        if (tid == 0) *slot = (done && xb_ld(done) >= target) ? 512 : (int)atomicAdd(ctr, 1u);
        __syncthreads();
        const int it = *slot;
        if (it >= 512) break;
        const int bs = it >> 2, h = it & 3;
        const float lg = ret_lg(h), g8 = __expf(8.f * lg), ig8 = __expf(-8.f * lg);
#pragma unroll
        for (int k = 0; k < 4; ++k) { const int e = tid + 512 * k, i = e >> 8, d = e & 255; const size_t src = (size_t)(MP + bs * 8 + i) * 1024 + h * 256 + d;
            qs[d * 8 + i] = bf2f(Zq[src]) * __expf((float)(i + 1) * lg); kds[d * 8 + i] = bf2f(Zk[src]) * __expf((float)(7 - i) * lg); }
        __syncthreads();
        if (tid < 64) { const int i = tid >> 3, s = tid & 7; float a = 0.f;
            if (s <= i) { for (int d = 0; d < 256; ++d) a += qs[d * 8 + i] * kds[d * 8 + s]; a *= ig8; }
            A8[tid] = a; }
        const int eg = tid & 127, dp = tid >> 7, e0 = 4 * eg;
        f32x4 vq[8];
#pragma unroll
        for (int jj = 0; jj < 4; ++jj) { const u32x4 wv = *(const u32x4*)(vTs + ((size_t)((bs * 4 + h) * 512 + e0 + jj)) * 8);
            vq[0][jj] = bflo(wv.x); vq[1][jj] = bfhi(wv.x); vq[2][jj] = bflo(wv.y); vq[3][jj] = bfhi(wv.y); vq[4][jj] = bflo(wv.z); vq[5][jj] = bfhi(wv.z); vq[6][jj] = bflo(wv.w); vq[7][jj] = bfhi(wv.w); }
        f32x4 cr[8];
#pragma unroll
        for (int i = 0; i < 8; ++i) cr[i] = (f32x4){0.f, 0.f, 0.f, 0.f};
        const size_t sbase = ((size_t)(bs * 4 + h) * 256 + dp * 64) * 512 + e0;
        const float* __restrict__ sp = P.state_ret + sbase; float* __restrict__ op = P.out + OFF_RSS + sbase;
        f32x4 sta[8];
#pragma unroll
        for (int j = 0; j < 8; ++j) sta[j] = __builtin_nontemporal_load((const f32x4*)(sp + (size_t)j * 512));
#pragma unroll 1
        for (int d0 = 0; d0 < 64; d0 += 8) {
            const bool more = d0 + 8 < 64;
#pragma unroll
            for (int j = 0; j < 8; ++j) {
                const int d = dp * 64 + d0 + j; const f32x4 st = sta[j];
                if (more) sta[j] = __builtin_nontemporal_load((const f32x4*)(sp + (size_t)(d0 + 8 + j) * 512));
                const f32x4 qa = *(const LAS f32x4*)(qs + d * 8), qb = *(const LAS f32x4*)(qs + d * 8 + 4), ka = *(const LAS f32x4*)(kds + d * 8), kb = *(const LAS f32x4*)(kds + d * 8 + 4);
                const float q8[8] = {qa[0], qa[1], qa[2], qa[3], qb[0], qb[1], qb[2], qb[3]}, k8[8] = {ka[0], ka[1], ka[2], ka[3], kb[0], kb[1], kb[2], kb[3]};
                f32x4 ns = st * g8;
#pragma unroll
                for (int s2 = 0; s2 < 8; ++s2) ns += vq[s2] * k8[s2];
                __builtin_nontemporal_store(ns, (f32x4*)(op + (size_t)(d0 + j) * 512));
#pragma unroll
                for (int i = 0; i < 8; ++i) cr[i] += st * q8[i];
                asm volatile("" ::: "memory");
            }
        }
#pragma unroll
        for (int i = 0; i < 8; ++i) *(LAS f32x4*)(red + (dp * 8 + i) * 512 + e0) = cr[i];
        __syncthreads();
        { const int i = tid >> 6, e8 = (tid & 63) * 8;
          float o[8];
#pragma unroll
          for (int jj = 0; jj < 8; ++jj) o[jj] = red[(0 * 8 + i) * 512 + e8 + jj] + red[(1 * 8 + i) * 512 + e8 + jj] + red[(2 * 8 + i) * 512 + e8 + jj] + red[(3 * 8 + i) * 512 + e8 + jj];
#pragma unroll
          for (int jj = 0; jj < 8; ++jj) { const u32x4 wv = *(const u32x4*)(vTs + ((size_t)((bs * 4 + h) * 512 + e8 + jj)) * 8);
              const float v8[8] = {bflo(wv.x), bfhi(wv.x), bflo(wv.y), bfhi(wv.y), bflo(wv.z), bfhi(wv.z), bflo(wv.w), bfhi(wv.w)};
#pragma unroll
              for (int s = 0; s < 8; ++s) o[jj] += A8[i * 8 + s] * v8[s]; }
          bf16_t* dst = ORET + (size_t)(MP + bs * 8 + i) * 2048 + h * 512 + e8;
          u32x4 ow; ow.x = cvt_pk_bf16(o[0], o[1]); ow.y = cvt_pk_bf16(o[2], o[3]); ow.z = cvt_pk_bf16(o[4], o[5]); ow.w = cvt_pk_bf16(o[6], o[7]); *(u32x4*)dst = ow; }
    }
}

__device__ __forceinline__ void ret_gnorm(const bf16_t* __restrict__ ORET, const bf16_t* __restrict__ Zg, bf16_t* __restrict__ OG, int G) {
    const int tid_o = otid(), wave = tid_o >> 6, lane = tid_o & 63;
    for (int task = blockIdx.x * 8 + wave; task < MT * 4; task += G * 8) {
        const size_t o = (size_t)(task >> 2) * 2048 + (task & 3) * 512 + lane * 8;
        const u32x4 ow = *(const u32x4*)(ORET + o); const f32x4 a = {bflo(ow.x), bfhi(ow.x), bflo(ow.y), bfhi(ow.y)}, b = {bflo(ow.z), bfhi(ow.z), bflo(ow.w), bfhi(ow.w)};
        const float mu = wave_sum(a[0] + a[1] + a[2] + a[3] + b[0] + b[1] + b[2] + b[3]) * (1.f / 512.f);
        const f32x4 da = a - mu, db = b - mu;
        const float var = wave_sum(da[0] * da[0] + da[1] * da[1] + da[2] * da[2] + da[3] * da[3] + db[0] * db[0] + db[1] * db[1] + db[2] * db[2] + db[3] * db[3]) * (1.f / 512.f);
        const float rs = rsqrtf(var + EPS);
        const u32x4 gw = *(const u32x4*)(Zg + o);
        u32x4 r;
        r.x = cvt_pk_bf16(da[0] * rs * bflo(gw.x), da[1] * rs * bfhi(gw.x)); r.y = cvt_pk_bf16(da[2] * rs * bflo(gw.y), da[3] * rs * bfhi(gw.y));
        r.z = cvt_pk_bf16(db[0] * rs * bflo(gw.z), db[1] * rs * bfhi(gw.z)); r.w = cvt_pk_bf16(db[2] * rs * bflo(gw.w), db[3] * rs * bfhi(gw.w));
        *(u32x4*)(OG + o) = r;
    }
}

__global__ void __launch_bounds__(NT) hybrid_fwd(Params P) {
    extern __shared__ __attribute__((aligned(16))) unsigned char lds_raw[];
    LAS unsigned char* lds = (LAS unsigned char*)lds_raw;
    cg::grid_group grid = cg::this_grid();
    const int G = gridDim.x, tid = threadIdx.x;
    unsigned char* ws = P.ws;
    bf16_t* WT_IN_ATTN = (bf16_t*)(ws + WS_WT_IN_ATTN); bf16_t* WT_OUT_ATTN = (bf16_t*)(ws + WS_WT_OUT_ATTN); bf16_t* WT_IN_RET = (bf16_t*)(ws + WS_WT_IN_RET); bf16_t* WT_OUT_RET = (bf16_t*)(ws + WS_WT_OUT_RET);
    bf16_t* WT_GATE = (bf16_t*)(ws + WS_WT_GATE); bf16_t* WT_PLE = (bf16_t*)(ws + WS_WT_PLE);
    float* TABA = (float*)(ws + WS_TABA); float* TABR = (float*)(ws + WS_TABR);
    bf16_t* H = (bf16_t*)(ws + WS_H); bf16_t* PB = (bf16_t*)(ws + WS_PB);
    bf16_t* PLE = (bf16_t*)(ws + WS_PLE); bf16_t* Y = (bf16_t*)(ws + WS_Y); bf16_t* X2 = (bf16_t*)(ws + WS_X2);
    bf16_t* OG = (bf16_t*)(ws + WS_OG); bf16_t* ZQ = (bf16_t*)(ws + WS_ZQ); bf16_t* ZK = (bf16_t*)(ws + WS_ZK); bf16_t* ZG = (bf16_t*)(ws + WS_ZG);
    bf16_t* VTP = (bf16_t*)(ws + WS_VTP); bf16_t* VTS = (bf16_t*)(ws + WS_VTS); bf16_t* ABUF = (bf16_t*)(ws + WS_ABUF); bf16_t* KDT = (bf16_t*)(ws + WS_KDT); bf16_t* ORET = (bf16_t*)(ws + WS_ORET);
    bf16_t* SC = (bf16_t*)(ws + WS_Y);
    pg8::StaticOrder SO;
    volatile LAS unsigned* bst = (volatile LAS unsigned*)(lds + LDS_BYTES - 16);
    if (tid < 4) bst[tid] = 0u;
    __syncthreads();
    const XcdBarrier xbar = xcd_barrier_post((unsigned*)(ws + WS_BAR), bst);
#define GSYNC() xcd_barrier(xbar)

for (int rep_ = 0; rep_ < REP_P0; ++rep_) {
    {
        LAS float* T = (LAS float*)lds;
        const int ttid = otid(), nn = ttid & 63, kq = ttid >> 6, kk2 = (ttid & 31) * 2, nq = ttid >> 5;
#define TILE_DESC(t_, W_, Wt_, K_, N_, perm_, tl_) do { \
        if ((t_) < 640) { W_ = P.w_in_attn; Wt_ = WT_IN_ATTN; K_ = 1024; N_ = 2560; perm_ = true; tl_ = (t_); } \
        else if ((t_) < 896) { W_ = P.w_out_attn; Wt_ = WT_OUT_ATTN; K_ = 1024; N_ = 1024; perm_ = false; tl_ = (t_) - 640; } \
        else if ((t_) < 2432) { W_ = P.w_in_ret; Wt_ = WT_IN_RET; K_ = 1024; N_ = 6144; perm_ = false; tl_ = (t_) - 896; } \
        else if ((t_) < 2944) { W_ = P.w_out_ret; Wt_ = WT_OUT_RET; K_ = 2048; N_ = 1024; perm_ = false; tl_ = (t_) - 2432; } \
        else if ((t_) < 3200) { W_ = P.w_gate; Wt_ = WT_GATE; K_ = 1024; N_ = 1024; perm_ = false; tl_ = (t_) - 2944; } \
        else if ((t_) < 3456) { W_ = P.w_gate + 1024 * 1024; Wt_ = WT_GATE + 1024 * 1024; K_ = 1024; N_ = 1024; perm_ = false; tl_ = (t_) - 3200; } \
        else if ((t_) < 3520) { W_ = P.w_ple; Wt_ = WT_PLE; K_ = 256; N_ = 1024; perm_ = false; tl_ = (t_) - 3456; } \
        else { W_ = P.w_ple + 256 * 1024; Wt_ = WT_PLE + 1024 * 256; K_ = 256; N_ = 1024; perm_ = false; tl_ = (t_) - 3520; } } while (0)
#define TILE_LOAD(W_, N_, perm_, tl_, r_) do { const int ntn_ = (N_) >> 6, n0_ = ((tl_) % ntn_) * 64, k0_ = ((tl_) / ntn_) * 64, nd_ = n0_ + nn; int ns_ = nd_; \
        if ((perm_) && nd_ < 1280) { const int p_ = nd_ & 63; ns_ = (nd_ - p_) + (p_ >> 5) * 16 + (p_ & 15) + ((p_ >> 4) & 1) * 32; } \
        _Pragma("unroll") for (int i_ = 0; i_ < 8; ++i_) r_[i_] = (W_)[(size_t)(k0_ + kq + 8 * i_) * (N_) + ns_]; } while (0)
        float r[8];
        const float* Wc; bf16_t* Wtc; int Kc, Nc, tlc; bool pc;
        const bool defer = (G == 256);
        const int ntile = defer ? 2816 : 3584;
#define TMAP(i_) (!defer ? (i_) : ((i_) < 2432 ? (i_) : ((i_) < 2688 ? 2944 + ((i_) - 2432) : 3456 + ((i_) - 2688))))
        int t = blockIdx.x;
        if (t < ntile) { const int tm = TMAP(t); TILE_DESC(tm, Wc, Wtc, Kc, Nc, pc, tlc); TILE_LOAD(Wc, Nc, pc, tlc, r); }
        for (; t < ntile; t += G) {
            __syncthreads();
#pragma unroll
            for (int i = 0; i < 8; ++i) T[(kq + 8 * i) * 65 + nn] = r[i];
            __syncthreads();
            const int ntn = Nc >> 6, n0 = (tlc % ntn) * 64, k0 = (tlc / ntn) * 64; bf16_t* Wto = Wtc; const int Ko = Kc;
            if (t + G < ntile) { const int tm = TMAP(t + G); TILE_DESC(tm, Wc, Wtc, Kc, Nc, pc, tlc); TILE_LOAD(Wc, Nc, pc, tlc, r); }
#pragma unroll
            for (int i = 0; i < 4; ++i) { const int n2 = nq + 16 * i; *(unsigned*)(Wto + (size_t)(n0 + n2) * Ko + k0 + kk2) = cvt_pk_bf16(T[kk2 * 65 + n2], T[(kk2 + 1) * 65 + n2]); }
        }
        __syncthreads();
#undef TILE_DESC
#undef TILE_LOAD
#undef TMAP
    }
    for (int e = blockIdx.x * NT + tid; e < 4104 * 160; e += G * NT) {
        const int pi = e / 160, f = e % 160; const int pos = pi < 4096 ? pi : 16384 + (pi - 4096);
        if (f < 32) { const float inv = powf(10000.f, -(float)f / 32.f), ang = (float)pos * inv; float cv, sv; cos_sin(ang, cv, sv); TABA[((size_t)pi * 32 + f) * 2] = cv; TABA[((size_t)pi * 32 + f) * 2 + 1] = sv; }
        else { const int f2 = f - 32; const float inv = powf(10000.f, -(float)f2 / 128.f), ang = (float)pos * inv; float cv, sv; cos_sin(ang, cv, sv); TABR[((size_t)pi * 128 + f2) * 2] = cv; TABR[((size_t)pi * 128 + f2) * 2 + 1] = sv; }
    }
    for (int e = blockIdx.x * NT + tid; e < 2 * MT * 64; e += G * NT) {
        const int i = e / (MT * 64), rem = e % (MT * 64), row = rem >> 6, c4 = (rem & 63) * 4;
        const float* src = row < MP ? P.p_prompt + ((size_t)i * MP + row) * 256 + c4 : P.p_sample + ((size_t)i * MS + row - MP) * 256 + c4;
        *(u32x2*)(PB + ((size_t)i * MT + row) * 256 + c4) = pk4(*(const f32x4*)src);
    }
    rms_rows(P.x_prompt, P.x_sample, P.pre_norm, H, G);
}
    if (P.ws == nullptr) grid.sync();
    GSYNC();

for (int rep_ = 0; rep_ < REP_GIN; ++rep_) {
    { pg8::Gemm g{H, WT_IN_ATTN, MT, 2560, 1024}; SO.init(MT, 2560, G, blockIdx.x);
      EpiInAttn E{ZQ, ZK, ZG, VTP, VTS, TABA, P.out}; pg8::gemm_phase(lds, g, SO, E); }
    { pg8::Gemm g{PB, WT_PLE, MP, 1024, 256}; EpiB16 E{PLE, 1024};
      if (G == 256) { pg8::TailOrder TO; TO.init(MP, 680 - 512, G, blockIdx.x); pg8::gemm_phase(lds, g, TO, E); }
      else { SO.init(MP, 1024, G, blockIdx.x); pg8::gemm_phase(lds, g, SO, E); }
      skinny_gemm(lds, PB + (size_t)MP * 256, WT_PLE, 256, SkB16{PLE + (size_t)MP * 1024}, G); }
}
    GSYNC();

for (int rep_ = 0; rep_ < REP_ATT; ++rep_) {
    attn_prompt(lds, ZQ, ZK, ZG, VTP, P.sinks, OG, G);
    attn_sample(lds, P, ZQ, ZK, ZG, VTS, OG, G);
}
    GSYNC();

for (int rep_ = 0; rep_ < REP_GN1; ++rep_) {
    { pg8::Gemm g{OG, WT_OUT_ATTN, MP, 1024, 1024}; SO.init(MP, 1024, G, blockIdx.x); EpiB16 E{Y, 1024}; pg8::gemm_phase(lds, g, SO, E);
      skinny_gemm(lds, OG + (size_t)MP * 1024, WT_OUT_ATTN, 1024, SkB16{Y + (size_t)MP * 1024}, G); }
}
    GSYNC();
for (int rep_ = 0; rep_ < REP_ROW; ++rep_) {
    resid_rows<false>(P.x_prompt, P.x_sample, nullptr, Y, P.post_norm, H, G);
}
    GSYNC();
for (int rep_ = 0; rep_ < REP_GN1; ++rep_) {
    { pg8::Gemm g{H, WT_GATE, MP, 1024, 1024}; SO.init(MP, 1024, G, blockIdx.x); EpiGate<true> E{H, PLE, nullptr, X2}; pg8::gemm_phase(lds, g, SO, E);
      skinny_gemm(lds, H + (size_t)MP * 1024, WT_GATE, 1024, SkGate<true>{H + (size_t)MP * 1024, PLE + (size_t)MP * 1024, nullptr, X2 + (size_t)MP * 1024}, G); }
}
    GSYNC();
for (int rep_ = 0; rep_ < REP_ROW; ++rep_) {
    rms_rows_b16(X2, P.pre_norm + 1024, H, G);
}
    GSYNC();
for (int rep_ = 0; rep_ < REP_GIN; ++rep_) {
    { pg8::Gemm g{H, WT_IN_RET, MT, 6144, 1024}; SO.init(MT, 6144, G, blockIdx.x);
      EpiInRet E{ZQ, ZK, ZG, VTP, VTS, TABR}; pg8::gemm_phase(lds, g, SO, E); }
    { pg8::Gemm g{PB + (size_t)MT * 256, WT_PLE + 1024 * 256, MP, 1024, 256}; EpiB16 E{PLE, 1024};
      if (G == 256) { pg8::TailOrder TO; TO.init(MP, 1632 - 6 * 256, G, blockIdx.x); pg8::gemm_phase(lds, g, TO, E); }
      else { SO.init(MP, 1024, G, blockIdx.x); pg8::gemm_phase(lds, g, SO, E); }
      skinny_gemm(lds, PB + (size_t)MT * 256 + (size_t)MP * 256, WT_PLE + 1024 * 256, 256, SkB16{PLE + (size_t)MP * 1024}, G); }
    if (G == 256 && blockIdx.x >= 96) {
        __syncthreads();
        for (int j = blockIdx.x - 96; j < 768; j += 160) {
            if (j < 512) transpose_tile(P.w_out_ret, WT_OUT_RET, 2048, 1024, false, j, (LAS float*)lds);
            else transpose_tile(P.w_gate + 1024 * 1024, WT_GATE + 1024 * 1024, 1024, 1024, false, j - 512, (LAS float*)lds);
        }
    }
}
    GSYNC();
for (int rep_ = 0; rep_ < REP_RA; ++rep_) {
    ret_A(lds, ZQ, ZK, ABUF, KDT, G);
}
    GSYNC();
    { unsigned* ctr = (unsigned*)(ws + WS_BAR + 14336);
      if (blockIdx.x < 128) for (int u = blockIdx.x; u < 128; u += G) ret_seq_unit(lds, u, ZQ, VTP, ABUF, KDT, ORET, P.out);
      ret_sample(lds, P, ZQ, ZK, VTS, ORET, ctr, nullptr, 0u); }
for (int rep_ = 0; rep_ < REP_SYNC; ++rep_) GSYNC();
    GSYNC();
for (int rep_ = 0; rep_ < REP_ROW; ++rep_) {
    ret_gnorm(ORET, ZG, OG, G);
}
    GSYNC();
for (int rep_ = 0; rep_ < REP_GN1; ++rep_) {
    { pg8::Gemm g{OG, WT_OUT_RET, MP, 1024, 2048}; SO.init(MP, 1024, G, blockIdx.x); EpiB16 E{Y, 1024}; pg8::gemm_phase(lds, g, SO, E);
      skinny_gemm(lds, OG + (size_t)MP * 2048, WT_OUT_RET, 2048, SkB16{Y + (size_t)MP * 1024}, G); }
}
    GSYNC();
for (int rep_ = 0; rep_ < REP_ROW; ++rep_) {
    resid_rows<true>(nullptr, nullptr, X2, Y, P.post_norm + 1024, H, G);
}
    GSYNC();
for (int rep_ = 0; rep_ < REP_GN1; ++rep_) {
    { pg8::Gemm g{H, WT_GATE + 1024 * 1024, MP, 1024, 1024}; SO.init(MP, 1024, G, blockIdx.x); EpiGate<false> E{H, PLE, P.out, nullptr}; pg8::gemm_phase(lds, g, SO, E);
      skinny_gemm(lds, H + (size_t)MP * 1024, WT_GATE + 1024 * 1024, 1024, SkGate<false>{H + (size_t)MP * 1024, PLE + (size_t)MP * 1024, P.out + (size_t)MP * 1024, nullptr}, G); }
}
}

extern "C" void kernel_launch(void* const* d_in, const int* in_sizes, int n_in, void* d_out, int out_size, void* d_ws, size_t ws_size, hipStream_t stream) {
    static int grid_blocks = 0;
    if (!grid_blocks) {
        int dev = 0, cus = 0, per_cu = 0;
        hipGetDevice(&dev);
        hipDeviceGetAttribute(&cus, hipDeviceAttributeMultiprocessorCount, dev);
        hipFuncSetAttribute((const void*)hybrid_fwd, hipFuncAttributeMaxDynamicSharedMemorySize, LDS_BYTES);
        hipOccupancyMaxActiveBlocksPerMultiprocessor(&per_cu, (const void*)hybrid_fwd, NT, LDS_BYTES);
        if (per_cu < 1) per_cu = 1;
        if (per_cu > 1) per_cu = 1;
        grid_blocks = cus * per_cu;
        if (ws_size < WS_END) fprintf(stderr, "kernel_launch: workspace too small: %zu < %zu\n", ws_size, (size_t)WS_END);
    }
    Params p{};
    p.x_prompt = (const float*)d_in[0]; p.x_sample = (const float*)d_in[1]; p.cache_k = (const float*)d_in[2]; p.cache_v = (const float*)d_in[3]; p.state_ret = (const float*)d_in[4];
    p.p_prompt = (const float*)d_in[5]; p.p_sample = (const float*)d_in[6]; p.pre_norm = (const float*)d_in[7]; p.post_norm = (const float*)d_in[8]; p.w_in_attn = (const float*)d_in[9];
    p.sinks = (const float*)d_in[10]; p.w_out_attn = (const float*)d_in[11]; p.w_in_ret = (const float*)d_in[12]; p.w_out_ret = (const float*)d_in[13]; p.w_ple = (const float*)d_in[14]; p.w_gate = (const float*)d_in[15];
    p.out = (float*)d_out; p.ws = (unsigned char*)d_ws;
    (void)hipMemsetAsync((unsigned char*)d_ws + WS_BAR, 0, 16384, stream);
    void* args[] = {&p};
    hipError_t e = hipLaunchCooperativeKernel((const void*)hybrid_fwd, dim3(grid_blocks), dim3(NT), args, LDS_BYTES, stream);
    if (e != hipSuccess) fprintf(stderr, "cooperative launch failed: %s (grid %d)\n", hipGetErrorString(e), grid_blocks);
}
```
